# Optimizing an MI355X kernel written in HIP

```python
import math, functools
import jax, jax.numpy as jnp
from jax import lax
import numpy as np

D_MODEL = 1024
BATCH = 4
SEQ = 8192
DEPTH = 2

GRID_W = 64
CTX_LEN = 256
EPS = 1e-6

DN_HEADS = 4
DN_DK = 128
DN_DV = 128
DN_CHUNK = 64
DN_CONV_W = 3
QK_W = DN_HEADS * DN_DK
V_W = DN_HEADS * DN_DV
QKV_W = 2 * QK_W + V_W
POOL_WINDOWS = (2, 4, 8, 16)
POOL_GROUP = D_MODEL // 8
POOL_WIDTH = len(POOL_WINDOWS) * POOL_GROUP
MIX_WIDTH = V_W + POOL_WIDTH
EVEN_IN = QKV_W + V_W + 4 * DN_HEADS + POOL_WIDTH
SC_CONV_W = 3
N_EXPERTS = 16
D_EXPERT = D_MODEL // 2
EC_CAPACITY_FACTOR = 2

N_EVEN = (DEPTH + 1) // 2
N_ODD = DEPTH // 2

kernel_name = "hybrid_dit_deltanet_pool_shortconv_ecmoe"


def rms_norm(x, g):
    xf = x.astype(jnp.float32)
    y = xf * lax.rsqrt(jnp.mean(xf * xf, axis=-1, keepdims=True) + EPS)
    return (y * g.astype(jnp.float32)).astype(x.dtype)


def modulate(h, shift, scale):
    return h * (1 + scale[:, None]) + shift[:, None]


def dw_conv(x, w):
    k = w.shape[0]
    pad_l = (k - 1) // 2
    return lax.conv_general_dilated(
        x, w[:, None, :].astype(x.dtype), window_strides=(1,), padding=[(pad_l, k - 1 - pad_l)],
        dimension_numbers=('NWC', 'WIO', 'NWC'), feature_group_count=x.shape[-1])


def l2norm(t):
    return t * lax.rsqrt(jnp.sum(t * t, axis=-1, keepdims=True) + EPS)


def to_heads(t, d):
    b, L, _ = t.shape
    return t.reshape(b, L, DN_HEADS, d).transpose(0, 2, 1, 3)


def gated_delta_chunked(q, k, v, beta, log_decay, s0):
    b, h, L, dk = k.shape
    dv = v.shape[-1]
    c = DN_CHUNK
    n = L // c
    k = k.reshape(b, h, n, c, dk)
    v = v.reshape(b, h, n, c, dv)
    beta = beta.reshape(b, h, n, c)
    gam = jnp.cumsum(log_decay.reshape(b, h, n, c), axis=-1)
    incl = jnp.tril(jnp.ones((c, c), dtype=bool))
    strict = jnp.tril(jnp.ones((c, c), dtype=bool), k=-1)
    diff = gam[..., :, None] - gam[..., None, :]
    decay = jnp.where(incl, jnp.exp(jnp.where(incl, diff, 0.0)), 0.0)
    kk = jnp.einsum('bhnid,bhnjd->bhnij', k, k)
    t_mat = jnp.eye(c, dtype=jnp.float32) + jnp.where(strict, kk * decay, 0.0) * beta[..., :, None]
    solve = functools.partial(lax.linalg.triangular_solve, left_side=True, lower=True, unit_diagonal=True)
    u = solve(t_mat, v * beta[..., None])
    wk = solve(t_mat, k * (beta * jnp.exp(gam))[..., None])
    k_dec = k * jnp.exp(gam[..., -1:] - gam)[..., None]
    chunk_decay = jnp.exp(gam[..., -1])[..., None, None]
    to_scan = lambda t: jnp.moveaxis(t, 2, 0)

    def advance(s, u_c, wk_c, kd_c, cd_c):
        w = u_c - jnp.einsum('bhck,bhkv->bhcv', wk_c, s)
        return w, cd_c * s + jnp.einsum('bhck,bhcv->bhkv', kd_c, w)

    if q is None:
        def step_state(s, inp):
            _, s_new = advance(s, *inp)
            return s_new, None
        s_fin, _ = lax.scan(step_state, s0, tuple(map(to_scan, (u, wk, k_dec, chunk_decay))))
        return None, s_fin

    q = q.reshape(b, h, n, c, dk)
    qk = jnp.einsum('bhnid,bhnjd->bhnij', q, k) * decay
    q_dec = q * jnp.exp(gam)[..., None]

    def step(s, inp):
        u_c, wk_c, kd_c, cd_c, qk_c, qd_c = inp
        w, s_new = advance(s, u_c, wk_c, kd_c, cd_c)
        o = jnp.einsum('bhck,bhkv->bhcv', qd_c, s) + jnp.einsum('bhij,bhjv->bhiv', qk_c, w)
        return s_new, o

    s_fin, o = lax.scan(step, s0, tuple(map(to_scan, (u, wk, k_dec, chunk_decay, qk, q_dec))))
    return jnp.moveaxis(o, 0, 2).reshape(b, h, L, dv), s_fin


def even_project(h, w_in, conv_w, a_log, dt_bias):
    proj = h @ w_in
    qkv, z, gates, pool_in = jnp.split(proj, [QKV_W, QKV_W + V_W, QKV_W + V_W + 4 * DN_HEADS], axis=-1)
    qkv = jax.nn.silu(dw_conv(qkv, conv_w)).astype(jnp.float32)
    q, k, v = jnp.split(qkv, [QK_W, 2 * QK_W], axis=-1)
    q = l2norm(to_heads(q, DN_DK)) * DN_DK ** -0.5
    k = l2norm(to_heads(k, DN_DK))
    v = to_heads(v, DN_DV)
    b, L, _ = gates.shape
    gates = gates.astype(jnp.float32).reshape(b, L, 4, DN_HEADS).transpose(2, 0, 3, 1)
    beta = jax.nn.sigmoid(gates[:2])
    a_log = a_log.astype(jnp.float32)[:, None, :, None]
    dt_bias = dt_bias.astype(jnp.float32)[:, None, :, None]
    log_decay = -jnp.exp(a_log) * jax.nn.softplus(gates[2:] + dt_bias)
    return q, k, v, z, beta, log_decay, pool_in


def centred_mean(u, n_seg, seg_len, w):
    b, L, ch = u.shape
    us = u.astype(jnp.float32).reshape(b, n_seg, seg_len, ch)
    cs = jnp.concatenate([jnp.zeros_like(us[:, :, :1]), jnp.cumsum(us, axis=2)], axis=2)
    t = jnp.arange(seg_len)
    lo = jnp.clip(t - w // 2, 0, seg_len)
    hi = jnp.clip(t + w - w // 2, 0, seg_len)
    cnt = (hi - lo).astype(jnp.float32)[:, None]
    return ((cs[:, :, hi] - cs[:, :, lo]) / cnt).reshape(b, L, ch).astype(u.dtype)


def even_output(o, z, pool_in, o_norm, pool_w, pool_scale, w_out, n_seg, seg_len):
    b, _, L, _ = o.shape
    o = o.transpose(0, 2, 1, 3)
    zh = z.reshape(b, L, DN_HEADS, DN_DV).astype(jnp.float32)
    o = (rms_norm(o, o_norm) * jax.nn.silu(zh)).reshape(b, L, V_W).astype(z.dtype)
    groups = jnp.stack([centred_mean(pg, n_seg, seg_len, w) - pg
                        for pg, w in zip(jnp.split(pool_in, len(POOL_WINDOWS), axis=-1), POOL_WINDOWS)], axis=2)
    pooled = jnp.einsum('blgc,gcd->blgd', groups, pool_w).reshape(b, L, POOL_WIDTH) * pool_scale
    return jnp.concatenate([o, pooled], axis=-1) @ w_out


def even_mixer(hl, hc, w_in, conv_w, a_log, dt_bias, o_norm, pool_w, pool_scale, w_out, rows, ctx_out):
    ql, kl, vl, zl, betal, gl, pl = even_project(hl, w_in, conv_w, a_log, dt_bias)
    qc, kc, vc, zc, betac, gc, pc = even_project(hc, w_in, conv_w, a_log, dt_bias)
    flip = lambda t: jnp.flip(t, axis=2)
    s0 = jnp.zeros((hl.shape[0], DN_HEADS, DN_DK, DN_DV), jnp.float32)
    oc_f, sc_f = gated_delta_chunked(qc if ctx_out else None, kc, vc, betac[0], gc[0], s0)
    oc_b, sc_b = gated_delta_chunked(flip(qc) if ctx_out else None, flip(kc), flip(vc), flip(betac[1]), flip(gc[1]), s0)
    ol_f, _ = gated_delta_chunked(ql, kl, vl, betal[0], gl[0], sc_f)
    ol_b, _ = gated_delta_chunked(flip(ql), flip(kl), flip(vl), flip(betal[1]), flip(gl[1]), sc_b)
    y_lat = even_output(ol_f + flip(ol_b), zl, pl, o_norm, pool_w, pool_scale, w_out, rows, GRID_W)
    if not ctx_out:
        return y_lat, None
    y_ctx = even_output(oc_f + flip(oc_b), zc, pc, o_norm, pool_w, pool_scale, w_out, 1, hc.shape[1])
    return y_lat, y_ctx


def short_conv_mixer(h, w_in, conv_w, w_out):
    gb, gc, xin = jnp.split(h @ w_in, 3, axis=-1)
    return (gb * dw_conv(gc * xin, conv_w)) @ w_out


def expert_choice_ffn(h, router, w_gate, w_up, w_down):
    b, n, _ = h.shape
    cap = EC_CAPACITY_FACTOR * n // N_EXPERTS
    aff = jax.nn.softmax(jnp.einsum('bnd,de->bne', h, router).astype(jnp.float32), axis=-1)
    gate, idx = lax.top_k(aff.transpose(0, 2, 1), cap)
    bidx = jnp.arange(b)[:, None, None]
    xg = h[bidx, idx]
    hid = jax.nn.silu(jnp.einsum('becd,edf->becf', xg, w_gate)) * jnp.einsum('becd,edf->becf', xg, w_up)
    y = jnp.einsum('becf,efd->becd', hid, w_down) * gate[..., None].astype(h.dtype)
    return jnp.zeros_like(h).at[bidx, idx].add(y)


def setup_inputs(seed: int = 0) -> dict:
    key = jax.random.key(seed)
    ks = jax.random.split(key, 24)
    f32 = jnp.float32
    D = D_MODEL
    nrm = lambda k, shape, s: jax.random.normal(k, shape, f32) * s
    dt = jnp.exp(jax.random.uniform(ks[10], (N_EVEN, 2, DN_HEADS), f32, math.log(1e-3), math.log(1e-1)))
    return {
        "x": nrm(ks[0], (BATCH, SEQ, D), 1.0),
        "c": nrm(ks[1], (BATCH, D), 1.0),
        "ctx": nrm(ks[2], (BATCH, CTX_LEN, D), 1.0),
        "c_ctx": nrm(ks[3], (D,), 1.0),
        "ada_w": nrm(ks[4], (DEPTH, D, 6 * D), 0.5 * D ** -0.5),
        "ada_b": nrm(ks[5], (DEPTH, 6 * D), 0.02),
        "norm_mix": 1.0 + nrm(ks[6], (DEPTH, D), 0.02),
        "norm_ffn": 1.0 + nrm(ks[7], (DEPTH, D), 0.02),
        "norm_final": 1.0 + nrm(ks[8], (D,), 0.02),
        "ev_w_in": nrm(ks[9], (N_EVEN, D, EVEN_IN), D ** -0.5),
        "dn_conv": nrm(ks[11], (N_EVEN, DN_CONV_W, QKV_W), DN_CONV_W ** -0.5),
        "dn_a_log": jnp.log(jax.random.uniform(ks[12], (N_EVEN, 2, DN_HEADS), f32, 1.0, 16.0)),
        "dn_dt_bias": dt + jnp.log(-jnp.expm1(-dt)),
        "dn_norm": 1.0 + nrm(ks[13], (N_EVEN, DN_DV), 0.02),
        "pool_w": nrm(ks[14], (N_EVEN, len(POOL_WINDOWS), POOL_GROUP, POOL_GROUP), POOL_GROUP ** -0.5),
        "pool_scale": 1.0 + nrm(ks[15], (N_EVEN, POOL_WIDTH), 0.1),
        "ev_w_out": nrm(ks[16], (N_EVEN, MIX_WIDTH, D), MIX_WIDTH ** -0.5),
        "sc_w_in": nrm(ks[17], (N_ODD, D, 3 * D), D ** -0.5),
        "sc_conv": nrm(ks[18], (N_ODD, SC_CONV_W, D), SC_CONV_W ** -0.5),
        "sc_w_out": nrm(ks[19], (N_ODD, D, D), D ** -0.5),
        "router": nrm(ks[20], (DEPTH, D, N_EXPERTS), D ** -0.5),
        "w_gate": nrm(ks[21], (DEPTH, N_EXPERTS, D, D_EXPERT), D ** -0.5),
        "w_up": nrm(ks[22], (DEPTH, N_EXPERTS, D, D_EXPERT), D ** -0.5),
        "w_down": nrm(ks[23], (DEPTH, N_EXPERTS, D_EXPERT, D), D_EXPERT ** -0.5),
    }


def reference(x, c, ctx, c_ctx, ada_w, ada_b, norm_mix, norm_ffn, norm_final,
              ev_w_in, dn_conv, dn_a_log, dn_dt_bias, dn_norm, pool_w, pool_scale, ev_w_out,
              sc_w_in, sc_conv, sc_w_out, router, w_gate, w_up, w_down):
    rows = x.shape[1] // GRID_W
    xl, xc = x, ctx
    for i in range(DEPTH):
        j = i // 2
        ctx_read = i % 2 == 0
        ctx_live = any(l % 2 == 0 for l in range(i + 1, DEPTH))
        sh1_l, sc1_l, g1_l, sh2_l, sc2_l, g2_l = jnp.split(jax.nn.silu(c) @ ada_w[i] + ada_b[i], 6, axis=-1)
        hl = modulate(rms_norm(xl, norm_mix[i]), sh1_l, sc1_l)
        yc = None
        if ctx_read or ctx_live:
            sh1_c, sc1_c, g1_c, sh2_c, sc2_c, g2_c = jnp.split((jax.nn.silu(c_ctx) @ ada_w[i] + ada_b[i])[None], 6, axis=-1)
            hc = modulate(rms_norm(xc, norm_mix[i]), sh1_c, sc1_c)
        if ctx_read:
            yl, yc = even_mixer(hl, hc, ev_w_in[j], dn_conv[j], dn_a_log[j], dn_dt_bias[j], dn_norm[j],
                                pool_w[j], pool_scale[j], ev_w_out[j], rows, ctx_live)
        else:
            yl = short_conv_mixer(hl, sc_w_in[j], sc_conv[j], sc_w_out[j])
            if ctx_live:
                yc = short_conv_mixer(hc, sc_w_in[j], sc_conv[j], sc_w_out[j])
        xl = xl + g1_l[:, None] * yl
        hl2 = modulate(rms_norm(xl, norm_ffn[i]), sh2_l, sc2_l)
        xl = xl + g2_l[:, None] * expert_choice_ffn(hl2, router[i], w_gate[i], w_up[i], w_down[i])
        if ctx_live:
            xc = xc + g1_c[:, None] * yc
            hc2 = modulate(rms_norm(xc, norm_ffn[i]), sh2_c, sc2_c)
            xc = xc + g2_c[:, None] * expert_choice_ffn(hc2, router[i], w_gate[i], w_up[i], w_down[i])
    return rms_norm(xl, norm_final)
```

```cpp
#include <hip/hip_runtime.h>
#include <cstdio>
#include <cstdint>

namespace {
constexpr int D = 1024, BATCH = 4, SEQ = 8192, CTX = 256, NH = 4, DK = 128, DV = 128;
constexpr int EVEN_IN = 2576, NE = 16, DE = 512, CAP = 1024;
constexpr float EPS = 1e-6f;

__device__ __forceinline__ float silu_f(float x) { return x / (1.f + __expf(-x)); }
__device__ __forceinline__ float sigmoid_f(float x) { return 1.f / (1.f + __expf(-x)); }
__device__ __forceinline__ float softplus_f(float x) { return x > 20.f ? x : log1pf(__expf(x)); }
__device__ __forceinline__ float wave_sum(float v) {
#pragma unroll
    for (int o = 1; o < 64; o <<= 1) v += __shfl_xor(v, o);
    return v;
}

__global__ void k_ada(const float* c, const float* c_ctx, const float* ada_w, const float* ada_b, float* out) {
    const int n = blockIdx.x * 256 + threadIdx.x, r = blockIdx.y, l = blockIdx.z;
    const float* vec = r < 4 ? c + r * D : c_ctx;
    const float* w = ada_w + (size_t)l * D * 6 * D;
    float acc = 0.f;
    for (int k = 0; k < D; ++k) acc += silu_f(vec[k]) * w[(size_t)k * 6 * D + n];
    out[((size_t)l * 5 + r) * 6 * D + n] = acc + ada_b[l * 6 * D + n];
}

__global__ void k_norm_mod(const float* x, float* out, const float* gw, const float* shift, const float* scale, int rows) {
    const int lane = threadIdx.x & 63, wv = (blockIdx.x * blockDim.x + threadIdx.x) >> 6, nw = (gridDim.x * blockDim.x) >> 6;
    for (int r = wv; r < rows; r += nw) {
        const float* xr = x + (size_t)r * D;
        float v[16]; float s = 0.f;
#pragma unroll
        for (int j = 0; j < 16; ++j) { v[j] = xr[lane + 64 * j]; s += v[j] * v[j]; }
        const float rs = rsqrtf(wave_sum(s) * (1.f / D) + EPS);
#pragma unroll
        for (int j = 0; j < 16; ++j) { const int n = lane + 64 * j; float y = v[j] * rs * gw[n];
            if (shift) y = y * (1.f + scale[n]) + shift[n];
            out[(size_t)r * D + n] = y; }
    }
}

struct GemmArgs { const float* A; const float* B; float* C; const int* idx; const float* colscale; long sA, sB, sC; int M, N, K, lda, ldb, ldc, sIdx, sScale; };
__global__ void __launch_bounds__(256) k_gemm(GemmArgs g) {
    __shared__ float As[16][68];
    __shared__ float Bs[16][68];
    const int z = blockIdx.z;
    const float* A = g.A + z * g.sA; const float* B = g.B + z * g.sB; float* C = g.C + z * g.sC;
    const int* idx = g.idx ? g.idx + z * g.sIdx : nullptr;
    const int tid = threadIdx.x, tx = tid & 15, ty = tid >> 4;
    const int m0 = blockIdx.y * 64, n0 = blockIdx.x * 64;
    const int ar = tid >> 2, ak = (tid & 3) * 4;
    const int arow = idx ? idx[m0 + ar] : (m0 + ar);
    const float* ap = A + (size_t)arow * g.lda + ak;
    const int bk = tid >> 4, bn = (tid & 15) * 4;
    const bool bok = (n0 + bn) < g.N;
    const float* bp = B + (size_t)bk * g.ldb + n0 + bn;
    float acc[4][4] = {};
    for (int k0 = 0; k0 < g.K; k0 += 16) {
        const float4 av = *(const float4*)(ap + k0);
        float4 bv = make_float4(0.f, 0.f, 0.f, 0.f);
        if (bok) bv = *(const float4*)(bp + (size_t)k0 * g.ldb);
        As[ak + 0][ar] = av.x; As[ak + 1][ar] = av.y; As[ak + 2][ar] = av.z; As[ak + 3][ar] = av.w;
        *(float4*)&Bs[bk][bn] = bv;
        __syncthreads();
#pragma unroll
        for (int k = 0; k < 16; ++k) {
            const float4 a4 = *(const float4*)&As[k][ty * 4];
            const float4 b4 = *(const float4*)&Bs[k][tx * 4];
            const float a[4] = {a4.x, a4.y, a4.z, a4.w}, b[4] = {b4.x, b4.y, b4.z, b4.w};
#pragma unroll
            for (int i = 0; i < 4; ++i)
#pragma unroll
                for (int j = 0; j < 4; ++j) acc[i][j] += a[i] * b[j];
        }
        __syncthreads();
    }
    const float* cs = g.colscale ? g.colscale + z * g.sScale : nullptr;
#pragma unroll
    for (int i = 0; i < 4; ++i)
#pragma unroll
        for (int j = 0; j < 4; ++j) { const int n = n0 + tx * 4 + j; if (n < g.N) C[(size_t)(m0 + ty * 4 + i) * g.ldc + n] = acc[i][j] * (cs ? cs[n] : 1.f); }
}

__global__ void k_conv_qkv(const float* proj, int ldp, int L, const float* cw  , float* q, float* k, float* v) {
    const int lane = threadIdx.x & 63, wv = (blockIdx.x * blockDim.x + threadIdx.x) >> 6, nw = (gridDim.x * blockDim.x) >> 6;
    for (int it = wv; it < L * NH; it += nw) {
        const int t = it / NH, h = it % NH;
        float o[3][2];
#pragma unroll
        for (int w = 0; w < 3; ++w)
#pragma unroll
            for (int j = 0; j < 2; ++j) {
                const int col = w * 512 + h * 128 + lane + 64 * j;
                float a = cw[1536 + col] * proj[(size_t)t * ldp + col];
                if (t > 0) a += cw[col] * proj[(size_t)(t - 1) * ldp + col];
                if (t < L - 1) a += cw[2 * 1536 + col] * proj[(size_t)(t + 1) * ldp + col];
                o[w][j] = silu_f(a);
            }
        const float sq = wave_sum(o[0][0] * o[0][0] + o[0][1] * o[0][1]);
        const float sk = wave_sum(o[1][0] * o[1][0] + o[1][1] * o[1][1]);
        const float rq = rsqrtf(sq + EPS) * 0.08838834764831845f, rk = rsqrtf(sk + EPS);
#pragma unroll
        for (int j = 0; j < 2; ++j) {
            const size_t off = (size_t)t * 512 + h * 128 + lane + 64 * j;
            q[off] = o[0][j] * rq; k[off] = o[1][j] * rk; v[off] = o[2][j];
        }
    }
}

__global__ void k_gates(const float* proj, int ldp, int L, const float* a_log, const float* dt_bias, float* beta, float* alpha) {
    const int i = blockIdx.x * blockDim.x + threadIdx.x;
    if (i >= L * 8) return;
    const int t = i / 8, dir = (i % 8) / 4, h = i % 4;
    const float gb = proj[(size_t)t * ldp + 2048 + dir * 4 + h], ga = proj[(size_t)t * ldp + 2048 + (2 + dir) * 4 + h];
    beta[((size_t)dir * NH + h) * L + t] = sigmoid_f(gb);
    const float ld = -__expf(a_log[dir * 4 + h]) * softplus_f(ga + dt_bias[dir * 4 + h]);
    alpha[((size_t)dir * NH + h) * L + t] = __expf(ld);
}

__global__ void __launch_bounds__(128) k_delta(const float* qc, const float* kc, const float* vc, const float* betac, const float* alphac,
                                               const float* ql, const float* kl, const float* vl, const float* betal, const float* alphal,
                                               float* of, float* ob) {
    __shared__ float red[2][2][20];
    const int sl = blockIdx.x, dir = blockIdx.y, h = blockIdx.z, dk = threadIdx.x, lane = dk & 63, wv = dk >> 6;
    float S[8];
#pragma unroll
    for (int j = 0; j < 8; ++j) S[j] = 0.f;
    float* o = dir ? ob : of;
    int par = 0;
    for (int ph = 0; ph < 2; ++ph) {
        const int L = ph ? SEQ : CTX;
        const float* q = ph ? ql : qc; const float* k = ph ? kl : kc; const float* v = ph ? vl : vc;
        const float* be = (ph ? betal : betac) + ((size_t)dir * NH + h) * L; const float* al = (ph ? alphal : alphac) + ((size_t)dir * NH + h) * L;
        for (int s = 0; s < L; ++s) {
            const int t = dir ? (L - 1 - s) : s;
            const float kv = k[(size_t)t * 512 + h * 128 + dk], qv = q[(size_t)t * 512 + h * 128 + dk];
            float r[17];
#pragma unroll
            for (int j = 0; j < 8; ++j) { r[j] = kv * S[j]; r[8 + j] = qv * S[j]; }
            r[16] = kv * qv;
#pragma unroll
            for (int j = 0; j < 17; ++j) r[j] = wave_sum(r[j]);
            if (lane < 17) { float x = r[0];
#pragma unroll
                for (int j = 1; j < 17; ++j) x = (lane == j) ? r[j] : x;
                red[par][wv][lane] = x; }
            __syncthreads();
            const float b = be[t], a = al[t];
            float w[8];
#pragma unroll
            for (int j = 0; j < 8; ++j) {
                const float kS = red[par][0][j] + red[par][1][j];
                w[j] = b * (v[(size_t)t * 512 + h * 128 + sl * 8 + j] - a * kS);
                S[j] = a * S[j] + kv * w[j];
            }
            if (ph && dk < 8) {
                const float Sq = red[par][0][8 + dk] + red[par][1][8 + dk], kq = red[par][0][16] + red[par][1][16];
                float wj = w[0];
#pragma unroll
                for (int j = 1; j < 8; ++j) wj = (dk == j) ? w[j] : wj;
                o[(size_t)t * 512 + h * 128 + sl * 8 + dk] = a * Sq + kq * wj;
            }
            par ^= 1;
        }
    }
}

__global__ void k_even_A(const float* of, const float* ob, const float* proj, int ldp, const float* onorm, float* A, float* P) {
    const int lane = threadIdx.x & 63, wv = (blockIdx.x * blockDim.x + threadIdx.x) >> 6, nw = (gridDim.x * blockDim.x) >> 6;
    for (int it = wv; it < SEQ * NH; it += nw) {
        const int t = it / NH, h = it % NH;
        float o[2]; float s = 0.f;
#pragma unroll
        for (int j = 0; j < 2; ++j) { const size_t off = (size_t)t * 512 + h * 128 + lane + 64 * j; o[j] = of[off] + ob[off]; s += o[j] * o[j]; }
        const float rs = rsqrtf(wave_sum(s) * (1.f / 128.f) + EPS);
#pragma unroll
        for (int j = 0; j < 2; ++j) { const int c = lane + 64 * j; const float z = proj[(size_t)t * ldp + 1536 + h * 128 + c];
            A[(size_t)t * D + h * 128 + c] = o[j] * rs * onorm[c] * silu_f(z); }
        const int w = 2 << h, pos = t & 63, row0 = t - pos;
        int lo = pos - w / 2; if (lo < 0) lo = 0; int hi = pos + w - w / 2; if (hi > 64) hi = 64;
#pragma unroll
        for (int j = 0; j < 2; ++j) { const int col = 2064 + h * 128 + lane + 64 * j; float m = 0.f;
            for (int p = lo; p < hi; ++p) m += proj[(size_t)(row0 + p) * ldp + col];
            P[(size_t)t * 512 + h * 128 + lane + 64 * j] = m / (float)(hi - lo) - proj[(size_t)t * ldp + col]; }
    }
}

__global__ void k_resid(float* xl, const float* y, const float* g, int rows) {
    const size_t i = (size_t)blockIdx.x * blockDim.x + threadIdx.x;
    if (i < (size_t)rows * D) xl[i] += g[i & (D - 1)] * y[i];
}

__global__ void k_router(const float* h, const float* router  , float* aff) {
    const int lane = threadIdx.x & 63, wv = (blockIdx.x * blockDim.x + threadIdx.x) >> 6, nw = (gridDim.x * blockDim.x) >> 6;
    for (int t = wv; t < SEQ; t += nw) {
        float lg[16];
#pragma unroll
        for (int e = 0; e < 16; ++e) lg[e] = 0.f;
        for (int j = 0; j < 16; ++j) { const int k = lane + 64 * j; const float hv = h[(size_t)t * D + k];
#pragma unroll
            for (int e = 0; e < 16; ++e) lg[e] += hv * router[k * 16 + e]; }
        float mx = -1e30f;
#pragma unroll
        for (int e = 0; e < 16; ++e) { lg[e] = wave_sum(lg[e]); mx = fmaxf(mx, lg[e]); }
        float sum = 0.f;
#pragma unroll
        for (int e = 0; e < 16; ++e) { lg[e] = __expf(lg[e] - mx); sum += lg[e]; }
        if (lane < 16) { float x = lg[0];
#pragma unroll
            for (int e = 1; e < 16; ++e) x = (lane == e) ? lg[e] : x;
            aff[(size_t)lane * SEQ + t] = x / sum; }
    }
}

__global__ void __launch_bounds__(512) k_topk(const float* aff, int* idx, float* gate, int* sel) {
    __shared__ unsigned keys[SEQ];
    __shared__ unsigned hist[256];
    __shared__ unsigned sh_prefix, sh_need;
    __shared__ unsigned cg[512], ce[512];
    const int e = blockIdx.x, tid = threadIdx.x;
    for (int i = tid; i < SEQ; i += 512) keys[i] = __float_as_uint(aff[(size_t)e * SEQ + i]);
    if (tid == 0) { sh_prefix = 0u; sh_need = CAP; }
    __syncthreads();
    unsigned mask = 0u;
    for (int pass = 0; pass < 4; ++pass) {
        const int shift = 24 - 8 * pass;
        if (tid < 256) hist[tid] = 0u;
        __syncthreads();
        const unsigned prefix = sh_prefix;
        for (int i = tid; i < SEQ; i += 512) { const unsigned kx = keys[i]; if ((kx & mask) == prefix) atomicAdd(&hist[(kx >> shift) & 255u], 1u); }
        __syncthreads();
        if (tid == 0) { unsigned need = sh_need, cum = 0u; int bin = 255;
            for (; bin > 0; --bin) { if (cum + hist[bin] >= need) break; cum += hist[bin]; }
            sh_prefix = prefix | ((unsigned)bin << shift); sh_need = need - cum; }
        mask |= 0xFFu << shift;
        __syncthreads();
    }
    const unsigned T = sh_prefix, need = sh_need;
    unsigned ng = 0u, nq = 0u;
    for (int j = 0; j < 16; ++j) { const unsigned kx = keys[tid * 16 + j]; ng += kx > T; nq += kx == T; }
    cg[tid] = ng; ce[tid] = nq;
    __syncthreads();
    if (tid == 0) { unsigned a = 0u, b = 0u; for (int i = 0; i < 512; ++i) { const unsigned x = cg[i], y = ce[i]; cg[i] = a; ce[i] = b; a += x; b += y; } }
    __syncthreads();
    unsigned g0 = cg[tid], q0 = ce[tid];
    for (int j = 0; j < 16; ++j) { const int t = tid * 16 + j; const unsigned kx = keys[t]; int slot = -1;
        if (kx > T) { slot = (int)(g0 + (q0 < need ? q0 : need)); ++g0; }
        else if (kx == T) { if (q0 < need) slot = (int)(g0 + q0); ++q0; }
        sel[(size_t)t * NE + e] = slot;
        if (slot >= 0) { idx[e * CAP + slot] = t; gate[e * CAP + slot] = __uint_as_float(kx); } }
}

__global__ void k_silu_mul(float* g, const float* u, size_t n) {
    const size_t i = (size_t)blockIdx.x * blockDim.x + threadIdx.x;
    if (i < n) g[i] = silu_f(g[i]) * u[i];
}

__global__ void k_moe_combine(float* xl, const float* ye, const int* sel, const float* gate, const float* g2) {
    const int t = blockIdx.x, tid = threadIdx.x;
    float acc[4] = {0.f, 0.f, 0.f, 0.f};
    for (int e = 0; e < NE; ++e) { const int s = sel[(size_t)t * NE + e]; if (s < 0) continue;
        const float gt = gate[e * CAP + s]; const float* yr = ye + ((size_t)e * CAP + s) * D;
#pragma unroll
        for (int j = 0; j < 4; ++j) acc[j] += gt * yr[tid + 256 * j]; }
#pragma unroll
    for (int j = 0; j < 4; ++j) { const int n = tid + 256 * j; xl[(size_t)t * D + n] += g2[n] * acc[j]; }
}

__global__ void k_sc_glue(const float* proj  , const float* cw  , float* a) {
    const size_t i = (size_t)blockIdx.x * blockDim.x + threadIdx.x;
    if (i >= (size_t)SEQ * D) return;
    const int t = (int)(i >> 10), c = (int)(i & 1023);
    const float* p = proj + (size_t)t * 3072;
    float s = cw[D + c] * p[D + c] * p[2 * D + c];
    if (t > 0) s += cw[c] * p[-3072 + D + c] * p[-3072 + 2 * D + c];
    if (t < SEQ - 1) s += cw[2 * D + c] * p[3072 + D + c] * p[3072 + 2 * D + c];
    a[i] = p[c] * s;
}

inline void gemm(hipStream_t st, const float* A, const float* B, float* C, int M, int N, int K, int lda, int ldb, int ldc,
                 int batch = 1, long sA = 0, long sB = 0, long sC = 0, const int* idx = nullptr, int sIdx = 0, const float* cs = nullptr, int sScale = 0) {
    GemmArgs g{A, B, C, idx, cs, sA, sB, sC, M, N, K, lda, ldb, ldc, sIdx, sScale};
    static_assert(sizeof(GemmArgs) == 96, "no padding");
    hipLaunchKernelGGL(k_gemm, dim3((N + 63) / 64, M / 64, batch), dim3(256), 0, st, g);
}
}

extern "C" void kernel_launch(void* const* d_in, const int* in_sizes, int n_in, void* d_out, int out_size, void* d_ws, size_t ws_size, hipStream_t st) {
    const float* x = (const float*)d_in[0]; const float* c = (const float*)d_in[1]; const float* ctx = (const float*)d_in[2]; const float* c_ctx = (const float*)d_in[3];
    const float* ada_w = (const float*)d_in[4]; const float* ada_b = (const float*)d_in[5]; const float* norm_mix = (const float*)d_in[6]; const float* norm_ffn = (const float*)d_in[7];
    const float* norm_final = (const float*)d_in[8]; const float* ev_w_in = (const float*)d_in[9]; const float* dn_conv = (const float*)d_in[10]; const float* dn_a_log = (const float*)d_in[11];
    const float* dn_dt_bias = (const float*)d_in[12]; const float* dn_norm = (const float*)d_in[13]; const float* pool_w = (const float*)d_in[14]; const float* pool_scale = (const float*)d_in[15];
    const float* ev_w_out = (const float*)d_in[16]; const float* sc_w_in = (const float*)d_in[17]; const float* sc_conv = (const float*)d_in[18]; const float* sc_w_out = (const float*)d_in[19];
    const float* router = (const float*)d_in[20]; const float* w_gate = (const float*)d_in[21]; const float* w_up = (const float*)d_in[22]; const float* w_down = (const float*)d_in[23];
    float* out = (float*)d_out;
    float* ws = (float*)d_ws;
    size_t off = 0;
    auto take = [&](size_t n) { float* p = ws + off; off += (n + 63) & ~(size_t)63; return p; };
    float* ADA = take(2 * 5 * 6 * D);
    float* H = take((size_t)SEQ * D); float* HC = take((size_t)CTX * D);
    float* R1 = take((size_t)SEQ * 3072);
    float* PROJC = take((size_t)CTX * EVEN_IN);
    float* R2 = take((size_t)SEQ * 512 * 5);
    float* QC = take((size_t)CTX * 512 * 3);
    float* BETA = take(8 * SEQ); float* ALPHA = take(8 * SEQ); float* BETAC = take(8 * CTX); float* ALPHAC = take(8 * CTX);
    float* PF = take((size_t)SEQ * 512); float* AM = take((size_t)SEQ * D); float* Y = take((size_t)SEQ * D);
    float* AFF = take((size_t)NE * SEQ); int* IDX = (int*)take(NE * CAP); float* GATE = take(NE * CAP); int* SEL = (int*)take((size_t)SEQ * NE);
    float *Q = R2, *K = R2 + (size_t)SEQ * 512, *V = R2 + (size_t)SEQ * 1024, *OF = R2 + (size_t)SEQ * 1536, *OB = R2 + (size_t)SEQ * 2048;
    float *G = R2, *U = R2 + (size_t)NE * CAP * DE, *YE = R1;
    if (off * 4 > ws_size) { fprintf(stderr, "workspace too small\n"); return; }

    hipMemcpyAsync(out, x, (size_t)BATCH * SEQ * D * 4, hipMemcpyDeviceToDevice, st);
    hipLaunchKernelGGL(k_ada, dim3(6 * D / 256, 5, 2), dim3(256), 0, st, c, c_ctx, ada_w, ada_b, ADA);
    for (int b = 0; b < BATCH; ++b) {
        float* xl = out + (size_t)b * SEQ * D;
        for (int l = 0; l < 2; ++l) {
            const float* ad = ADA + ((size_t)l * 5 + b) * 6 * D; const float* adc = ADA + ((size_t)l * 5 + 4) * 6 * D;
            hipLaunchKernelGGL(k_norm_mod, dim3(1024), dim3(256), 0, st, xl, H, norm_mix + l * D, ad, ad + D, SEQ);
            if (l == 0) {
                hipLaunchKernelGGL(k_norm_mod, dim3(64), dim3(256), 0, st, ctx + (size_t)b * CTX * D, HC, norm_mix, adc, adc + D, CTX);
                gemm(st, H, ev_w_in, R1, SEQ, EVEN_IN, D, D, EVEN_IN, EVEN_IN);
                gemm(st, HC, ev_w_in, PROJC, CTX, EVEN_IN, D, D, EVEN_IN, EVEN_IN);
                hipLaunchKernelGGL(k_conv_qkv, dim3(2048), dim3(256), 0, st, R1, EVEN_IN, SEQ, dn_conv, Q, K, V);
                hipLaunchKernelGGL(k_conv_qkv, dim3(256), dim3(256), 0, st, PROJC, EVEN_IN, CTX, dn_conv, QC, QC + CTX * 512, QC + 2 * CTX * 512);
                hipLaunchKernelGGL(k_gates, dim3(SEQ * 8 / 256), dim3(256), 0, st, R1, EVEN_IN, SEQ, dn_a_log, dn_dt_bias, BETA, ALPHA);
                hipLaunchKernelGGL(k_gates, dim3(CTX * 8 / 256), dim3(256), 0, st, PROJC, EVEN_IN, CTX, dn_a_log, dn_dt_bias, BETAC, ALPHAC);
                hipLaunchKernelGGL(k_delta, dim3(16, 2, NH), dim3(128), 0, st, QC, QC + CTX * 512, QC + 2 * CTX * 512, BETAC, ALPHAC, Q, K, V, BETA, ALPHA, OF, OB);
                hipLaunchKernelGGL(k_even_A, dim3(2048), dim3(256), 0, st, OF, OB, R1, EVEN_IN, dn_norm, AM, PF);
                gemm(st, PF, pool_w, AM + 512, SEQ, 128, 128, 512, 128, D, 4, 128, 128 * 128, 128, nullptr, 0, pool_scale, 128);
                gemm(st, AM, ev_w_out, Y, SEQ, D, D, D, D, D);
            } else {
                gemm(st, H, sc_w_in, R1, SEQ, 3072, D, D, 3072, 3072);
                hipLaunchKernelGGL(k_sc_glue, dim3(SEQ * D / 256), dim3(256), 0, st, R1, sc_conv, AM);
                gemm(st, AM, sc_w_out, Y, SEQ, D, D, D, D, D);
            }
            hipLaunchKernelGGL(k_resid, dim3(SEQ * D / 256), dim3(256), 0, st, xl, Y, ad + 2 * D, SEQ);
            hipLaunchKernelGGL(k_norm_mod, dim3(1024), dim3(256), 0, st, xl, H, norm_ffn + l * D, ad + 3 * D, ad + 4 * D, SEQ);
            hipLaunchKernelGGL(k_router, dim3(1024), dim3(256), 0, st, H, router + (size_t)l * D * NE, AFF);
            hipLaunchKernelGGL(k_topk, dim3(NE), dim3(512), 0, st, AFF, IDX, GATE, SEL);
            gemm(st, H, w_gate + (size_t)l * NE * D * DE, G, CAP, DE, D, D, DE, DE, NE, 0, (long)D * DE, (long)CAP * DE, IDX, CAP);
            gemm(st, H, w_up + (size_t)l * NE * D * DE, U, CAP, DE, D, D, DE, DE, NE, 0, (long)D * DE, (long)CAP * DE, IDX, CAP);
            hipLaunchKernelGGL(k_silu_mul, dim3(NE * CAP * DE / 256), dim3(256), 0, st, G, U, (size_t)NE * CAP * DE);
            gemm(st, G, w_down + (size_t)l * NE * DE * D, YE, CAP, D, DE, DE, D, D, NE, (long)CAP * DE, (long)DE * D, (long)CAP * D);
            hipLaunchKernelGGL(k_moe_combine, dim3(SEQ), dim3(256), 0, st, xl, YE, SEL, GATE, ad + 5 * D);
        }
    }
    hipLaunchKernelGGL(k_norm_mod, dim3(2048), dim3(256), 0, st, out, out, norm_final, (const float*)nullptr, (const float*)nullptr, BATCH * SEQ);
}
```

```cpp
#include <hip/hip_runtime.h>
#include <cstdio>
#include <cstdint>

namespace {
constexpr int D = 1024, BATCH = 4, SEQ = 8192, CTX = 256, NH = 4, DK = 128, DV = 128;
constexpr int EVEN_IN = 2576, NE = 16, DE = 512, CAP = 1024;
constexpr float EPS = 1e-6f;

__device__ __forceinline__ float silu_f(float x) { return x / (1.f + __expf(-x)); }
__device__ __forceinline__ float sigmoid_f(float x) { return 1.f / (1.f + __expf(-x)); }
__device__ __forceinline__ float softplus_f(float x) { return x > 20.f ? x : log1pf(__expf(x)); }
__device__ __forceinline__ float wave_sum(float v) {
#pragma unroll
    for (int o = 1; o < 64; o <<= 1) v += __shfl_xor(v, o);
    return v;
}

__global__ void k_ada(const float* c, const float* c_ctx, const float* ada_w, const float* ada_b, float* out) {
    const int n = blockIdx.x * 256 + threadIdx.x, r = blockIdx.y, l = blockIdx.z;
    const float* vec = r < 4 ? c + r * D : c_ctx;
    const float* w = ada_w + (size_t)l * D * 6 * D;
    float acc = 0.f;
    for (int k = 0; k < D; ++k) acc += silu_f(vec[k]) * w[(size_t)k * 6 * D + n];
    out[((size_t)l * 5 + r) * 6 * D + n] = acc + ada_b[l * 6 * D + n];
}

__global__ void k_norm_mod(const float* x, float* out, const float* gw, const float* shift, const float* scale, int rows) {
    const int lane = threadIdx.x & 63, wv = (blockIdx.x * blockDim.x + threadIdx.x) >> 6, nw = (gridDim.x * blockDim.x) >> 6;
    for (int r = wv; r < rows; r += nw) {
        const float* xr = x + (size_t)r * D;
        float v[16]; float s = 0.f;
#pragma unroll
        for (int j = 0; j < 16; ++j) { v[j] = xr[lane + 64 * j]; s += v[j] * v[j]; }
        const float rs = rsqrtf(wave_sum(s) * (1.f / D) + EPS);
#pragma unroll
        for (int j = 0; j < 16; ++j) { const int n = lane + 64 * j; float y = v[j] * rs * gw[n];
            if (shift) y = y * (1.f + scale[n]) + shift[n];
            out[(size_t)r * D + n] = y; }
    }
}

struct GemmArgs { const float* A; const float* B; float* C; const int* idx; const float* colscale; long sA, sB, sC; int M, N, K, lda, ldb, ldc, sIdx, sScale; };
__global__ void __launch_bounds__(256) k_gemm(GemmArgs g) {
    __shared__ float As[16][68];
    __shared__ float Bs[16][68];
    const int z = blockIdx.z;
    const float* A = g.A + z * g.sA; const float* B = g.B + z * g.sB; float* C = g.C + z * g.sC;
    const int* idx = g.idx ? g.idx + z * g.sIdx : nullptr;
    const int tid = threadIdx.x, tx = tid & 15, ty = tid >> 4;
    const int m0 = blockIdx.y * 64, n0 = blockIdx.x * 64;
    const int ar = tid >> 2, ak = (tid & 3) * 4;
    const int arow = idx ? idx[m0 + ar] : (m0 + ar);
    const float* ap = A + (size_t)arow * g.lda + ak;
    const int bk = tid >> 4, bn = (tid & 15) * 4;
    const bool bok = (n0 + bn) < g.N;
    const float* bp = B + (size_t)bk * g.ldb + n0 + bn;
    float acc[4][4] = {};
    for (int k0 = 0; k0 < g.K; k0 += 16) {
        const float4 av = *(const float4*)(ap + k0);
        float4 bv = make_float4(0.f, 0.f, 0.f, 0.f);
        if (bok) bv = *(const float4*)(bp + (size_t)k0 * g.ldb);
        As[ak + 0][ar] = av.x; As[ak + 1][ar] = av.y; As[ak + 2][ar] = av.z; As[ak + 3][ar] = av.w;
        *(float4*)&Bs[bk][bn] = bv;
        __syncthreads();
#pragma unroll
        for (int k = 0; k < 16; ++k) {
            const float4 a4 = *(const float4*)&As[k][ty * 4];
            const float4 b4 = *(const float4*)&Bs[k][tx * 4];
            const float a[4] = {a4.x, a4.y, a4.z, a4.w}, b[4] = {b4.x, b4.y, b4.z, b4.w};
#pragma unroll
            for (int i = 0; i < 4; ++i)
#pragma unroll
                for (int j = 0; j < 4; ++j) acc[i][j] += a[i] * b[j];
        }
        __syncthreads();
    }
    const float* cs = g.colscale ? g.colscale + z * g.sScale : nullptr;
#pragma unroll
    for (int i = 0; i < 4; ++i)
#pragma unroll
        for (int j = 0; j < 4; ++j) { const int n = n0 + tx * 4 + j; if (n < g.N) C[(size_t)(m0 + ty * 4 + i) * g.ldc + n] = acc[i][j] * (cs ? cs[n] : 1.f); }
}

__global__ void k_conv_qkv(const float* proj, int ldp, int L, const float* cw  , float* q, float* k, float* v) {
    const int lane = threadIdx.x & 63, wv = (blockIdx.x * blockDim.x + threadIdx.x) >> 6, nw = (gridDim.x * blockDim.x) >> 6;
    for (int it = wv; it < L * NH; it += nw) {
        const int t = it / NH, h = it % NH;
        float o[3][2];
#pragma unroll
        for (int w = 0; w < 3; ++w)
#pragma unroll
            for (int j = 0; j < 2; ++j) {
                const int col = w * 512 + h * 128 + lane + 64 * j;
                float a = cw[1536 + col] * proj[(size_t)t * ldp + col];
                if (t > 0) a += cw[col] * proj[(size_t)(t - 1) * ldp + col];
                if (t < L - 1) a += cw[2 * 1536 + col] * proj[(size_t)(t + 1) * ldp + col];
                o[w][j] = silu_f(a);
            }
        const float sq = wave_sum(o[0][0] * o[0][0] + o[0][1] * o[0][1]);
        const float sk = wave_sum(o[1][0] * o[1][0] + o[1][1] * o[1][1]);
        const float rq = rsqrtf(sq + EPS) * 0.08838834764831845f, rk = rsqrtf(sk + EPS);
#pragma unroll
        for (int j = 0; j < 2; ++j) {
            const size_t off = (size_t)t * 512 + h * 128 + lane + 64 * j;
            q[off] = o[0][j] * rq; k[off] = o[1][j] * rk; v[off] = o[2][j];
        }
    }
}

__global__ void k_gates(const float* proj, int ldp, int L, const float* a_log, const float* dt_bias, float* beta, float* alpha) {
    const int i = blockIdx.x * blockDim.x + threadIdx.x;
    if (i >= L * 8) return;
    const int t = i / 8, dir = (i % 8) / 4, h = i % 4;
    const float gb = proj[(size_t)t * ldp + 2048 + dir * 4 + h], ga = proj[(size_t)t * ldp + 2048 + (2 + dir) * 4 + h];
    beta[((size_t)dir * NH + h) * L + t] = sigmoid_f(gb);
    const float ld = -__expf(a_log[dir * 4 + h]) * softplus_f(ga + dt_bias[dir * 4 + h]);
    alpha[((size_t)dir * NH + h) * L + t] = __expf(ld);
}

__global__ void __launch_bounds__(128) k_delta(const float* qc, const float* kc, const float* vc, const float* betac, const float* alphac,
                                               const float* ql, const float* kl, const float* vl, const float* betal, const float* alphal,
                                               float* of, float* ob) {
    __shared__ float red[2][2][20];
    const int sl = blockIdx.x, dir = blockIdx.y, h = blockIdx.z, dk = threadIdx.x, lane = dk & 63, wv = dk >> 6;
    float S[8];
#pragma unroll
    for (int j = 0; j < 8; ++j) S[j] = 0.f;
    float* o = dir ? ob : of;
    int par = 0;
    for (int ph = 0; ph < 2; ++ph) {
        const int L = ph ? SEQ : CTX;
        const float* q = ph ? ql : qc; const float* k = ph ? kl : kc; const float* v = ph ? vl : vc;
        const float* be = (ph ? betal : betac) + ((size_t)dir * NH + h) * L; const float* al = (ph ? alphal : alphac) + ((size_t)dir * NH + h) * L;
        for (int s = 0; s < L; ++s) {
            const int t = dir ? (L - 1 - s) : s;
            const float kv = k[(size_t)t * 512 + h * 128 + dk], qv = q[(size_t)t * 512 + h * 128 + dk];
            float r[17];
#pragma unroll
            for (int j = 0; j < 8; ++j) { r[j] = kv * S[j]; r[8 + j] = qv * S[j]; }
            r[16] = kv * qv;
#pragma unroll
            for (int j = 0; j < 17; ++j) r[j] = wave_sum(r[j]);
            if (lane < 17) { float x = r[0];
#pragma unroll
                for (int j = 1; j < 17; ++j) x = (lane == j) ? r[j] : x;
                red[par][wv][lane] = x; }
            __syncthreads();
            const float b = be[t], a = al[t];
            float w[8];
#pragma unroll
            for (int j = 0; j < 8; ++j) {
                const float kS = red[par][0][j] + red[par][1][j];
                w[j] = b * (v[(size_t)t * 512 + h * 128 + sl * 8 + j] - a * kS);
                S[j] = a * S[j] + kv * w[j];
            }
            if (ph && dk < 8) {
                const float Sq = red[par][0][8 + dk] + red[par][1][8 + dk], kq = red[par][0][16] + red[par][1][16];
                float wj = w[0];
#pragma unroll
                for (int j = 1; j < 8; ++j) wj = (dk == j) ? w[j] : wj;
                o[(size_t)t * 512 + h * 128 + sl * 8 + dk] = a * Sq + kq * wj;
            }
            par ^= 1;
        }
    }
}

__global__ void k_even_A(const float* of, const float* ob, const float* proj, int ldp, const float* onorm, float* A, float* P) {
    const int lane = threadIdx.x & 63, wv = (blockIdx.x * blockDim.x + threadIdx.x) >> 6, nw = (gridDim.x * blockDim.x) >> 6;
    for (int it = wv; it < SEQ * NH; it += nw) {
        const int t = it / NH, h = it % NH;
        float o[2]; float s = 0.f;
#pragma unroll
        for (int j = 0; j < 2; ++j) { const size_t off = (size_t)t * 512 + h * 128 + lane + 64 * j; o[j] = of[off] + ob[off]; s += o[j] * o[j]; }
        const float rs = rsqrtf(wave_sum(s) * (1.f / 128.f) + EPS);
#pragma unroll
        for (int j = 0; j < 2; ++j) { const int c = lane + 64 * j; const float z = proj[(size_t)t * ldp + 1536 + h * 128 + c];
            A[(size_t)t * D + h * 128 + c] = o[j] * rs * onorm[c] * silu_f(z); }
        const int w = 2 << h, pos = t & 63, row0 = t - pos;
        int lo = pos - w / 2; if (lo < 0) lo = 0; int hi = pos + w - w / 2; if (hi > 64) hi = 64;
#pragma unroll
        for (int j = 0; j < 2; ++j) { const int col = 2064 + h * 128 + lane + 64 * j; float m = 0.f;
            for (int p = lo; p < hi; ++p) m += proj[(size_t)(row0 + p) * ldp + col];
            P[(size_t)t * 512 + h * 128 + lane + 64 * j] = m / (float)(hi - lo) - proj[(size_t)t * ldp + col]; }
    }
}

__global__ void k_resid(float* xl, const float* y, const float* g, int rows) {
    const size_t i = (size_t)blockIdx.x * blockDim.x + threadIdx.x;
    if (i < (size_t)rows * D) xl[i] += g[i & (D - 1)] * y[i];
}

__global__ void k_router(const float* h, const float* router  , float* aff) {
    const int lane = threadIdx.x & 63, wv = (blockIdx.x * blockDim.x + threadIdx.x) >> 6, nw = (gridDim.x * blockDim.x) >> 6;
    for (int t = wv; t < SEQ; t += nw) {
        float lg[16];
#pragma unroll
        for (int e = 0; e < 16; ++e) lg[e] = 0.f;
        for (int j = 0; j < 16; ++j) { const int k = lane + 64 * j; const float hv = h[(size_t)t * D + k];
#pragma unroll
            for (int e = 0; e < 16; ++e) lg[e] += hv * router[k * 16 + e]; }
        float mx = -1e30f;
#pragma unroll
        for (int e = 0; e < 16; ++e) { lg[e] = wave_sum(lg[e]); mx = fmaxf(mx, lg[e]); }
        float sum = 0.f;
#pragma unroll
        for (int e = 0; e < 16; ++e) { lg[e] = __expf(lg[e] - mx); sum += lg[e]; }
        if (lane < 16) { float x = lg[0];
#pragma unroll
            for (int e = 1; e < 16; ++e) x = (lane == e) ? lg[e] : x;
            aff[(size_t)lane * SEQ + t] = x / sum; }
    }
}

__global__ void __launch_bounds__(512) k_topk(const float* aff, int* idx, float* gate, int* sel) {
    __shared__ unsigned keys[SEQ];
    __shared__ unsigned hist[256];
    __shared__ unsigned sh_prefix, sh_need;
    __shared__ unsigned cg[512], ce[512];
    const int e = blockIdx.x, tid = threadIdx.x;
    for (int i = tid; i < SEQ; i += 512) keys[i] = __float_as_uint(aff[(size_t)e * SEQ + i]);
    if (tid == 0) { sh_prefix = 0u; sh_need = CAP; }
    __syncthreads();
    unsigned mask = 0u;
    for (int pass = 0; pass < 4; ++pass) {
        const int shift = 24 - 8 * pass;
        if (tid < 256) hist[tid] = 0u;
        __syncthreads();
        const unsigned prefix = sh_prefix;
        for (int i = tid; i < SEQ; i += 512) { const unsigned kx = keys[i]; if ((kx & mask) == prefix) atomicAdd(&hist[(kx >> shift) & 255u], 1u); }
        __syncthreads();
        if (tid == 0) { unsigned need = sh_need, cum = 0u; int bin = 255;
            for (; bin > 0; --bin) { if (cum + hist[bin] >= need) break; cum += hist[bin]; }
            sh_prefix = prefix | ((unsigned)bin << shift); sh_need = need - cum; }
        mask |= 0xFFu << shift;
        __syncthreads();
    }
    const unsigned T = sh_prefix, need = sh_need;
    unsigned ng = 0u, nq = 0u;
    for (int j = 0; j < 16; ++j) { const unsigned kx = keys[tid * 16 + j]; ng += kx > T; nq += kx == T; }
    cg[tid] = ng; ce[tid] = nq;
    __syncthreads();
    if (tid == 0) { unsigned a = 0u, b = 0u; for (int i = 0; i < 512; ++i) { const unsigned x = cg[i], y = ce[i]; cg[i] = a; ce[i] = b; a += x; b += y; } }
    __syncthreads();
    unsigned g0 = cg[tid], q0 = ce[tid];
    for (int j = 0; j < 16; ++j) { const int t = tid * 16 + j; const unsigned kx = keys[t]; int slot = -1;
        if (kx > T) { slot = (int)(g0 + (q0 < need ? q0 : need)); ++g0; }
        else if (kx == T) { if (q0 < need) slot = (int)(g0 + q0); ++q0; }
        sel[(size_t)t * NE + e] = slot;
        if (slot >= 0) { idx[e * CAP + slot] = t; gate[e * CAP + slot] = __uint_as_float(kx); } }
}

__global__ void k_silu_mul(float* g, const float* u, size_t n) {
    const size_t i = (size_t)blockIdx.x * blockDim.x + threadIdx.x;
    if (i < n) g[i] = silu_f(g[i]) * u[i];
}

__global__ void k_moe_combine(float* xl, const float* ye, const int* sel, const float* gate, const float* g2) {
    const int t = blockIdx.x, tid = threadIdx.x;
    float acc[4] = {0.f, 0.f, 0.f, 0.f};
    for (int e = 0; e < NE; ++e) { const int s = sel[(size_t)t * NE + e]; if (s < 0) continue;
        const float gt = gate[e * CAP + s]; const float* yr = ye + ((size_t)e * CAP + s) * D;
#pragma unroll
        for (int j = 0; j < 4; ++j) acc[j] += gt * yr[tid + 256 * j]; }
#pragma unroll
    for (int j = 0; j < 4; ++j) { const int n = tid + 256 * j; xl[(size_t)t * D + n] += g2[n] * acc[j]; }
}

__global__ void k_sc_glue(const float* proj  , const float* cw  , float* a) {
    const size_t i = (size_t)blockIdx.x * blockDim.x + threadIdx.x;
    if (i >= (size_t)SEQ * D) return;
    const int t = (int)(i >> 10), c = (int)(i & 1023);
    const float* p = proj + (size_t)t * 3072;
    float s = cw[D + c] * p[D + c] * p[2 * D + c];
    if (t > 0) s += cw[c] * p[-3072 + D + c] * p[-3072 + 2 * D + c];
    if (t < SEQ - 1) s += cw[2 * D + c] * p[3072 + D + c] * p[3072 + 2 * D + c];
    a[i] = p[c] * s;
}

inline void gemm(hipStream_t st, const float* A, const float* B, float* C, int M, int N, int K, int lda, int ldb, int ldc,
                 int batch = 1, long sA = 0, long sB = 0, long sC = 0, const int* idx = nullptr, int sIdx = 0, const float* cs = nullptr, int sScale = 0) {
    GemmArgs g{A, B, C, idx, cs, sA, sB, sC, M, N, K, lda, ldb, ldc, sIdx, sScale};
    static_assert(sizeof(GemmArgs) == 96, "no padding");
    hipLaunchKernelGGL(k_gemm, dim3((N + 63) / 64, M / 64, batch), dim3(256), 0, st, g);
}

namespace mk {
#define LAS __attribute__((address_space(3)))
#define GAS __attribute__((address_space(1)))
typedef unsigned short bf16_t;
typedef short bf16x8 __attribute__((ext_vector_type(8)));
typedef float f32x4 __attribute__((ext_vector_type(4)));
typedef float f32x2 __attribute__((ext_vector_type(2)));
typedef unsigned u32x4 __attribute__((ext_vector_type(4)));
typedef unsigned u32x2 __attribute__((ext_vector_type(2)));
constexpr int M_LAT = BATCH * SEQ;
constexpr int BM = 256, BK = 64, HALF = 128, HTB = HALF * BK * 2, STAGE_BYTES = 8 * HTB;
constexpr int LDS_BYTES = 147456, GTAB_OFF = 131072  , MISC_OFF = 147456 - 256;
constexpr int NTHREADS = 512, NWAVES = 8;

__device__ __forceinline__ unsigned f2bf(float f) { unsigned u = __builtin_bit_cast(unsigned, f); return (u + 0x7fffu + ((u >> 16) & 1u)) >> 16; }
__device__ __forceinline__ unsigned pk2(float lo, float hi) { return f2bf(lo) | (f2bf(hi) << 16); }
__device__ __forceinline__ unsigned cvt_pk_bf16(float lo, float hi) { unsigned r; asm volatile("v_cvt_pk_bf16_f32 %0, %1, %2" : "=v"(r) : "v"(lo), "v"(hi)); return r; }
__device__ __forceinline__ float bf_lo(unsigned w) { return __uint_as_float(w << 16); }
__device__ __forceinline__ float bf_hi(unsigned w) { return __uint_as_float(w & 0xffff0000u); }

#define XB_TMO      128
#define XB_XCNT(j)  (256  + 64 * (j))
#define XB_XSUB(j)  (1280 + 64 * (j))
#define XB_XGEN(j)  (2304 + 64 * (j))
#define XB_TOP      3328
#define XB_TOPGEN   3392
#define XCD_BAR_WORDS 3456
#define XB_SPIN_CAP (1u << 18)
__device__ __forceinline__ unsigned xb_ld(unsigned* p)              { return __hip_atomic_load(p, __ATOMIC_RELAXED, __HIP_MEMORY_SCOPE_AGENT); }
__device__ __forceinline__ unsigned xb_add(unsigned* p, unsigned v) { return __hip_atomic_fetch_add(p, v, __ATOMIC_RELAXED, __HIP_MEMORY_SCOPE_AGENT); }
__device__ __forceinline__ unsigned xb_xcc_id() { return (unsigned)__builtin_amdgcn_s_getreg((3 << 11) | 20) & 0xFu; }
#define XB_SPIN(cond, bar) do { unsigned _sp = 0; while (cond) { __builtin_amdgcn_s_sleep(1); \
    if ((++_sp & 255u) == 0u) { if (xb_ld(&(bar)[XB_TMO])) break; if (_sp > XB_SPIN_CAP) { atomicAdd(&(bar)[XB_TMO], 1u); break; } } } } while (0)
struct XcdBarrier { unsigned* bar; unsigned x; volatile LAS unsigned* st; };
__device__ __forceinline__ XcdBarrier xcd_barrier_post(unsigned* bar, volatile LAS unsigned* st) {
    XcdBarrier b; b.bar = bar; b.x = xb_xcc_id(); b.st = st;
    if (threadIdx.x == 0) (void)xb_add(&bar[XB_XCNT(b.x)], 1u);
    return b;
}
__device__ __forceinline__ void xcd_barrier_complete(unsigned* bar, unsigned x, unsigned& nloc, unsigned& nx) {
    const unsigned G = gridDim.x * gridDim.y * gridDim.z;
    unsigned sum, cnt, mine, sp = 0u;
    for (;;) {
        sum = 0u; cnt = 0u; mine = 0u;
#pragma unroll
        for (unsigned j = 0; j < 16; ++j) { const unsigned c = xb_ld(&bar[XB_XCNT(j)]); sum += c; cnt += (c > 0u) ? 1u : 0u; mine = (j == x) ? c : mine; }
        if (sum == G) break;
        __builtin_amdgcn_s_sleep(1);
        if ((++sp & 255u) == 0u) { if (xb_ld(&bar[XB_TMO])) break; if (sp > XB_SPIN_CAP) { atomicAdd(&bar[XB_TMO], 1u); break; } }
    }
    nloc = mine > 0u ? mine : 1u; nx = cnt > 0u ? cnt : 1u;
}
__device__ __forceinline__ void xcd_barrier(const XcdBarrier& b) {
    asm volatile("s_waitcnt vmcnt(0)" ::: "memory");
    __syncthreads();
    if (threadIdx.x == 0) {
        unsigned* bar = b.bar;
        __builtin_amdgcn_s_waitcnt(0);
        unsigned nloc = b.st[0], nx = b.st[1];
        if (nloc == 0u) { xcd_barrier_complete(bar, b.x, nloc, nx); b.st[0] = nloc; b.st[1] = nx; }
        const unsigned old = xb_add(&bar[XB_XSUB(b.x)], 1u);
        const unsigned gen = old / nloc;
        if (old + 1u == (gen + 1u) * nloc) {
            __builtin_amdgcn_fence(__ATOMIC_RELEASE, "agent");
            asm volatile("s_waitcnt vmcnt(0)" ::: "memory");
            const unsigned og = xb_add(&bar[XB_TOP], 1u);
            const unsigned tg = og / nx;
            if (og + 1u == (tg + 1u) * nx) xb_add(&bar[XB_TOPGEN], 1u);
            else XB_SPIN(xb_ld(&bar[XB_TOPGEN]) == tg, bar);
            __builtin_amdgcn_fence(__ATOMIC_ACQUIRE, "agent");
            xb_add(&bar[XB_XGEN(b.x)], 1u);
            asm volatile("s_waitcnt vmcnt(0)" ::: "memory");
        } else {
            XB_SPIN(xb_ld(&bar[XB_XGEN(b.x)]) == gen, bar);
            __builtin_amdgcn_fence(__ATOMIC_ACQUIRE, "agent");
            asm volatile("s_waitcnt vmcnt(0)" ::: "memory");
        }
    }
    __syncthreads();
}

__host__ __device__ __forceinline__ int lds_byte(int r, int c) { const int st = (r >> 4) * 2 + (c >> 5), rr = r & 15, cc = c & 31, ob = rr * 64 + cc * 2; return st * 1024 + (ob ^ (((ob >> 9) & 1) << 5)); }
__host__ __device__ __forceinline__ void stage_rc(int b, int& R, int& C) { const int st = b / 1024, sb = b % 1024, swz = sb ^ (((sb >> 9) & 1) << 5); R = (st >> 1) * 16 + swz / 64; C = (st & 1) * 32 + (swz % 64) / 2; }
__host__ __device__ __forceinline__ int perm32(int rho) { const int n = rho >> 4, i = rho & 15; return 8 * (i >> 2) + 4 * n + (i & 3); }

struct Unit { int arow, brow, orow, ocol; };

template <class Epi, class Sched, bool GATHER>
__device__ __forceinline__ void gemm_phase(LAS unsigned char* lds, const bf16_t* Abase, const bf16_t* Btbase, const int K, const Sched& S, const Epi& E) {
    const int tid = threadIdx.x, wid = __builtin_amdgcn_readfirstlane(tid >> 6), lane = tid & 63, wr = wid >> 2, wc = wid & 3, fr = lane & 15, fq = lane >> 4;
    const int nt = K / BK;
    unsigned voffA[2], voffB[2];
#pragma unroll
    for (int i = 0; i < 2; ++i) { int R, C; stage_rc(tid * 16 + i * 8192, R, C); const int Rb = Epi::PERM ? ((R & ~31) + perm32(R & 31)) : R;
        voffA[i] = (unsigned)(R * K + C) * 2u; voffB[i] = (unsigned)(Rb * K + C) * 2u; }
    const size_t kstep = (size_t)(BK * 2);
    const size_t hstep = (size_t)HALF * K * 2;
    const unsigned ldsw = (unsigned)wid * 1024u;
    const int aoff = lds_byte(wr * 64 + fr, fq * 8), boff = lds_byte(wc * 32 + fr, fq * 8);
    LAS const int* gtab = (LAS const int*)(lds + GTAB_OFF);
    unsigned goff[2][2];
#define PG8_SA(b, h) (((b) * 2 + (h)) * HTB)
#define PG8_SB(b, h) ((4 + (b) * 2 + (h)) * HTB)
#define PG8_STAGE(bufoff, gbase, voff) do { _Pragma("unroll") for (int _i = 0; _i < 2; ++_i) \
        __builtin_amdgcn_global_load_lds((const unsigned*)((const char*)(gbase) + (voff)[_i]), (LAS unsigned*)(lds + (bufoff) + ldsw + _i * 8192), 16, 0, 0); } while (0)
#define PG8_STAGE_A(bufoff, abase, h) do { if constexpr (GATHER) { PG8_STAGE(bufoff, abase, goff[h]); } else { PG8_STAGE(bufoff, (abase) + (h) * hstep, voffA); } } while (0)
#define PG8_LDA(dst, b, h) do { _Pragma("unroll") for (int m = 0; m < 4; ++m) _Pragma("unroll") for (int k = 0; k < 2; ++k) dst[m][k] = *(const LAS bf16x8*)(lds + PG8_SA(b, h) + aoff + m * 2048 + k * 1024); } while (0)
#define PG8_LDB(dst, b, h) do { _Pragma("unroll") for (int n = 0; n < 2; ++n) _Pragma("unroll") for (int k = 0; k < 2; ++k) dst[n][k] = *(const LAS bf16x8*)(lds + PG8_SB(b, h) + boff + n * 2048 + k * 1024); } while (0)
#define PG8_MMA(ai, bj, At, Bt) do { __builtin_amdgcn_s_setprio(1); _Pragma("unroll") for (int m = 0; m < 4; ++m) _Pragma("unroll") for (int n = 0; n < 2; ++n) _Pragma("unroll") for (int k = 0; k < 2; ++k) \
        acc[ai][bj][m][n] = __builtin_amdgcn_mfma_f32_16x16x32_bf16(Bt[n][k], At[m][k], acc[ai][bj][m][n], 0, 0, 0); __builtin_amdgcn_s_setprio(0); } while (0)
#define PG8_WAIT_V(n) asm volatile("s_waitcnt vmcnt(" #n ")" ::: "memory")
#define PG8_WAIT_L(n) asm volatile("s_waitcnt lgkmcnt(" #n ")" ::: "memory")
#define PG8_BAR __builtin_amdgcn_s_barrier()
#define PG8_SCHED __builtin_amdgcn_sched_barrier(0)
#define PG8_GLOAD(ui_) do { if constexpr (GATHER) { _Pragma("unroll") for (int _i = 0; _i < 2; ++_i) { int _R, _C; stage_rc(tid * 16 + _i * 8192, _R, _C); _Pragma("unroll") for (int _h = 0; _h < 2; ++_h) \
        goff[_h][_i] = (unsigned)(gtab[((ui_) & 3) * 256 + _h * HALF + _R] * K * 2 + _C * 2); } } } while (0)
    Unit cur, nxt; int ui = 0;
    if (!S.next(0, cur)) return;
    if constexpr (GATHER) {
        Unit t;
        for (int j = 0; j < 4; ++j) if (S.next(j, t)) { if (tid < 256) ((LAS int*)(lds + GTAB_OFF))[j * 256 + tid] = S.gidx(t, tid); }
        __syncthreads();
    }
    f32x4 acc[2][2][4][2];
#pragma unroll
    for (int a = 0; a < 2; ++a)
#pragma unroll
        for (int b = 0; b < 2; ++b)
#pragma unroll
            for (int m = 0; m < 4; ++m)
#pragma unroll
                for (int n = 0; n < 2; ++n) acc[a][b][m][n] = (f32x4){0.f, 0.f, 0.f, 0.f};
    bf16x8 At[4][2], B0[2][2], B1[2][2];
    const char* cA = (const char*)Abase + (size_t)cur.arow * K * 2; const char* cB = (const char*)Btbase + (size_t)cur.brow * K * 2;
    PG8_GLOAD(0);
    PG8_STAGE(PG8_SB(0, 0), cB, voffB); PG8_STAGE(PG8_SB(0, 1), cB + hstep, voffB); PG8_STAGE_A(PG8_SA(0, 0), cA, 0); PG8_STAGE_A(PG8_SA(0, 1), cA, 1);
    if (wr == 1) PG8_BAR;
    PG8_WAIT_V(2); PG8_BAR;
    PG8_STAGE(PG8_SB(1, 0), cB + kstep, voffB); PG8_STAGE_A(PG8_SA(1, 0), cA + kstep, 0); PG8_STAGE(PG8_SB(1, 1), cB + hstep + kstep, voffB);
    PG8_WAIT_V(6); PG8_BAR;
    for (;;) {
        const bool has_next = S.next(ui + 1, nxt);
        const char* nA = has_next ? (const char*)Abase + (size_t)nxt.arow * K * 2 : cA; const char* nB = has_next ? (const char*)Btbase + (size_t)nxt.brow * K * 2 : cB;
        for (int t = 0; t < nt; t += 2) {
            const bool last = (t == nt - 2);
            const char* a1 = cA + (size_t)(t + 1) * kstep;
            const char* a2 = last ? nA : cA + (size_t)(t + 2) * kstep; const char* b2 = last ? nB : cB + (size_t)(t + 2) * kstep;
            const char* a3 = a2 + kstep; const char* b3 = b2 + kstep;
            PG8_LDB(B0, 0, 0); PG8_LDB(B1, 0, 1); PG8_SCHED; PG8_LDA(At, 0, 0); PG8_STAGE_A(PG8_SA(1, 1), a1, 1);
            if constexpr (GATHER) { if (last && has_next) PG8_GLOAD(ui + 1); }
            PG8_WAIT_V(8); PG8_WAIT_L(0); PG8_BAR; PG8_MMA(0, 0, At, B0); PG8_MMA(0, 1, At, B1); PG8_BAR; PG8_SCHED;
            PG8_LDA(At, 0, 1); PG8_STAGE(PG8_SB(0, 0), b2, voffB); PG8_STAGE(PG8_SB(0, 1), b2 + hstep, voffB); PG8_STAGE_A(PG8_SA(0, 0), a2, 0);
            PG8_WAIT_V(8); PG8_WAIT_L(0); PG8_BAR; PG8_MMA(1, 0, At, B0); PG8_MMA(1, 1, At, B1); PG8_BAR; PG8_SCHED;
            PG8_LDB(B0, 1, 0); PG8_LDB(B1, 1, 1); PG8_SCHED; PG8_LDA(At, 1, 0); PG8_STAGE_A(PG8_SA(0, 1), a2, 1);
            PG8_WAIT_V(8); PG8_WAIT_L(0); PG8_BAR; PG8_MMA(0, 0, At, B0); PG8_MMA(0, 1, At, B1); PG8_BAR; PG8_SCHED;
            PG8_LDA(At, 1, 1); PG8_STAGE(PG8_SB(1, 0), b3, voffB); PG8_STAGE(PG8_SB(1, 1), b3 + hstep, voffB); PG8_STAGE_A(PG8_SA(1, 0), a3, 0);
            PG8_WAIT_V(8); PG8_WAIT_L(0); PG8_BAR; PG8_MMA(1, 0, At, B0); PG8_MMA(1, 1, At, B1); PG8_BAR; PG8_SCHED;
        }
        if (wr == 0) PG8_BAR;
        E(acc, cur, wr, wc, fr, fq);
        if (!has_next) break;
#pragma unroll
        for (int a = 0; a < 2; ++a)
#pragma unroll
            for (int b = 0; b < 2; ++b)
#pragma unroll
                for (int m = 0; m < 4; ++m)
#pragma unroll
                    for (int n = 0; n < 2; ++n) acc[a][b][m][n] = (f32x4){0.f, 0.f, 0.f, 0.f};
        cur = nxt; cA = nA; cB = nB; ++ui;
        if (wr == 1) PG8_BAR;
    }
    PG8_WAIT_V(0);
    PG8_BAR;
#undef PG8_SA
#undef PG8_SB
#undef PG8_STAGE
#undef PG8_STAGE_A
#undef PG8_LDA
#undef PG8_LDB
#undef PG8_MMA
#undef PG8_WAIT_V
#undef PG8_WAIT_L
#undef PG8_BAR
#undef PG8_SCHED
#undef PG8_GLOAD
}

__device__ __forceinline__ float silu1(float x) { return x * __builtin_amdgcn_rcpf(1.f + __expf(-x)); }
struct EpiSiluMul {
    static constexpr bool PERM = true;
    bf16_t* O; int ldo;
    __device__ __forceinline__ void operator()(const f32x4 (&acc)[2][2][4][2], const Unit& u, int wr, int wc, int fr, int fq) const {
        const int row0 = u.orow + wr * 64 + fr, col0 = u.ocol + wc * 32 + 8 * fq;
#pragma unroll
        for (int ai = 0; ai < 2; ++ai)
#pragma unroll
            for (int m = 0; m < 4; ++m) { bf16_t* rowp = O + (size_t)(row0 + ai * HALF + m * 16) * ldo + col0;
                const f32x4 g0 = acc[ai][0][m][0], g1 = acc[ai][0][m][1], u0 = acc[ai][1][m][0], u1 = acc[ai][1][m][1];
                u32x4 w; w.x = cvt_pk_bf16(silu1(g0[0]) * u0[0], silu1(g0[1]) * u0[1]); w.y = cvt_pk_bf16(silu1(g0[2]) * u0[2], silu1(g0[3]) * u0[3]);
                w.z = cvt_pk_bf16(silu1(g1[0]) * u1[0], silu1(g1[1]) * u1[1]); w.w = cvt_pk_bf16(silu1(g1[2]) * u1[2], silu1(g1[3]) * u1[3]);
                *(u32x4*)rowp = w; }
    }
};
struct EpiRowScale {
    static constexpr bool PERM = true;
    bf16_t* O; int ldo; const float* rowscale;
    __device__ __forceinline__ void operator()(const f32x4 (&acc)[2][2][4][2], const Unit& u, int wr, int wc, int fr, int fq) const {
        const int row0 = u.orow + wr * 64 + fr, col0 = u.ocol + wc * 32 + 8 * fq;
#pragma unroll
        for (int ai = 0; ai < 2; ++ai)
#pragma unroll
            for (int m = 0; m < 4; ++m) { const int row = row0 + ai * HALF + m * 16; const float sc = rowscale[row]; bf16_t* rowp = O + (size_t)row * ldo + col0;
#pragma unroll
                for (int bj = 0; bj < 2; ++bj) { const f32x4 v0 = acc[ai][bj][m][0] * sc, v1 = acc[ai][bj][m][1] * sc;
                    u32x4 w; w.x = cvt_pk_bf16(v0[0], v0[1]); w.y = cvt_pk_bf16(v0[2], v0[3]); w.z = cvt_pk_bf16(v1[0], v1[1]); w.w = cvt_pk_bf16(v1[2], v1[3]);
                    *(u32x4*)(rowp + bj * HALF) = w; } }
    }
};

constexpr size_t MiB = 1u << 20;
constexpr size_t WS_CTL = 0;
constexpr size_t WS_ADA = 1 * MiB;
constexpr size_t WS_AFF = 2 * MiB;
constexpr size_t WS_IDX = 4 * MiB;
constexpr size_t WS_GATE = 4 * MiB + 512 * 1024;
constexpr size_t WS_SEL = 5 * MiB;
constexpr size_t WS_WGU = 8 * MiB;
constexpr size_t WS_WDN = 72 * MiB;
constexpr size_t WS_TMP = 112 * MiB;
constexpr size_t WS_ACT = WS_TMP;
constexpr size_t WS_HID = WS_TMP + 64 * MiB;
constexpr size_t WS_Y = WS_TMP + 128 * MiB;
constexpr size_t WS_END = WS_TMP + 400 * MiB;
constexpr int CW_BAR = 4096;

struct Args {
    const float* in[24]; float* out; unsigned char* ws; int ph_lo, ph_hi, li, pad;
};

struct Frame {
    LAS unsigned char* lds; int tid, lane, wave, G, vcu;
};

__device__ __forceinline__ void transpose_item(const float* W, int K, int ldn, int n0, int k0, bf16_t* WT, int drow0, LAS float* scr, int lane) {
#pragma unroll 8
    for (int i = 0; i < 32; ++i) { const int kk = 2 * i + (lane >> 5); scr[kk * 33 + (lane & 31)] = W[(size_t)(k0 + kk) * ldn + n0 + (lane & 31)]; }
    asm volatile("s_waitcnt lgkmcnt(0)" ::: "memory");
    const int c = lane & 7;
#pragma unroll
    for (int j = 0; j < 4; ++j) { const int n = (lane >> 3) + 8 * j; const LAS float* s = scr + (8 * c) * 33 + n;
        u32x4 o; o.x = pk2(s[0 * 33], s[1 * 33]); o.y = pk2(s[2 * 33], s[3 * 33]); o.z = pk2(s[4 * 33], s[5 * 33]); o.w = pk2(s[6 * 33], s[7 * 33]);
        *(u32x4*)(WT + (size_t)(drow0 + n) * K + k0 + 8 * c) = o; }
    asm volatile("s_waitcnt lgkmcnt(0)" ::: "memory");
}

struct SchedMoeUp {
    int vcu, layer; const int* idx;
    __device__ __forceinline__ bool next(int i, Unit& u) const {
        const int L = i * 256 + vcu; if (L >= 1024) return false;
        const int g = L >> 4, pm = (L >> 2) & 3, pn = L & 3, b = g >> 4, e = g & 15;
        u.arow = b * SEQ; u.brow = ((layer * NE + e) * 4 + pn) * 256; u.orow = g * CAP + pm * 256; u.ocol = pn * 128;
        return true;
    }
    __device__ __forceinline__ int gidx(const Unit& u, int r) const { return idx[u.orow + r]; }
};
struct SchedMoeDown {
    int vcu, layer;
    __device__ __forceinline__ bool next(int i, Unit& u) const {
        const int L = i * 256 + vcu; if (L >= 1024) return false;
        const int g = L >> 4, pm = (L >> 2) & 3, pn = L & 3, e = g & 15;
        u.arow = g * CAP + pm * 256; u.brow = ((layer * NE + e) * 4 + pn) * 256; u.orow = g * CAP + pm * 256; u.ocol = pn * 256;
        return true;
    }
    __device__ __forceinline__ int gidx(const Unit&, int) const { return 0; }
};

__device__ __forceinline__ float wsum(float v) {
#pragma unroll
    for (int o = 1; o < 64; o <<= 1) v += __shfl_xor(v, o);
    return v;
}

__device__ __forceinline__ void ph_norm_router(const Frame& F, const float* xl, bf16_t* act, const float* gw, const float* ada  , const float* router, float* aff) {
    LAS float* rt = (LAS float*)F.lds;
    for (int i = F.tid; i < D * NE; i += NTHREADS) { const int k = i >> 4, e = i & 15; rt[e * D + k] = router[i]; }
    __syncthreads();
    const int gw_ = F.vcu * NWAVES + F.wave, NGW = F.G * NWAVES;
    for (int r = gw_; r < M_LAT; r += NGW) {
        const int b = r >> 13, t = r & (SEQ - 1);
        const float* sh = ada + (size_t)b * 6 * D + 3 * D; const float* sc = sh + D;
        const f32x4* xr = (const f32x4*)(xl + (size_t)r * D) + F.lane;
        f32x4 v[4]; float s = 0.f;
#pragma unroll
        for (int j = 0; j < 4; ++j) { v[j] = xr[64 * j]; s += (v[j].x * v[j].x + v[j].y * v[j].y) + (v[j].z * v[j].z + v[j].w * v[j].w); }
        const float rs = rsqrtf(wsum(s) * (1.f / D) + EPS);
        unsigned long long* o8 = (unsigned long long*)(act + (size_t)r * D) + F.lane;
#pragma unroll
        for (int j = 0; j < 4; ++j) { const int c = 256 * j + 4 * F.lane;
            const f32x4 g4 = *(const f32x4*)(gw + c), s4 = *(const f32x4*)(sc + c), h4 = *(const f32x4*)(sh + c);
            v[j] = v[j] * rs * g4 * (s4 + 1.f) + h4;
            o8[64 * j] = (unsigned long long)pk2(v[j].x, v[j].y) | ((unsigned long long)pk2(v[j].z, v[j].w) << 32); }
        float lg[16];
#pragma unroll
        for (int eg = 0; eg < 4; ++eg) {
#pragma unroll
            for (int e2 = 0; e2 < 4; ++e2) { const int e = eg * 4 + e2; float a = 0.f;
#pragma unroll
                for (int j = 0; j < 4; ++j) { const f32x4 w4 = *(const LAS f32x4*)(rt + e * D + 256 * j + 4 * F.lane); a += (v[j].x * w4.x + v[j].y * w4.y) + (v[j].z * w4.z + v[j].w * w4.w); }
                lg[e] = wsum(a); }
            asm volatile("" ::: "memory");
        }
        float mx = lg[0];
#pragma unroll
        for (int e = 1; e < 16; ++e) mx = fmaxf(mx, lg[e]);
        float sum = 0.f;
#pragma unroll
        for (int e = 0; e < 16; ++e) { lg[e] = __expf(lg[e] - mx); sum += lg[e]; }
        if (F.lane < 16) { float x = lg[0];
#pragma unroll
            for (int e = 1; e < 16; ++e) x = (F.lane == e) ? lg[e] : x;
            aff[((size_t)b * NE + F.lane) * SEQ + t] = x / sum; }
    }
    __syncthreads();
}

__device__ __forceinline__ void ph_topk(const Frame& F, const float* aff, int* idx, float* gate, int* sel) {
    LAS unsigned* keys = (LAS unsigned*)F.lds;
    LAS unsigned* hist = keys + SEQ;
    LAS unsigned* cg = hist + 256; LAS unsigned* ce = cg + 512;
    LAS unsigned* shv = ce + 512;
    const int tid = F.tid;
    for (int item = F.vcu; item < BATCH * NE; item += F.G) {
        const int b = item >> 4, e = item & 15;
        for (int i = tid; i < SEQ; i += NTHREADS) keys[i] = __float_as_uint(aff[(size_t)item * SEQ + i]);
        if (tid == 0) { shv[0] = 0u; shv[1] = CAP; }
        __syncthreads();
        unsigned mask = 0u;
        for (int pass = 0; pass < 4; ++pass) {
            const int shift = 24 - 8 * pass;
            if (tid < 256) hist[tid] = 0u;
            __syncthreads();
            const unsigned prefix = shv[0];
            for (int i = tid; i < SEQ; i += NTHREADS) { const unsigned kx = keys[i]; if ((kx & mask) == prefix) __hip_atomic_fetch_add(&hist[(kx >> shift) & 255u], 1u, __ATOMIC_RELAXED, __HIP_MEMORY_SCOPE_WORKGROUP); }
            __syncthreads();
            if (tid == 0) { unsigned need = shv[1], cum = 0u; int bin = 255;
                for (; bin > 0; --bin) { const unsigned hb = hist[bin]; if (cum + hb >= need) break; cum += hb; }
                shv[0] = prefix | ((unsigned)bin << shift); shv[1] = need - cum; }
            mask |= 0xFFu << shift;
            __syncthreads();
        }
        const unsigned T = shv[0], need = shv[1];
        unsigned ng = 0u, nq = 0u;
        for (int j = 0; j < 16; ++j) { const unsigned kx = keys[tid * 16 + j]; ng += kx > T; nq += kx == T; }
        cg[tid] = ng; ce[tid] = nq;
        __syncthreads();
        if (tid == 0) { unsigned a = 0u, c2 = 0u; for (int i = 0; i < 512; ++i) { const unsigned x = cg[i], y = ce[i]; cg[i] = a; ce[i] = c2; a += x; c2 += y; } }
        __syncthreads();
        unsigned g0 = cg[tid], q0 = ce[tid];
        for (int j = 0; j < 16; ++j) { const int t = tid * 16 + j; const unsigned kx = keys[t]; int slot = -1;
            if (kx > T) { slot = (int)(g0 + (q0 < need ? q0 : need)); ++g0; }
            else if (kx == T) { if (q0 < need) slot = (int)(g0 + q0); ++q0; }
            sel[((size_t)b * SEQ + t) * NE + e] = slot;
            if (slot >= 0) { idx[item * CAP + slot] = t; gate[item * CAP + slot] = __uint_as_float(kx); } }
        __syncthreads();
    }
}

template <bool FINAL>
__device__ __forceinline__ void ph_combine(const Frame& F, float* xl, const bf16_t* y, const int* sel, const float* ada  , const float* gwn, const float* ada_next, bf16_t* act) {
    const int gw_ = F.vcu * NWAVES + F.wave, NGW = F.G * NWAVES;
    for (int r = gw_; r < M_LAT; r += NGW) {
        const int b = r >> 13;
        const int myslot = F.lane < NE ? sel[(size_t)r * NE + F.lane] : -1;
        f32x4 a[4];
#pragma unroll
        for (int j = 0; j < 4; ++j) a[j] = (f32x4){0.f, 0.f, 0.f, 0.f};
        for (int e = 0; e < NE; ++e) {
            const int s = __builtin_amdgcn_readlane(myslot, e);
            if (s < 0) continue;
            const u32x2* yr = (const u32x2*)(y + ((size_t)(b * NE + e) * CAP + s) * D) + F.lane;
#pragma unroll
            for (int j = 0; j < 4; ++j) { const u32x2 w = yr[64 * j]; a[j].x += bf_lo(w.x); a[j].y += bf_hi(w.x); a[j].z += bf_lo(w.y); a[j].w += bf_hi(w.y); }
        }
        const float* g2 = ada + (size_t)b * 6 * D + 5 * D;
        f32x4* xr = (f32x4*)(xl + (size_t)r * D) + F.lane;
        f32x4 v[4]; float s = 0.f;
#pragma unroll
        for (int j = 0; j < 4; ++j) { const f32x4 g4 = *(const f32x4*)(g2 + 256 * j + 4 * F.lane); v[j] = xr[64 * j] + g4 * a[j];
            s += (v[j].x * v[j].x + v[j].y * v[j].y) + (v[j].z * v[j].z + v[j].w * v[j].w); }
        const float rs = rsqrtf(wsum(s) * (1.f / D) + EPS);
        if constexpr (FINAL) {
#pragma unroll
            for (int j = 0; j < 4; ++j) { const f32x4 g4 = *(const f32x4*)(gwn + 256 * j + 4 * F.lane); xr[64 * j] = v[j] * rs * g4; }
        } else {
            const float* sh = ada_next + (size_t)b * 6 * D; const float* sc = sh + D;
            unsigned long long* o8 = (unsigned long long*)(act + (size_t)r * D) + F.lane;
#pragma unroll
            for (int j = 0; j < 4; ++j) { const int c = 256 * j + 4 * F.lane; xr[64 * j] = v[j];
                const f32x4 g4 = *(const f32x4*)(gwn + c), s4 = *(const f32x4*)(sc + c), h4 = *(const f32x4*)(sh + c);
                const f32x4 o = v[j] * rs * g4 * (s4 + 1.f) + h4;
                o8[64 * j] = (unsigned long long)pk2(o.x, o.y) | ((unsigned long long)pk2(o.z, o.w) << 32); }
        }
    }
}

enum { PH_PREP = 0, PH_M1_0, PH_M2_0, PH_M3_0, PH_M4_0, PH_M5_0, PH_M1_1, PH_M2_1, PH_M3_1, PH_M4_1, PH_M5_1, PH_COUNT };

__global__ void __launch_bounds__(NTHREADS, 2) mega(Args args) {
    extern __shared__ __attribute__((aligned(16))) unsigned char lds_raw[];
    Frame F;
    F.lds = (LAS unsigned char*)lds_raw;
    F.tid = threadIdx.x; F.lane = F.tid & 63; F.wave = __builtin_amdgcn_readfirstlane(F.tid >> 6);
    F.G = gridDim.x; { const int bx = blockIdx.x; F.vcu = (F.G % 8 == 0) ? (bx % 8) * (F.G / 8) + bx / 8 : bx; }
    volatile LAS unsigned* MISC = (volatile LAS unsigned*)(F.lds + MISC_OFF);
    if (F.tid < 64) MISC[F.tid] = 0u;
    __syncthreads();
    unsigned char* ws = args.ws;
    XcdBarrier bar = xcd_barrier_post((unsigned*)(ws + WS_CTL) + CW_BAR + args.li * XCD_BAR_WORDS, MISC + 8);
    const int lo = args.ph_lo, hi = args.ph_hi;
#define IN(k) (lo <= (k) && (k) < hi)
#define SEAM(k) do { if (IN(k) && IN((k) + 1)) xcd_barrier(bar); } while (0)
    const float* ADA = (const float*)(ws + WS_ADA);
    float* AFF = (float*)(ws + WS_AFF); int* IDX = (int*)(ws + WS_IDX); float* GATE = (float*)(ws + WS_GATE); int* SEL = (int*)(ws + WS_SEL);
    bf16_t* WGU = (bf16_t*)(ws + WS_WGU); bf16_t* WDN = (bf16_t*)(ws + WS_WDN);
    bf16_t* ACT = (bf16_t*)(ws + WS_ACT); bf16_t* HID = (bf16_t*)(ws + WS_HID); bf16_t* Y = (bf16_t*)(ws + WS_Y);
    float* xl = args.out;

    if (IN(PH_PREP)) {
        LAS float* scr = (LAS float*)(F.lds + F.wave * 16384);
        const int gw_ = F.vcu * NWAVES + F.wave, NGW = F.G * NWAVES;
        const float* w_gate = args.in[21]; const float* w_up = args.in[22]; const float* w_down = args.in[23];
        for (int it = gw_; it < 2 * NE * 768; it += NGW) {
            const int le = it / 768, r = it % 768;
            if (r < 512) { const int up = r >> 8, q = r & 255, kb = q >> 4, nb = q & 15, n0 = 32 * nb;
                transpose_item((up ? w_up : w_gate) + (size_t)le * D * DE, D, DE, n0, 64 * kb, WGU + (size_t)le * 1024 * D, (n0 >> 7) * 256 + up * 128 + (n0 & 127), scr, F.lane); }
            else { const int q = r - 512, kb = q >> 5, nb = q & 31;
                transpose_item(w_down + (size_t)le * DE * D, DE, D, 32 * nb, 64 * kb, WDN + (size_t)le * D * DE, 32 * nb, scr, F.lane); }
        }
    }
    SEAM(PH_PREP);
#define MOE_SEGMENT(l, p0) do { \
        const float* ada_l = ADA + (size_t)(l) * 5 * 6 * D; \
        if (IN(p0)) ph_norm_router(F, xl, ACT, args.in[7] + (l) * D, ada_l, args.in[20] + (size_t)(l) * D * NE, AFF); \
        SEAM(p0); \
        if (IN((p0) + 1)) ph_topk(F, AFF, IDX, GATE, SEL); \
        SEAM((p0) + 1); \
        if (IN((p0) + 2)) { SchedMoeUp S{F.vcu, (l), IDX}; EpiSiluMul E{HID, DE}; gemm_phase<EpiSiluMul, SchedMoeUp, true>(F.lds, ACT, WGU, D, S, E); } \
        SEAM((p0) + 2); \
        if (IN((p0) + 3)) { SchedMoeDown S{F.vcu, (l)}; EpiRowScale E{Y, D, GATE}; gemm_phase<EpiRowScale, SchedMoeDown, false>(F.lds, HID, WDN, DE, S, E); } \
        SEAM((p0) + 3); \
        if (IN((p0) + 4)) { \
            if ((l) == 0) ph_combine<false>(F, xl, Y, SEL, ada_l, args.in[6] + D, ADA + (size_t)5 * 6 * D, ACT); \
            else ph_combine<true>(F, xl, Y, SEL, ada_l, args.in[8], nullptr, nullptr); \
        } \
    } while (0)
    MOE_SEGMENT(0, PH_M1_0);
    SEAM(PH_M5_0);
    MOE_SEGMENT(1, PH_M1_1);
#undef MOE_SEGMENT
#undef IN
#undef SEAM
}
}

}

extern "C" void kernel_launch(void* const* d_in, const int* in_sizes, int n_in, void* d_out, int out_size, void* d_ws, size_t ws_size, hipStream_t st) {
    const float* x = (const float*)d_in[0]; const float* c = (const float*)d_in[1]; const float* ctx = (const float*)d_in[2]; const float* c_ctx = (const float*)d_in[3];
    const float* ada_w = (const float*)d_in[4]; const float* ada_b = (const float*)d_in[5]; const float* norm_mix = (const float*)d_in[6]; const float* norm_ffn = (const float*)d_in[7];
    const float* norm_final = (const float*)d_in[8]; const float* ev_w_in = (const float*)d_in[9]; const float* dn_conv = (const float*)d_in[10]; const float* dn_a_log = (const float*)d_in[11];
    const float* dn_dt_bias = (const float*)d_in[12]; const float* dn_norm = (const float*)d_in[13]; const float* pool_w = (const float*)d_in[14]; const float* pool_scale = (const float*)d_in[15];
    const float* ev_w_out = (const float*)d_in[16]; const float* sc_w_in = (const float*)d_in[17]; const float* sc_conv = (const float*)d_in[18]; const float* sc_w_out = (const float*)d_in[19];
    const float* router = (const float*)d_in[20]; const float* w_gate = (const float*)d_in[21]; const float* w_up = (const float*)d_in[22]; const float* w_down = (const float*)d_in[23];
    (void)norm_final;
    float* out = (float*)d_out;
    static int grid = 0;
    if (grid == 0) {
        int dev = 0, cus = 0;
        if (hipGetDevice(&dev) != hipSuccess || hipDeviceGetAttribute(&cus, hipDeviceAttributeMultiprocessorCount, dev) != hipSuccess) { grid = -1; return; }
        if (hipFuncSetAttribute((const void*)mk::mega, hipFuncAttributeMaxDynamicSharedMemorySize, mk::LDS_BYTES) != hipSuccess) { fprintf(stderr, "hipFuncSetAttribute failed\n"); grid = -1; return; }
        if (ws_size < mk::WS_END) { fprintf(stderr, "workspace too small: %zu < %zu\n", ws_size, (size_t)mk::WS_END); grid = -1; return; }
        grid = cus;
    }
    if (grid < 0) return;
    (void)hipMemsetAsync((char*)d_ws + mk::WS_CTL, 0, mk::MiB, st);
    float* ws = (float*)((char*)d_ws + mk::WS_TMP);
    size_t off = 0;
    auto take = [&](size_t n) { float* p = ws + off; off += (n + 63) & ~(size_t)63; return p; };
    float* ADA = (float*)((char*)d_ws + mk::WS_ADA);
    float* H = take((size_t)SEQ * D); float* HC = take((size_t)CTX * D);
    float* R1 = take((size_t)SEQ * 3072);
    float* PROJC = take((size_t)CTX * EVEN_IN);
    float* R2 = take((size_t)SEQ * 512 * 5);
    float* QC = take((size_t)CTX * 512 * 3);
    float* BETA = take(8 * SEQ); float* ALPHA = take(8 * SEQ); float* BETAC = take(8 * CTX); float* ALPHAC = take(8 * CTX);
    float* PF = take((size_t)SEQ * 512); float* AM = take((size_t)SEQ * D); float* Y = take((size_t)SEQ * D);
    float* AFF = take((size_t)NE * SEQ); int* IDX = (int*)take(NE * CAP); float* GATE = take(NE * CAP); int* SEL = (int*)take((size_t)SEQ * NE);
    float *Q = R2, *K = R2 + (size_t)SEQ * 512, *V = R2 + (size_t)SEQ * 1024, *OF = R2 + (size_t)SEQ * 1536, *OB = R2 + (size_t)SEQ * 2048;
    float *G = R2, *U = R2 + (size_t)NE * CAP * DE, *YE = R1;
    if (off * 4 + mk::WS_TMP > mk::WS_END) { fprintf(stderr, "naive temporaries too large\n"); return; }

    mk::Args a{};
    for (int i = 0; i < 24; ++i) a.in[i] = (const float*)d_in[i];
    a.out = out; a.ws = (unsigned char*)d_ws;
    int n_mega = 0;
    auto mega = [&](int lo, int hi) { a.ph_lo = lo; a.ph_hi = hi; a.li = n_mega++; hipLaunchKernelGGL(mk::mega, dim3(grid), dim3(mk::NTHREADS), mk::LDS_BYTES, st, a); };

    (void)hipMemcpyAsync(out, x, (size_t)BATCH * SEQ * D * 4, hipMemcpyDeviceToDevice, st);
    hipLaunchKernelGGL(k_ada, dim3(6 * D / 256, 5, 2), dim3(256), 0, st, c, c_ctx, ada_w, ada_b, ADA);
    mega(mk::PH_PREP, mk::PH_PREP + 1);
    auto mixer = [&](int b, int l) {
        float* xl = out + (size_t)b * SEQ * D;
        const float* ad = ADA + ((size_t)l * 5 + b) * 6 * D; const float* adc = ADA + ((size_t)l * 5 + 4) * 6 * D;
        hipLaunchKernelGGL(k_norm_mod, dim3(1024), dim3(256), 0, st, xl, H, norm_mix + l * D, ad, ad + D, SEQ);
        if (l == 0) {
            hipLaunchKernelGGL(k_norm_mod, dim3(64), dim3(256), 0, st, ctx + (size_t)b * CTX * D, HC, norm_mix, adc, adc + D, CTX);
            gemm(st, H, ev_w_in, R1, SEQ, EVEN_IN, D, D, EVEN_IN, EVEN_IN);
            gemm(st, HC, ev_w_in, PROJC, CTX, EVEN_IN, D, D, EVEN_IN, EVEN_IN);
            hipLaunchKernelGGL(k_conv_qkv, dim3(2048), dim3(256), 0, st, R1, EVEN_IN, SEQ, dn_conv, Q, K, V);
            hipLaunchKernelGGL(k_conv_qkv, dim3(256), dim3(256), 0, st, PROJC, EVEN_IN, CTX, dn_conv, QC, QC + CTX * 512, QC + 2 * CTX * 512);
            hipLaunchKernelGGL(k_gates, dim3(SEQ * 8 / 256), dim3(256), 0, st, R1, EVEN_IN, SEQ, dn_a_log, dn_dt_bias, BETA, ALPHA);
            hipLaunchKernelGGL(k_gates, dim3(CTX * 8 / 256), dim3(256), 0, st, PROJC, EVEN_IN, CTX, dn_a_log, dn_dt_bias, BETAC, ALPHAC);
            hipLaunchKernelGGL(k_delta, dim3(16, 2, NH), dim3(128), 0, st, QC, QC + CTX * 512, QC + 2 * CTX * 512, BETAC, ALPHAC, Q, K, V, BETA, ALPHA, OF, OB);
            hipLaunchKernelGGL(k_even_A, dim3(2048), dim3(256), 0, st, OF, OB, R1, EVEN_IN, dn_norm, AM, PF);
            gemm(st, PF, pool_w, AM + 512, SEQ, 128, 128, 512, 128, D, 4, 128, 128 * 128, 128, nullptr, 0, pool_scale, 128);
            gemm(st, AM, ev_w_out, Y, SEQ, D, D, D, D, D);
        } else {
            gemm(st, H, sc_w_in, R1, SEQ, 3072, D, D, 3072, 3072);
            hipLaunchKernelGGL(k_sc_glue, dim3(SEQ * D / 256), dim3(256), 0, st, R1, sc_conv, AM);
            gemm(st, AM, sc_w_out, Y, SEQ, D, D, D, D, D);
        }
        hipLaunchKernelGGL(k_resid, dim3(SEQ * D / 256), dim3(256), 0, st, xl, Y, ad + 2 * D, SEQ);
    };
    auto moe = [&](int b, int l) {
        float* xl = out + (size_t)b * SEQ * D;
        const float* ad = ADA + ((size_t)l * 5 + b) * 6 * D;
        hipLaunchKernelGGL(k_norm_mod, dim3(1024), dim3(256), 0, st, xl, H, norm_ffn + l * D, ad + 3 * D, ad + 4 * D, SEQ);
        hipLaunchKernelGGL(k_router, dim3(1024), dim3(256), 0, st, H, router + (size_t)l * D * NE, AFF);
        hipLaunchKernelGGL(k_topk, dim3(NE), dim3(512), 0, st, AFF, IDX, GATE, SEL);
        gemm(st, H, w_gate + (size_t)l * NE * D * DE, G, CAP, DE, D, D, DE, DE, NE, 0, (long)D * DE, (long)CAP * DE, IDX, CAP);
        gemm(st, H, w_up + (size_t)l * NE * D * DE, U, CAP, DE, D, D, DE, DE, NE, 0, (long)D * DE, (long)CAP * DE, IDX, CAP);
        hipLaunchKernelGGL(k_silu_mul, dim3(NE * CAP * DE / 256), dim3(256), 0, st, G, U, (size_t)NE * CAP * DE);
        gemm(st, G, w_down + (size_t)l * NE * DE * D, YE, CAP, D, DE, DE, D, D, NE, (long)CAP * DE, (long)DE * D, (long)CAP * D);
        hipLaunchKernelGGL(k_moe_combine, dim3(SEQ), dim3(256), 0, st, xl, YE, SEL, GATE, ad + 5 * D);
    };
    (void)moe;
    for (int b = 0; b < BATCH; ++b) { mixer(b, 0); moe(b, 0); mixer(b, 1); }
    for (int p = mk::PH_M1_1; p <= mk::PH_M5_1; ++p) mega(p, p + 1);
}
```

```cpp
#include <hip/hip_runtime.h>
#include <cstdio>
#include <cstdint>

namespace {
constexpr int D = 1024, BATCH = 4, SEQ = 8192, CTX = 256, NH = 4, DK = 128, DV = 128;
constexpr int EVEN_IN = 2576, NE = 16, DE = 512, CAP = 1024;
constexpr float EPS = 1e-6f;

__device__ __forceinline__ float silu_f(float x) { return x / (1.f + __expf(-x)); }
__device__ __forceinline__ float sigmoid_f(float x) { return 1.f / (1.f + __expf(-x)); }
__device__ __forceinline__ float softplus_f(float x) { return x > 20.f ? x : log1pf(__expf(x)); }
__device__ __forceinline__ float wave_sum(float v) {
#pragma unroll
    for (int o = 1; o < 64; o <<= 1) v += __shfl_xor(v, o);
    return v;
}


namespace mk {
#define LAS __attribute__((address_space(3)))
#define GAS __attribute__((address_space(1)))
typedef unsigned short bf16_t;
typedef short bf16x8 __attribute__((ext_vector_type(8)));
typedef float f32x4 __attribute__((ext_vector_type(4)));
typedef float f32x2 __attribute__((ext_vector_type(2)));
typedef unsigned u32x4 __attribute__((ext_vector_type(4)));
typedef unsigned u32x2 __attribute__((ext_vector_type(2)));
constexpr int M_LAT = BATCH * SEQ;
constexpr int BM = 256, BK = 64, HALF = 128, HTB = HALF * BK * 2, STAGE_BYTES = 8 * HTB;
constexpr int LDS_BYTES = 147456, GTAB_OFF = 131072  , MISC_OFF = 147456 - 256;
constexpr int NTHREADS = 512, NWAVES = 8;

__device__ __forceinline__ unsigned f2bf(float f) { unsigned u = __builtin_bit_cast(unsigned, f); return (u + 0x7fffu + ((u >> 16) & 1u)) >> 16; }
__device__ __forceinline__ unsigned pk2(float lo, float hi) { return f2bf(lo) | (f2bf(hi) << 16); }
__device__ __forceinline__ unsigned cvt_pk_bf16(float lo, float hi) { unsigned r; asm volatile("v_cvt_pk_bf16_f32 %0, %1, %2" : "=v"(r) : "v"(lo), "v"(hi)); return r; }
__device__ __forceinline__ float bf_lo(unsigned w) { return __uint_as_float(w << 16); }
__device__ __forceinline__ float bf_hi(unsigned w) { return __uint_as_float(w & 0xffff0000u); }

#define XB_TMO      128
#define XB_XCNT(j)  (256  + 64 * (j))
#define XB_XSUB(j)  (1280 + 64 * (j))
#define XB_XGEN(j)  (2304 + 64 * (j))
#define XB_TOP      3328
#define XB_TOPGEN   3392
#define XCD_BAR_WORDS 3456
#define XB_SPIN_CAP (1u << 18)
__device__ __forceinline__ unsigned xb_ld(unsigned* p)              { return __hip_atomic_load(p, __ATOMIC_RELAXED, __HIP_MEMORY_SCOPE_AGENT); }
__device__ __forceinline__ unsigned xb_add(unsigned* p, unsigned v) { return __hip_atomic_fetch_add(p, v, __ATOMIC_RELAXED, __HIP_MEMORY_SCOPE_AGENT); }
__device__ __forceinline__ unsigned xb_xcc_id() { return (unsigned)__builtin_amdgcn_s_getreg((3 << 11) | 20) & 0xFu; }
#define XB_SPIN(cond, bar) do { unsigned _sp = 0; while (cond) { __builtin_amdgcn_s_sleep(1); \
    if ((++_sp & 255u) == 0u) { if (xb_ld(&(bar)[XB_TMO])) break; if (_sp > XB_SPIN_CAP) { atomicAdd(&(bar)[XB_TMO], 1u); break; } } } } while (0)
struct XcdBarrier { unsigned* bar; unsigned x; volatile LAS unsigned* st; };
__device__ __forceinline__ XcdBarrier xcd_barrier_post(unsigned* bar, volatile LAS unsigned* st) {
    XcdBarrier b; b.bar = bar; b.x = xb_xcc_id(); b.st = st;
    if (threadIdx.x == 0) (void)xb_add(&bar[XB_XCNT(b.x)], 1u);
    return b;
}
__device__ __forceinline__ void xcd_barrier_complete(unsigned* bar, unsigned x, unsigned& nloc, unsigned& nx) {
    const unsigned G = gridDim.x * gridDim.y * gridDim.z;
    unsigned sum, cnt, mine, sp = 0u;
    for (;;) {
        sum = 0u; cnt = 0u; mine = 0u;
#pragma unroll
        for (unsigned j = 0; j < 16; ++j) { const unsigned c = xb_ld(&bar[XB_XCNT(j)]); sum += c; cnt += (c > 0u) ? 1u : 0u; mine = (j == x) ? c : mine; }
        if (sum == G) break;
        __builtin_amdgcn_s_sleep(1);
        if ((++sp & 255u) == 0u) { if (xb_ld(&bar[XB_TMO])) break; if (sp > XB_SPIN_CAP) { atomicAdd(&bar[XB_TMO], 1u); break; } }
    }
    nloc = mine > 0u ? mine : 1u; nx = cnt > 0u ? cnt : 1u;
}
__device__ __forceinline__ void xcd_barrier(const XcdBarrier& b) {
    asm volatile("s_waitcnt vmcnt(0)" ::: "memory");
    __syncthreads();
    if (threadIdx.x == 0) {
        unsigned* bar = b.bar;
        __builtin_amdgcn_s_waitcnt(0);
        unsigned nloc = b.st[0], nx = b.st[1];
        if (nloc == 0u) { xcd_barrier_complete(bar, b.x, nloc, nx); b.st[0] = nloc; b.st[1] = nx; }
        const unsigned old = xb_add(&bar[XB_XSUB(b.x)], 1u);
        const unsigned gen = old / nloc;
        if (old + 1u == (gen + 1u) * nloc) {
            __builtin_amdgcn_fence(__ATOMIC_RELEASE, "agent");
            asm volatile("s_waitcnt vmcnt(0)" ::: "memory");
            const unsigned og = xb_add(&bar[XB_TOP], 1u);
            const unsigned tg = og / nx;
            if (og + 1u == (tg + 1u) * nx) xb_add(&bar[XB_TOPGEN], 1u);
            else XB_SPIN(xb_ld(&bar[XB_TOPGEN]) == tg, bar);
            __builtin_amdgcn_fence(__ATOMIC_ACQUIRE, "agent");
            xb_add(&bar[XB_XGEN(b.x)], 1u);
            asm volatile("s_waitcnt vmcnt(0)" ::: "memory");
        } else {
            XB_SPIN(xb_ld(&bar[XB_XGEN(b.x)]) == gen, bar);
            __builtin_amdgcn_fence(__ATOMIC_ACQUIRE, "agent");
            asm volatile("s_waitcnt vmcnt(0)" ::: "memory");
        }
    }
    __syncthreads();
}

__host__ __device__ __forceinline__ int lds_byte(int r, int c) { const int st = (r >> 4) * 2 + (c >> 5), rr = r & 15, cc = c & 31, ob = rr * 64 + cc * 2; return st * 1024 + (ob ^ (((ob >> 9) & 1) << 5)); }
__host__ __device__ __forceinline__ void stage_rc(int b, int& R, int& C) { const int st = b / 1024, sb = b % 1024, swz = sb ^ (((sb >> 9) & 1) << 5); R = (st >> 1) * 16 + swz / 64; C = (st & 1) * 32 + (swz % 64) / 2; }
__host__ __device__ __forceinline__ int perm32(int rho) { const int n = rho >> 4, i = rho & 15; return 8 * (i >> 2) + 4 * n + (i & 3); }

struct Unit { int arow, brow, orow, ocol; };

template <class Epi, class Sched, bool GATHER>
__device__ __forceinline__ void gemm_phase(LAS unsigned char* lds, const bf16_t* Abase, const bf16_t* Btbase, const int K, const Sched& S, const Epi& E) {
    const int tid = threadIdx.x, wid = __builtin_amdgcn_readfirstlane(tid >> 6), lane = tid & 63, wr = wid >> 2, wc = wid & 3, fr = lane & 15, fq = lane >> 4;
    const int nt = K / BK;
    unsigned voffA[2], voffB[2];
#pragma unroll
    for (int i = 0; i < 2; ++i) { int R, C; stage_rc(tid * 16 + i * 8192, R, C); const int Rb = Epi::PERM ? ((R & ~31) + perm32(R & 31)) : R;
        voffA[i] = (unsigned)(R * K + C) * 2u; voffB[i] = (unsigned)(Rb * K + C) * 2u; }
    const size_t kstep = (size_t)(BK * 2);
    const size_t hstep = (size_t)HALF * K * 2;
    const unsigned ldsw = (unsigned)wid * 1024u;
    const int aoff = lds_byte(wr * 64 + fr, fq * 8), boff = lds_byte(wc * 32 + fr, fq * 8);
    LAS const int* gtab = (LAS const int*)(lds + GTAB_OFF);
    unsigned goff[2][2];
#define PG8_SA(b, h) (((b) * 2 + (h)) * HTB)
#define PG8_SB(b, h) ((4 + (b) * 2 + (h)) * HTB)
#define PG8_STAGE(bufoff, gbase, voff) do { _Pragma("unroll") for (int _i = 0; _i < 2; ++_i) \
        __builtin_amdgcn_global_load_lds((const unsigned*)((const char*)(gbase) + (voff)[_i]), (LAS unsigned*)(lds + (bufoff) + ldsw + _i * 8192), 16, 0, 0); } while (0)
#define PG8_STAGE_A(bufoff, abase, h) do { if constexpr (GATHER) { PG8_STAGE(bufoff, abase, goff[h]); } else { PG8_STAGE(bufoff, (abase) + (h) * hstep, voffA); } } while (0)
#define PG8_LDA(dst, b, h) do { _Pragma("unroll") for (int m = 0; m < 4; ++m) _Pragma("unroll") for (int k = 0; k < 2; ++k) dst[m][k] = *(const LAS bf16x8*)(lds + PG8_SA(b, h) + aoff + m * 2048 + k * 1024); } while (0)
#define PG8_LDB(dst, b, h) do { _Pragma("unroll") for (int n = 0; n < 2; ++n) _Pragma("unroll") for (int k = 0; k < 2; ++k) dst[n][k] = *(const LAS bf16x8*)(lds + PG8_SB(b, h) + boff + n * 2048 + k * 1024); } while (0)
#define PG8_MMA(ai, bj, At, Bt) do { __builtin_amdgcn_s_setprio(1); _Pragma("unroll") for (int m = 0; m < 4; ++m) _Pragma("unroll") for (int n = 0; n < 2; ++n) _Pragma("unroll") for (int k = 0; k < 2; ++k) \
        acc[ai][bj][m][n] = __builtin_amdgcn_mfma_f32_16x16x32_bf16(Bt[n][k], At[m][k], acc[ai][bj][m][n], 0, 0, 0); __builtin_amdgcn_s_setprio(0); } while (0)
#define PG8_WAIT_V(n) asm volatile("s_waitcnt vmcnt(" #n ")" ::: "memory")
#define PG8_WAIT_L(n) asm volatile("s_waitcnt lgkmcnt(" #n ")" ::: "memory")
#define PG8_BAR __builtin_amdgcn_s_barrier()
#define PG8_SCHED __builtin_amdgcn_sched_barrier(0)
#define PG8_GLOAD(ui_) do { if constexpr (GATHER) { _Pragma("unroll") for (int _i = 0; _i < 2; ++_i) { int _R, _C; stage_rc(tid * 16 + _i * 8192, _R, _C); _Pragma("unroll") for (int _h = 0; _h < 2; ++_h) \
        goff[_h][_i] = (unsigned)(gtab[((ui_) & 3) * 256 + _h * HALF + _R] * K * 2 + _C * 2); } } } while (0)
    Unit cur, nxt; int ui = 0;
    if (!S.next(0, cur)) return;
    if constexpr (GATHER) {
        Unit t;
        for (int j = 0; j < 4; ++j) if (S.next(j, t)) { if (tid < 256) ((LAS int*)(lds + GTAB_OFF))[j * 256 + tid] = S.gidx(t, tid); }
        __syncthreads();
    }
    f32x4 acc[2][2][4][2];
#pragma unroll
    for (int a = 0; a < 2; ++a)
#pragma unroll
        for (int b = 0; b < 2; ++b)
#pragma unroll
            for (int m = 0; m < 4; ++m)
#pragma unroll
                for (int n = 0; n < 2; ++n) acc[a][b][m][n] = (f32x4){0.f, 0.f, 0.f, 0.f};
    bf16x8 At[4][2], B0[2][2], B1[2][2];
    const char* cA = (const char*)Abase + (size_t)cur.arow * K * 2; const char* cB = (const char*)Btbase + (size_t)cur.brow * K * 2;
    PG8_GLOAD(0);
    PG8_STAGE(PG8_SB(0, 0), cB, voffB); PG8_STAGE(PG8_SB(0, 1), cB + hstep, voffB); PG8_STAGE_A(PG8_SA(0, 0), cA, 0); PG8_STAGE_A(PG8_SA(0, 1), cA, 1);
    if (wr == 1) PG8_BAR;
    PG8_WAIT_V(2); PG8_BAR;
    PG8_STAGE(PG8_SB(1, 0), cB + kstep, voffB); PG8_STAGE_A(PG8_SA(1, 0), cA + kstep, 0); PG8_STAGE(PG8_SB(1, 1), cB + hstep + kstep, voffB);
    PG8_WAIT_V(6); PG8_BAR;
    for (;;) {
        const bool has_next = S.next(ui + 1, nxt);
        const char* nA = has_next ? (const char*)Abase + (size_t)nxt.arow * K * 2 : cA; const char* nB = has_next ? (const char*)Btbase + (size_t)nxt.brow * K * 2 : cB;
        for (int t = 0; t < nt; t += 2) {
            const bool last = (t == nt - 2);
            const char* a1 = cA + (size_t)(t + 1) * kstep;
            const char* a2 = last ? nA : cA + (size_t)(t + 2) * kstep; const char* b2 = last ? nB : cB + (size_t)(t + 2) * kstep;
            const char* a3 = a2 + kstep; const char* b3 = b2 + kstep;
            PG8_LDB(B0, 0, 0); PG8_LDB(B1, 0, 1); PG8_SCHED; PG8_LDA(At, 0, 0); PG8_STAGE_A(PG8_SA(1, 1), a1, 1);
            if constexpr (GATHER) { if (last && has_next) PG8_GLOAD(ui + 1); }
            PG8_WAIT_V(8); PG8_WAIT_L(0); PG8_BAR; PG8_MMA(0, 0, At, B0); PG8_MMA(0, 1, At, B1); PG8_BAR; PG8_SCHED;
            PG8_LDA(At, 0, 1); PG8_STAGE(PG8_SB(0, 0), b2, voffB); PG8_STAGE(PG8_SB(0, 1), b2 + hstep, voffB); PG8_STAGE_A(PG8_SA(0, 0), a2, 0);
            PG8_WAIT_V(8); PG8_WAIT_L(0); PG8_BAR; PG8_MMA(1, 0, At, B0); PG8_MMA(1, 1, At, B1); PG8_BAR; PG8_SCHED;
            PG8_LDB(B0, 1, 0); PG8_LDB(B1, 1, 1); PG8_SCHED; PG8_LDA(At, 1, 0); PG8_STAGE_A(PG8_SA(0, 1), a2, 1);
            PG8_WAIT_V(8); PG8_WAIT_L(0); PG8_BAR; PG8_MMA(0, 0, At, B0); PG8_MMA(0, 1, At, B1); PG8_BAR; PG8_SCHED;
            PG8_LDA(At, 1, 1); PG8_STAGE(PG8_SB(1, 0), b3, voffB); PG8_STAGE(PG8_SB(1, 1), b3 + hstep, voffB); PG8_STAGE_A(PG8_SA(1, 0), a3, 0);
            PG8_WAIT_V(8); PG8_WAIT_L(0); PG8_BAR; PG8_MMA(1, 0, At, B0); PG8_MMA(1, 1, At, B1); PG8_BAR; PG8_SCHED;
        }
        if (wr == 0) PG8_BAR;
        E(acc, cur, wr, wc, fr, fq);
        if (!has_next) break;
#pragma unroll
        for (int a = 0; a < 2; ++a)
#pragma unroll
            for (int b = 0; b < 2; ++b)
#pragma unroll
                for (int m = 0; m < 4; ++m)
#pragma unroll
                    for (int n = 0; n < 2; ++n) acc[a][b][m][n] = (f32x4){0.f, 0.f, 0.f, 0.f};
        cur = nxt; cA = nA; cB = nB; ++ui;
        if (wr == 1) PG8_BAR;
    }
    PG8_WAIT_V(0);
    PG8_BAR;
#undef PG8_SA
#undef PG8_SB
#undef PG8_STAGE
#undef PG8_STAGE_A
#undef PG8_LDA
#undef PG8_LDB
#undef PG8_MMA
#undef PG8_WAIT_V
#undef PG8_WAIT_L
#undef PG8_BAR
#undef PG8_SCHED
#undef PG8_GLOAD
}

__device__ __forceinline__ float silu1(float x) { return x * __builtin_amdgcn_rcpf(1.f + __expf(-x)); }
struct EpiSiluMul {
    static constexpr bool PERM = true;
    bf16_t* O; int ldo;
    __device__ __forceinline__ void operator()(const f32x4 (&acc)[2][2][4][2], const Unit& u, int wr, int wc, int fr, int fq) const {
        const int row0 = u.orow + wr * 64 + fr, col0 = u.ocol + wc * 32 + 8 * fq;
#pragma unroll
        for (int ai = 0; ai < 2; ++ai)
#pragma unroll
            for (int m = 0; m < 4; ++m) { bf16_t* rowp = O + (size_t)(row0 + ai * HALF + m * 16) * ldo + col0;
                const f32x4 g0 = acc[ai][0][m][0], g1 = acc[ai][0][m][1], u0 = acc[ai][1][m][0], u1 = acc[ai][1][m][1];
                u32x4 w; w.x = cvt_pk_bf16(silu1(g0[0]) * u0[0], silu1(g0[1]) * u0[1]); w.y = cvt_pk_bf16(silu1(g0[2]) * u0[2], silu1(g0[3]) * u0[3]);
                w.z = cvt_pk_bf16(silu1(g1[0]) * u1[0], silu1(g1[1]) * u1[1]); w.w = cvt_pk_bf16(silu1(g1[2]) * u1[2], silu1(g1[3]) * u1[3]);
                *(u32x4*)rowp = w; }
    }
};
struct EpiRowScale {
    static constexpr bool PERM = true;
    bf16_t* O; int ldo; const float* rowscale;
    __device__ __forceinline__ void operator()(const f32x4 (&acc)[2][2][4][2], const Unit& u, int wr, int wc, int fr, int fq) const {
        const int row0 = u.orow + wr * 64 + fr, col0 = u.ocol + wc * 32 + 8 * fq;
#pragma unroll
        for (int ai = 0; ai < 2; ++ai)
#pragma unroll
            for (int m = 0; m < 4; ++m) { const int row = row0 + ai * HALF + m * 16; const float sc = rowscale[row]; bf16_t* rowp = O + (size_t)row * ldo + col0;
#pragma unroll
                for (int bj = 0; bj < 2; ++bj) { const f32x4 v0 = acc[ai][bj][m][0] * sc, v1 = acc[ai][bj][m][1] * sc;
                    u32x4 w; w.x = cvt_pk_bf16(v0[0], v0[1]); w.y = cvt_pk_bf16(v0[2], v0[3]); w.z = cvt_pk_bf16(v1[0], v1[1]); w.w = cvt_pk_bf16(v1[2], v1[3]);
                    *(u32x4*)(rowp + bj * HALF) = w; } }
    }
};


struct EpiScIn {
    static constexpr bool PERM = true;
    bf16_t* GB; bf16_t* UU;
    __device__ __forceinline__ void operator()(const f32x4 (&acc)[2][2][4][2], const Unit& u, int wr, int wc, int fr, int fq) const {
        const int row0 = u.orow + wr * 64 + fr;
        if (u.ocol < 4) {
            const int col0 = u.ocol * 256 + wc * 32 + 8 * fq;
#pragma unroll
            for (int ai = 0; ai < 2; ++ai)
#pragma unroll
                for (int m = 0; m < 4; ++m) { bf16_t* rowp = GB + (size_t)(row0 + ai * HALF + m * 16) * D + col0;
#pragma unroll
                    for (int bj = 0; bj < 2; ++bj) { const f32x4 v0 = acc[ai][bj][m][0], v1 = acc[ai][bj][m][1];
                        u32x4 w; w.x = cvt_pk_bf16(v0[0], v0[1]); w.y = cvt_pk_bf16(v0[2], v0[3]); w.z = cvt_pk_bf16(v1[0], v1[1]); w.w = cvt_pk_bf16(v1[2], v1[3]);
                        *(u32x4*)(rowp + bj * HALF) = w; } }
        } else {
            const int col0 = (u.ocol - 4) * 128 + wc * 32 + 8 * fq;
#pragma unroll
            for (int ai = 0; ai < 2; ++ai)
#pragma unroll
                for (int m = 0; m < 4; ++m) { bf16_t* rowp = UU + (size_t)(row0 + ai * HALF + m * 16) * D + col0;
                    const f32x4 v0 = acc[ai][0][m][0] * acc[ai][1][m][0], v1 = acc[ai][0][m][1] * acc[ai][1][m][1];
                    u32x4 w; w.x = cvt_pk_bf16(v0[0], v0[1]); w.y = cvt_pk_bf16(v0[2], v0[3]); w.z = cvt_pk_bf16(v1[0], v1[1]); w.w = cvt_pk_bf16(v1[2], v1[3]);
                    *(u32x4*)rowp = w; }
        }
    }
};
struct EpiResid {
    static constexpr bool PERM = false;
    const float* base; float* out; const float* gada;
    __device__ __forceinline__ void operator()(const f32x4 (&acc)[2][2][4][2], const Unit& u, int wr, int wc, int fr, int fq) const {
        const int row0 = u.orow + wr * 64 + fr, col0 = u.ocol + wc * 32 + 4 * fq;
        const float* g = gada + (size_t)(u.orow >> 13) * 6 * D + col0;
        f32x4 gv[2][2];
#pragma unroll
        for (int bj = 0; bj < 2; ++bj)
#pragma unroll
            for (int n = 0; n < 2; ++n) gv[bj][n] = *(const f32x4*)(g + bj * HALF + n * 16);
#pragma unroll
        for (int ai = 0; ai < 2; ++ai)
#pragma unroll
            for (int m = 0; m < 4; ++m) { const size_t off = (size_t)(row0 + ai * HALF + m * 16) * D + col0;
#pragma unroll
                for (int bj = 0; bj < 2; ++bj)
#pragma unroll
                    for (int n = 0; n < 2; ++n) { const f32x4 b4 = *(const f32x4*)(base + off + bj * HALF + n * 16);
                        *(f32x4*)(out + off + bj * HALF + n * 16) = b4 + gv[bj][n] * acc[ai][bj][m][n]; } }
    }
};


struct EpiProj {
    static constexpr bool PERM = true;
    bf16_t* QKV; bf16_t* Z; bf16_t* POOL; bf16_t* CKV;
    __device__ __forceinline__ void operator()(const f32x4 (&acc)[2][2][4][2], const Unit& u, int wr, int wc, int fr, int fq) const {
        bf16_t* base; int ld;
        if (u.ocol < 6) { base = QKV + (size_t)u.orow * 1536 + u.ocol * 256; ld = 1536; }
        else if (u.ocol < 8) { base = Z + (size_t)u.orow * 512 + (u.ocol - 6) * 256; ld = 512; }
        else if (u.ocol < 10) { base = POOL + (size_t)u.orow * 512 + (u.ocol - 8) * 256; ld = 512; }
        else { base = CKV + (size_t)(u.orow - M_LAT) * 1024 + (u.ocol - 16) * 256; ld = 1024; }
        base += (size_t)(wr * 64 + fr) * ld + wc * 32 + 8 * fq;
#pragma unroll
        for (int ai = 0; ai < 2; ++ai)
#pragma unroll
            for (int m = 0; m < 4; ++m) { bf16_t* rowp = base + (size_t)(ai * HALF + m * 16) * ld;
#pragma unroll
                for (int bj = 0; bj < 2; ++bj) { const f32x4 v0 = acc[ai][bj][m][0], v1 = acc[ai][bj][m][1];
                    u32x4 w; w.x = cvt_pk_bf16(v0[0], v0[1]); w.y = cvt_pk_bf16(v0[2], v0[3]); w.z = cvt_pk_bf16(v1[0], v1[1]); w.w = cvt_pk_bf16(v1[2], v1[3]);
                    *(u32x4*)(rowp + bj * HALF) = w; } }
    }
};
struct SchedProj {
    int vcu, G;
    __device__ __forceinline__ bool next(int i, Unit& u) const {
        const int L = i * G + vcu; if (L >= 1296) return false;
        if (L < 1280) { const int pm = L / 10, pn = L % 10; u.arow = pm * 256; u.brow = pn * 256; u.orow = pm * 256; u.ocol = pn; }
        else { const int q = L - 1280, pm = q >> 2, pn = q & 3; u.arow = M_LAT + pm * 256; u.brow = 512 + pn * 256; u.orow = M_LAT + pm * 256; u.ocol = 16 + pn; }
        return true;
    }
    __device__ __forceinline__ int gidx(const Unit&, int) const { return 0; }
};

template <int NT, int COLMUL>
struct SchedDense {
    int vcu, G, nunits;
    __device__ __forceinline__ bool next(int i, Unit& u) const {
        const int L = i * G + vcu; if (L >= nunits) return false;
        const int pm = L / NT, pn = L % NT;
        u.arow = pm * 256; u.brow = pn * 256; u.orow = pm * 256; u.ocol = pn * COLMUL;
        return true;
    }
    __device__ __forceinline__ int gidx(const Unit&, int) const { return 0; }
};

constexpr size_t MiB = 1u << 20;
constexpr size_t WS_CTL = 0;
constexpr size_t WS_ADA = 1 * MiB;
constexpr size_t WS_AFF = 2 * MiB;
constexpr size_t WS_IDX = 4 * MiB;
constexpr size_t WS_GATE = 4 * MiB + 512 * 1024;
constexpr size_t WS_SEL = 5 * MiB;
constexpr size_t WS_GATES = 7 * MiB;
constexpr size_t WS_WGU = 16 * MiB;
constexpr size_t WS_WDN = 80 * MiB;
constexpr size_t WS_SCIN = 112 * MiB;
constexpr size_t WS_SCOUT = 118 * MiB;
constexpr size_t WS_WIN = 120 * MiB;
constexpr size_t WS_WOUT = 125 * MiB;
constexpr size_t WS_TMP = 128 * MiB;
constexpr size_t WS_ACT = WS_TMP;
constexpr size_t WS_QKV = 194 * MiB;
constexpr size_t WS_Z = 290 * MiB;
constexpr size_t WS_POOL = 322 * MiB;
constexpr size_t WS_CKV = 354 * MiB;
constexpr size_t WS_QN = 356 * MiB;
constexpr size_t WS_KT = 389 * MiB;
constexpr size_t WS_NWK = 422 * MiB;
constexpr size_t WS_SCL = 488 * MiB;
constexpr size_t WS_OF = WS_QKV;
constexpr size_t WS_OB = WS_QKV + 32 * MiB;
constexpr size_t WS_HID = 194 * MiB;
constexpr size_t WS_Y = 258 * MiB;
constexpr size_t WS_GB = WS_HID;
constexpr size_t WS_UU = WS_Y;
constexpr size_t WS_END = 512 * MiB;
constexpr int CW_BAR = 4096;

struct Args {
    const float* in[24]; float* out; unsigned char* ws; int ph_lo, ph_hi, li, pad;
};

struct Frame {
    LAS unsigned char* lds; int tid, lane, wave, G, vcu;
};

__device__ __forceinline__ void transpose_item(const float* W, int K, int ldn, int n0, int k0, bf16_t* WT, int drow0, LAS float* scr, int lane, int dcol0 = 0) {
#pragma unroll 8
    for (int i = 0; i < 32; ++i) { const int kk = 2 * i + (lane >> 5); scr[kk * 33 + (lane & 31)] = W[(size_t)(k0 + kk) * ldn + n0 + (lane & 31)]; }
    asm volatile("s_waitcnt lgkmcnt(0)" ::: "memory");
    const int c = lane & 7;
#pragma unroll
    for (int j = 0; j < 4; ++j) { const int n = (lane >> 3) + 8 * j; const LAS float* s = scr + (8 * c) * 33 + n;
        u32x4 o; o.x = pk2(s[0 * 33], s[1 * 33]); o.y = pk2(s[2 * 33], s[3 * 33]); o.z = pk2(s[4 * 33], s[5 * 33]); o.w = pk2(s[6 * 33], s[7 * 33]);
        *(u32x4*)(WT + (size_t)(drow0 + n) * K + dcol0 + k0 + 8 * c) = o; }
    asm volatile("s_waitcnt lgkmcnt(0)" ::: "memory");
}

struct SchedMoeUp {
    int vcu, layer; const int* idx;
    __device__ __forceinline__ bool next(int i, Unit& u) const {
        const int L = i * 256 + vcu; if (L >= 1024) return false;
        const int g = L >> 4, pm = (L >> 2) & 3, pn = L & 3, b = g >> 4, e = g & 15;
        u.arow = b * SEQ; u.brow = ((layer * NE + e) * 4 + pn) * 256; u.orow = g * CAP + pm * 256; u.ocol = pn * 128;
        return true;
    }
    __device__ __forceinline__ int gidx(const Unit& u, int r) const { return idx[u.orow + r]; }
};
struct SchedMoeDown {
    int vcu, layer;
    __device__ __forceinline__ bool next(int i, Unit& u) const {
        const int L = i * 256 + vcu; if (L >= 1024) return false;
        const int g = L >> 4, pm = (L >> 2) & 3, pn = L & 3, e = g & 15;
        u.arow = g * CAP + pm * 256; u.brow = ((layer * NE + e) * 4 + pn) * 256; u.orow = g * CAP + pm * 256; u.ocol = pn * 256;
        return true;
    }
    __device__ __forceinline__ int gidx(const Unit&, int) const { return 0; }
};

__device__ __forceinline__ float wsum(float v) {
#pragma unroll
    for (int o = 1; o < 64; o <<= 1) v += __shfl_xor(v, o);
    return v;
}

template <int MODE>
__device__ __forceinline__ void ph_norm16(const Frame& F, const float* xl, const float* xctx, bf16_t* act, const float* gw, const float* ada  , const float* w16, int ldw,
                                          float* out16, const float* a_log, const float* dt_bias) {
    LAS float* rt = (LAS float*)F.lds;
    for (int i = F.tid; i < D * NE; i += NTHREADS) { const int k = i >> 4, e = i & 15; rt[e * D + k] = w16[(size_t)k * ldw + e]; }
    __syncthreads();
    const int gw_ = F.vcu * NWAVES + F.wave, NGW = F.G * NWAVES;
    const int nrows = MODE == 0 ? M_LAT : M_LAT + BATCH * CTX;
    for (int r = gw_; r < nrows; r += NGW) {
        const bool lat = r < M_LAT;
        const int b = lat ? (r >> 13) : 4, t = r & (SEQ - 1);
        const float* sh = ada + (size_t)b * 6 * D + (MODE == 0 ? 3 * D : 0); const float* sc = sh + D;
        const f32x4* xr = (const f32x4*)(lat ? xl + (size_t)r * D : xctx + (size_t)(r - M_LAT) * D) + F.lane;
        f32x4 v[4]; float s = 0.f;
#pragma unroll
        for (int j = 0; j < 4; ++j) { v[j] = xr[64 * j]; s += (v[j].x * v[j].x + v[j].y * v[j].y) + (v[j].z * v[j].z + v[j].w * v[j].w); }
        const float rs = rsqrtf(wsum(s) * (1.f / D) + EPS);
        unsigned long long* o8 = (unsigned long long*)(act + (size_t)r * D) + F.lane;
#pragma unroll
        for (int j = 0; j < 4; ++j) { const int c = 256 * j + 4 * F.lane;
            const f32x4 g4 = *(const f32x4*)(gw + c), s4 = *(const f32x4*)(sc + c), h4 = *(const f32x4*)(sh + c);
            v[j] = v[j] * rs * g4 * (s4 + 1.f) + h4;
            o8[64 * j] = (unsigned long long)pk2(v[j].x, v[j].y) | ((unsigned long long)pk2(v[j].z, v[j].w) << 32); }
        float lg[16];
#pragma unroll
        for (int eg = 0; eg < 4; ++eg) {
#pragma unroll
            for (int e2 = 0; e2 < 4; ++e2) { const int e = eg * 4 + e2; float a = 0.f;
#pragma unroll
                for (int j = 0; j < 4; ++j) { const f32x4 w4 = *(const LAS f32x4*)(rt + e * D + 256 * j + 4 * F.lane); a += (v[j].x * w4.x + v[j].y * w4.y) + (v[j].z * w4.z + v[j].w * w4.w); }
                lg[e] = wsum(a); }
            asm volatile("" ::: "memory");
        }
        if constexpr (MODE == 0) {
            float mx = lg[0];
#pragma unroll
            for (int e = 1; e < 16; ++e) mx = fmaxf(mx, lg[e]);
            float sum = 0.f;
#pragma unroll
            for (int e = 0; e < 16; ++e) { lg[e] = __expf(lg[e] - mx); sum += lg[e]; }
            if (F.lane < 16) { float x = lg[0];
#pragma unroll
                for (int e = 1; e < 16; ++e) x = (F.lane == e) ? lg[e] : x;
                out16[((size_t)b * NE + F.lane) * SEQ + t] = x / sum; }
        } else {
            if (F.lane < 16) { float x = lg[0];
#pragma unroll
                for (int e = 1; e < 16; ++e) x = (F.lane == e) ? lg[e] : x;
                float o;
                if (F.lane < 8) o = 1.f / (1.f + __expf(-x));
                else { const float y = x + dt_bias[F.lane - 8]; const float sp = y > 20.f ? y : log1pf(__expf(y)); o = -__expf(a_log[F.lane - 8]) * sp; }
                out16[(size_t)r * 16 + F.lane] = o; }
        }
    }
    __syncthreads();
}

__device__ __forceinline__ void ph_topk(const Frame& F, const float* aff, int* idx, float* gate, int* sel) {
    LAS unsigned* keys = (LAS unsigned*)F.lds;
    LAS unsigned* hist = keys + SEQ;
    LAS unsigned* cg = hist + 256; LAS unsigned* ce = cg + 512;
    LAS unsigned* shv = ce + 512;
    const int tid = F.tid;
    for (int item = F.vcu; item < BATCH * NE; item += F.G) {
        const int b = item >> 4, e = item & 15;
        for (int i = tid; i < SEQ; i += NTHREADS) keys[i] = __float_as_uint(aff[(size_t)item * SEQ + i]);
        if (tid == 0) { shv[0] = 0u; shv[1] = CAP; }
        __syncthreads();
        unsigned mask = 0u;
        for (int pass = 0; pass < 4; ++pass) {
            const int shift = 24 - 8 * pass;
            if (tid < 256) hist[tid] = 0u;
            __syncthreads();
            const unsigned prefix = shv[0];
            for (int i = tid; i < SEQ; i += NTHREADS) { const unsigned kx = keys[i]; if ((kx & mask) == prefix) __hip_atomic_fetch_add(&hist[(kx >> shift) & 255u], 1u, __ATOMIC_RELAXED, __HIP_MEMORY_SCOPE_WORKGROUP); }
            __syncthreads();
            if (tid == 0) { unsigned need = shv[1], cum = 0u; int bin = 255;
                for (; bin > 0; --bin) { const unsigned hb = hist[bin]; if (cum + hb >= need) break; cum += hb; }
                shv[0] = prefix | ((unsigned)bin << shift); shv[1] = need - cum; }
            mask |= 0xFFu << shift;
            __syncthreads();
        }
        const unsigned T = shv[0], need = shv[1];
        unsigned ng = 0u, nq = 0u;
        for (int j = 0; j < 16; ++j) { const unsigned kx = keys[tid * 16 + j]; ng += kx > T; nq += kx == T; }
        cg[tid] = ng; ce[tid] = nq;
        __syncthreads();
        if (tid == 0) { unsigned a = 0u, c2 = 0u; for (int i = 0; i < 512; ++i) { const unsigned x = cg[i], y = ce[i]; cg[i] = a; ce[i] = c2; a += x; c2 += y; } }
        __syncthreads();
        unsigned g0 = cg[tid], q0 = ce[tid];
        for (int j = 0; j < 16; ++j) { const int t = tid * 16 + j; const unsigned kx = keys[t]; int slot = -1;
            if (kx > T) { slot = (int)(g0 + (q0 < need ? q0 : need)); ++g0; }
            else if (kx == T) { if (q0 < need) slot = (int)(g0 + q0); ++q0; }
            sel[((size_t)b * SEQ + t) * NE + e] = slot;
            if (slot >= 0) { idx[item * CAP + slot] = t; gate[item * CAP + slot] = __uint_as_float(kx); } }
        __syncthreads();
    }
}

template <bool FINAL>
__device__ __forceinline__ void ph_combine(const Frame& F, float* xl, const bf16_t* y, const int* sel, const float* ada  , const float* gwn, const float* ada_next, bf16_t* act) {
    const int gw_ = F.vcu * NWAVES + F.wave, NGW = F.G * NWAVES;
    for (int r = gw_; r < M_LAT; r += NGW) {
        const int b = r >> 13;
        const int myslot = F.lane < NE ? sel[(size_t)r * NE + F.lane] : -1;
        f32x4 a[4];
#pragma unroll
        for (int j = 0; j < 4; ++j) a[j] = (f32x4){0.f, 0.f, 0.f, 0.f};
        for (int e = 0; e < NE; ++e) {
            const int s = __builtin_amdgcn_readlane(myslot, e);
            if (s < 0) continue;
            const u32x2* yr = (const u32x2*)(y + ((size_t)(b * NE + e) * CAP + s) * D) + F.lane;
#pragma unroll
            for (int j = 0; j < 4; ++j) { const u32x2 w = yr[64 * j]; a[j].x += bf_lo(w.x); a[j].y += bf_hi(w.x); a[j].z += bf_lo(w.y); a[j].w += bf_hi(w.y); }
        }
        const float* g2 = ada + (size_t)b * 6 * D + 5 * D;
        f32x4* xr = (f32x4*)(xl + (size_t)r * D) + F.lane;
        f32x4 v[4]; float s = 0.f;
#pragma unroll
        for (int j = 0; j < 4; ++j) { const f32x4 g4 = *(const f32x4*)(g2 + 256 * j + 4 * F.lane); v[j] = xr[64 * j] + g4 * a[j];
            s += (v[j].x * v[j].x + v[j].y * v[j].y) + (v[j].z * v[j].z + v[j].w * v[j].w); }
        const float rs = rsqrtf(wsum(s) * (1.f / D) + EPS);
        if constexpr (FINAL) {
#pragma unroll
            for (int j = 0; j < 4; ++j) { const f32x4 g4 = *(const f32x4*)(gwn + 256 * j + 4 * F.lane); xr[64 * j] = v[j] * rs * g4; }
        } else {
            const float* sh = ada_next + (size_t)b * 6 * D; const float* sc = sh + D;
            unsigned long long* o8 = (unsigned long long*)(act + (size_t)r * D) + F.lane;
#pragma unroll
            for (int j = 0; j < 4; ++j) { const int c = 256 * j + 4 * F.lane; xr[64 * j] = v[j];
                const f32x4 g4 = *(const f32x4*)(gwn + c), s4 = *(const f32x4*)(sc + c), h4 = *(const f32x4*)(sh + c);
                const f32x4 o = v[j] * rs * g4 * (s4 + 1.f) + h4;
                o8[64 * j] = (unsigned long long)pk2(o.x, o.y) | ((unsigned long long)pk2(o.z, o.w) << 32); }
        }
    }
}


__device__ __forceinline__ void ph_sc_glue(const Frame& F, const bf16_t* gb, const bf16_t* uu, const float* cw  , bf16_t* act) {
    const int gw_ = F.vcu * NWAVES + F.wave, NGW = F.G * NWAVES;
    for (int r = gw_; r < M_LAT; r += NGW) {
        const int t = r & (SEQ - 1);
#pragma unroll
        for (int hh = 0; hh < 2; ++hh) {
            const int c = hh * 512 + 8 * F.lane;
            const u32x4 g = *(const u32x4*)(gb + (size_t)r * D + c), u1 = *(const u32x4*)(uu + (size_t)r * D + c);
            u32x4 u0 = (u32x4){0u, 0u, 0u, 0u}, u2 = (u32x4){0u, 0u, 0u, 0u};
            if (t > 0) u0 = *(const u32x4*)(uu + (size_t)(r - 1) * D + c);
            if (t < SEQ - 1) u2 = *(const u32x4*)(uu + (size_t)(r + 1) * D + c);
            u32x4 o;
#pragma unroll
            for (int q = 0; q < 4; ++q) {
                const f32x2 w0 = *(const f32x2*)(cw + c + 2 * q), w1 = *(const f32x2*)(cw + D + c + 2 * q), w2 = *(const f32x2*)(cw + 2 * D + c + 2 * q);
                const float lo = bf_lo(g[q]) * (w0.x * bf_lo(u0[q]) + w1.x * bf_lo(u1[q]) + w2.x * bf_lo(u2[q]));
                const float hi = bf_hi(g[q]) * (w0.y * bf_hi(u0[q]) + w1.y * bf_hi(u1[q]) + w2.y * bf_hi(u2[q]));
                o[q] = pk2(lo, hi);
            }
            *(u32x4*)(act + (size_t)r * D + c) = o;
        }
    }
}


constexpr int NSLOT = 132;
constexpr int NCHAIN = BATCH * NH;
__device__ __forceinline__ int kperm(int s, int g, int j) { return 16 * (2 * s + (j >> 2)) + 4 * g + (j & 3); }

struct ScanPtrs { unsigned char* QN; unsigned char* KT; unsigned char* NWK; unsigned char* QK; unsigned char* U; float* SCL; };
__device__ __forceinline__ size_t so_shared(int chain, int slot) { return ((size_t)chain * NSLOT + slot) * 16384; }
__device__ __forceinline__ size_t so_dir(int dir, int chain, int slot) { return (((size_t)dir * NCHAIN + chain) * NSLOT + slot); }

__device__ __forceinline__ void ph_chunk_prep(const Frame& F, const bf16_t* QKV, const bf16_t* CKV, const float* GATES, const float* cw  , const ScanPtrs P) {
    LAS unsigned char* L = F.lds;
    LAS bf16_t* kn = (LAS bf16_t*)(L);
    LAS bf16_t* qn = (LAS bf16_t*)(L + 17408);
    LAS float* vv = (LAS float*)(L + 34816);
    LAS float* KK = (LAS float*)(L + 68608);
    LAS float* QKr = (LAS float*)(L + 86016);
    LAS bf16_t* WKs = (LAS bf16_t*)(L + 68608);
    LAS float* NT = (LAS float*)(L + 103424);
    LAS float* gamP = (LAS float*)(L + 136192);
    LAS float* betP = gamP + 128;
    LAS float* begP = gamP + 256;
    const int wave = F.wave;
    for (int item = F.vcu; item < NCHAIN * NSLOT; item += F.G) {
        int tid = F.tid; asm volatile("" : "+v"(tid));
        const int lane = tid & 63;
        const int chain = item / NSLOT, slot = item % NSLOT, b = chain >> 2, h = chain & 3;
        const bool isctx = slot < 4;
        const int Lseq = isctx ? CTX : SEQ, t0 = isctx ? slot * 64 : (slot - 4) * 64;
        {
            const int i = tid >> 3, cg = tid & 7, t = t0 + i;
            const bf16_t* src; int ld, qoff, koff, voff;
            if (isctx) { src = CKV + (size_t)(b * CTX) * 1024; ld = 1024; qoff = -1; koff = h * 128; voff = 512 + h * 128; }
            else { src = QKV + (size_t)(b * SEQ) * 1536; ld = 1536; qoff = h * 128; koff = 512 + h * 128; voff = 1024 + h * 128; }
            float o[3][16];
#pragma unroll
            for (int w = 0; w < 3; ++w) {
                const int off = w == 0 ? qoff : (w == 1 ? koff : voff);
                if (off < 0) {
#pragma unroll
                    for (int c = 0; c < 16; ++c) o[w][c] = 0.f;
                    continue;
                }
                const int wcol = w * 512 + h * 128 + cg * 16;
#pragma unroll
                for (int c = 0; c < 16; ++c) o[w][c] = 0.f;
#pragma unroll
                for (int tap = 0; tap < 3; ++tap) {
                    const int tt = t + tap - 1;
                    if (tt < 0 || tt >= Lseq) continue;
                    const u32x4 a0 = *(const u32x4*)(src + (size_t)tt * ld + off + cg * 16), a1 = *(const u32x4*)(src + (size_t)tt * ld + off + cg * 16 + 8);
                    const float* wp = cw + tap * 1536 + wcol;
#pragma unroll
                    for (int q = 0; q < 4; ++q) { o[w][2 * q] += wp[2 * q] * bf_lo(a0[q]); o[w][2 * q + 1] += wp[2 * q + 1] * bf_hi(a0[q]);
                        o[w][8 + 2 * q] += wp[8 + 2 * q] * bf_lo(a1[q]); o[w][8 + 2 * q + 1] += wp[8 + 2 * q + 1] * bf_hi(a1[q]); }
                }
#pragma unroll
                for (int c = 0; c < 16; ++c) o[w][c] = silu1(o[w][c]);
            }
            float sq = 0.f, sk = 0.f;
#pragma unroll
            for (int c = 0; c < 16; ++c) { sq += o[0][c] * o[0][c]; sk += o[1][c] * o[1][c]; }
            sq += __shfl_xor(sq, 1); sq += __shfl_xor(sq, 2); sq += __shfl_xor(sq, 4);
            sk += __shfl_xor(sk, 1); sk += __shfl_xor(sk, 2); sk += __shfl_xor(sk, 4);
            const float rq = rsqrtf(sq + EPS) * 0.08838834764831845f, rk = rsqrtf(sk + EPS);
#pragma unroll
            for (int c = 0; c < 16; c += 2) {
                *(LAS unsigned*)(qn + i * 136 + cg * 16 + c) = pk2(o[0][c] * rq, o[0][c + 1] * rq);
                *(LAS unsigned*)(kn + i * 136 + cg * 16 + c) = pk2(o[1][c] * rk, o[1][c + 1] * rk);
                vv[i * 132 + cg * 16 + c] = o[2][c]; vv[i * 132 + cg * 16 + c + 1] = o[2][c + 1];
            }
        }
        if (wave < 2) {
            const int dir = wave, i = dir ? 63 - lane : lane;
            const size_t grow = isctx ? (size_t)M_LAT + b * CTX + t0 + i : (size_t)b * SEQ + t0 + i;
            float g = GATES[grow * 16 + 8 + dir * 4 + h];
#pragma unroll
            for (int o2 = 1; o2 < 64; o2 <<= 1) { const float x = __shfl_up(g, o2); if (lane >= o2) g += x; }
            gamP[dir * 64 + lane] = g; const float bt0 = GATES[grow * 16 + dir * 4 + h]; betP[dir * 64 + lane] = bt0; begP[dir * 64 + lane] = bt0 * __expf(g);
        }
        __syncthreads();
        {
            const int fr = lane & 15, fq = lane >> 4;
#pragma unroll
            for (int tt = 0; tt < 4; ++tt) {
                const int tile = wave * 4 + tt, which = tile >> 4, mt = (tile >> 2) & 3, nt = tile & 3;
                LAS bf16_t* Am = which ? qn : kn;
                f32x4 acc = (f32x4){0.f, 0.f, 0.f, 0.f};
#pragma unroll
                for (int s = 0; s < 4; ++s) {
                    const bf16x8 a = *(const LAS bf16x8*)(Am + (16 * mt + fr) * 136 + 32 * s + 8 * fq);
                    const bf16x8 bb = *(const LAS bf16x8*)(kn + (16 * nt + fr) * 136 + 32 * s + 8 * fq);
                    acc = __builtin_amdgcn_mfma_f32_16x16x32_bf16(a, bb, acc, 0, 0, 0);
                }
                LAS float* Om = which ? QKr : KK;
#pragma unroll
                for (int r = 0; r < 4; ++r) Om[(16 * mt + 4 * fq + r) * 68 + 16 * nt + fr] = acc[r];
            }
        }
        __syncthreads();
        {
#pragma unroll 2
            for (int it = 0; it < 16; ++it) {
                const int idx = tid + 512 * it, dir = idx >> 12, pp = (idx >> 6) & 63, p = idx & 63;
                float val = 0.f;
                if (p > pp) { const int ip = dir ? 63 - p : p, ipp = dir ? 63 - pp : pp;
                    val = betP[dir * 64 + p] * KK[ip * 68 + ipp] * __expf(gamP[dir * 64 + p] - gamP[dir * 64 + pp]); }
                NT[idx] = val;
            }
            const int f = tid >> 6, l2 = tid & 63, g = l2 >> 4;
            if (!isctx) {
#pragma unroll
                for (int dir = 0; dir < 2; ++dir) {
                    const int m = f >> 1, s = f & 1, io = 16 * m + (l2 & 15);
                    const float gi = gamP[dir * 64 + (dir ? 63 - io : io)];
                    float vals[8];
#pragma unroll
                    for (int e = 0; e < 8; ++e) { const int j = kperm(s, g, e); const bool keep = dir ? (j >= io) : (j <= io);
                        vals[e] = keep ? QKr[io * 68 + j] * __expf(gi - gamP[dir * 64 + (dir ? 63 - j : j)]) : 0.f; }
                    u32x4 w; w.x = pk2(vals[0], vals[1]); w.y = pk2(vals[2], vals[3]); w.z = pk2(vals[4], vals[5]); w.w = pk2(vals[6], vals[7]);
                    *(u32x4*)(P.QK + so_dir(dir, chain, slot) * 8192 + (size_t)tid * 16) = w;
                }
#pragma unroll
                for (int it = 0; it < 2; ++it) {
                    const int q = tid + 512 * it, ff = q >> 6, m = ff >> 2, s = ff & 3, row = 16 * m + (l2 & 15);
                    const u32x2 lo = *(const LAS u32x2*)(qn + row * 136 + 32 * s + 4 * g), hi = *(const LAS u32x2*)(qn + row * 136 + 32 * s + 16 + 4 * g);
                    *(u32x4*)(P.QN + so_shared(chain, slot) + (size_t)q * 16) = (u32x4){lo.x, lo.y, hi.x, hi.y};
                }
            }
#pragma unroll
            for (int it = 0; it < 2; ++it) {
                const int q = tid + 512 * it, ff = q >> 6, mp = ff >> 1, s = ff & 1, dk = 16 * mp + (l2 & 15);
                unsigned short e8[8];
#pragma unroll
                for (int e = 0; e < 8; ++e) e8[e] = kn[kperm(s, g, e) * 136 + dk];
                u32x4 w; w.x = e8[0] | ((unsigned)e8[1] << 16); w.y = e8[2] | ((unsigned)e8[3] << 16); w.z = e8[4] | ((unsigned)e8[5] << 16); w.w = e8[6] | ((unsigned)e8[7] << 16);
                *(u32x4*)(P.KT + so_shared(chain, slot) + (size_t)q * 16) = w;
            }
            if (tid < 128) { const int dir = tid >> 6, i = tid & 63, p = dir ? 63 - i : i;
                const float gl = gamP[dir * 64 + 63], gi = gamP[dir * 64 + p];
                float* sc = P.SCL + so_dir(dir, chain, slot) * 256;
                sc[i] = __expf(gi); sc[64 + i] = __expf(gl - gi); if (i == 0) sc[128] = __expf(gl); }
        }
        __syncthreads();
        {
            const int dir = wave >> 2, kind = (wave >> 1) & 1, c = (wave & 1) * 64 + lane;
            float Y[64];
            if (kind) {
#pragma unroll
                for (int p = 0; p < 64; ++p) { const int i = dir ? 63 - p : p; Y[p] = begP[dir * 64 + p] * bf_lo((unsigned)kn[i * 136 + c]); }
            } else {
#pragma unroll
                for (int p = 0; p < 64; ++p) { const int i = dir ? 63 - p : p; Y[p] = betP[dir * 64 + p] * vv[i * 132 + c]; }
            }
            const LAS float* nt = NT + dir * 4096;
#pragma unroll
            for (int pp = 0; pp < 63; ++pp) {
                const float y = Y[pp];
                int zdep; asm("v_and_b32 %0, 0, %1" : "=v"(zdep) : "v"(y));
                const LAS float* ntp = nt + zdep;
#pragma unroll
                for (int q4 = (pp + 1) & ~3; q4 < 64; q4 += 4) {
                    const f32x4 n4 = *(const LAS f32x4*)(ntp + pp * 64 + q4);
                    if (q4 + 0 > pp) Y[q4 + 0] -= n4.x * y;
                    if (q4 + 1 > pp) Y[q4 + 1] -= n4.y * y;
                    if (q4 + 2 > pp) Y[q4 + 2] -= n4.z * y;
                    if (q4 + 3 > pp) Y[q4 + 3] -= n4.w * y;
                }
            }
            __syncthreads();
            if (kind == 0) {
                const int T = c >> 4;
                unsigned char* ub = P.U + so_dir(dir, chain, slot) * 16384;
#pragma unroll
                for (int m = 0; m < 4; ++m)
#pragma unroll
                    for (int g = 0; g < 4; ++g) { const int i0 = 16 * m + 4 * g;
                        const float y0 = Y[dir ? 63 - i0 : i0], y1 = Y[dir ? 62 - i0 : i0 + 1], y2 = Y[dir ? 61 - i0 : i0 + 2], y3 = Y[dir ? 60 - i0 : i0 + 3];
                        *(u32x2*)(ub + (size_t)(((T * 4 + m) * 64) + g * 16 + (c & 15)) * 8) = (u32x2){pk2(y0, y1), pk2(y2, y3)}; }
            } else {
#pragma unroll
                for (int p = 0; p < 64; ++p) { const int i = dir ? 63 - p : p; WKs[(dir * 64 + i) * 136 + c] = (bf16_t)f2bf(-Y[p]); }
            }
        }
        __syncthreads();
#pragma unroll
        for (int it = 0; it < 4; ++it) {
            const int q = tid + 512 * it, dir = q >> 10, q1 = q & 1023, ff = q1 >> 6, l2 = q1 & 63, g = l2 >> 4, m = ff >> 2, s = ff & 3, row = 16 * m + (l2 & 15);
            const LAS bf16_t* wt = WKs + (dir * 64 + row) * 136;
            const u32x2 lo = *(const LAS u32x2*)(wt + 32 * s + 4 * g), hi = *(const LAS u32x2*)(wt + 32 * s + 16 + 4 * g);
            *(u32x4*)(P.NWK + so_dir(dir, chain, slot) * 16384 + (size_t)q1 * 16) = (u32x4){lo.x, lo.y, hi.x, hi.y};
        }
        __syncthreads();
    }
}

constexpr int SC_NWK = 0, SC_QN = 16384, SC_KT = 32768, SC_QK = 49152, SC_U = 57344, SC_SCL = 65536, SC_STAGE = 66560;
__device__ __forceinline__ void ph_scan(const Frame& F, const ScanPtrs P, bf16_t* OF, bf16_t* OB) {
    const int xg = F.vcu >> 5, xj = F.vcu & 31;
    if (xj >= 8 || xg >= 8) return;
    const int sb = xg * 8 + xj, half = sb & 1, dir = (sb >> 1) & 1, chain = sb >> 2, b = chain >> 2, h = chain & 3;
    LAS unsigned char* L = F.lds;
    const int lane = F.lane, wave = F.wave, g = lane >> 4;
    bf16_t* O = dir ? OB : OF;
    auto slot_of = [&](int step) { return dir ? (step < 4 ? 3 - step : 135 - step) : step; };
    auto issue = [&](int step) {
        const int slot = slot_of(step); const unsigned sbase = (unsigned)(step & 1) * SC_STAGE; const bool emit = slot >= 4;
        const int w4 = wave - 4;
        const unsigned char* nwk = P.NWK + so_dir(dir, chain, slot) * 16384; const unsigned char* kt = P.KT + so_shared(chain, slot);
        const unsigned char* qn = P.QN + so_shared(chain, slot); const unsigned char* qk = P.QK + so_dir(dir, chain, slot) * 8192;
        const unsigned char* uu = P.U + so_dir(dir, chain, slot) * 16384 + half * 8192; const unsigned char* sc = (const unsigned char*)(P.SCL + so_dir(dir, chain, slot) * 256);
#pragma unroll
        for (int i = 0; i < 4; ++i) { const int pc = w4 * 4 + i;
            __builtin_amdgcn_global_load_lds((const unsigned*)(nwk + pc * 1024 + lane * 16), (LAS unsigned*)(L + sbase + SC_NWK + pc * 1024), 16, 0, 0);
            __builtin_amdgcn_global_load_lds((const unsigned*)(kt + pc * 1024 + lane * 16), (LAS unsigned*)(L + sbase + SC_KT + pc * 1024), 16, 0, 0); }
#pragma unroll
        for (int i = 0; i < 2; ++i) { const int pc = w4 * 2 + i;
            __builtin_amdgcn_global_load_lds((const unsigned*)(uu + pc * 1024 + lane * 16), (LAS unsigned*)(L + sbase + SC_U + pc * 1024), 16, 0, 0); }
        if (w4 == 0) __builtin_amdgcn_global_load_lds((const unsigned*)(sc + lane * 16), (LAS unsigned*)(L + sbase + SC_SCL), 16, 0, 0);
        if (emit) {
#pragma unroll
            for (int i = 0; i < 4; ++i) { const int pc = w4 * 4 + i;
                __builtin_amdgcn_global_load_lds((const unsigned*)(qn + pc * 1024 + lane * 16), (LAS unsigned*)(L + sbase + SC_QN + pc * 1024), 16, 0, 0); }
#pragma unroll
            for (int i = 0; i < 2; ++i) { const int pc = w4 * 2 + i;
                __builtin_amdgcn_global_load_lds((const unsigned*)(qk + pc * 1024 + lane * 16), (LAS unsigned*)(L + sbase + SC_QK + pc * 1024), 16, 0, 0); }
        }
    };
    f32x4 accS[8]; bf16x8 bS[4];
#pragma unroll
    for (int m = 0; m < 8; ++m) accS[m] = (f32x4){0.f, 0.f, 0.f, 0.f};
#pragma unroll
    for (int s = 0; s < 4; ++s) bS[s] = (bf16x8){0, 0, 0, 0, 0, 0, 0, 0};
    if (wave >= 4) { issue(0); asm volatile("s_waitcnt vmcnt(0)" ::: "memory"); }
    __syncthreads();
    for (int step = 0; step < NSLOT; ++step) {
        if (wave >= 4) { if (step + 1 < NSLOT) issue(step + 1); asm volatile("s_waitcnt vmcnt(0)" ::: "memory"); }
        else {
            const int slot = slot_of(step); const bool emit = slot >= 4;
            const LAS unsigned char* st = L + (step & 1) * SC_STAGE;
            const LAS float* scl = (const LAS float*)(st + SC_SCL);
            f32x4 accw[4], acco[4];
#pragma unroll
            for (int m = 0; m < 4; ++m) { const u32x2 uv = *(const LAS u32x2*)(st + SC_U + ((wave * 4 + m) * 64 + lane) * 8);
                accw[m] = (f32x4){bf_lo(uv.x), bf_hi(uv.x), bf_lo(uv.y), bf_hi(uv.y)}; acco[m] = (f32x4){0.f, 0.f, 0.f, 0.f}; }
#pragma unroll
            for (int s = 0; s < 4; ++s)
#pragma unroll
                for (int m = 0; m < 4; ++m) accw[m] = __builtin_amdgcn_mfma_f32_16x16x32_bf16(*(const LAS bf16x8*)(st + SC_NWK + ((m * 4 + s) * 64 + lane) * 16), bS[s], accw[m], 0, 0, 0);
            if (emit) {
#pragma unroll
                for (int s = 0; s < 4; ++s)
#pragma unroll
                    for (int m = 0; m < 4; ++m) acco[m] = __builtin_amdgcn_mfma_f32_16x16x32_bf16(*(const LAS bf16x8*)(st + SC_QN + ((m * 4 + s) * 64 + lane) * 16), bS[s], acco[m], 0, 0, 0);
#pragma unroll
                for (int m = 0; m < 4; ++m) acco[m] = acco[m] * *(const LAS f32x4*)(scl + 16 * m + 4 * g);
            }
            bf16x8 bW[2], bWs[2];
#pragma unroll
            for (int s = 0; s < 2; ++s) {
                const f32x4 w0 = accw[2 * s], w1 = accw[2 * s + 1];
                const f32x4 e0 = *(const LAS f32x4*)(scl + 64 + 16 * (2 * s) + 4 * g), e1 = *(const LAS f32x4*)(scl + 64 + 16 * (2 * s + 1) + 4 * g);
                u32x4 a, c2;
                a.x = cvt_pk_bf16(w0[0], w0[1]); a.y = cvt_pk_bf16(w0[2], w0[3]); a.z = cvt_pk_bf16(w1[0], w1[1]); a.w = cvt_pk_bf16(w1[2], w1[3]);
                c2.x = cvt_pk_bf16(w0[0] * e0[0], w0[1] * e0[1]); c2.y = cvt_pk_bf16(w0[2] * e0[2], w0[3] * e0[3]); c2.z = cvt_pk_bf16(w1[0] * e1[0], w1[1] * e1[1]); c2.w = cvt_pk_bf16(w1[2] * e1[2], w1[3] * e1[3]);
                bW[s] = __builtin_bit_cast(bf16x8, a); bWs[s] = __builtin_bit_cast(bf16x8, c2);
            }
            const float cd = scl[128];
#pragma unroll
            for (int m = 0; m < 8; ++m) accS[m] = accS[m] * cd;
#pragma unroll
            for (int s = 0; s < 2; ++s)
#pragma unroll
                for (int m = 0; m < 8; ++m) accS[m] = __builtin_amdgcn_mfma_f32_16x16x32_bf16(*(const LAS bf16x8*)(st + SC_KT + ((m * 2 + s) * 64 + lane) * 16), bWs[s], accS[m], 0, 0, 0);
            if (emit) {
#pragma unroll
                for (int s = 0; s < 2; ++s)
#pragma unroll
                    for (int m = 0; m < 4; ++m) acco[m] = __builtin_amdgcn_mfma_f32_16x16x32_bf16(*(const LAS bf16x8*)(st + SC_QK + ((m * 2 + s) * 64 + lane) * 16), bW[s], acco[m], 0, 0, 0);
                bf16_t* orow = O + ((size_t)b * SEQ + (slot - 4) * 64) * 512 + h * 128 + half * 64 + wave * 16 + (lane & 15);
#pragma unroll
                for (int m = 0; m < 4; ++m)
#pragma unroll
                    for (int r = 0; r < 4; ++r) orow[(size_t)(16 * m + 4 * g + r) * 512] = (bf16_t)f2bf(acco[m][r]);
            }
#pragma unroll
            for (int s = 0; s < 4; ++s) {
                const f32x4 s0 = accS[2 * s], s1 = accS[2 * s + 1];
                u32x4 a; a.x = cvt_pk_bf16(s0[0], s0[1]); a.y = cvt_pk_bf16(s0[2], s0[3]); a.z = cvt_pk_bf16(s1[0], s1[1]); a.w = cvt_pk_bf16(s1[2], s1[3]);
                bS[s] = __builtin_bit_cast(bf16x8, a);
            }
        }
        __syncthreads();
    }
}

__device__ __forceinline__ void ph_even_A(const Frame& F, const bf16_t* OF, const bf16_t* OB, const bf16_t* Z, const bf16_t* POOL, const float* onorm, bf16_t* act) {
    const int gw_ = F.vcu * NWAVES + F.wave, NGW = F.G * NWAVES, lane = F.lane;
    for (int r = gw_; r < M_LAT; r += NGW) {
        const u32x4 a = *(const u32x4*)(OF + (size_t)r * 512 + 8 * lane), b2 = *(const u32x4*)(OB + (size_t)r * 512 + 8 * lane), z = *(const u32x4*)(Z + (size_t)r * 512 + 8 * lane);
        float o[8]; float s = 0.f;
#pragma unroll
        for (int q = 0; q < 4; ++q) { o[2 * q] = bf_lo(a[q]) + bf_lo(b2[q]); o[2 * q + 1] = bf_hi(a[q]) + bf_hi(b2[q]); s += o[2 * q] * o[2 * q] + o[2 * q + 1] * o[2 * q + 1]; }
        s += __shfl_xor(s, 1); s += __shfl_xor(s, 2); s += __shfl_xor(s, 4); s += __shfl_xor(s, 8);
        const float rs = rsqrtf(s * (1.f / 128.f) + EPS);
        const float* gn = onorm + ((8 * lane) & 127);
        u32x4 w;
#pragma unroll
        for (int q = 0; q < 4; ++q) w[q] = pk2(o[2 * q] * rs * gn[2 * q] * silu1(bf_lo(z[q])), o[2 * q + 1] * rs * gn[2 * q + 1] * silu1(bf_hi(z[q])));
        *(u32x4*)(act + (size_t)r * D + 8 * lane) = w;
        const int grp = lane >> 4, win = 2 << grp, pos = r & 63, row0 = r - pos;
        int lo = pos - win / 2; if (lo < 0) lo = 0; int hi = pos + win - win / 2; if (hi > 64) hi = 64;
        float m[8];
#pragma unroll
        for (int q = 0; q < 8; ++q) m[q] = 0.f;
        for (int p = lo; p < hi; ++p) { const u32x4 pv = *(const u32x4*)(POOL + (size_t)(row0 + p) * 512 + 8 * lane);
#pragma unroll
            for (int q = 0; q < 4; ++q) { m[2 * q] += bf_lo(pv[q]); m[2 * q + 1] += bf_hi(pv[q]); } }
        const float inv = 1.f / (float)(hi - lo);
        const u32x4 self = *(const u32x4*)(POOL + (size_t)r * 512 + 8 * lane);
#pragma unroll
        for (int q = 0; q < 4; ++q) w[q] = pk2(m[2 * q] * inv - bf_lo(self[q]), m[2 * q + 1] * inv - bf_hi(self[q]));
        *(u32x4*)(act + (size_t)r * D + 512 + 8 * lane) = w;
    }
}

enum { PH_PREP = 0, PH_E1, PH_E2, PH_E3, PH_E4, PH_E5, PH_E6, PH_M1_0, PH_M2_0, PH_M3_0, PH_M4_0, PH_M5_0, PH_X1, PH_X2, PH_X3, PH_M1_1, PH_M2_1, PH_M3_1, PH_M4_1, PH_M5_1, PH_COUNT };

__global__ void __launch_bounds__(NTHREADS, 2) mega(Args args) {
    extern __shared__ __attribute__((aligned(16))) unsigned char lds_raw[];
    Frame F;
    F.lds = (LAS unsigned char*)lds_raw;
    F.tid = threadIdx.x; F.lane = F.tid & 63; F.wave = __builtin_amdgcn_readfirstlane(F.tid >> 6);
    F.G = gridDim.x; { const int bx = blockIdx.x; F.vcu = (F.G % 8 == 0) ? (bx % 8) * (F.G / 8) + bx / 8 : bx; }
    volatile LAS unsigned* MISC = (volatile LAS unsigned*)(F.lds + MISC_OFF);
    if (F.tid < 64) MISC[F.tid] = 0u;
    __syncthreads();
    unsigned char* ws = args.ws;
    XcdBarrier bar = xcd_barrier_post((unsigned*)(ws + WS_CTL) + CW_BAR + args.li * XCD_BAR_WORDS, MISC + 8);
    const int lo = args.ph_lo, hi = args.ph_hi;
#define IN(k) (lo <= (k) && (k) < hi)
#define SEAM(k) do { if (IN(k) && IN((k) + 1)) xcd_barrier(bar); } while (0)
    const float* ADA = (const float*)(ws + WS_ADA); float* ADAw = (float*)(ws + WS_ADA);
    float* AFF = (float*)(ws + WS_AFF); int* IDX = (int*)(ws + WS_IDX); float* GATE = (float*)(ws + WS_GATE); int* SEL = (int*)(ws + WS_SEL);
    bf16_t* WGU = (bf16_t*)(ws + WS_WGU); bf16_t* WDN = (bf16_t*)(ws + WS_WDN); bf16_t* SCIN = (bf16_t*)(ws + WS_SCIN); bf16_t* SCOUT = (bf16_t*)(ws + WS_SCOUT);
    bf16_t* GBp = (bf16_t*)(ws + WS_GB); bf16_t* UUp = (bf16_t*)(ws + WS_UU);
    bf16_t* WIN = (bf16_t*)(ws + WS_WIN); bf16_t* WOUT = (bf16_t*)(ws + WS_WOUT); float* GATES = (float*)(ws + WS_GATES);
    const ScanPtrs SP{ws + WS_QN, ws + WS_KT, ws + WS_NWK, (unsigned char*)args.out + 66 * MiB, (unsigned char*)args.out, (float*)(ws + WS_SCL)};
    bf16_t* OFp = (bf16_t*)(ws + WS_OF); bf16_t* OBp = (bf16_t*)(ws + WS_OB);
    bf16_t* QKV = (bf16_t*)(ws + WS_QKV); bf16_t* Zp = (bf16_t*)(ws + WS_Z); bf16_t* POOLp = (bf16_t*)(ws + WS_POOL); bf16_t* CKV = (bf16_t*)(ws + WS_CKV);
    bf16_t* ACT = (bf16_t*)(ws + WS_ACT); bf16_t* HID = (bf16_t*)(ws + WS_HID); bf16_t* Y = (bf16_t*)(ws + WS_Y);
    float* xl = args.out;

    if (IN(PH_PREP)) {
        LAS float* scr = (LAS float*)(F.lds + F.wave * 16384);
        const int gw_ = F.vcu * NWAVES + F.wave, NGW = F.G * NWAVES;
        const float* w_gate = args.in[21]; const float* w_up = args.in[22]; const float* w_down = args.in[23];
        for (int it = gw_; it < 192; it += NGW) { const int l = it / 96, n = (it % 96) * 64 + F.lane;
            const float* w = args.in[4] + (size_t)l * D * 6 * D + n; float acc[5] = {0.f, 0.f, 0.f, 0.f, 0.f};
            for (int k = 0; k < D; ++k) { const float wv = w[(size_t)k * 6 * D];
#pragma unroll
                for (int r = 0; r < 5; ++r) { const float cv = r < 4 ? args.in[1][r * D + k] : args.in[3][k]; acc[r] += silu1(cv) * wv; } }
            const float bb = args.in[5][l * 6 * D + n];
#pragma unroll
            for (int r = 0; r < 5; ++r) ADAw[((size_t)l * 5 + r) * 6 * D + n] = acc[r] + bb; }
        for (int it = gw_; it < 256; it += NGW) { const int kb = it >> 5, nb = it & 31;
            transpose_item(args.in[16], D, D, 32 * nb, 64 * kb, WOUT, 32 * nb, scr, F.lane); }
        for (int it = gw_; it < 4 * 128 * 16; it += NGW) { const int gq = it >> 11, c = (it >> 4) & 127, n = (it & 15) * 64 + F.lane;
            const float* pw = args.in[14] + ((size_t)gq * 128 + c) * 128; const float* ps = args.in[15] + gq * 128; const float* wo = args.in[16] + (size_t)(512 + gq * 128) * D + n;
            float acc = 0.f;
            for (int d = 0; d < 128; ++d) acc += pw[d] * ps[d] * wo[(size_t)d * D];
            WOUT[(size_t)n * D + 512 + gq * 128 + c] = (bf16_t)f2bf(acc); }
        for (int it = gw_; it < 1280; it += NGW) { const int kb = it / 80, nb = it % 80, n0 = 32 * nb;
            transpose_item(args.in[9], D, EVEN_IN, n0 < 2048 ? n0 : n0 + 16, 64 * kb, WIN, n0, scr, F.lane); }
        for (int it = gw_; it < 2048; it += NGW) {
            if (it < 1536) { const int kb = it / 96, nb = it % 96, n0 = 32 * nb; int drow;
                if (n0 < D) drow = n0; else if (n0 < 2 * D) drow = D + ((n0 - D) >> 7) * 256 + (n0 & 127); else drow = D + ((n0 - 2 * D) >> 7) * 256 + 128 + (n0 & 127);
                transpose_item(args.in[17], D, 3 * D, n0, 64 * kb, SCIN, drow, scr, F.lane); }
            else { const int q = it - 1536, kb = q >> 5, nb = q & 31;
                transpose_item(args.in[19], D, D, 32 * nb, 64 * kb, SCOUT, 32 * nb, scr, F.lane); }
        }
        for (int it = gw_; it < 2 * NE * 768; it += NGW) {
            const int le = it / 768, r = it % 768;
            if (r < 512) { const int up = r >> 8, q = r & 255, kb = q >> 4, nb = q & 15, n0 = 32 * nb;
                transpose_item((up ? w_up : w_gate) + (size_t)le * D * DE, D, DE, n0, 64 * kb, WGU + (size_t)le * 1024 * D, (n0 >> 7) * 256 + up * 128 + (n0 & 127), scr, F.lane); }
            else { const int q = r - 512, kb = q >> 5, nb = q & 31;
                transpose_item(w_down + (size_t)le * DE * D, DE, D, 32 * nb, 64 * kb, WDN + (size_t)le * D * DE, 32 * nb, scr, F.lane); }
        }
    }
    SEAM(PH_PREP);
    if (IN(PH_E1)) ph_norm16<1>(F, args.in[0], args.in[2], ACT, args.in[6], ADA, args.in[9] + 2048, EVEN_IN, GATES, args.in[11], args.in[12]);
    SEAM(PH_E1);
    if (IN(PH_E2)) { SchedProj S{F.vcu, F.G}; EpiProj E{QKV, Zp, POOLp, CKV}; gemm_phase<EpiProj, SchedProj, false>(F.lds, ACT, WIN, D, S, E); }
    SEAM(PH_E2);
    if (IN(PH_E3)) ph_chunk_prep(F, QKV, CKV, GATES, args.in[10], SP);
    SEAM(PH_E3);
    if (IN(PH_E4)) ph_scan(F, SP, OFp, OBp);
    SEAM(PH_E4);
    if (IN(PH_E5)) ph_even_A(F, OFp, OBp, Zp, POOLp, args.in[13], ACT);
    SEAM(PH_E5);
    if (IN(PH_E6)) { SchedDense<4, 256> S{F.vcu, F.G, 128 * 4}; EpiResid E{args.in[0], xl, ADA + 2 * D}; gemm_phase<EpiResid, SchedDense<4, 256>, false>(F.lds, ACT, WOUT, D, S, E); }
    SEAM(PH_E6);
#define MOE_SEGMENT(l, p0) do { \
        const float* ada_l = ADA + (size_t)(l) * 5 * 6 * D; \
        if (IN(p0)) ph_norm16<0>(F, xl, nullptr, ACT, args.in[7] + (l) * D, ada_l, args.in[20] + (size_t)(l) * D * NE, NE, AFF, nullptr, nullptr); \
        SEAM(p0); \
        if (IN((p0) + 1)) ph_topk(F, AFF, IDX, GATE, SEL); \
        SEAM((p0) + 1); \
        if (IN((p0) + 2)) { SchedMoeUp S{F.vcu, (l), IDX}; EpiSiluMul E{HID, DE}; gemm_phase<EpiSiluMul, SchedMoeUp, true>(F.lds, ACT, WGU, D, S, E); } \
        SEAM((p0) + 2); \
        if (IN((p0) + 3)) { SchedMoeDown S{F.vcu, (l)}; EpiRowScale E{Y, D, GATE}; gemm_phase<EpiRowScale, SchedMoeDown, false>(F.lds, HID, WDN, DE, S, E); } \
        SEAM((p0) + 3); \
        if (IN((p0) + 4)) { \
            if ((l) == 0) ph_combine<false>(F, xl, Y, SEL, ada_l, args.in[6] + D, ADA + (size_t)5 * 6 * D, ACT); \
            else ph_combine<true>(F, xl, Y, SEL, ada_l, args.in[8], nullptr, nullptr); \
        } \
    } while (0)
    MOE_SEGMENT(0, PH_M1_0);
    SEAM(PH_M5_0);
    if (IN(PH_X1)) { SchedDense<12, 1> S{F.vcu, F.G, 128 * 12}; EpiScIn E{GBp, UUp}; gemm_phase<EpiScIn, SchedDense<12, 1>, false>(F.lds, ACT, SCIN, D, S, E); }
    SEAM(PH_X1);
    if (IN(PH_X2)) ph_sc_glue(F, GBp, UUp, args.in[18], ACT);
    SEAM(PH_X2);
    if (IN(PH_X3)) { SchedDense<4, 256> S{F.vcu, F.G, 128 * 4}; EpiResid E{xl, xl, ADA + (size_t)5 * 6 * D + 2 * D}; gemm_phase<EpiResid, SchedDense<4, 256>, false>(F.lds, ACT, SCOUT, D, S, E); }
    SEAM(PH_X3);
    MOE_SEGMENT(1, PH_M1_1);
#undef MOE_SEGMENT
#undef IN
#undef SEAM
}
}

}

extern "C" void kernel_launch(void* const* d_in, const int* in_sizes, int n_in, void* d_out, int out_size, void* d_ws, size_t ws_size, hipStream_t st) {
    static int grid = 0;
    if (grid == 0) {
        int dev = 0, cus = 0;
        if (hipGetDevice(&dev) != hipSuccess || hipDeviceGetAttribute(&cus, hipDeviceAttributeMultiprocessorCount, dev) != hipSuccess) { grid = -1; return; }
        if (hipFuncSetAttribute((const void*)mk::mega, hipFuncAttributeMaxDynamicSharedMemorySize, mk::LDS_BYTES) != hipSuccess) { fprintf(stderr, "hipFuncSetAttribute failed\n"); grid = -1; return; }
        if (ws_size < mk::WS_END) { fprintf(stderr, "workspace too small: %zu < %zu\n", ws_size, (size_t)mk::WS_END); grid = -1; return; }
        grid = cus;
    }
    if (grid < 0) return;
    (void)hipMemsetAsync((char*)d_ws + mk::WS_CTL, 0, mk::MiB, st);
    mk::Args a{};
    for (int i = 0; i < 24; ++i) a.in[i] = (const float*)d_in[i];
    a.out = (float*)d_out; a.ws = (unsigned char*)d_ws;
    int n_mega = 0;
    auto mega = [&](int lo, int hi) { a.ph_lo = lo; a.ph_hi = hi; a.li = n_mega++; hipLaunchKernelGGL(mk::mega, dim3(grid), dim3(mk::NTHREADS), mk::LDS_BYTES, st, a); };
    mega(0, mk::PH_COUNT);
}
```

```cpp
#include <hip/hip_runtime.h>
#include <cstdio>
#include <cstdint>

namespace {
constexpr int D = 1024, BATCH = 4, SEQ = 8192, CTX = 256, NH = 4, DK = 128, DV = 128;
constexpr int EVEN_IN = 2576, NE = 16, DE = 512, CAP = 1024;
constexpr float EPS = 1e-6f;

__device__ __forceinline__ float silu_f(float x) { return x / (1.f + __expf(-x)); }
__device__ __forceinline__ float sigmoid_f(float x) { return 1.f / (1.f + __expf(-x)); }
__device__ __forceinline__ float softplus_f(float x) { return x > 20.f ? x : log1pf(__expf(x)); }
__device__ __forceinline__ float wave_sum(float v) {
#pragma unroll
    for (int o = 1; o < 64; o <<= 1) v += __shfl_xor(v, o);
    return v;
}


namespace mk {
#define LAS __attribute__((address_space(3)))
#define GAS __attribute__((address_space(1)))
typedef unsigned short bf16_t;
typedef short bf16x8 __attribute__((ext_vector_type(8)));
typedef float f32x4 __attribute__((ext_vector_type(4)));
typedef float f32x2 __attribute__((ext_vector_type(2)));
typedef unsigned u32x4 __attribute__((ext_vector_type(4)));
typedef unsigned u32x2 __attribute__((ext_vector_type(2)));
constexpr int M_LAT = BATCH * SEQ;
constexpr int BM = 256, BK = 64, HALF = 128, HTB = HALF * BK * 2, STAGE_BYTES = 8 * HTB;
constexpr int LDS_BYTES = 147456, GTAB_OFF = 131072  , MISC_OFF = 147456 - 256;
constexpr int NTHREADS = 512, NWAVES = 8;

__device__ __forceinline__ unsigned f2bf(float f) { unsigned u = __builtin_bit_cast(unsigned, f); return (u + 0x7fffu + ((u >> 16) & 1u)) >> 16; }
__device__ __forceinline__ unsigned pk2(float lo, float hi) { return f2bf(lo) | (f2bf(hi) << 16); }
__device__ __forceinline__ unsigned cvt_pk_bf16(float lo, float hi) { unsigned r; asm volatile("v_cvt_pk_bf16_f32 %0, %1, %2" : "=v"(r) : "v"(lo), "v"(hi)); return r; }
__device__ __forceinline__ float bf_lo(unsigned w) { return __uint_as_float(w << 16); }
__device__ __forceinline__ float bf_hi(unsigned w) { return __uint_as_float(w & 0xffff0000u); }

__device__ __forceinline__ void lds_barrier() { asm volatile("s_waitcnt lgkmcnt(0)" ::: "memory"); __builtin_amdgcn_s_barrier(); asm volatile("" ::: "memory"); }

#define XB_TMO      128
#define XB_XCNT(j)  (256  + 64 * (j))
#define XB_XSUB(j)  (1280 + 64 * (j))
#define XB_XGEN(j)  (2304 + 64 * (j))
#define XB_TOP      3328
#define XB_TOPGEN   3392
#define XCD_BAR_WORDS 3456
#define XB_SPIN_CAP (1u << 18)
__device__ __forceinline__ unsigned xb_ld(unsigned* p)              { return __hip_atomic_load(p, __ATOMIC_RELAXED, __HIP_MEMORY_SCOPE_AGENT); }
__device__ __forceinline__ unsigned xb_add(unsigned* p, unsigned v) { return __hip_atomic_fetch_add(p, v, __ATOMIC_RELAXED, __HIP_MEMORY_SCOPE_AGENT); }
__device__ __forceinline__ unsigned xb_xcc_id() { return (unsigned)__builtin_amdgcn_s_getreg((3 << 11) | 20) & 0xFu; }
#define XB_SPIN(cond, bar) do { unsigned _sp = 0; while (cond) { __builtin_amdgcn_s_sleep(1); \
    if ((++_sp & 255u) == 0u) { if (xb_ld(&(bar)[XB_TMO])) break; if (_sp > XB_SPIN_CAP) { atomicAdd(&(bar)[XB_TMO], 1u); break; } } } } while (0)
struct XcdBarrier { unsigned* bar; unsigned x; volatile LAS unsigned* st; };
__device__ __forceinline__ XcdBarrier xcd_barrier_post(unsigned* bar, volatile LAS unsigned* st) {
    XcdBarrier b; b.bar = bar; b.x = xb_xcc_id(); b.st = st;
    if (threadIdx.x == 0) (void)xb_add(&bar[XB_XCNT(b.x)], 1u);
    return b;
}
__device__ __forceinline__ void xcd_barrier_complete(unsigned* bar, unsigned x, unsigned& nloc, unsigned& nx) {
    const unsigned G = gridDim.x * gridDim.y * gridDim.z;
    unsigned sum, cnt, mine, sp = 0u;
    for (;;) {
        sum = 0u; cnt = 0u; mine = 0u;
#pragma unroll
        for (unsigned j = 0; j < 16; ++j) { const unsigned c = xb_ld(&bar[XB_XCNT(j)]); sum += c; cnt += (c > 0u) ? 1u : 0u; mine = (j == x) ? c : mine; }
        if (sum == G) break;
        __builtin_amdgcn_s_sleep(1);
        if ((++sp & 255u) == 0u) { if (xb_ld(&bar[XB_TMO])) break; if (sp > XB_SPIN_CAP) { atomicAdd(&bar[XB_TMO], 1u); break; } }
    }
    nloc = mine > 0u ? mine : 1u; nx = cnt > 0u ? cnt : 1u;
}
__device__ __forceinline__ void xcd_barrier(const XcdBarrier& b) {
    asm volatile("s_waitcnt vmcnt(0)" ::: "memory");
    __syncthreads();
    if (threadIdx.x == 0) {
        unsigned* bar = b.bar;
        __builtin_amdgcn_s_waitcnt(0);
        unsigned nloc = b.st[0], nx = b.st[1];
        if (nloc == 0u) { xcd_barrier_complete(bar, b.x, nloc, nx); b.st[0] = nloc; b.st[1] = nx; }
        const unsigned old = xb_add(&bar[XB_XSUB(b.x)], 1u);
        const unsigned gen = old / nloc;
        if (old + 1u == (gen + 1u) * nloc) {
            __builtin_amdgcn_fence(__ATOMIC_RELEASE, "agent");
            asm volatile("s_waitcnt vmcnt(0)" ::: "memory");
            const unsigned og = xb_add(&bar[XB_TOP], 1u);
            const unsigned tg = og / nx;
            if (og + 1u == (tg + 1u) * nx) xb_add(&bar[XB_TOPGEN], 1u);
            else XB_SPIN(xb_ld(&bar[XB_TOPGEN]) == tg, bar);
            __builtin_amdgcn_fence(__ATOMIC_ACQUIRE, "agent");
            xb_add(&bar[XB_XGEN(b.x)], 1u);
            asm volatile("s_waitcnt vmcnt(0)" ::: "memory");
        } else {
            XB_SPIN(xb_ld(&bar[XB_XGEN(b.x)]) == gen, bar);
            __builtin_amdgcn_fence(__ATOMIC_ACQUIRE, "agent");
            asm volatile("s_waitcnt vmcnt(0)" ::: "memory");
        }
    }
    __syncthreads();
}

__host__ __device__ __forceinline__ int lds_byte(int r, int c) { const int st = (r >> 4) * 2 + (c >> 5), rr = r & 15, cc = c & 31, ob = rr * 64 + cc * 2; return st * 1024 + (ob ^ (((ob >> 9) & 1) << 5)); }
__host__ __device__ __forceinline__ void stage_rc(int b, int& R, int& C) { const int st = b / 1024, sb = b % 1024, swz = sb ^ (((sb >> 9) & 1) << 5); R = (st >> 1) * 16 + swz / 64; C = (st & 1) * 32 + (swz % 64) / 2; }
__host__ __device__ __forceinline__ int perm32(int rho) { const int n = rho >> 4, i = rho & 15; return 8 * (i >> 2) + 4 * n + (i & 3); }

struct Unit { int arow, brow, orow, ocol; };

template <class Epi, class Sched, bool GATHER>
__device__ __forceinline__ void gemm_phase(LAS unsigned char* lds, const bf16_t* Abase, const bf16_t* Btbase, const int K, const Sched& S, const Epi& E) {
    const int tid = threadIdx.x, wid = __builtin_amdgcn_readfirstlane(tid >> 6), lane = tid & 63, wr = wid >> 2, wc = wid & 3, fr = lane & 15, fq = lane >> 4;
    const int nt = K / BK;
    unsigned voffA[2], voffB[2];
#pragma unroll
    for (int i = 0; i < 2; ++i) { int R, C; stage_rc(tid * 16 + i * 8192, R, C); const int Rb = Epi::PERM ? ((R & ~31) + perm32(R & 31)) : R;
        voffA[i] = (unsigned)(R * K + C) * 2u; voffB[i] = (unsigned)(Rb * K + C) * 2u; }
    const size_t kstep = (size_t)(BK * 2);
    const size_t hstep = (size_t)HALF * K * 2;
    const unsigned ldsw = (unsigned)wid * 1024u;
    const int aoff = lds_byte(wr * 64 + fr, fq * 8), boff = lds_byte(wc * 32 + fr, fq * 8);
    LAS const int* gtab = (LAS const int*)(lds + GTAB_OFF);
    unsigned goff[2][2];
#define PG8_SA(b, h) (((b) * 2 + (h)) * HTB)
#define PG8_SB(b, h) ((4 + (b) * 2 + (h)) * HTB)
#define PG8_STAGE(bufoff, gbase, voff) do { _Pragma("unroll") for (int _i = 0; _i < 2; ++_i) \
        __builtin_amdgcn_global_load_lds((const unsigned*)((const char*)(gbase) + (voff)[_i]), (LAS unsigned*)(lds + (bufoff) + ldsw + _i * 8192), 16, 0, 0); } while (0)
#define PG8_STAGE_A(bufoff, abase, h) do { if constexpr (GATHER) { PG8_STAGE(bufoff, abase, goff[h]); } else { PG8_STAGE(bufoff, (abase) + (h) * hstep, voffA); } } while (0)
#define PG8_LDA(dst, b, h) do { _Pragma("unroll") for (int m = 0; m < 4; ++m) _Pragma("unroll") for (int k = 0; k < 2; ++k) dst[m][k] = *(const LAS bf16x8*)(lds + PG8_SA(b, h) + aoff + m * 2048 + k * 1024); } while (0)
#define PG8_LDB(dst, b, h) do { _Pragma("unroll") for (int n = 0; n < 2; ++n) _Pragma("unroll") for (int k = 0; k < 2; ++k) dst[n][k] = *(const LAS bf16x8*)(lds + PG8_SB(b, h) + boff + n * 2048 + k * 1024); } while (0)
#define PG8_MMA(ai, bj, At, Bt) do { __builtin_amdgcn_s_setprio(1); _Pragma("unroll") for (int m = 0; m < 4; ++m) _Pragma("unroll") for (int n = 0; n < 2; ++n) _Pragma("unroll") for (int k = 0; k < 2; ++k) \
        acc[ai][bj][m][n] = __builtin_amdgcn_mfma_f32_16x16x32_bf16(Bt[n][k], At[m][k], acc[ai][bj][m][n], 0, 0, 0); __builtin_amdgcn_s_setprio(0); } while (0)
#define PG8_WAIT_V(n) asm volatile("s_waitcnt vmcnt(" #n ")" ::: "memory")
#define PG8_WAIT_L(n) asm volatile("s_waitcnt lgkmcnt(" #n ")" ::: "memory")
#define PG8_BAR __builtin_amdgcn_s_barrier()
#define PG8_SCHED __builtin_amdgcn_sched_barrier(0)
#define PG8_GLOAD(ui_) do { if constexpr (GATHER) { _Pragma("unroll") for (int _i = 0; _i < 2; ++_i) { int _R, _C; stage_rc(tid * 16 + _i * 8192, _R, _C); _Pragma("unroll") for (int _h = 0; _h < 2; ++_h) \
        goff[_h][_i] = (unsigned)(gtab[((ui_) & 3) * 256 + _h * HALF + _R] * K * 2 + _C * 2); } } } while (0)
    Unit cur, nxt; int ui = 0;
    if (!S.next(0, cur)) return;
    if constexpr (GATHER) {
        Unit t;
        for (int j = 0; j < 4; ++j) if (S.next(j, t)) { if (tid < 256) ((LAS int*)(lds + GTAB_OFF))[j * 256 + tid] = S.gidx(t, tid); }
        __syncthreads();
    }
    f32x4 acc[2][2][4][2];
#pragma unroll
    for (int a = 0; a < 2; ++a)
#pragma unroll
        for (int b = 0; b < 2; ++b)
#pragma unroll
            for (int m = 0; m < 4; ++m)
#pragma unroll
                for (int n = 0; n < 2; ++n) acc[a][b][m][n] = (f32x4){0.f, 0.f, 0.f, 0.f};
    bf16x8 At[4][2], B0[2][2], B1[2][2];
    const char* cA = (const char*)Abase + (size_t)cur.arow * K * 2; const char* cB = (const char*)Btbase + (size_t)cur.brow * K * 2;
    PG8_GLOAD(0);
    PG8_STAGE(PG8_SB(0, 0), cB, voffB); PG8_STAGE(PG8_SB(0, 1), cB + hstep, voffB); PG8_STAGE_A(PG8_SA(0, 0), cA, 0); PG8_STAGE_A(PG8_SA(0, 1), cA, 1);
    if (wr == 1) PG8_BAR;
    PG8_WAIT_V(2); PG8_BAR;
    PG8_STAGE(PG8_SB(1, 0), cB + kstep, voffB); PG8_STAGE_A(PG8_SA(1, 0), cA + kstep, 0); PG8_STAGE(PG8_SB(1, 1), cB + hstep + kstep, voffB);
    PG8_WAIT_V(6); PG8_BAR;
    for (;;) {
        const bool has_next = S.next(ui + 1, nxt);
        const char* nA = has_next ? (const char*)Abase + (size_t)nxt.arow * K * 2 : cA; const char* nB = has_next ? (const char*)Btbase + (size_t)nxt.brow * K * 2 : cB;
        for (int t = 0; t < nt; t += 2) {
            const bool last = (t == nt - 2);
            const char* a1 = cA + (size_t)(t + 1) * kstep;
            const char* a2 = last ? nA : cA + (size_t)(t + 2) * kstep; const char* b2 = last ? nB : cB + (size_t)(t + 2) * kstep;
            const char* a3 = a2 + kstep; const char* b3 = b2 + kstep;
            PG8_LDB(B0, 0, 0); PG8_LDB(B1, 0, 1); PG8_SCHED; PG8_LDA(At, 0, 0); PG8_STAGE_A(PG8_SA(1, 1), a1, 1);
            if constexpr (GATHER) { if (last && has_next) PG8_GLOAD(ui + 1); }
            PG8_WAIT_V(8); PG8_WAIT_L(0); PG8_BAR; PG8_MMA(0, 0, At, B0); PG8_MMA(0, 1, At, B1); PG8_BAR; PG8_SCHED;
            PG8_LDA(At, 0, 1); PG8_STAGE(PG8_SB(0, 0), b2, voffB); PG8_STAGE(PG8_SB(0, 1), b2 + hstep, voffB); PG8_STAGE_A(PG8_SA(0, 0), a2, 0);
            PG8_WAIT_V(8); PG8_WAIT_L(0); PG8_BAR; PG8_MMA(1, 0, At, B0); PG8_MMA(1, 1, At, B1); PG8_BAR; PG8_SCHED;
            PG8_LDB(B0, 1, 0); PG8_LDB(B1, 1, 1); PG8_SCHED; PG8_LDA(At, 1, 0); PG8_STAGE_A(PG8_SA(0, 1), a2, 1);
            PG8_WAIT_V(8); PG8_WAIT_L(0); PG8_BAR; PG8_MMA(0, 0, At, B0); PG8_MMA(0, 1, At, B1); PG8_BAR; PG8_SCHED;
            PG8_LDA(At, 1, 1); PG8_STAGE(PG8_SB(1, 0), b3, voffB); PG8_STAGE(PG8_SB(1, 1), b3 + hstep, voffB); PG8_STAGE_A(PG8_SA(1, 0), a3, 0);
            PG8_WAIT_V(8); PG8_WAIT_L(0); PG8_BAR; PG8_MMA(1, 0, At, B0); PG8_MMA(1, 1, At, B1); PG8_BAR; PG8_SCHED;
        }
        if (wr == 0) PG8_BAR;
        E(acc, cur, wr, wc, fr, fq);
        if (!has_next) break;
#pragma unroll
        for (int a = 0; a < 2; ++a)
#pragma unroll
            for (int b = 0; b < 2; ++b)
#pragma unroll
                for (int m = 0; m < 4; ++m)
#pragma unroll
                    for (int n = 0; n < 2; ++n) acc[a][b][m][n] = (f32x4){0.f, 0.f, 0.f, 0.f};
        cur = nxt; cA = nA; cB = nB; ++ui;
        if (wr == 1) PG8_BAR;
    }
    PG8_WAIT_V(0);
    PG8_BAR;
#undef PG8_SA
#undef PG8_SB
#undef PG8_STAGE
#undef PG8_STAGE_A
#undef PG8_LDA
#undef PG8_LDB
#undef PG8_MMA
#undef PG8_WAIT_V
#undef PG8_WAIT_L
#undef PG8_BAR
#undef PG8_SCHED
#undef PG8_GLOAD
}

__device__ __forceinline__ float silu1(float x) { return x * __builtin_amdgcn_rcpf(1.f + __expf(-x)); }
struct EpiSiluMul {
    static constexpr bool PERM = true;
    bf16_t* O; int ldo;
    __device__ __forceinline__ void operator()(const f32x4 (&acc)[2][2][4][2], const Unit& u, int wr, int wc, int fr, int fq) const {
        const int row0 = u.orow + wr * 64 + fr, col0 = u.ocol + wc * 32 + 8 * fq;
#pragma unroll
        for (int ai = 0; ai < 2; ++ai)
#pragma unroll
            for (int m = 0; m < 4; ++m) { bf16_t* rowp = O + (size_t)(row0 + ai * HALF + m * 16) * ldo + col0;
                const f32x4 g0 = acc[ai][0][m][0], g1 = acc[ai][0][m][1], u0 = acc[ai][1][m][0], u1 = acc[ai][1][m][1];
                u32x4 w; w.x = cvt_pk_bf16(silu1(g0[0]) * u0[0], silu1(g0[1]) * u0[1]); w.y = cvt_pk_bf16(silu1(g0[2]) * u0[2], silu1(g0[3]) * u0[3]);
                w.z = cvt_pk_bf16(silu1(g1[0]) * u1[0], silu1(g1[1]) * u1[1]); w.w = cvt_pk_bf16(silu1(g1[2]) * u1[2], silu1(g1[3]) * u1[3]);
                *(u32x4*)rowp = w; }
    }
};
struct EpiRowScale {
    static constexpr bool PERM = true;
    bf16_t* O; int ldo; const float* rowscale;
    __device__ __forceinline__ void operator()(const f32x4 (&acc)[2][2][4][2], const Unit& u, int wr, int wc, int fr, int fq) const {
        const int row0 = u.orow + wr * 64 + fr, col0 = u.ocol + wc * 32 + 8 * fq;
#pragma unroll
        for (int ai = 0; ai < 2; ++ai)
#pragma unroll
            for (int m = 0; m < 4; ++m) { const int row = row0 + ai * HALF + m * 16; const float sc = rowscale[row]; bf16_t* rowp = O + (size_t)row * ldo + col0;
#pragma unroll
                for (int bj = 0; bj < 2; ++bj) { const f32x4 v0 = acc[ai][bj][m][0] * sc, v1 = acc[ai][bj][m][1] * sc;
                    u32x4 w; w.x = cvt_pk_bf16(v0[0], v0[1]); w.y = cvt_pk_bf16(v0[2], v0[3]); w.z = cvt_pk_bf16(v1[0], v1[1]); w.w = cvt_pk_bf16(v1[2], v1[3]);
                    *(u32x4*)(rowp + bj * HALF) = w; } }
    }
};


struct EpiScIn {
    static constexpr bool PERM = true;
    bf16_t* GB; bf16_t* UU;
    __device__ __forceinline__ void operator()(const f32x4 (&acc)[2][2][4][2], const Unit& u, int wr, int wc, int fr, int fq) const {
        const int row0 = u.orow + wr * 64 + fr;
        if (u.ocol < 4) {
            const int col0 = u.ocol * 256 + wc * 32 + 8 * fq;
#pragma unroll
            for (int ai = 0; ai < 2; ++ai)
#pragma unroll
                for (int m = 0; m < 4; ++m) { bf16_t* rowp = GB + (size_t)(row0 + ai * HALF + m * 16) * D + col0;
#pragma unroll
                    for (int bj = 0; bj < 2; ++bj) { const f32x4 v0 = acc[ai][bj][m][0], v1 = acc[ai][bj][m][1];
                        u32x4 w; w.x = cvt_pk_bf16(v0[0], v0[1]); w.y = cvt_pk_bf16(v0[2], v0[3]); w.z = cvt_pk_bf16(v1[0], v1[1]); w.w = cvt_pk_bf16(v1[2], v1[3]);
                        *(u32x4*)(rowp + bj * HALF) = w; } }
        } else {
            const int col0 = (u.ocol - 4) * 128 + wc * 32 + 8 * fq;
#pragma unroll
            for (int ai = 0; ai < 2; ++ai)
#pragma unroll
                for (int m = 0; m < 4; ++m) { bf16_t* rowp = UU + (size_t)(row0 + ai * HALF + m * 16) * D + col0;
                    const f32x4 v0 = acc[ai][0][m][0] * acc[ai][1][m][0], v1 = acc[ai][0][m][1] * acc[ai][1][m][1];
                    u32x4 w; w.x = cvt_pk_bf16(v0[0], v0[1]); w.y = cvt_pk_bf16(v0[2], v0[3]); w.z = cvt_pk_bf16(v1[0], v1[1]); w.w = cvt_pk_bf16(v1[2], v1[3]);
                    *(u32x4*)rowp = w; }
        }
    }
};
struct EpiResid {
    static constexpr bool PERM = false;
    const float* base; float* out; const float* gada;
    __device__ __forceinline__ void operator()(const f32x4 (&acc)[2][2][4][2], const Unit& u, int wr, int wc, int fr, int fq) const {
        const int row0 = u.orow + wr * 64 + fr, col0 = u.ocol + wc * 32 + 4 * fq;
        const float* g = gada + (size_t)(u.orow >> 13) * 6 * D + col0;
        f32x4 gv[2][2];
#pragma unroll
        for (int bj = 0; bj < 2; ++bj)
#pragma unroll
            for (int n = 0; n < 2; ++n) gv[bj][n] = *(const f32x4*)(g + bj * HALF + n * 16);
#pragma unroll
        for (int ai = 0; ai < 2; ++ai)
#pragma unroll
            for (int m = 0; m < 4; ++m) { const size_t off = (size_t)(row0 + ai * HALF + m * 16) * D + col0;
#pragma unroll
                for (int bj = 0; bj < 2; ++bj)
#pragma unroll
                    for (int n = 0; n < 2; ++n) { const f32x4 b4 = *(const f32x4*)(base + off + bj * HALF + n * 16);
                        *(f32x4*)(out + off + bj * HALF + n * 16) = b4 + gv[bj][n] * acc[ai][bj][m][n]; } }
    }
};


struct EpiProj {
    static constexpr bool PERM = true;
    bf16_t* QKV; bf16_t* Z; bf16_t* POOL; bf16_t* CKV;
    __device__ __forceinline__ void operator()(const f32x4 (&acc)[2][2][4][2], const Unit& u, int wr, int wc, int fr, int fq) const {
        bf16_t* base; int ld;
        if (u.ocol < 6) { base = QKV + (size_t)u.orow * 1536 + u.ocol * 256; ld = 1536; }
        else if (u.ocol < 8) { base = Z + (size_t)u.orow * 512 + (u.ocol - 6) * 256; ld = 512; }
        else if (u.ocol < 10) { base = POOL + (size_t)u.orow * 512 + (u.ocol - 8) * 256; ld = 512; }
        else { base = CKV + (size_t)(u.orow - M_LAT) * 1024 + (u.ocol - 16) * 256; ld = 1024; }
        base += (size_t)(wr * 64 + fr) * ld + wc * 32 + 8 * fq;
#pragma unroll
        for (int ai = 0; ai < 2; ++ai)
#pragma unroll
            for (int m = 0; m < 4; ++m) { bf16_t* rowp = base + (size_t)(ai * HALF + m * 16) * ld;
#pragma unroll
                for (int bj = 0; bj < 2; ++bj) { const f32x4 v0 = acc[ai][bj][m][0], v1 = acc[ai][bj][m][1];
                    u32x4 w; w.x = cvt_pk_bf16(v0[0], v0[1]); w.y = cvt_pk_bf16(v0[2], v0[3]); w.z = cvt_pk_bf16(v1[0], v1[1]); w.w = cvt_pk_bf16(v1[2], v1[3]);
                    *(u32x4*)(rowp + bj * HALF) = w; } }
    }
};
struct SchedProj {
    int vcu, G;
    __device__ __forceinline__ bool next(int i, Unit& u) const {
        const int L = i * G + vcu; if (L >= 1296) return false;
        if (L < 1280) { const int pm = L / 10, pn = L % 10; u.arow = pm * 256; u.brow = pn * 256; u.orow = pm * 256; u.ocol = pn; }
        else { const int q = L - 1280, pm = q >> 2, pn = q & 3; u.arow = M_LAT + pm * 256; u.brow = 512 + pn * 256; u.orow = M_LAT + pm * 256; u.ocol = 16 + pn; }
        return true;
    }
    __device__ __forceinline__ int gidx(const Unit&, int) const { return 0; }
};

template <int NT, int COLMUL>
struct SchedDense {
    int vcu, G, nunits;
    __device__ __forceinline__ bool next(int i, Unit& u) const {
        const int L = i * G + vcu; if (L >= nunits) return false;
        const int pm = L / NT, pn = L % NT;
        u.arow = pm * 256; u.brow = pn * 256; u.orow = pm * 256; u.ocol = pn * COLMUL;
        return true;
    }
    __device__ __forceinline__ int gidx(const Unit&, int) const { return 0; }
};

constexpr size_t MiB = 1u << 20;
constexpr size_t WS_CTL = 0;
constexpr size_t WS_ADA = 1 * MiB;
constexpr size_t WS_AFF = 2 * MiB;
constexpr size_t WS_IDX = 4 * MiB;
constexpr size_t WS_GATE = 4 * MiB + 512 * 1024;
constexpr size_t WS_SEL = 5 * MiB;
constexpr size_t WS_GATES = 7 * MiB;
constexpr size_t WS_WGU = 16 * MiB;
constexpr size_t WS_WDN = 80 * MiB;
constexpr size_t WS_SCIN = 112 * MiB;
constexpr size_t WS_SCOUT = 118 * MiB;
constexpr size_t WS_WIN = 120 * MiB;
constexpr size_t WS_WOUT = 125 * MiB;
constexpr size_t WS_TMP = 128 * MiB;
constexpr size_t WS_ACT = WS_TMP;
constexpr size_t WS_QKV = 194 * MiB;
constexpr size_t WS_Z = 290 * MiB;
constexpr size_t WS_POOL = 322 * MiB;
constexpr size_t WS_CKV = 354 * MiB;
constexpr size_t WS_QN = 356 * MiB;
constexpr size_t WS_KT = 389 * MiB;
constexpr size_t WS_NWK = 422 * MiB;
constexpr size_t WS_SCL = 488 * MiB;
constexpr size_t WS_OF = WS_QKV;
constexpr size_t WS_OB = WS_QKV + 32 * MiB;
constexpr size_t WS_HID = 194 * MiB;
constexpr size_t WS_Y = 258 * MiB;
constexpr size_t WS_GB = WS_HID;
constexpr size_t WS_UU = WS_Y;
constexpr size_t WS_END = 512 * MiB;
constexpr int CW_BAR = 4096;

struct Args {
    const float* in[24]; float* out; unsigned char* ws; int ph_lo, ph_hi, li, pad;
};

struct Frame {
    LAS unsigned char* lds; int tid, lane, wave, G, vcu;
};

__device__ __forceinline__ void transpose_item(const float* W, int K, int ldn, int n0, int k0, bf16_t* WT, int drow0, LAS float* scr, int lane, int dcol0 = 0) {
    float tv[32];
#pragma unroll
    for (int i = 0; i < 32; ++i) tv[i] = W[(size_t)(k0 + 2 * i + (lane >> 5)) * ldn + n0 + (lane & 31)];
#pragma unroll
    for (int i = 0; i < 32; ++i) scr[(2 * i + (lane >> 5)) * 33 + (lane & 31)] = tv[i];
    asm volatile("s_waitcnt lgkmcnt(0)" ::: "memory");
    const int c = lane & 7;
#pragma unroll
    for (int j = 0; j < 4; ++j) { const int n = (lane >> 3) + 8 * j; const LAS float* s = scr + (8 * c) * 33 + n;
        u32x4 o; o.x = pk2(s[0 * 33], s[1 * 33]); o.y = pk2(s[2 * 33], s[3 * 33]); o.z = pk2(s[4 * 33], s[5 * 33]); o.w = pk2(s[6 * 33], s[7 * 33]);
        *(u32x4*)(WT + (size_t)(drow0 + n) * K + dcol0 + k0 + 8 * c) = o; }
    asm volatile("s_waitcnt lgkmcnt(0)" ::: "memory");
}

struct SchedMoeUp {
    int vcu, layer; const int* idx;
    __device__ __forceinline__ bool next(int i, Unit& u) const {
        const int L = i * 256 + vcu; if (L >= 1024) return false;
        const int g = L >> 4, pm = (L >> 2) & 3, pn = L & 3, b = g >> 4, e = g & 15;
        u.arow = b * SEQ; u.brow = ((layer * NE + e) * 4 + pn) * 256; u.orow = g * CAP + pm * 256; u.ocol = pn * 128;
        return true;
    }
    __device__ __forceinline__ int gidx(const Unit& u, int r) const { return idx[u.orow + r]; }
};
struct SchedMoeDown {
    int vcu, layer;
    __device__ __forceinline__ bool next(int i, Unit& u) const {
        const int L = i * 256 + vcu; if (L >= 1024) return false;
        const int g = L >> 4, pm = (L >> 2) & 3, pn = L & 3, e = g & 15;
        u.arow = g * CAP + pm * 256; u.brow = ((layer * NE + e) * 4 + pn) * 256; u.orow = g * CAP + pm * 256; u.ocol = pn * 256;
        return true;
    }
    __device__ __forceinline__ int gidx(const Unit&, int) const { return 0; }
};

__device__ __forceinline__ float wsum(float v) {
#pragma unroll
    for (int o = 1; o < 64; o <<= 1) v += __shfl_xor(v, o);
    return v;
}

template <int MODE>
__device__ __forceinline__ void ph_norm16(const Frame& F, const float* xl, const float* xctx, bf16_t* act, const float* gw, const float* ada  , const float* w16, int ldw,
                                          float* out16, const float* a_log, const float* dt_bias) {
    LAS float* rt = (LAS float*)F.lds;
    for (int i = F.tid; i < D * NE; i += NTHREADS) { const int k = i >> 4, e = i & 15; rt[e * D + k] = w16[(size_t)k * ldw + e]; }
    __syncthreads();
    const int gw_ = F.vcu * NWAVES + F.wave, NGW = F.G * NWAVES;
    const int nrows = MODE == 0 ? M_LAT : M_LAT + BATCH * CTX;
    int curb = -1; f32x4 mA[4], mB[4];
#pragma unroll
    for (int j = 0; j < 4; ++j) { mA[j] = (f32x4){0.f, 0.f, 0.f, 0.f}; mB[j] = mA[j]; }
    f32x4 nx[4];
    if (gw_ < nrows) { const f32x4* xr0 = (const f32x4*)(gw_ < M_LAT ? xl + (size_t)gw_ * D : xctx + (size_t)(gw_ - M_LAT) * D) + F.lane;
#pragma unroll
        for (int j = 0; j < 4; ++j) nx[j] = xr0[64 * j]; }
    for (int r = gw_; r < nrows; r += NGW) {
        const bool lat = r < M_LAT;
        const int b = lat ? (r >> 13) : 4, t = r & (SEQ - 1);
        f32x4 v[4];
#pragma unroll
        for (int j = 0; j < 4; ++j) v[j] = nx[j];
        { const int rn = r + NGW;
          if (rn < nrows) { const f32x4* xrn = (const f32x4*)(rn < M_LAT ? xl + (size_t)rn * D : xctx + (size_t)(rn - M_LAT) * D) + F.lane;
#pragma unroll
              for (int j = 0; j < 4; ++j) nx[j] = xrn[64 * j]; } }
        if (b != curb) { curb = b;
            const float* sh = ada + (size_t)b * 6 * D + (MODE == 0 ? 3 * D : 0); const float* sc = sh + D;
#pragma unroll
            for (int j = 0; j < 4; ++j) { const int c = 256 * j + 4 * F.lane;
                const f32x4 g4 = *(const f32x4*)(gw + c), s4 = *(const f32x4*)(sc + c), h4 = *(const f32x4*)(sh + c); mA[j] = g4 * (s4 + 1.f); mB[j] = h4; } }
        float s = 0.f;
#pragma unroll
        for (int j = 0; j < 4; ++j) s += (v[j].x * v[j].x + v[j].y * v[j].y) + (v[j].z * v[j].z + v[j].w * v[j].w);
        const float rs = rsqrtf(wsum(s) * (1.f / D) + EPS);
        unsigned long long* o8 = (unsigned long long*)(act + (size_t)r * D) + F.lane;
#pragma unroll
        for (int j = 0; j < 4; ++j) {
            v[j] = v[j] * rs * mA[j] + mB[j];
            o8[64 * j] = (unsigned long long)pk2(v[j].x, v[j].y) | ((unsigned long long)pk2(v[j].z, v[j].w) << 32); }
        float lg[16];
#pragma unroll
        for (int eg = 0; eg < 4; ++eg) {
#pragma unroll
            for (int e2 = 0; e2 < 4; ++e2) { const int e = eg * 4 + e2; float a = 0.f;
#pragma unroll
                for (int j = 0; j < 4; ++j) { const f32x4 w4 = *(const LAS f32x4*)(rt + e * D + 256 * j + 4 * F.lane); a += (v[j].x * w4.x + v[j].y * w4.y) + (v[j].z * w4.z + v[j].w * w4.w); }
                lg[e] = a; }
            asm volatile("" ::: "memory");
        }
        float r8[8], r4[4], r2[2], tot;
        { const bool hb = (F.lane & 32) != 0;
#pragma unroll
          for (int i = 0; i < 8; ++i) { const float snd = hb ? lg[i] : lg[i + 8], kp = hb ? lg[i + 8] : lg[i]; r8[i] = kp + __shfl_xor(snd, 32); } }
        { const bool hb = (F.lane & 16) != 0;
#pragma unroll
          for (int i = 0; i < 4; ++i) { const float snd = hb ? r8[i] : r8[i + 4], kp = hb ? r8[i + 4] : r8[i]; r4[i] = kp + __shfl_xor(snd, 16); } }
        { const bool hb = (F.lane & 8) != 0;
#pragma unroll
          for (int i = 0; i < 2; ++i) { const float snd = hb ? r4[i] : r4[i + 2], kp = hb ? r4[i + 2] : r4[i]; r2[i] = kp + __shfl_xor(snd, 8); } }
        { const bool hb = (F.lane & 4) != 0; const float snd = hb ? r2[0] : r2[1], kp = hb ? r2[1] : r2[0]; tot = kp + __shfl_xor(snd, 4); }
        tot += __shfl_xor(tot, 2); tot += __shfl_xor(tot, 1);
        const int ecol = (F.lane >> 2) & 15;
        if constexpr (MODE == 0) {
            float mx = tot;
            mx = fmaxf(mx, __shfl_xor(mx, 4)); mx = fmaxf(mx, __shfl_xor(mx, 8)); mx = fmaxf(mx, __shfl_xor(mx, 16)); mx = fmaxf(mx, __shfl_xor(mx, 32));
            const float ex = __expf(tot - mx);
            float sum = ex;
            sum += __shfl_xor(sum, 4); sum += __shfl_xor(sum, 8); sum += __shfl_xor(sum, 16); sum += __shfl_xor(sum, 32);
            if ((F.lane & 3) == 0) out16[((size_t)b * NE + ecol) * SEQ + t] = ex / sum;
        } else {
            if ((F.lane & 3) == 0) { const float x = tot; float o;
                if (ecol < 8) o = 1.f / (1.f + __expf(-x));
                else { const float y = x + dt_bias[ecol - 8]; const float sp = y > 20.f ? y : log1pf(__expf(y)); o = -__expf(a_log[ecol - 8]) * sp; }
                out16[(size_t)r * 16 + ecol] = o; }
        }
    }
    __syncthreads();
}

__device__ __forceinline__ void ph_topk(const Frame& F, const float* aff, int* idx, float* gate, int* sel) {
    LAS unsigned* keys = (LAS unsigned*)F.lds;
    LAS unsigned* hist = keys + SEQ;
    LAS unsigned* cg = hist + 256; LAS unsigned* ce = cg + 512;
    LAS unsigned* shv = ce + 512;
    const int tid = F.tid;
    for (int item = F.vcu; item < BATCH * NE; item += F.G) {
        const int b = item >> 4, e = item & 15;
        for (int i = tid; i < SEQ; i += NTHREADS) keys[i] = __float_as_uint(aff[(size_t)item * SEQ + i]);
        if (tid == 0) { shv[0] = 0u; shv[1] = CAP; }
        lds_barrier();
        unsigned mask = 0u;
        for (int pass = 0; pass < 4; ++pass) {
            const int shift = 24 - 8 * pass;
            if (tid < 256) hist[tid] = 0u;
            lds_barrier();
            const unsigned prefix = shv[0];
            for (int i = tid; i < SEQ; i += NTHREADS) { const unsigned kx = keys[i]; if ((kx & mask) == prefix) __hip_atomic_fetch_add(&hist[(kx >> shift) & 255u], 1u, __ATOMIC_RELAXED, __HIP_MEMORY_SCOPE_WORKGROUP); }
            lds_barrier();
            for (int off2 = 1; off2 < 256; off2 <<= 1) {
                unsigned v2 = 0u;
                if (tid < 256) v2 = hist[tid] + (tid + off2 < 256 ? hist[tid + off2] : 0u);
                lds_barrier();
                if (tid < 256) hist[tid] = v2;
                lds_barrier();
            }
            if (tid < 256) { const unsigned need = shv[1], sfx = hist[tid], above = tid < 255 ? hist[tid + 1] : 0u;
                if (sfx >= need && above < need) { shv[2] = prefix | ((unsigned)tid << shift); shv[3] = need - above; } }
            lds_barrier();
            if (tid == 0) { shv[0] = shv[2]; shv[1] = shv[3]; }
            mask |= 0xFFu << shift;
            lds_barrier();
        }
        const unsigned T = shv[0], need = shv[1];
        unsigned ng = 0u, nq = 0u;
        for (int j = 0; j < 16; ++j) { const unsigned kx = keys[tid * 16 + j]; ng += kx > T; nq += kx == T; }
        unsigned ig = ng, iq = nq;
#pragma unroll
        for (int o2 = 1; o2 < 64; o2 <<= 1) { const unsigned xg = __shfl_up(ig, o2), xq = __shfl_up(iq, o2); if ((tid & 63) >= o2) { ig += xg; iq += xq; } }
        if ((tid & 63) == 63) { cg[tid >> 6] = ig; ce[tid >> 6] = iq; }
        lds_barrier();
        unsigned g0 = ig - ng, q0 = iq - nq;
        for (int w2 = 0; w2 < (tid >> 6); ++w2) { g0 += cg[w2]; q0 += ce[w2]; }
        for (int j = 0; j < 16; ++j) { const int t = tid * 16 + j; const unsigned kx = keys[t]; int slot = -1;
            if (kx > T) { slot = (int)(g0 + (q0 < need ? q0 : need)); ++g0; }
            else if (kx == T) { if (q0 < need) slot = (int)(g0 + q0); ++q0; }
            sel[((size_t)b * SEQ + t) * NE + e] = slot;
            if (slot >= 0) { idx[item * CAP + slot] = t; gate[item * CAP + slot] = __uint_as_float(kx); } }
        lds_barrier();
    }
}

template <bool FINAL>
__device__ __forceinline__ void ph_combine(const Frame& F, float* xl, const bf16_t* y, const int* sel, const float* ada  , const float* gwn, const float* ada_next, bf16_t* act) {
    const int gw_ = F.vcu * NWAVES + F.wave, NGW = F.G * NWAVES, lane = F.lane;
    int curb = -1; f32x4 g2v[4], mA[4], mB[4];
#pragma unroll
    for (int j = 0; j < 4; ++j) { g2v[j] = (f32x4){0.f, 0.f, 0.f, 0.f}; mA[j] = g2v[j]; mB[j] = g2v[j]; }
    int nslot = -1; f32x4 nx[4];
    if (gw_ < M_LAT) { nslot = lane < NE ? sel[(size_t)gw_ * NE + lane] : -1; const f32x4* xr0 = (const f32x4*)(xl + (size_t)gw_ * D) + lane;
#pragma unroll
        for (int j = 0; j < 4; ++j) nx[j] = xr0[64 * j]; }
    for (int r = gw_; r < M_LAT; r += NGW) {
        const int b = r >> 13;
        const int myslot = nslot; f32x4 xv[4];
#pragma unroll
        for (int j = 0; j < 4; ++j) xv[j] = nx[j];
        { const int rn = r + NGW; if (rn < M_LAT) { nslot = lane < NE ? sel[(size_t)rn * NE + lane] : -1; const f32x4* xrn = (const f32x4*)(xl + (size_t)rn * D) + lane;
#pragma unroll
              for (int j = 0; j < 4; ++j) nx[j] = xrn[64 * j]; } }
        if (b != curb) { curb = b; const float* g2 = ada + (size_t)b * 6 * D + 5 * D;
#pragma unroll
            for (int j = 0; j < 4; ++j) { const int c = 256 * j + 4 * lane; g2v[j] = *(const f32x4*)(g2 + c);
                const f32x4 g4 = *(const f32x4*)(gwn + c);
                if constexpr (FINAL) { mA[j] = g4; } else { const float* sh = ada_next + (size_t)b * 6 * D; mA[j] = g4 * (*(const f32x4*)(sh + D + c) + 1.f); mB[j] = *(const f32x4*)(sh + c); } } }
        f32x4 a[4];
#pragma unroll
        for (int j = 0; j < 4; ++j) a[j] = (f32x4){0.f, 0.f, 0.f, 0.f};
        unsigned mask = (unsigned)(__ballot(myslot >= 0) & 0xFFFFull);
        while (mask) {
            const bf16_t* rp[4]; float wv[4];
#pragma unroll
            for (int q = 0; q < 4; ++q) { const bool ok = mask != 0u; const int e = ok ? __builtin_ctz(mask) : 0; mask &= mask - 1u;
                const int s = __builtin_amdgcn_readlane(myslot, e);
                rp[q] = ok ? y + ((size_t)(b * NE + e) * CAP + s) * D : y; wv[q] = ok ? 1.f : 0.f; }
            u32x2 w[4][4];
#pragma unroll
            for (int q = 0; q < 4; ++q)
#pragma unroll
                for (int j = 0; j < 4; ++j) w[q][j] = ((const u32x2*)rp[q] + lane)[64 * j];
#pragma unroll
            for (int q = 0; q < 4; ++q)
#pragma unroll
                for (int j = 0; j < 4; ++j) { a[j].x += wv[q] * bf_lo(w[q][j].x); a[j].y += wv[q] * bf_hi(w[q][j].x); a[j].z += wv[q] * bf_lo(w[q][j].y); a[j].w += wv[q] * bf_hi(w[q][j].y); }
        }
        f32x4* xr = (f32x4*)(xl + (size_t)r * D) + lane;
        f32x4 v[4]; float s = 0.f;
#pragma unroll
        for (int j = 0; j < 4; ++j) { v[j] = xv[j] + g2v[j] * a[j]; s += (v[j].x * v[j].x + v[j].y * v[j].y) + (v[j].z * v[j].z + v[j].w * v[j].w); }
        const float rs = rsqrtf(wsum(s) * (1.f / D) + EPS);
        if constexpr (FINAL) {
#pragma unroll
            for (int j = 0; j < 4; ++j) xr[64 * j] = v[j] * rs * mA[j];
        } else {
            unsigned long long* o8 = (unsigned long long*)(act + (size_t)r * D) + lane;
#pragma unroll
            for (int j = 0; j < 4; ++j) { xr[64 * j] = v[j];
                const f32x4 o = v[j] * rs * mA[j] + mB[j];
                o8[64 * j] = (unsigned long long)pk2(o.x, o.y) | ((unsigned long long)pk2(o.z, o.w) << 32); }
        }
    }
}

__device__ __forceinline__ void ph_sc_glue(const Frame& F, const bf16_t* gb, const bf16_t* uu, const float* cw  , bf16_t* act) {
    const int gw_ = F.vcu * NWAVES + F.wave, NGW = F.G * NWAVES, lane = F.lane;
    float w0[16], w1[16], w2[16];
#pragma unroll
    for (int hh = 0; hh < 2; ++hh)
#pragma unroll
        for (int q = 0; q < 8; ++q) { const int c = hh * 512 + 8 * lane + q; w0[hh * 8 + q] = cw[c]; w1[hh * 8 + q] = cw[D + c]; w2[hh * 8 + q] = cw[2 * D + c]; }
    const u32x4 zero4 = (u32x4){0u, 0u, 0u, 0u};
    for (int blk = gw_; blk < M_LAT / 16; blk += NGW) {
        const int r0 = blk * 16, t0 = r0 & (SEQ - 1);
        u32x4 up[2], uc[2];
#pragma unroll
        for (int hh = 0; hh < 2; ++hh) { const int c = hh * 512 + 8 * lane;
            up[hh] = t0 > 0 ? *(const u32x4*)(uu + (size_t)(r0 - 1) * D + c) : zero4; uc[hh] = *(const u32x4*)(uu + (size_t)r0 * D + c); }
#pragma unroll 1
        for (int i0 = 0; i0 < 16; i0 += 4) {
            u32x4 gq[4][2], un[4][2];
#pragma unroll
            for (int i = 0; i < 4; ++i)
#pragma unroll
                for (int hh = 0; hh < 2; ++hh) { const int r = r0 + i0 + i, c = hh * 512 + 8 * lane;
                    gq[i][hh] = *(const u32x4*)(gb + (size_t)r * D + c);
                    un[i][hh] = (t0 + i0 + i + 1 < SEQ) ? *(const u32x4*)(uu + (size_t)(r + 1) * D + c) : zero4; }
#pragma unroll
            for (int i = 0; i < 4; ++i) {
#pragma unroll
                for (int hh = 0; hh < 2; ++hh) {
                    u32x4 o;
#pragma unroll
                    for (int q = 0; q < 4; ++q) {
                        const float lo = bf_lo(gq[i][hh][q]) * (w0[hh * 8 + 2 * q] * bf_lo(up[hh][q]) + w1[hh * 8 + 2 * q] * bf_lo(uc[hh][q]) + w2[hh * 8 + 2 * q] * bf_lo(un[i][hh][q]));
                        const float hi = bf_hi(gq[i][hh][q]) * (w0[hh * 8 + 2 * q + 1] * bf_hi(up[hh][q]) + w1[hh * 8 + 2 * q + 1] * bf_hi(uc[hh][q]) + w2[hh * 8 + 2 * q + 1] * bf_hi(un[i][hh][q]));
                        o[q] = pk2(lo, hi);
                    }
                    *(u32x4*)(act + (size_t)(r0 + i0 + i) * D + hh * 512 + 8 * lane) = o;
                    up[hh] = uc[hh]; uc[hh] = un[i][hh];
                }
            }
        }
    }
}

constexpr int NSLOT = 132;
constexpr int NCHAIN = BATCH * NH;
__device__ __forceinline__ int kperm(int s, int g, int j) { return 16 * (2 * s + (j >> 2)) + 4 * g + (j & 3); }

struct ScanPtrs { unsigned char* QN; unsigned char* KT; unsigned char* NWK; unsigned char* QK; unsigned char* U; float* SCL; };
__device__ __forceinline__ size_t so_shared(int chain, int slot) { return ((size_t)chain * NSLOT + slot) * 16384; }
__device__ __forceinline__ size_t so_dir(int dir, int chain, int slot) { return (((size_t)dir * NCHAIN + chain) * NSLOT + slot); }

__device__ __forceinline__ void ph_chunk_prep(const Frame& F, const bf16_t* QKV, const bf16_t* CKV, const float* GATES, const float* cw  , const ScanPtrs P) {
    LAS unsigned char* L = F.lds;
    LAS bf16_t* kn = (LAS bf16_t*)(L);
    LAS bf16_t* qn = (LAS bf16_t*)(L + 17408);
    LAS float* vv = (LAS float*)(L + 34816);
    LAS float* KK = (LAS float*)(L + 68608);
    LAS float* QKr = (LAS float*)(L + 86016);
    LAS bf16_t* WKs = (LAS bf16_t*)(L + 68608);
    LAS float* NT = (LAS float*)(L + 103424);
    LAS float* gamP = (LAS float*)(L + 136192);
    LAS float* betP = gamP + 128;
    LAS float* begP = gamP + 256;
    const int wave = F.wave;
    for (int item = F.vcu; item < NCHAIN * NSLOT; item += F.G) {
        int tid = F.tid; asm volatile("" : "+v"(tid));
        const int lane = tid & 63;
        const int chain = item / NSLOT, slot = item % NSLOT, b = chain >> 2, h = chain & 3;
        const bool isctx = slot < 4;
        const int Lseq = isctx ? CTX : SEQ, t0 = isctx ? slot * 64 : (slot - 4) * 64;
        {
            const int i = tid >> 3, cg = tid & 7, t = t0 + i;
            const bf16_t* src; int ld, qoff, koff, voff;
            if (isctx) { src = CKV + (size_t)(b * CTX) * 1024; ld = 1024; qoff = -1; koff = h * 128; voff = 512 + h * 128; }
            else { src = QKV + (size_t)(b * SEQ) * 1536; ld = 1536; qoff = h * 128; koff = 512 + h * 128; voff = 1024 + h * 128; }
            float o[3][16];
#pragma unroll
            for (int w = 0; w < 3; ++w) {
                const int off = w == 0 ? qoff : (w == 1 ? koff : voff);
                if (off < 0) {
#pragma unroll
                    for (int c = 0; c < 16; ++c) o[w][c] = 0.f;
                    continue;
                }
                const int wcol = w * 512 + h * 128 + cg * 16;
#pragma unroll
                for (int c = 0; c < 16; ++c) o[w][c] = 0.f;
#pragma unroll
                for (int tap = 0; tap < 3; ++tap) {
                    const int tt = t + tap - 1;
                    if (tt < 0 || tt >= Lseq) continue;
                    const u32x4 a0 = *(const u32x4*)(src + (size_t)tt * ld + off + cg * 16), a1 = *(const u32x4*)(src + (size_t)tt * ld + off + cg * 16 + 8);
                    const float* wp = cw + tap * 1536 + wcol;
#pragma unroll
                    for (int q = 0; q < 4; ++q) { o[w][2 * q] += wp[2 * q] * bf_lo(a0[q]); o[w][2 * q + 1] += wp[2 * q + 1] * bf_hi(a0[q]);
                        o[w][8 + 2 * q] += wp[8 + 2 * q] * bf_lo(a1[q]); o[w][8 + 2 * q + 1] += wp[8 + 2 * q + 1] * bf_hi(a1[q]); }
                }
#pragma unroll
                for (int c = 0; c < 16; ++c) o[w][c] = silu1(o[w][c]);
            }
            float sq = 0.f, sk = 0.f;
#pragma unroll
            for (int c = 0; c < 16; ++c) { sq += o[0][c] * o[0][c]; sk += o[1][c] * o[1][c]; }
            sq += __shfl_xor(sq, 1); sq += __shfl_xor(sq, 2); sq += __shfl_xor(sq, 4);
            sk += __shfl_xor(sk, 1); sk += __shfl_xor(sk, 2); sk += __shfl_xor(sk, 4);
            const float rq = rsqrtf(sq + EPS) * 0.08838834764831845f, rk = rsqrtf(sk + EPS);
#pragma unroll
            for (int c = 0; c < 16; c += 2) {
                *(LAS unsigned*)(qn + i * 136 + cg * 16 + c) = pk2(o[0][c] * rq, o[0][c + 1] * rq);
                *(LAS unsigned*)(kn + i * 136 + cg * 16 + c) = pk2(o[1][c] * rk, o[1][c + 1] * rk);
                vv[i * 132 + cg * 16 + c] = o[2][c]; vv[i * 132 + cg * 16 + c + 1] = o[2][c + 1];
            }
        }
        if (wave < 2) {
            const int dir = wave, i = dir ? 63 - lane : lane;
            const size_t grow = isctx ? (size_t)M_LAT + b * CTX + t0 + i : (size_t)b * SEQ + t0 + i;
            float g = GATES[grow * 16 + 8 + dir * 4 + h];
#pragma unroll
            for (int o2 = 1; o2 < 64; o2 <<= 1) { const float x = __shfl_up(g, o2); if (lane >= o2) g += x; }
            gamP[dir * 64 + lane] = g; const float bt0 = GATES[grow * 16 + dir * 4 + h]; betP[dir * 64 + lane] = bt0; begP[dir * 64 + lane] = bt0 * __expf(g);
        }
        lds_barrier();
        {
            const int fr = lane & 15, fq = lane >> 4;
#pragma unroll
            for (int tt = 0; tt < 4; ++tt) {
                const int tile = wave * 4 + tt, which = tile >> 4, mt = (tile >> 2) & 3, nt = tile & 3;
                LAS bf16_t* Am = which ? qn : kn;
                f32x4 acc = (f32x4){0.f, 0.f, 0.f, 0.f};
#pragma unroll
                for (int s = 0; s < 4; ++s) {
                    const bf16x8 a = *(const LAS bf16x8*)(Am + (16 * mt + fr) * 136 + 32 * s + 8 * fq);
                    const bf16x8 bb = *(const LAS bf16x8*)(kn + (16 * nt + fr) * 136 + 32 * s + 8 * fq);
                    acc = __builtin_amdgcn_mfma_f32_16x16x32_bf16(a, bb, acc, 0, 0, 0);
                }
                LAS float* Om = which ? QKr : KK;
#pragma unroll
                for (int r = 0; r < 4; ++r) Om[(16 * mt + 4 * fq + r) * 68 + 16 * nt + fr] = acc[r];
            }
        }
        lds_barrier();
        {
#pragma unroll 2
            for (int it = 0; it < 16; ++it) {
                const int idx = tid + 512 * it, dir = idx >> 12, pp = (idx >> 6) & 63, p = idx & 63;
                float val = 0.f;
                if (p > pp) { const int ip = dir ? 63 - p : p, ipp = dir ? 63 - pp : pp;
                    val = betP[dir * 64 + p] * KK[ip * 68 + ipp] * __expf(gamP[dir * 64 + p] - gamP[dir * 64 + pp]); }
                NT[idx] = val;
            }
            const int f = tid >> 6, l2 = tid & 63, g = l2 >> 4;
            if (!isctx) {
#pragma unroll
                for (int dir = 0; dir < 2; ++dir) {
                    const int m = f >> 1, s = f & 1, io = 16 * m + (l2 & 15);
                    const float gi = gamP[dir * 64 + (dir ? 63 - io : io)];
                    float vals[8];
#pragma unroll
                    for (int e = 0; e < 8; ++e) { const int j = kperm(s, g, e); const bool keep = dir ? (j >= io) : (j <= io);
                        vals[e] = keep ? QKr[io * 68 + j] * __expf(gi - gamP[dir * 64 + (dir ? 63 - j : j)]) : 0.f; }
                    u32x4 w; w.x = pk2(vals[0], vals[1]); w.y = pk2(vals[2], vals[3]); w.z = pk2(vals[4], vals[5]); w.w = pk2(vals[6], vals[7]);
                    *(u32x4*)(P.QK + so_dir(dir, chain, slot) * 8192 + (size_t)tid * 16) = w;
                }
#pragma unroll
                for (int it = 0; it < 2; ++it) {
                    const int q = tid + 512 * it, ff = q >> 6, m = ff >> 2, s = ff & 3, row = 16 * m + (l2 & 15);
                    const u32x2 lo = *(const LAS u32x2*)(qn + row * 136 + 32 * s + 4 * g), hi = *(const LAS u32x2*)(qn + row * 136 + 32 * s + 16 + 4 * g);
                    *(u32x4*)(P.QN + so_shared(chain, slot) + (size_t)q * 16) = (u32x4){lo.x, lo.y, hi.x, hi.y};
                }
            }
#pragma unroll
            for (int it = 0; it < 2; ++it) {
                const int q = tid + 512 * it, ff = q >> 6, mp = ff >> 1, s = ff & 1, dk = 16 * mp + (l2 & 15);
                unsigned short e8[8];
#pragma unroll
                for (int e = 0; e < 8; ++e) e8[e] = kn[kperm(s, g, e) * 136 + dk];
                u32x4 w; w.x = e8[0] | ((unsigned)e8[1] << 16); w.y = e8[2] | ((unsigned)e8[3] << 16); w.z = e8[4] | ((unsigned)e8[5] << 16); w.w = e8[6] | ((unsigned)e8[7] << 16);
                *(u32x4*)(P.KT + so_shared(chain, slot) + (size_t)q * 16) = w;
            }
            if (tid < 128) { const int dir = tid >> 6, i = tid & 63, p = dir ? 63 - i : i;
                const float gl = gamP[dir * 64 + 63], gi = gamP[dir * 64 + p];
                float* sc = P.SCL + so_dir(dir, chain, slot) * 256;
                sc[i] = __expf(gi); sc[64 + i] = __expf(gl - gi); if (i == 0) sc[128] = __expf(gl); }
        }
        lds_barrier();
        {
            const int dir = wave >> 2, kind = (wave >> 1) & 1, c = (wave & 1) * 64 + lane;
            float Y[64];
            if (kind) {
#pragma unroll
                for (int p = 0; p < 64; ++p) { const int i = dir ? 63 - p : p; Y[p] = begP[dir * 64 + p] * bf_lo((unsigned)kn[i * 136 + c]); }
            } else {
#pragma unroll
                for (int p = 0; p < 64; ++p) { const int i = dir ? 63 - p : p; Y[p] = betP[dir * 64 + p] * vv[i * 132 + c]; }
            }
            const LAS float* nt = NT + dir * 4096;
#pragma unroll
            for (int pp = 0; pp < 63; ++pp) {
                const float y = Y[pp];
                int zdep; asm("v_and_b32 %0, 0, %1" : "=v"(zdep) : "v"(y));
                const LAS float* ntp = nt + zdep;
#pragma unroll
                for (int q4 = (pp + 1) & ~3; q4 < 64; q4 += 4) {
                    const f32x4 n4 = *(const LAS f32x4*)(ntp + pp * 64 + q4);
                    if (q4 + 0 > pp) Y[q4 + 0] -= n4.x * y;
                    if (q4 + 1 > pp) Y[q4 + 1] -= n4.y * y;
                    if (q4 + 2 > pp) Y[q4 + 2] -= n4.z * y;
                    if (q4 + 3 > pp) Y[q4 + 3] -= n4.w * y;
                }
            }
            lds_barrier();
            if (kind == 0) {
                const int T = c >> 4;
                unsigned char* ub = P.U + so_dir(dir, chain, slot) * 16384;
#pragma unroll
                for (int m = 0; m < 4; ++m)
#pragma unroll
                    for (int g = 0; g < 4; ++g) { const int i0 = 16 * m + 4 * g;
                        const float y0 = Y[dir ? 63 - i0 : i0], y1 = Y[dir ? 62 - i0 : i0 + 1], y2 = Y[dir ? 61 - i0 : i0 + 2], y3 = Y[dir ? 60 - i0 : i0 + 3];
                        *(u32x2*)(ub + (size_t)(((T * 4 + m) * 64) + g * 16 + (c & 15)) * 8) = (u32x2){pk2(y0, y1), pk2(y2, y3)}; }
            } else {
#pragma unroll
                for (int p = 0; p < 64; ++p) { const int i = dir ? 63 - p : p; WKs[(dir * 64 + i) * 136 + c] = (bf16_t)f2bf(-Y[p]); }
            }
        }
        lds_barrier();
#pragma unroll
        for (int it = 0; it < 4; ++it) {
            const int q = tid + 512 * it, dir = q >> 10, q1 = q & 1023, ff = q1 >> 6, l2 = q1 & 63, g = l2 >> 4, m = ff >> 2, s = ff & 3, row = 16 * m + (l2 & 15);
            const LAS bf16_t* wt = WKs + (dir * 64 + row) * 136;
            const u32x2 lo = *(const LAS u32x2*)(wt + 32 * s + 4 * g), hi = *(const LAS u32x2*)(wt + 32 * s + 16 + 4 * g);
            *(u32x4*)(P.NWK + so_dir(dir, chain, slot) * 16384 + (size_t)q1 * 16) = (u32x4){lo.x, lo.y, hi.x, hi.y};
        }
        lds_barrier();
    }
}

constexpr int SC_NWK = 0, SC_QN = 16384, SC_KT = 32768, SC_QK = 49152, SC_U = 57344, SC_SCL = 65536, SC_STAGE = 66560;
__device__ __forceinline__ void ph_scan(const Frame& F, const ScanPtrs P, bf16_t* OF, bf16_t* OB) {
    const int xg = F.vcu >> 5, xj = F.vcu & 31;
    if (xj >= 8 || xg >= 8) return;
    const int sb = xg * 8 + xj, half = sb & 1, dir = (sb >> 1) & 1, chain = sb >> 2, b = chain >> 2, h = chain & 3;
    LAS unsigned char* L = F.lds;
    const int lane = F.lane, wave = F.wave, g = lane >> 4;
    bf16_t* O = dir ? OB : OF;
    auto slot_of = [&](int step) { return dir ? (step < 4 ? 3 - step : 135 - step) : step; };
    auto issue = [&](int step) {
        const int slot = slot_of(step); const unsigned sbase = (unsigned)(step & 1) * SC_STAGE; const bool emit = slot >= 4;
        const int w4 = wave - 4;
        const unsigned char* nwk = P.NWK + so_dir(dir, chain, slot) * 16384; const unsigned char* kt = P.KT + so_shared(chain, slot);
        const unsigned char* qn = P.QN + so_shared(chain, slot); const unsigned char* qk = P.QK + so_dir(dir, chain, slot) * 8192;
        const unsigned char* uu = P.U + so_dir(dir, chain, slot) * 16384 + half * 8192; const unsigned char* sc = (const unsigned char*)(P.SCL + so_dir(dir, chain, slot) * 256);
#pragma unroll
        for (int i = 0; i < 4; ++i) { const int pc = w4 * 4 + i;
            __builtin_amdgcn_global_load_lds((const unsigned*)(nwk + pc * 1024 + lane * 16), (LAS unsigned*)(L + sbase + SC_NWK + pc * 1024), 16, 0, 0);
            __builtin_amdgcn_global_load_lds((const unsigned*)(kt + pc * 1024 + lane * 16), (LAS unsigned*)(L + sbase + SC_KT + pc * 1024), 16, 0, 0); }
#pragma unroll
        for (int i = 0; i < 2; ++i) { const int pc = w4 * 2 + i;
            __builtin_amdgcn_global_load_lds((const unsigned*)(uu + pc * 1024 + lane * 16), (LAS unsigned*)(L + sbase + SC_U + pc * 1024), 16, 0, 0); }
        if (w4 == 0) __builtin_amdgcn_global_load_lds((const unsigned*)(sc + lane * 16), (LAS unsigned*)(L + sbase + SC_SCL), 16, 0, 0);
        if (emit) {
#pragma unroll
            for (int i = 0; i < 4; ++i) { const int pc = w4 * 4 + i;
                __builtin_amdgcn_global_load_lds((const unsigned*)(qn + pc * 1024 + lane * 16), (LAS unsigned*)(L + sbase + SC_QN + pc * 1024), 16, 0, 0); }
#pragma unroll
            for (int i = 0; i < 2; ++i) { const int pc = w4 * 2 + i;
                __builtin_amdgcn_global_load_lds((const unsigned*)(qk + pc * 1024 + lane * 16), (LAS unsigned*)(L + sbase + SC_QK + pc * 1024), 16, 0, 0); }
        }
    };
    f32x4 accS[8]; bf16x8 bS[4];
#pragma unroll
    for (int m = 0; m < 8; ++m) accS[m] = (f32x4){0.f, 0.f, 0.f, 0.f};
#pragma unroll
    for (int s = 0; s < 4; ++s) bS[s] = (bf16x8){0, 0, 0, 0, 0, 0, 0, 0};
    if (wave >= 4) { issue(0); asm volatile("s_waitcnt vmcnt(0)" ::: "memory"); }
    lds_barrier();
    for (int step = 0; step < NSLOT; ++step) {
        if (wave >= 4) { if (step + 1 < NSLOT) issue(step + 1); asm volatile("s_waitcnt vmcnt(0)" ::: "memory"); }
        else {
            const int slot = slot_of(step); const bool emit = slot >= 4;
            const unsigned sva = (unsigned)(unsigned long long)(L) + (unsigned)(step & 1) * SC_STAGE + (unsigned)lane * 16u;
            const unsigned sua = sva - (unsigned)lane * 8u + SC_U + (unsigned)wave * 2048u;
            const unsigned ssa = sva - (unsigned)lane * 16u + SC_SCL + (unsigned)g * 16u;
#define SC_RD128(dst, addr, off) asm volatile("ds_read_b128 %0, %1 offset:%2" : "=v"(dst) : "v"(addr), "n"(off))
#define SC_LOAD(dst, base, first) do { _Pragma("unroll") for (int i_ = 0; i_ < 8; ++i_) SC_RD128(dst[i_], sva, (base) + ((first) + i_) * 1024); } while (0)
#define SC_WAIT(n, a) do { asm volatile("s_waitcnt lgkmcnt(%8)" : "+v"(a[0]), "+v"(a[1]), "+v"(a[2]), "+v"(a[3]), "+v"(a[4]), "+v"(a[5]), "+v"(a[6]), "+v"(a[7]) : "n"(n)); __builtin_amdgcn_sched_barrier(0); } while (0)
            f32x4 accw[4], acco[4], eg4[4], ek4[4]; u32x2 uv[4]; float cd;
            bf16x8 fa[8], fb[8];
#pragma unroll
            for (int m = 0; m < 4; ++m) asm volatile("ds_read_b64 %0, %1 offset:%2" : "=v"(uv[m]) : "v"(sua), "n"(m * 512));
#pragma unroll
            for (int m = 0; m < 4; ++m) { SC_RD128(ek4[m], ssa, 256 + m * 64); SC_RD128(eg4[m], ssa, m * 64); }
            asm volatile("ds_read_b32 %0, %1 offset:512" : "=v"(cd) : "v"(ssa - (unsigned)g * 16u));
            SC_LOAD(fa, SC_NWK, 0);
            asm volatile("s_waitcnt lgkmcnt(8)" : "+v"(uv[0]), "+v"(uv[1]), "+v"(uv[2]), "+v"(uv[3]), "+v"(ek4[0]), "+v"(ek4[1]), "+v"(ek4[2]), "+v"(ek4[3]),
                         "+v"(eg4[0]), "+v"(eg4[1]), "+v"(eg4[2]), "+v"(eg4[3]), "+v"(cd)); __builtin_amdgcn_sched_barrier(0);
#pragma unroll
            for (int m = 0; m < 4; ++m) { accw[m] = (f32x4){bf_lo(uv[m].x), bf_hi(uv[m].x), bf_lo(uv[m].y), bf_hi(uv[m].y)}; acco[m] = (f32x4){0.f, 0.f, 0.f, 0.f}; }
            SC_LOAD(fb, SC_NWK, 8);
            SC_WAIT(8, fa);
#pragma unroll
            for (int f = 0; f < 8; ++f) accw[f >> 2] = __builtin_amdgcn_mfma_f32_16x16x32_bf16(fa[f], bS[f & 3], accw[f >> 2], 0, 0, 0);
            if (emit) SC_LOAD(fa, SC_QN, 0); else SC_LOAD(fa, SC_KT, 0);
            SC_WAIT(8, fb);
#pragma unroll
            for (int f = 0; f < 8; ++f) accw[2 + (f >> 2)] = __builtin_amdgcn_mfma_f32_16x16x32_bf16(fb[f], bS[f & 3], accw[2 + (f >> 2)], 0, 0, 0);
            if (emit) SC_LOAD(fb, SC_QN, 8); else SC_LOAD(fb, SC_KT, 8);
            bf16x8 bW[2], bWs[2];
#pragma unroll
            for (int s = 0; s < 2; ++s) {
                const f32x4 w0 = accw[2 * s], w1 = accw[2 * s + 1], e0 = ek4[2 * s], e1 = ek4[2 * s + 1];
                u32x4 a, c2;
                a.x = cvt_pk_bf16(w0[0], w0[1]); a.y = cvt_pk_bf16(w0[2], w0[3]); a.z = cvt_pk_bf16(w1[0], w1[1]); a.w = cvt_pk_bf16(w1[2], w1[3]);
                c2.x = cvt_pk_bf16(w0[0] * e0[0], w0[1] * e0[1]); c2.y = cvt_pk_bf16(w0[2] * e0[2], w0[3] * e0[3]); c2.z = cvt_pk_bf16(w1[0] * e1[0], w1[1] * e1[1]); c2.w = cvt_pk_bf16(w1[2] * e1[2], w1[3] * e1[3]);
                bW[s] = __builtin_bit_cast(bf16x8, a); bWs[s] = __builtin_bit_cast(bf16x8, c2);
            }
#pragma unroll
            for (int m = 0; m < 8; ++m) accS[m] = accS[m] * cd;
            if (emit) {
                SC_WAIT(8, fa);
#pragma unroll
                for (int f = 0; f < 8; ++f) acco[f >> 2] = __builtin_amdgcn_mfma_f32_16x16x32_bf16(fa[f], bS[f & 3], acco[f >> 2], 0, 0, 0);
                SC_LOAD(fa, SC_KT, 0);
                SC_WAIT(8, fb);
#pragma unroll
                for (int f = 0; f < 8; ++f) acco[2 + (f >> 2)] = __builtin_amdgcn_mfma_f32_16x16x32_bf16(fb[f], bS[f & 3], acco[2 + (f >> 2)], 0, 0, 0);
                SC_LOAD(fb, SC_KT, 8);
#pragma unroll
                for (int m = 0; m < 4; ++m) acco[m] = acco[m] * eg4[m];
            }
            SC_WAIT(8, fa);
#pragma unroll
            for (int f = 0; f < 8; ++f) accS[f >> 1] = __builtin_amdgcn_mfma_f32_16x16x32_bf16(fa[f], bWs[f & 1], accS[f >> 1], 0, 0, 0);
            if (emit) { SC_LOAD(fa, SC_QK, 0); SC_WAIT(8, fb); } else SC_WAIT(0, fb);
#pragma unroll
            for (int f = 0; f < 8; ++f) accS[4 + (f >> 1)] = __builtin_amdgcn_mfma_f32_16x16x32_bf16(fb[f], bWs[f & 1], accS[4 + (f >> 1)], 0, 0, 0);
            if (emit) {
                SC_WAIT(0, fa);
#pragma unroll
                for (int f = 0; f < 8; ++f) acco[f >> 1] = __builtin_amdgcn_mfma_f32_16x16x32_bf16(fa[f], bW[f & 1], acco[f >> 1], 0, 0, 0);
                bf16_t* orow = O + ((size_t)b * SEQ + (slot - 4) * 64) * 512 + h * 128 + half * 64 + wave * 16 + (lane & 15);
#pragma unroll
                for (int m = 0; m < 4; ++m)
#pragma unroll
                    for (int r = 0; r < 4; ++r) orow[(size_t)(16 * m + 4 * g + r) * 512] = (bf16_t)f2bf(acco[m][r]);
            }
#pragma unroll
            for (int s = 0; s < 4; ++s) {
                const f32x4 s0 = accS[2 * s], s1 = accS[2 * s + 1];
                u32x4 a; a.x = cvt_pk_bf16(s0[0], s0[1]); a.y = cvt_pk_bf16(s0[2], s0[3]); a.z = cvt_pk_bf16(s1[0], s1[1]); a.w = cvt_pk_bf16(s1[2], s1[3]);
                bS[s] = __builtin_bit_cast(bf16x8, a);
            }
#undef SC_LOAD
#undef SC_WAIT
#undef SC_RD128
        }
        lds_barrier();
    }
}

__device__ __forceinline__ void ph_even_A(const Frame& F, const bf16_t* OF, const bf16_t* OB, const bf16_t* Z, const bf16_t* POOL, const float* onorm, bf16_t* act) {
    LAS unsigned char* L = F.lds;
    for (int seg = F.vcu; seg < M_LAT / 64; seg += F.G) {
        int tid = F.tid; asm volatile("" : "+v"(tid));
        const int lane = tid & 63;
        const size_t row0 = (size_t)seg * 64;
#pragma unroll
        for (int i = 0; i < 8; ++i) { const int q = tid + 512 * i;
            *(LAS u32x4*)(L + q * 16) = *(const u32x4*)(POOL + row0 * 512 + (size_t)q * 8); }
        __syncthreads();
#pragma unroll 1
        for (int i0 = 0; i0 < 8; i0 += 4) {
            u32x4 av[4], bv[4], zv[4];
#pragma unroll
            for (int i = 0; i < 4; ++i) { const size_t r = row0 + F.wave * 8 + i0 + i;
                av[i] = *(const u32x4*)(OF + r * 512 + 8 * lane); bv[i] = *(const u32x4*)(OB + r * 512 + 8 * lane); zv[i] = *(const u32x4*)(Z + r * 512 + 8 * lane); }
#pragma unroll
            for (int i = 0; i < 4; ++i) {
                const int pos = F.wave * 8 + i0 + i; const size_t r = row0 + pos;
                const u32x4 a = av[i], b2 = bv[i], z = zv[i];
                float o[8]; float s = 0.f;
#pragma unroll
                for (int q = 0; q < 4; ++q) { o[2 * q] = bf_lo(a[q]) + bf_lo(b2[q]); o[2 * q + 1] = bf_hi(a[q]) + bf_hi(b2[q]); s += o[2 * q] * o[2 * q] + o[2 * q + 1] * o[2 * q + 1]; }
                s += __shfl_xor(s, 1); s += __shfl_xor(s, 2); s += __shfl_xor(s, 4); s += __shfl_xor(s, 8);
                const float rs = rsqrtf(s * (1.f / 128.f) + EPS);
                const float* gn = onorm + ((8 * lane) & 127);
                u32x4 w;
#pragma unroll
                for (int q = 0; q < 4; ++q) w[q] = pk2(o[2 * q] * rs * gn[2 * q] * silu1(bf_lo(z[q])), o[2 * q + 1] * rs * gn[2 * q + 1] * silu1(bf_hi(z[q])));
                *(u32x4*)(act + r * D + 8 * lane) = w;
                const int grp = lane >> 4, win = 2 << grp;
                int lo = pos - win / 2; if (lo < 0) lo = 0; int hi = pos + win - win / 2; if (hi > 64) hi = 64;
                float m[8];
#pragma unroll
                for (int q = 0; q < 8; ++q) m[q] = 0.f;
#pragma unroll
                for (int p = 0; p < 16; ++p) { const int rr = lo + p; const bool ok = rr < hi;
                    const u32x4 pv = *(const LAS u32x4*)(L + (ok ? rr : pos) * 1024 + lane * 16);
                    if (ok) {
#pragma unroll
                        for (int q = 0; q < 4; ++q) { m[2 * q] += bf_lo(pv[q]); m[2 * q + 1] += bf_hi(pv[q]); } } }
                const float inv = 1.f / (float)(hi - lo);
                const u32x4 self = *(const LAS u32x4*)(L + pos * 1024 + lane * 16);
#pragma unroll
                for (int q = 0; q < 4; ++q) w[q] = pk2(m[2 * q] * inv - bf_lo(self[q]), m[2 * q + 1] * inv - bf_hi(self[q]));
                *(u32x4*)(act + r * D + 512 + 8 * lane) = w;
            }
        }
        __syncthreads();
    }
}

__device__ __forceinline__ void prep_late(const Frame& F, const Args& args, int widx, int nw, bf16_t* WOUT, bf16_t* SCIN, bf16_t* SCOUT, bf16_t* WGU, bf16_t* WDN) {
    LAS float* scr = (LAS float*)(F.lds + F.wave * 16384);
    const float* w_gate = args.in[21]; const float* w_up = args.in[22]; const float* w_down = args.in[23];
    for (int it = widx; it < 256; it += nw) { const int kb = it >> 5, nb = it & 31;
        transpose_item(args.in[16], D, D, 32 * nb, 64 * kb, WOUT, 32 * nb, scr, F.lane); }
    for (int it = widx; it < 4 * 128 * 16; it += nw) { const int gq = it >> 11, c = (it >> 4) & 127, n = (it & 15) * 64 + F.lane;
        const float* pw = args.in[14] + ((size_t)gq * 128 + c) * 128; const float* ps = args.in[15] + gq * 128; const float* wo = args.in[16] + (size_t)(512 + gq * 128) * D + n;
        float acc = 0.f;
#pragma unroll 8
        for (int d = 0; d < 128; ++d) acc += pw[d] * ps[d] * wo[(size_t)d * D];
        WOUT[(size_t)n * D + 512 + gq * 128 + c] = (bf16_t)f2bf(acc); }
    for (int it = widx; it < 2048; it += nw) {
        if (it < 1536) { const int kb = it / 96, nb = it % 96, n0 = 32 * nb; int drow;
            if (n0 < D) drow = n0; else if (n0 < 2 * D) drow = D + ((n0 - D) >> 7) * 256 + (n0 & 127); else drow = D + ((n0 - 2 * D) >> 7) * 256 + 128 + (n0 & 127);
            transpose_item(args.in[17], D, 3 * D, n0, 64 * kb, SCIN, drow, scr, F.lane); }
        else { const int q = it - 1536, kb = q >> 5, nb = q & 31;
            transpose_item(args.in[19], D, D, 32 * nb, 64 * kb, SCOUT, 32 * nb, scr, F.lane); }
    }
    for (int it = widx; it < 2 * NE * 768; it += nw) {
        const int le = it / 768, r = it % 768;
        if (r < 512) { const int up = r >> 8, q = r & 255, kb = q >> 4, nb = q & 15, n0 = 32 * nb;
            transpose_item((up ? w_up : w_gate) + (size_t)le * D * DE, D, DE, n0, 64 * kb, WGU + (size_t)le * 1024 * D, (n0 >> 7) * 256 + up * 128 + (n0 & 127), scr, F.lane); }
        else { const int q = r - 512, kb = q >> 5, nb = q & 31;
            transpose_item(w_down + (size_t)le * DE * D, DE, D, 32 * nb, 64 * kb, WDN + (size_t)le * D * DE, 32 * nb, scr, F.lane); }
    }
}

enum { PH_PREP = 0, PH_E1, PH_E2, PH_E3, PH_E4, PH_E5, PH_E6, PH_M1_0, PH_M2_0, PH_M3_0, PH_M4_0, PH_M5_0, PH_X1, PH_X2, PH_X3, PH_M1_1, PH_M2_1, PH_M3_1, PH_M4_1, PH_M5_1, PH_COUNT };

__global__ void __launch_bounds__(NTHREADS, 2) mega(Args args) {
    extern __shared__ __attribute__((aligned(16))) unsigned char lds_raw[];
    Frame F;
    F.lds = (LAS unsigned char*)lds_raw;
    F.tid = threadIdx.x; F.lane = F.tid & 63; F.wave = __builtin_amdgcn_readfirstlane(F.tid >> 6);
    F.G = gridDim.x; { const int bx = blockIdx.x; F.vcu = (F.G % 8 == 0) ? (bx % 8) * (F.G / 8) + bx / 8 : bx; }
    volatile LAS unsigned* MISC = (volatile LAS unsigned*)(F.lds + MISC_OFF);
    if (F.tid < 64) MISC[F.tid] = 0u;
    __syncthreads();
    unsigned char* ws = args.ws;
    XcdBarrier bar = xcd_barrier_post((unsigned*)(ws + WS_CTL) + CW_BAR + args.li * XCD_BAR_WORDS, MISC + 8);
    const int lo = args.ph_lo, hi = args.ph_hi;
#define IN(k) (lo <= (k) && (k) < hi)
#define SEAM(k) do { if (IN(k) && IN((k) + 1)) xcd_barrier(bar); } while (0)
    const float* ADA = (const float*)(ws + WS_ADA); float* ADAw = (float*)(ws + WS_ADA);
    float* AFF = (float*)(ws + WS_AFF); int* IDX = (int*)(ws + WS_IDX); float* GATE = (float*)(ws + WS_GATE); int* SEL = (int*)(ws + WS_SEL);
    bf16_t* WGU = (bf16_t*)(ws + WS_WGU); bf16_t* WDN = (bf16_t*)(ws + WS_WDN); bf16_t* SCIN = (bf16_t*)(ws + WS_SCIN); bf16_t* SCOUT = (bf16_t*)(ws + WS_SCOUT);
    bf16_t* GBp = (bf16_t*)(ws + WS_GB); bf16_t* UUp = (bf16_t*)(ws + WS_UU);
    bf16_t* WIN = (bf16_t*)(ws + WS_WIN); bf16_t* WOUT = (bf16_t*)(ws + WS_WOUT); float* GATES = (float*)(ws + WS_GATES);
    const ScanPtrs SP{ws + WS_QN, ws + WS_KT, ws + WS_NWK, (unsigned char*)args.out + 66 * MiB, (unsigned char*)args.out, (float*)(ws + WS_SCL)};
    bf16_t* OFp = (bf16_t*)(ws + WS_OF); bf16_t* OBp = (bf16_t*)(ws + WS_OB);
    bf16_t* QKV = (bf16_t*)(ws + WS_QKV); bf16_t* Zp = (bf16_t*)(ws + WS_Z); bf16_t* POOLp = (bf16_t*)(ws + WS_POOL); bf16_t* CKV = (bf16_t*)(ws + WS_CKV);
    bf16_t* ACT = (bf16_t*)(ws + WS_ACT); bf16_t* HID = (bf16_t*)(ws + WS_HID); bf16_t* Y = (bf16_t*)(ws + WS_Y);
    float* xl = args.out;

    if (IN(PH_PREP)) {
        LAS float* scr = (LAS float*)(F.lds + F.wave * 16384);
        const int gw_ = F.vcu * NWAVES + F.wave, NGW = F.G * NWAVES;
        for (int it = F.vcu; it < 192; it += F.G) { const int l = it / 96, n = (it % 96) * 64 + F.lane;
            const float* w = args.in[4] + (size_t)l * D * 6 * D + (size_t)(128 * F.wave) * 6 * D + n; float acc[5] = {0.f, 0.f, 0.f, 0.f, 0.f};
#pragma unroll 8
            for (int k2 = 0; k2 < 128; ++k2) { const float wv = w[(size_t)k2 * 6 * D]; const int kk = 128 * F.wave + k2;
#pragma unroll
                for (int r = 0; r < 5; ++r) { const float cv = r < 4 ? args.in[1][r * D + kk] : args.in[3][kk]; acc[r] += silu1(cv) * wv; } }
            LAS float* red = (LAS float*)(F.lds + 8 * 16384);
#pragma unroll
            for (int r = 0; r < 5; ++r) red[(F.wave * 5 + r) * 64 + F.lane] = acc[r];
            __syncthreads();
            if (F.tid < 320) { const int r = F.tid >> 6, ln = F.tid & 63; float sacc = 0.f;
#pragma unroll
                for (int w2 = 0; w2 < 8; ++w2) sacc += red[(w2 * 5 + r) * 64 + ln];
                const int n2 = (it % 96) * 64 + ln;
                ADAw[((size_t)l * 5 + r) * 6 * D + n2] = sacc + args.in[5][l * 6 * D + n2]; }
            __syncthreads(); }
        for (int it = gw_; it < 1280; it += NGW) { const int kb = it / 80, nb = it % 80, n0 = 32 * nb;
            transpose_item(args.in[9], D, EVEN_IN, n0 < 2048 ? n0 : n0 + 16, 64 * kb, WIN, n0, scr, F.lane); }
    }
    SEAM(PH_PREP);
    if (IN(PH_E1)) ph_norm16<1>(F, args.in[0], args.in[2], ACT, args.in[6], ADA, args.in[9] + 2048, EVEN_IN, GATES, args.in[11], args.in[12]);
    SEAM(PH_E1);
    if (IN(PH_E2)) { SchedProj S{F.vcu, F.G}; EpiProj E{QKV, Zp, POOLp, CKV}; gemm_phase<EpiProj, SchedProj, false>(F.lds, ACT, WIN, D, S, E); }
    SEAM(PH_E2);
    if (IN(PH_E3)) ph_chunk_prep(F, QKV, CKV, GATES, args.in[10], SP);
    SEAM(PH_E3);
    if (IN(PH_E4)) {
        if ((F.vcu & 31) < 8) ph_scan(F, SP, OFp, OBp);
        else prep_late(F, args, ((F.vcu >> 5) * 24 + (F.vcu & 31) - 8) * NWAVES + F.wave, 192 * NWAVES, WOUT, SCIN, SCOUT, WGU, WDN);
    }
    SEAM(PH_E4);
    if (IN(PH_E5)) ph_even_A(F, OFp, OBp, Zp, POOLp, args.in[13], ACT);
    SEAM(PH_E5);
    if (IN(PH_E6)) { SchedDense<4, 256> S{F.vcu, F.G, 128 * 4}; EpiResid E{args.in[0], xl, ADA + 2 * D}; gemm_phase<EpiResid, SchedDense<4, 256>, false>(F.lds, ACT, WOUT, D, S, E); }
    SEAM(PH_E6);
#define MOE_SEGMENT(l, p0) do { \
        const float* ada_l = ADA + (size_t)(l) * 5 * 6 * D; \
        if (IN(p0)) ph_norm16<0>(F, xl, nullptr, ACT, args.in[7] + (l) * D, ada_l, args.in[20] + (size_t)(l) * D * NE, NE, AFF, nullptr, nullptr); \
        SEAM(p0); \
        if (IN((p0) + 1)) ph_topk(F, AFF, IDX, GATE, SEL); \
        SEAM((p0) + 1); \
        if (IN((p0) + 2)) { SchedMoeUp S{F.vcu, (l), IDX}; EpiSiluMul E{HID, DE}; gemm_phase<EpiSiluMul, SchedMoeUp, true>(F.lds, ACT, WGU, D, S, E); } \
        SEAM((p0) + 2); \
        if (IN((p0) + 3)) { SchedMoeDown S{F.vcu, (l)}; EpiRowScale E{Y, D, GATE}; gemm_phase<EpiRowScale, SchedMoeDown, false>(F.lds, HID, WDN, DE, S, E); } \
        SEAM((p0) + 3); \
        if (IN((p0) + 4)) { \
            if ((l) == 0) ph_combine<false>(F, xl, Y, SEL, ada_l, args.in[6] + D, ADA + (size_t)5 * 6 * D, ACT); \
            else ph_combine<true>(F, xl, Y, SEL, ada_l, args.in[8], nullptr, nullptr); \
        } \
    } while (0)
    MOE_SEGMENT(0, PH_M1_0);
    SEAM(PH_M5_0);
    if (IN(PH_X1)) { SchedDense<12, 1> S{F.vcu, F.G, 128 * 12}; EpiScIn E{GBp, UUp}; gemm_phase<EpiScIn, SchedDense<12, 1>, false>(F.lds, ACT, SCIN, D, S, E); }
    SEAM(PH_X1);
    if (IN(PH_X2)) ph_sc_glue(F, GBp, UUp, args.in[18], ACT);
    SEAM(PH_X2);
    if (IN(PH_X3)) { SchedDense<4, 256> S{F.vcu, F.G, 128 * 4}; EpiResid E{xl, xl, ADA + (size_t)5 * 6 * D + 2 * D}; gemm_phase<EpiResid, SchedDense<4, 256>, false>(F.lds, ACT, SCOUT, D, S, E); }
    SEAM(PH_X3);
    MOE_SEGMENT(1, PH_M1_1);
#undef MOE_SEGMENT
#undef IN
#undef SEAM
}
}

}

extern "C" void kernel_launch(void* const* d_in, const int* in_sizes, int n_in, void* d_out, int out_size, void* d_ws, size_t ws_size, hipStream_t st) {
    static int grid = 0;
    if (grid == 0) {
        int dev = 0, cus = 0;
        if (hipGetDevice(&dev) != hipSuccess || hipDeviceGetAttribute(&cus, hipDeviceAttributeMultiprocessorCount, dev) != hipSuccess) { grid = -1; return; }
        if (hipFuncSetAttribute((const void*)mk::mega, hipFuncAttributeMaxDynamicSharedMemorySize, mk::LDS_BYTES) != hipSuccess) { fprintf(stderr, "hipFuncSetAttribute failed\n"); grid = -1; return; }
        if (ws_size < mk::WS_END) { fprintf(stderr, "workspace too small: %zu < %zu\n", ws_size, (size_t)mk::WS_END); grid = -1; return; }
        grid = cus;
    }
    if (grid < 0) return;
    (void)hipMemsetAsync((char*)d_ws + mk::WS_CTL, 0, mk::MiB, st);
    mk::Args a{};
    for (int i = 0; i < 24; ++i) a.in[i] = (const float*)d_in[i];
    a.out = (float*)d_out; a.ws = (unsigned char*)d_ws;
    int n_mega = 0;
    auto mega = [&](int lo, int hi) { a.ph_lo = lo; a.ph_hi = hi; a.li = n_mega++; hipLaunchKernelGGL(mk::mega, dim3(grid), dim3(mk::NTHREADS), mk::LDS_BYTES, st, a); };
    mega(0, mk::PH_COUNT);
}
```

```cpp
#include <hip/hip_runtime.h>
#include <cstdio>
#include <cstdint>

namespace {
constexpr int D = 1024, BATCH = 4, SEQ = 8192, CTX = 256, NH = 4, DK = 128, DV = 128;
constexpr int EVEN_IN = 2576, NE = 16, DE = 512, CAP = 1024;
constexpr float EPS = 1e-6f;

__device__ __forceinline__ float silu_f(float x) { return x / (1.f + __expf(-x)); }
__device__ __forceinline__ float sigmoid_f(float x) { return 1.f / (1.f + __expf(-x)); }
__device__ __forceinline__ float softplus_f(float x) { return x > 20.f ? x : log1pf(__expf(x)); }
__device__ __forceinline__ float wave_sum(float v) {
#pragma unroll
    for (int o = 1; o < 64; o <<= 1) v += __shfl_xor(v, o);
    return v;
}


namespace mk {
#define LAS __attribute__((address_space(3)))
#define GAS __attribute__((address_space(1)))
typedef unsigned short bf16_t;
typedef short bf16x8 __attribute__((ext_vector_type(8)));
typedef float f32x4 __attribute__((ext_vector_type(4)));
typedef float f32x2 __attribute__((ext_vector_type(2)));
typedef unsigned u32x4 __attribute__((ext_vector_type(4)));
typedef unsigned u32x2 __attribute__((ext_vector_type(2)));
constexpr int M_LAT = BATCH * SEQ;
constexpr int BM = 256, BK = 64, HALF = 128, HTB = HALF * BK * 2, STAGE_BYTES = 8 * HTB;
constexpr int LDS_BYTES = 163840, GTAB_OFF = 131072  , MISC_OFF = LDS_BYTES - 256;
constexpr int NTHREADS = 512, NWAVES = 8;

__device__ __forceinline__ unsigned f2bf(float f) { unsigned u = __builtin_bit_cast(unsigned, f); return (u + 0x7fffu + ((u >> 16) & 1u)) >> 16; }
__device__ __forceinline__ unsigned pk2(float lo, float hi) { return f2bf(lo) | (f2bf(hi) << 16); }
typedef __bf16 bf16x2_t __attribute__((ext_vector_type(2)));
__device__ __forceinline__ unsigned cvt_pk_bf16(float lo, float hi) { const f32x2 v = {lo, hi}; const bf16x2_t b2 = __builtin_convertvector(v, bf16x2_t); return __builtin_bit_cast(unsigned, b2); }
__device__ __forceinline__ float bf_lo(unsigned w) { return __uint_as_float(w << 16); }
__device__ __forceinline__ float bf_hi(unsigned w) { return __uint_as_float(w & 0xffff0000u); }

__device__ __forceinline__ void lds_barrier() { asm volatile("s_waitcnt lgkmcnt(0)" ::: "memory"); __builtin_amdgcn_s_barrier(); asm volatile("" ::: "memory"); }

#define XB_TMO      128
#define XB_XCNT(j)  (256  + 64 * (j))
#define XB_XSUB(j)  (1280 + 64 * (j))
#define XB_XGEN(j)  (2304 + 64 * (j))
#define XB_TOP      3328
#define XB_TOPGEN   3392
#define XCD_BAR_WORDS 3456
#define XB_SPIN_CAP (1u << 18)
__device__ __forceinline__ unsigned xb_ld(unsigned* p)              { return __hip_atomic_load(p, __ATOMIC_RELAXED, __HIP_MEMORY_SCOPE_AGENT); }
__device__ __forceinline__ unsigned xb_add(unsigned* p, unsigned v) { return __hip_atomic_fetch_add(p, v, __ATOMIC_RELAXED, __HIP_MEMORY_SCOPE_AGENT); }
__device__ __forceinline__ unsigned xb_xcc_id() { return (unsigned)__builtin_amdgcn_s_getreg((3 << 11) | 20) & 0xFu; }
#define XB_SPIN(cond, bar) do { unsigned _sp = 0; while (cond) { __builtin_amdgcn_s_sleep(1); \
    if ((++_sp & 255u) == 0u) { if (xb_ld(&(bar)[XB_TMO])) break; if (_sp > XB_SPIN_CAP) { atomicAdd(&(bar)[XB_TMO], 1u); break; } } } } while (0)
struct XcdBarrier { unsigned* bar; unsigned x; volatile LAS unsigned* st; };
__device__ __forceinline__ XcdBarrier xcd_barrier_post(unsigned* bar, volatile LAS unsigned* st) {
    XcdBarrier b; b.bar = bar; b.x = xb_xcc_id(); b.st = st;
    if (threadIdx.x == 0) (void)xb_add(&bar[XB_XCNT(b.x)], 1u);
    return b;
}
__device__ __forceinline__ void xcd_barrier_complete(unsigned* bar, unsigned x, unsigned& nloc, unsigned& nx) {
    const unsigned G = gridDim.x * gridDim.y * gridDim.z;
    unsigned sum, cnt, mine, sp = 0u;
    for (;;) {
        sum = 0u; cnt = 0u; mine = 0u;
#pragma unroll
        for (unsigned j = 0; j < 16; ++j) { const unsigned c = xb_ld(&bar[XB_XCNT(j)]); sum += c; cnt += (c > 0u) ? 1u : 0u; mine = (j == x) ? c : mine; }
        if (sum == G) break;
        __builtin_amdgcn_s_sleep(1);
        if ((++sp & 255u) == 0u) { if (xb_ld(&bar[XB_TMO])) break; if (sp > XB_SPIN_CAP) { atomicAdd(&bar[XB_TMO], 1u); break; } }
    }
    nloc = mine > 0u ? mine : 1u; nx = cnt > 0u ? cnt : 1u;
}
__device__ __forceinline__ void xcd_barrier(const XcdBarrier& b) {
    asm volatile("s_waitcnt vmcnt(0)" ::: "memory");
    __syncthreads();
    if (threadIdx.x == 0) {
        unsigned* bar = b.bar;
        __builtin_amdgcn_s_waitcnt(0);
        unsigned nloc = b.st[0], nx = b.st[1];
        if (nloc == 0u) { xcd_barrier_complete(bar, b.x, nloc, nx); b.st[0] = nloc; b.st[1] = nx; }
        const unsigned old = xb_add(&bar[XB_XSUB(b.x)], 1u);
        const unsigned gen = old / nloc;
        if (old + 1u == (gen + 1u) * nloc) {
            __builtin_amdgcn_fence(__ATOMIC_RELEASE, "agent");
            asm volatile("s_waitcnt vmcnt(0)" ::: "memory");
            const unsigned og = xb_add(&bar[XB_TOP], 1u);
            const unsigned tg = og / nx;
            if (og + 1u == (tg + 1u) * nx) xb_add(&bar[XB_TOPGEN], 1u);
            else XB_SPIN(xb_ld(&bar[XB_TOPGEN]) == tg, bar);
            __builtin_amdgcn_fence(__ATOMIC_ACQUIRE, "agent");
            xb_add(&bar[XB_XGEN(b.x)], 1u);
            asm volatile("s_waitcnt vmcnt(0)" ::: "memory");
        } else {
            XB_SPIN(xb_ld(&bar[XB_XGEN(b.x)]) == gen, bar);
            __builtin_amdgcn_fence(__ATOMIC_ACQUIRE, "agent");
            asm volatile("s_waitcnt vmcnt(0)" ::: "memory");
        }
    }
    __syncthreads();
}

__host__ __device__ __forceinline__ int lds_byte(int r, int c) { const int st = (r >> 4) * 2 + (c >> 5), rr = r & 15, cc = c & 31, ob = rr * 64 + cc * 2; return st * 1024 + (ob ^ (((ob >> 9) & 1) << 5)); }
__host__ __device__ __forceinline__ void stage_rc(int b, int& R, int& C) { const int st = b / 1024, sb = b % 1024, swz = sb ^ (((sb >> 9) & 1) << 5); R = (st >> 1) * 16 + swz / 64; C = (st & 1) * 32 + (swz % 64) / 2; }
__host__ __device__ __forceinline__ int perm32(int rho) { const int n = rho >> 4, i = rho & 15; return 8 * (i >> 2) + 4 * n + (i & 3); }

struct Unit { int arow, brow, orow, ocol; };

template <class Epi, class Sched, bool GATHER>
__device__ __forceinline__ void gemm_phase(LAS unsigned char* lds, const bf16_t* Abase, const bf16_t* Btbase, const int K, const Sched& S, const Epi& E) {
    const int tid = threadIdx.x, wid = __builtin_amdgcn_readfirstlane(tid >> 6), lane = tid & 63, wr = wid >> 2, wc = wid & 3, fr = lane & 15, fq = lane >> 4;
    const int nt = K / BK;
    unsigned voffA[2], voffB[2];
#pragma unroll
    for (int i = 0; i < 2; ++i) { int R, C; stage_rc(tid * 16 + i * 8192, R, C); const int Rb = Epi::PERM ? ((R & ~31) + perm32(R & 31)) : R;
        voffA[i] = (unsigned)(R * K + C) * 2u; voffB[i] = (unsigned)(Rb * K + C) * 2u; }
    const size_t kstep = (size_t)(BK * 2);
    const size_t hstep = (size_t)HALF * K * 2;
    const unsigned ldsw = (unsigned)wid * 1024u;
    const int aoff = lds_byte(wr * 64 + fr, fq * 8), boff = lds_byte(wc * 32 + fr, fq * 8);
    LAS const int* gtab = (LAS const int*)(lds + GTAB_OFF);
    unsigned goff[2][2];
#define PG8_SA(b, h) (((b) * 2 + (h)) * HTB)
#define PG8_SB(b, h) ((4 + (b) * 2 + (h)) * HTB)
#define PG8_STAGE(bufoff, gbase, voff) do { _Pragma("unroll") for (int _i = 0; _i < 2; ++_i) \
        __builtin_amdgcn_global_load_lds((const unsigned*)((const char*)(gbase) + (voff)[_i]), (LAS unsigned*)(lds + (bufoff) + ldsw + _i * 8192), 16, 0, 0); } while (0)
#define PG8_STAGE_A(bufoff, abase, h) do { if constexpr (GATHER) { PG8_STAGE(bufoff, abase, goff[h]); } else { PG8_STAGE(bufoff, (abase) + (h) * hstep, voffA); } } while (0)
#define PG8_LDA(dst, b, h) do { _Pragma("unroll") for (int m = 0; m < 4; ++m) _Pragma("unroll") for (int k = 0; k < 2; ++k) dst[m][k] = *(const LAS bf16x8*)(lds + PG8_SA(b, h) + aoff + m * 2048 + k * 1024); } while (0)
#define PG8_LDB(dst, b, h) do { _Pragma("unroll") for (int n = 0; n < 2; ++n) _Pragma("unroll") for (int k = 0; k < 2; ++k) dst[n][k] = *(const LAS bf16x8*)(lds + PG8_SB(b, h) + boff + n * 2048 + k * 1024); } while (0)
#define PG8_MMA(ai, bj, At, Bt) do { __builtin_amdgcn_s_setprio(1); _Pragma("unroll") for (int m = 0; m < 4; ++m) _Pragma("unroll") for (int n = 0; n < 2; ++n) _Pragma("unroll") for (int k = 0; k < 2; ++k) \
        acc[ai][bj][m][n] = __builtin_amdgcn_mfma_f32_16x16x32_bf16(Bt[n][k], At[m][k], acc[ai][bj][m][n], 0, 0, 0); __builtin_amdgcn_s_setprio(0); } while (0)
#define PG8_WAIT_V(n) asm volatile("s_waitcnt vmcnt(" #n ")" ::: "memory")
#define PG8_WAIT_L(n) asm volatile("s_waitcnt lgkmcnt(" #n ")" ::: "memory")
#define PG8_BAR __builtin_amdgcn_s_barrier()
#define PG8_SCHED __builtin_amdgcn_sched_barrier(0)
#define PG8_GLOAD(ui_) do { if constexpr (GATHER) { _Pragma("unroll") for (int _i = 0; _i < 2; ++_i) { int _R, _C; stage_rc(tid * 16 + _i * 8192, _R, _C); _Pragma("unroll") for (int _h = 0; _h < 2; ++_h) \
        goff[_h][_i] = (unsigned)(gtab[((ui_) & 3) * 256 + _h * HALF + _R] * K * 2 + _C * 2); } } } while (0)
    Unit cur, nxt; int ui = 0;
    if (!S.next(0, cur)) return;
    if constexpr (GATHER) {
        Unit t;
        for (int j = 0; j < 4; ++j) if (S.next(j, t)) { if (tid < 256) ((LAS int*)(lds + GTAB_OFF))[j * 256 + tid] = S.gidx(t, tid); }
        __syncthreads();
    }
    f32x4 acc[2][2][4][2];
#pragma unroll
    for (int a = 0; a < 2; ++a)
#pragma unroll
        for (int b = 0; b < 2; ++b)
#pragma unroll
            for (int m = 0; m < 4; ++m)
#pragma unroll
                for (int n = 0; n < 2; ++n) acc[a][b][m][n] = (f32x4){0.f, 0.f, 0.f, 0.f};
    bf16x8 At[4][2], B0[2][2], B1[2][2];
    const char* cA = (const char*)Abase + (size_t)cur.arow * K * 2; const char* cB = (const char*)Btbase + (size_t)cur.brow * K * 2;
    PG8_GLOAD(0);
    PG8_STAGE(PG8_SB(0, 0), cB, voffB); PG8_STAGE(PG8_SB(0, 1), cB + hstep, voffB); PG8_STAGE_A(PG8_SA(0, 0), cA, 0); PG8_STAGE_A(PG8_SA(0, 1), cA, 1);
    if (wr == 1) PG8_BAR;
    PG8_WAIT_V(2); PG8_BAR;
    PG8_STAGE(PG8_SB(1, 0), cB + kstep, voffB); PG8_STAGE_A(PG8_SA(1, 0), cA + kstep, 0); PG8_STAGE(PG8_SB(1, 1), cB + hstep + kstep, voffB);
    PG8_WAIT_V(6); PG8_BAR;
    for (;;) {
        const bool has_next = S.next(ui + 1, nxt);
        const char* nA = has_next ? (const char*)Abase + (size_t)nxt.arow * K * 2 : cA; const char* nB = has_next ? (const char*)Btbase + (size_t)nxt.brow * K * 2 : cB;
        for (int t = 0; t < nt; t += 2) {
            const bool last = (t == nt - 2);
            const char* a1 = cA + (size_t)(t + 1) * kstep;
            const char* a2 = last ? nA : cA + (size_t)(t + 2) * kstep; const char* b2 = last ? nB : cB + (size_t)(t + 2) * kstep;
            const char* a3 = a2 + kstep; const char* b3 = b2 + kstep;
            PG8_LDB(B0, 0, 0); PG8_LDB(B1, 0, 1); PG8_SCHED; PG8_LDA(At, 0, 0); PG8_STAGE_A(PG8_SA(1, 1), a1, 1);
            if constexpr (GATHER) { if (last && has_next) PG8_GLOAD(ui + 1); }
            PG8_WAIT_V(8); PG8_WAIT_L(0); PG8_BAR; PG8_MMA(0, 0, At, B0); PG8_MMA(0, 1, At, B1); PG8_BAR; PG8_SCHED;
            PG8_LDA(At, 0, 1); PG8_STAGE(PG8_SB(0, 0), b2, voffB); PG8_STAGE(PG8_SB(0, 1), b2 + hstep, voffB); PG8_STAGE_A(PG8_SA(0, 0), a2, 0);
            PG8_WAIT_V(8); PG8_WAIT_L(0); PG8_BAR; PG8_MMA(1, 0, At, B0); PG8_MMA(1, 1, At, B1); PG8_BAR; PG8_SCHED;
            PG8_LDB(B0, 1, 0); PG8_LDB(B1, 1, 1); PG8_SCHED; PG8_LDA(At, 1, 0); PG8_STAGE_A(PG8_SA(0, 1), a2, 1);
            PG8_WAIT_V(8); PG8_WAIT_L(0); PG8_BAR; PG8_MMA(0, 0, At, B0); PG8_MMA(0, 1, At, B1); PG8_BAR; PG8_SCHED;
            PG8_LDA(At, 1, 1); PG8_STAGE(PG8_SB(1, 0), b3, voffB); PG8_STAGE(PG8_SB(1, 1), b3 + hstep, voffB); PG8_STAGE_A(PG8_SA(1, 0), a3, 0);
            PG8_WAIT_V(8); PG8_WAIT_L(0); PG8_BAR; PG8_MMA(1, 0, At, B0); PG8_MMA(1, 1, At, B1); PG8_BAR; PG8_SCHED;
        }
        if (wr == 0) PG8_BAR;
        E(acc, cur, wr, wc, fr, fq);
        if (!has_next) break;
#pragma unroll
        for (int a = 0; a < 2; ++a)
#pragma unroll
            for (int b = 0; b < 2; ++b)
#pragma unroll
                for (int m = 0; m < 4; ++m)
#pragma unroll
                    for (int n = 0; n < 2; ++n) acc[a][b][m][n] = (f32x4){0.f, 0.f, 0.f, 0.f};
        cur = nxt; cA = nA; cB = nB; ++ui;
        if (wr == 1) PG8_BAR;
    }
    PG8_WAIT_V(0);
    PG8_BAR;
#undef PG8_SA
#undef PG8_SB
#undef PG8_STAGE
#undef PG8_STAGE_A
#undef PG8_LDA
#undef PG8_LDB
#undef PG8_MMA
#undef PG8_WAIT_V
#undef PG8_WAIT_L
#undef PG8_BAR
#undef PG8_SCHED
#undef PG8_GLOAD
}

__device__ __forceinline__ float silu1(float x) { return x * __builtin_amdgcn_rcpf(1.f + __expf(-x)); }
struct EpiSiluMul {
    static constexpr bool PERM = true;
    bf16_t* O; int ldo;
    __device__ __forceinline__ void operator()(const f32x4 (&acc)[2][2][4][2], const Unit& u, int wr, int wc, int fr, int fq) const {
        const int row0 = u.orow + wr * 64 + fr, col0 = u.ocol + wc * 32 + 8 * fq;
#pragma unroll
        for (int ai = 0; ai < 2; ++ai)
#pragma unroll
            for (int m = 0; m < 4; ++m) { bf16_t* rowp = O + (size_t)(row0 + ai * HALF + m * 16) * ldo + col0;
                const f32x4 g0 = acc[ai][0][m][0], g1 = acc[ai][0][m][1], u0 = acc[ai][1][m][0], u1 = acc[ai][1][m][1];
                u32x4 w; w.x = cvt_pk_bf16(silu1(g0[0]) * u0[0], silu1(g0[1]) * u0[1]); w.y = cvt_pk_bf16(silu1(g0[2]) * u0[2], silu1(g0[3]) * u0[3]);
                w.z = cvt_pk_bf16(silu1(g1[0]) * u1[0], silu1(g1[1]) * u1[1]); w.w = cvt_pk_bf16(silu1(g1[2]) * u1[2], silu1(g1[3]) * u1[3]);
                *(u32x4*)rowp = w; }
    }
};
struct EpiRowScale {
    static constexpr bool PERM = true;
    bf16_t* O; int ldo; const float* rowscale;
    __device__ __forceinline__ void operator()(const f32x4 (&acc)[2][2][4][2], const Unit& u, int wr, int wc, int fr, int fq) const {
        const int row0 = u.orow + wr * 64 + fr, col0 = u.ocol + wc * 32 + 8 * fq;
#pragma unroll
        for (int ai = 0; ai < 2; ++ai)
#pragma unroll
            for (int m = 0; m < 4; ++m) { const int row = row0 + ai * HALF + m * 16; const float sc = rowscale[row]; bf16_t* rowp = O + (size_t)row * ldo + col0;
#pragma unroll
                for (int bj = 0; bj < 2; ++bj) { const f32x4 v0 = acc[ai][bj][m][0] * sc, v1 = acc[ai][bj][m][1] * sc;
                    u32x4 w; w.x = cvt_pk_bf16(v0[0], v0[1]); w.y = cvt_pk_bf16(v0[2], v0[3]); w.z = cvt_pk_bf16(v1[0], v1[1]); w.w = cvt_pk_bf16(v1[2], v1[3]);
                    *(u32x4*)(rowp + bj * HALF) = w; } }
    }
};


struct EpiScIn {
    static constexpr bool PERM = true;
    bf16_t* GB; bf16_t* UU;
    __device__ __forceinline__ void operator()(const f32x4 (&acc)[2][2][4][2], const Unit& u, int wr, int wc, int fr, int fq) const {
        const int row0 = u.orow + wr * 64 + fr;
        if (u.ocol < 4) {
            const int col0 = u.ocol * 256 + wc * 32 + 8 * fq;
#pragma unroll
            for (int ai = 0; ai < 2; ++ai)
#pragma unroll
                for (int m = 0; m < 4; ++m) { bf16_t* rowp = GB + (size_t)(row0 + ai * HALF + m * 16) * D + col0;
#pragma unroll
                    for (int bj = 0; bj < 2; ++bj) { const f32x4 v0 = acc[ai][bj][m][0], v1 = acc[ai][bj][m][1];
                        u32x4 w; w.x = cvt_pk_bf16(v0[0], v0[1]); w.y = cvt_pk_bf16(v0[2], v0[3]); w.z = cvt_pk_bf16(v1[0], v1[1]); w.w = cvt_pk_bf16(v1[2], v1[3]);
                        *(u32x4*)(rowp + bj * HALF) = w; } }
        } else {
            const int col0 = (u.ocol - 4) * 128 + wc * 32 + 8 * fq;
#pragma unroll
            for (int ai = 0; ai < 2; ++ai)
#pragma unroll
                for (int m = 0; m < 4; ++m) { bf16_t* rowp = UU + (size_t)(row0 + ai * HALF + m * 16) * D + col0;
                    const f32x4 v0 = acc[ai][0][m][0] * acc[ai][1][m][0], v1 = acc[ai][0][m][1] * acc[ai][1][m][1];
                    u32x4 w; w.x = cvt_pk_bf16(v0[0], v0[1]); w.y = cvt_pk_bf16(v0[2], v0[3]); w.z = cvt_pk_bf16(v1[0], v1[1]); w.w = cvt_pk_bf16(v1[2], v1[3]);
                    *(u32x4*)rowp = w; }
        }
    }
};
template <bool BASE_BF16>
struct EpiResid {
    static constexpr bool PERM = true;
    const void* base; bf16_t* out; const float* gada;
    __device__ __forceinline__ void operator()(const f32x4 (&acc)[2][2][4][2], const Unit& u, int wr, int wc, int fr, int fq) const {
        const int row0 = u.orow + wr * 64 + fr, col0 = u.ocol + wc * 32 + 8 * fq;
        const float* g = gada + (size_t)(u.orow >> 13) * 6 * D + col0;
        f32x4 gv[2][2];
#pragma unroll
        for (int bj = 0; bj < 2; ++bj)
#pragma unroll
            for (int n = 0; n < 2; ++n) gv[bj][n] = *(const f32x4*)(g + bj * HALF + n * 4);
#pragma unroll
        for (int ai = 0; ai < 2; ++ai)
#pragma unroll
            for (int m = 0; m < 4; ++m) { const size_t off = (size_t)(row0 + ai * HALF + m * 16) * D + col0;
#pragma unroll
                for (int bj = 0; bj < 2; ++bj) {
                    f32x4 b0, b1;
                    if constexpr (BASE_BF16) { const u32x4 bw = *(const u32x4*)((const bf16_t*)base + off + bj * HALF);
                        b0 = (f32x4){bf_lo(bw.x), bf_hi(bw.x), bf_lo(bw.y), bf_hi(bw.y)}; b1 = (f32x4){bf_lo(bw.z), bf_hi(bw.z), bf_lo(bw.w), bf_hi(bw.w)}; }
                    else { b0 = *(const f32x4*)((const float*)base + off + bj * HALF); b1 = *(const f32x4*)((const float*)base + off + bj * HALF + 4); }
                    const f32x4 v0 = b0 + gv[bj][0] * acc[ai][bj][m][0], v1 = b1 + gv[bj][1] * acc[ai][bj][m][1];
                    u32x4 w; w.x = cvt_pk_bf16(v0[0], v0[1]); w.y = cvt_pk_bf16(v0[2], v0[3]); w.z = cvt_pk_bf16(v1[0], v1[1]); w.w = cvt_pk_bf16(v1[2], v1[3]);
                    *(u32x4*)(out + off + bj * HALF) = w; } }
    }
};

struct EpiProj {
    static constexpr bool PERM = true;
    bf16_t* QKV; bf16_t* Z; bf16_t* POOL; bf16_t* CKV;
    __device__ __forceinline__ void operator()(const f32x4 (&acc)[2][2][4][2], const Unit& u, int wr, int wc, int fr, int fq) const {
        bf16_t* base; int ld;
        if (u.ocol < 6) { base = QKV + (size_t)u.orow * 1536 + u.ocol * 256; ld = 1536; }
        else if (u.ocol < 8) { base = Z + (size_t)u.orow * 512 + (u.ocol - 6) * 256; ld = 512; }
        else if (u.ocol < 10) { base = POOL + (size_t)u.orow * 512 + (u.ocol - 8) * 256; ld = 512; }
        else { base = CKV + (size_t)(u.orow - M_LAT) * 1024 + (u.ocol - 16) * 256; ld = 1024; }
        base += (size_t)(wr * 64 + fr) * ld + wc * 32 + 8 * fq;
#pragma unroll
        for (int ai = 0; ai < 2; ++ai)
#pragma unroll
            for (int m = 0; m < 4; ++m) { bf16_t* rowp = base + (size_t)(ai * HALF + m * 16) * ld;
#pragma unroll
                for (int bj = 0; bj < 2; ++bj) { const f32x4 v0 = acc[ai][bj][m][0], v1 = acc[ai][bj][m][1];
                    u32x4 w; w.x = cvt_pk_bf16(v0[0], v0[1]); w.y = cvt_pk_bf16(v0[2], v0[3]); w.z = cvt_pk_bf16(v1[0], v1[1]); w.w = cvt_pk_bf16(v1[2], v1[3]);
                    *(u32x4*)(rowp + bj * HALF) = w; } }
    }
};
struct SchedProj {
    int vcu, G;
    __device__ __forceinline__ bool next(int i, Unit& u) const {
        const int L = i * G + vcu; if (L >= 1296) return false;
        if (L < 1280) { const int pm = L / 10, pn = L % 10; u.arow = pm * 256; u.brow = pn * 256; u.orow = pm * 256; u.ocol = pn; }
        else { const int q = L - 1280, pm = q >> 2, pn = q & 3; u.arow = M_LAT + pm * 256; u.brow = 512 + pn * 256; u.orow = M_LAT + pm * 256; u.ocol = 16 + pn; }
        return true;
    }
    __device__ __forceinline__ int gidx(const Unit&, int) const { return 0; }
};

template <int NT, int COLMUL>
struct SchedDense {
    int vcu, G, nunits;
    __device__ __forceinline__ bool next(int i, Unit& u) const {
        const int L = i * G + vcu; if (L >= nunits) return false;
        const int pm = L / NT, pn = L % NT;
        u.arow = pm * 256; u.brow = pn * 256; u.orow = pm * 256; u.ocol = pn * COLMUL;
        return true;
    }
    __device__ __forceinline__ int gidx(const Unit&, int) const { return 0; }
};

constexpr size_t MiB = 1u << 20;
constexpr size_t WS_CTL = 0;
constexpr size_t WS_ADA = 1 * MiB;
constexpr size_t WS_AFF = 2 * MiB;
constexpr size_t WS_IDX = 4 * MiB;
constexpr size_t WS_GATE = 4 * MiB + 512 * 1024;
constexpr size_t WS_SEL = 5 * MiB;
constexpr size_t WS_GATES = 7 * MiB;
constexpr size_t WS_WGU = 16 * MiB;
constexpr size_t WS_WDN = 80 * MiB;
constexpr size_t WS_SCIN = 112 * MiB;
constexpr size_t WS_SCOUT = 118 * MiB;
constexpr size_t WS_WIN = 120 * MiB;
constexpr size_t WS_WOUT = 125 * MiB;
constexpr size_t WS_TMP = 128 * MiB;
constexpr size_t WS_ACT = WS_TMP;
constexpr size_t WS_QKV = 194 * MiB;
constexpr size_t WS_Z = 290 * MiB;
constexpr size_t WS_POOL = 322 * MiB;
constexpr size_t WS_CKV = 354 * MiB;
constexpr size_t WS_QN = 356 * MiB;
constexpr size_t WS_KT = 389 * MiB;
constexpr size_t WS_NWK = 422 * MiB;
constexpr size_t WS_SCL = 488 * MiB;
constexpr size_t WS_XLB = WS_NWK;
constexpr size_t WS_OF = WS_QKV;
constexpr size_t WS_OB = WS_QKV + 32 * MiB;
constexpr size_t WS_HID = 194 * MiB;
constexpr size_t WS_Y = 258 * MiB;
constexpr size_t WS_GB = WS_HID;
constexpr size_t WS_UU = WS_Y;
constexpr size_t WS_END = 512 * MiB;
constexpr int CW_BAR = 4096;
#ifndef PROBE_SEL
#define PROBE_SEL -1
#endif
#ifndef PROBE_WAVE
#define PROBE_WAVE 0
#endif
constexpr int CW_TS = 32768;
constexpr int CW_PROG = 16384;

struct Args {
    const float* in[24]; float* out; unsigned char* ws; int ph_lo, ph_hi, li, pad;
};

struct Frame {
    LAS unsigned char* lds; int tid, lane, wave, G, vcu;
};

__device__ __forceinline__ void transpose_item(const float* W, int K, int ldn, int n0, int k0, bf16_t* WT, int drow0, LAS float* scr, int lane, int dcol0 = 0) {
    float tv[32];
#pragma unroll
    for (int i = 0; i < 32; ++i) tv[i] = __builtin_nontemporal_load(W + (size_t)(k0 + 2 * i + (lane >> 5)) * ldn + n0 + (lane & 31));
#pragma unroll
    for (int i = 0; i < 32; ++i) scr[(2 * i + (lane >> 5)) * 33 + (lane & 31)] = tv[i];
    asm volatile("s_waitcnt lgkmcnt(0)" ::: "memory");
    const int c = lane & 7;
#pragma unroll
    for (int j = 0; j < 4; ++j) { const int n = (lane >> 3) + 8 * j; const LAS float* s = scr + (8 * c) * 33 + n;
        u32x4 o; o.x = pk2(s[0 * 33], s[1 * 33]); o.y = pk2(s[2 * 33], s[3 * 33]); o.z = pk2(s[4 * 33], s[5 * 33]); o.w = pk2(s[6 * 33], s[7 * 33]);
        __builtin_nontemporal_store(o, (u32x4*)(WT + (size_t)(drow0 + n) * K + dcol0 + k0 + 8 * c)); }
    asm volatile("s_waitcnt lgkmcnt(0)" ::: "memory");
}

struct SchedMoeUp {
    int vcu, layer; const int* idx;
    __device__ __forceinline__ bool next(int i, Unit& u) const {
        const int L = i * 256 + vcu; if (L >= 1024) return false;
        const int g = L >> 4, pm = (L >> 2) & 3, pn = L & 3, b = g >> 4, e = g & 15;
        u.arow = b * SEQ; u.brow = ((layer * NE + e) * 4 + pn) * 256; u.orow = g * CAP + pm * 256; u.ocol = pn * 128;
        return true;
    }
    __device__ __forceinline__ int gidx(const Unit& u, int r) const { return idx[u.orow + r]; }
};
struct SchedMoeDown {
    int vcu, layer;
    __device__ __forceinline__ bool next(int i, Unit& u) const {
        const int L = i * 256 + vcu; if (L >= 1024) return false;
        const int g = L >> 4, pm = (L >> 2) & 3, pn = L & 3, e = g & 15;
        u.arow = g * CAP + pm * 256; u.brow = ((layer * NE + e) * 4 + pn) * 256; u.orow = g * CAP + pm * 256; u.ocol = pn * 256;
        return true;
    }
    __device__ __forceinline__ int gidx(const Unit&, int) const { return 0; }
};

__device__ __forceinline__ float wsum(float v) {
#pragma unroll
    for (int o = 1; o < 64; o <<= 1) v += __shfl_xor(v, o);
    return v;
}

template <int MODE>
__device__ __forceinline__ void ph_norm16(const Frame& F, const void* xlv, const float* xctx, bf16_t* act, const float* gw, const float* ada  , const float* w16, int ldw,
                                          float* out16, const float* a_log, const float* dt_bias, int* selfill = nullptr) {
    constexpr int WLD = 1032;
    LAS bf16_t* wt = (LAS bf16_t*)F.lds;
    LAS float* mod = (LAS float*)(F.lds + 16 * WLD * 2);
    if (selfill) { u32x4* p = (u32x4*)selfill; const u32x4 m1 = (u32x4){~0u, ~0u, ~0u, ~0u};
        for (int i = F.vcu * NTHREADS + F.tid; i < M_LAT * NE / 4; i += F.G * NTHREADS) p[i] = m1; }
    { float wv[32];
#pragma unroll
        for (int q = 0; q < 32; ++q) { const int i = F.tid + NTHREADS * q; wv[q] = w16[(size_t)(i >> 4) * ldw + (i & 15)]; }
#pragma unroll
        for (int q = 0; q < 32; ++q) { const int i = F.tid + NTHREADS * q; wt[(i & 15) * WLD + (i >> 4)] = (bf16_t)f2bf(wv[q]); } }
#pragma unroll
    for (int i = F.tid; i < 5 * D; i += NTHREADS) { const int b = i >> 10, c = i & (D - 1);
        const float* sh = ada + (size_t)b * 6 * D + (MODE == 0 ? 3 * D : 0);
        mod[(b * 2) * D + c] = gw[c] * (sh[D + c] + 1.f); mod[(b * 2 + 1) * D + c] = sh[c]; }
    __syncthreads();
    const int gw_ = F.vcu * NWAVES + F.wave, NGW = F.G * NWAVES, lane = F.lane, rr = lane & 15, kq = lane >> 4;
    const int ntiles = (MODE == 0 ? M_LAT : M_LAT + BATCH * CTX) / 16;
    for (int tw = gw_; tw < ntiles; tw += NGW) {
        const int r0 = tw * 16, row = r0 + rr;
        const bool lat = r0 < M_LAT;
        const int b = lat ? (r0 >> 13) : 4;
        const char* src; size_t rowbytes;
        if constexpr (MODE == 0) { src = (const char*)xlv + (size_t)row * D * 2 + kq * 16; rowbytes = 0; }
        else { src = (const char*)(lat ? (const float*)xlv + (size_t)row * D : xctx + (size_t)(row - M_LAT) * D) + kq * 32; rowbytes = 0; }
        (void)rowbytes;
        float ss = 0.f;
#pragma unroll 1
        for (int s0 = 0; s0 < 32; s0 += 8) {
            if constexpr (MODE == 0) { u32x4 xv[8];
#pragma unroll
                for (int s = 0; s < 8; ++s) xv[s] = *(const u32x4*)(src + (s0 + s) * 64);
#pragma unroll
                for (int s = 0; s < 8; ++s)
#pragma unroll
                    for (int q = 0; q < 4; ++q) { const float a = bf_lo(xv[s][q]), c2 = bf_hi(xv[s][q]); ss += a * a + c2 * c2; } }
            else { f32x4 xv[8][2];
#pragma unroll
                for (int s = 0; s < 8; ++s) { xv[s][0] = *(const f32x4*)(src + (s0 + s) * 128); xv[s][1] = *(const f32x4*)(src + (s0 + s) * 128 + 16); }
#pragma unroll
                for (int s = 0; s < 8; ++s) ss += (xv[s][0].x * xv[s][0].x + xv[s][0].y * xv[s][0].y) + (xv[s][0].z * xv[s][0].z + xv[s][0].w * xv[s][0].w)
                                                + (xv[s][1].x * xv[s][1].x + xv[s][1].y * xv[s][1].y) + (xv[s][1].z * xv[s][1].z + xv[s][1].w * xv[s][1].w); }
        }
        ss += __shfl_xor(ss, 16); ss += __shfl_xor(ss, 32);
        const float rs = rsqrtf(ss * (1.f / D) + EPS);
        f32x4 acc = (f32x4){0.f, 0.f, 0.f, 0.f};
        const LAS float* mAp = mod + (b * 2) * D + kq * 8; const LAS float* mBp = mAp + D;
        const LAS bf16_t* wp = wt + rr * WLD + kq * 8;
        bf16_t* dst = act + (size_t)row * D + kq * 8;
#pragma unroll 1
        for (int s0 = 0; s0 < 32; s0 += 4) {
            float xf[4][8];
            if constexpr (MODE == 0) {
#pragma unroll
                for (int s = 0; s < 4; ++s) { const u32x4 w = *(const u32x4*)(src + (s0 + s) * 64);
#pragma unroll
                    for (int q = 0; q < 4; ++q) { xf[s][2 * q] = bf_lo(w[q]); xf[s][2 * q + 1] = bf_hi(w[q]); } }
            } else {
#pragma unroll
                for (int s = 0; s < 4; ++s) { const f32x4 a = *(const f32x4*)(src + (s0 + s) * 128), c2 = *(const f32x4*)(src + (s0 + s) * 128 + 16);
                    xf[s][0] = a.x; xf[s][1] = a.y; xf[s][2] = a.z; xf[s][3] = a.w; xf[s][4] = c2.x; xf[s][5] = c2.y; xf[s][6] = c2.z; xf[s][7] = c2.w; }
            }
#pragma unroll
            for (int s = 0; s < 4; ++s) {
                const f32x4 a0 = *(const LAS f32x4*)(mAp + (s0 + s) * 32), a1 = *(const LAS f32x4*)(mAp + (s0 + s) * 32 + 4);
                const f32x4 b0 = *(const LAS f32x4*)(mBp + (s0 + s) * 32), b1 = *(const LAS f32x4*)(mBp + (s0 + s) * 32 + 4);
                const float h0 = xf[s][0] * rs * a0.x + b0.x, h1 = xf[s][1] * rs * a0.y + b0.y, h2 = xf[s][2] * rs * a0.z + b0.z, h3 = xf[s][3] * rs * a0.w + b0.w;
                const float h4 = xf[s][4] * rs * a1.x + b1.x, h5 = xf[s][5] * rs * a1.y + b1.y, h6 = xf[s][6] * rs * a1.z + b1.z, h7 = xf[s][7] * rs * a1.w + b1.w;
                u32x4 hw; hw.x = cvt_pk_bf16(h0, h1); hw.y = cvt_pk_bf16(h2, h3); hw.z = cvt_pk_bf16(h4, h5); hw.w = cvt_pk_bf16(h6, h7);
                *(u32x4*)(dst + (s0 + s) * 32) = hw;
                const bf16x8 bfrag = *(const LAS bf16x8*)(wp + (s0 + s) * 32);
                acc = __builtin_amdgcn_mfma_f32_16x16x32_bf16(__builtin_bit_cast(bf16x8, hw), bfrag, acc, 0, 0, 0);
            }
        }
        if constexpr (MODE == 0) {
            f32x4 mx = acc;
#pragma unroll
            for (int o = 1; o < 16; o <<= 1) { mx.x = fmaxf(mx.x, __shfl_xor(mx.x, o)); mx.y = fmaxf(mx.y, __shfl_xor(mx.y, o)); mx.z = fmaxf(mx.z, __shfl_xor(mx.z, o)); mx.w = fmaxf(mx.w, __shfl_xor(mx.w, o)); }
            f32x4 ex; ex.x = __expf(acc.x - mx.x); ex.y = __expf(acc.y - mx.y); ex.z = __expf(acc.z - mx.z); ex.w = __expf(acc.w - mx.w);
            f32x4 sm = ex;
#pragma unroll
            for (int o = 1; o < 16; o <<= 1) { sm.x += __shfl_xor(sm.x, o); sm.y += __shfl_xor(sm.y, o); sm.z += __shfl_xor(sm.z, o); sm.w += __shfl_xor(sm.w, o); }
            const int t = (r0 & (SEQ - 1)) + 4 * kq;
            *(f32x4*)(out16 + ((size_t)b * NE + rr) * SEQ + t) = (f32x4){ex.x / sm.x, ex.y / sm.y, ex.z / sm.z, ex.w / sm.w};
        } else {
#pragma unroll
            for (int q = 0; q < 4; ++q) { const float x = acc[q]; float o;
                if (rr < 8) o = 1.f / (1.f + __expf(-x));
                else { const float y = x + dt_bias[rr - 8]; const float sp = y > 20.f ? y : log1pf(__expf(y)); o = -__expf(a_log[rr - 8]) * sp; }
                out16[(size_t)(r0 + 4 * kq + q) * 16 + rr] = o; }
        }
    }
    __syncthreads();
}

__device__ __forceinline__ void ph_topk(const Frame& F, const float* aff, int* idx, float* gate, int* sel) {
    LAS unsigned* keys = (LAS unsigned*)F.lds;
    LAS unsigned* hist = keys + SEQ;
    LAS unsigned* cg = hist + 256; LAS unsigned* ce = cg + 512;
    LAS unsigned* shv = ce + 512;
    const int tid = F.tid;
    for (int item = F.vcu; item < BATCH * NE; item += F.G) {
        const int b = item >> 4, e = item & 15;
        for (int i = tid; i < SEQ; i += NTHREADS) keys[i] = __float_as_uint(aff[(size_t)item * SEQ + i]);
        if (tid == 0) { shv[0] = 0u; shv[1] = CAP; }
        lds_barrier();
        unsigned mask = 0u;
        for (int pass = 0; pass < 4; ++pass) {
            const int shift = 24 - 8 * pass;
            if (tid < 256) hist[tid] = 0u;
            lds_barrier();
            const unsigned prefix = shv[0];
            for (int i = tid; i < SEQ; i += NTHREADS) { const unsigned kx = keys[i]; if ((kx & mask) == prefix) __hip_atomic_fetch_add(&hist[(kx >> shift) & 255u], 1u, __ATOMIC_RELAXED, __HIP_MEMORY_SCOPE_WORKGROUP); }
            lds_barrier();
            unsigned sfx = 0u;
            if (tid < 256) { sfx = hist[tid];
#pragma unroll
                for (int o2 = 1; o2 < 64; o2 <<= 1) { const unsigned x = __shfl_down(sfx, o2); if ((tid & 63) + o2 < 64) sfx += x; }
                if ((tid & 63) == 0) cg[tid >> 6] = sfx; }
            lds_barrier();
            if (tid < 256) { for (int w2 = (tid >> 6) + 1; w2 < 4; ++w2) sfx += cg[w2];
                const unsigned need = shv[1]; unsigned above = __shfl_down(sfx, 1); if ((tid & 63) == 63) { above = 0u; for (int w2 = (tid >> 6) + 1; w2 < 4; ++w2) above += cg[w2]; }
                if (sfx >= need && above < need) { shv[2] = prefix | ((unsigned)tid << shift); shv[3] = need - above; } }
            lds_barrier();
            if (tid == 0) { shv[0] = shv[2]; shv[1] = shv[3]; }
            mask |= 0xFFu << shift;
            lds_barrier();
        }
        const unsigned T = shv[0], need = shv[1];
        unsigned ng = 0u, nq = 0u; unsigned kk16[16];
#pragma unroll
        for (int q = 0; q < 4; ++q) { const u32x4 k4 = *(const LAS u32x4*)(keys + tid * 16 + 4 * q); kk16[4 * q] = k4.x; kk16[4 * q + 1] = k4.y; kk16[4 * q + 2] = k4.z; kk16[4 * q + 3] = k4.w; }
#pragma unroll
        for (int j = 0; j < 16; ++j) { const unsigned kx = kk16[j]; ng += kx > T; nq += kx == T; }
        unsigned ig = ng, iq = nq;
#pragma unroll
        for (int o2 = 1; o2 < 64; o2 <<= 1) { const unsigned xg = __shfl_up(ig, o2), xq = __shfl_up(iq, o2); if ((tid & 63) >= o2) { ig += xg; iq += xq; } }
        if ((tid & 63) == 63) { cg[tid >> 6] = ig; ce[tid >> 6] = iq; }
        lds_barrier();
        unsigned g0 = ig - ng, q0 = iq - nq;
        for (int w2 = 0; w2 < (tid >> 6); ++w2) { g0 += cg[w2]; q0 += ce[w2]; }
#pragma unroll
        for (int j = 0; j < 16; ++j) { const int t = tid * 16 + j; const unsigned kx = kk16[j]; int slot = -1;
            if (kx > T) { slot = (int)(g0 + (q0 < need ? q0 : need)); ++g0; }
            else if (kx == T) { if (q0 < need) slot = (int)(g0 + q0); ++q0; }
            if (slot >= 0) { sel[((size_t)b * SEQ + t) * NE + e] = slot; idx[item * CAP + slot] = t; gate[item * CAP + slot] = __uint_as_float(kx); } }
        lds_barrier();
    }
}

template <bool FINAL>
__device__ __forceinline__ void ph_combine(const Frame& F, bf16_t* xlb, float* outf, const bf16_t* y, const int* sel, const float* ada  , const float* gwn, const float* ada_next, bf16_t* act) {
    const int gw_ = F.vcu * NWAVES + F.wave, NGW = F.G * NWAVES, lane = F.lane;
    int curb = -1; f32x4 g2v[4], mA[4], mB[4];
#pragma unroll
    for (int j = 0; j < 4; ++j) { g2v[j] = (f32x4){0.f, 0.f, 0.f, 0.f}; mA[j] = g2v[j]; mB[j] = g2v[j]; }
    int nslot = -1; u32x2 nx[4];
    if (gw_ < M_LAT) { nslot = lane < NE ? sel[(size_t)gw_ * NE + lane] : -1; const u32x2* xr0 = (const u32x2*)(xlb + (size_t)gw_ * D) + lane;
#pragma unroll
        for (int j = 0; j < 4; ++j) nx[j] = xr0[64 * j]; }
    for (int r = gw_; r < M_LAT; r += NGW) {
        const int b = r >> 13;
        const int myslot = nslot; f32x4 xv[4];
#pragma unroll
        for (int j = 0; j < 4; ++j) xv[j] = (f32x4){bf_lo(nx[j].x), bf_hi(nx[j].x), bf_lo(nx[j].y), bf_hi(nx[j].y)};
        { const int rn = r + NGW; if (rn < M_LAT) { nslot = lane < NE ? sel[(size_t)rn * NE + lane] : -1; const u32x2* xrn = (const u32x2*)(xlb + (size_t)rn * D) + lane;
#pragma unroll
              for (int j = 0; j < 4; ++j) nx[j] = xrn[64 * j]; } }
        if (b != curb) { curb = b; const float* g2 = ada + (size_t)b * 6 * D + 5 * D;
#pragma unroll
            for (int j = 0; j < 4; ++j) { const int c = 256 * j + 4 * lane; g2v[j] = *(const f32x4*)(g2 + c);
                const f32x4 g4 = *(const f32x4*)(gwn + c);
                if constexpr (FINAL) { mA[j] = g4; } else { const float* sh = ada_next + (size_t)b * 6 * D; mA[j] = g4 * (*(const f32x4*)(sh + D + c) + 1.f); mB[j] = *(const f32x4*)(sh + c); } } }
        f32x4 a[4];
#pragma unroll
        for (int j = 0; j < 4; ++j) a[j] = (f32x4){0.f, 0.f, 0.f, 0.f};
        unsigned mask = (unsigned)(__ballot(myslot >= 0) & 0xFFFFull);
        while (mask) {
            const bf16_t* rp[4]; float wv[4];
#pragma unroll
            for (int q = 0; q < 4; ++q) { const bool ok = mask != 0u; const int e = ok ? __builtin_ctz(mask) : 0; mask &= mask - 1u;
                const int s = __builtin_amdgcn_readlane(myslot, e);
                rp[q] = ok ? y + ((size_t)(b * NE + e) * CAP + s) * D : y; wv[q] = ok ? 1.f : 0.f; }
            u32x2 w[4][4];
#pragma unroll
            for (int q = 0; q < 4; ++q)
#pragma unroll
                for (int j = 0; j < 4; ++j) w[q][j] = ((const u32x2*)rp[q] + lane)[64 * j];
#pragma unroll
            for (int q = 0; q < 4; ++q)
#pragma unroll
                for (int j = 0; j < 4; ++j) { a[j].x += wv[q] * bf_lo(w[q][j].x); a[j].y += wv[q] * bf_hi(w[q][j].x); a[j].z += wv[q] * bf_lo(w[q][j].y); a[j].w += wv[q] * bf_hi(w[q][j].y); }
        }
        f32x4 v[4]; float s = 0.f;
#pragma unroll
        for (int j = 0; j < 4; ++j) { v[j] = xv[j] + g2v[j] * a[j]; s += (v[j].x * v[j].x + v[j].y * v[j].y) + (v[j].z * v[j].z + v[j].w * v[j].w); }
        const float rs = rsqrtf(wsum(s) * (1.f / D) + EPS);
        if constexpr (FINAL) {
            f32x4* xr = (f32x4*)(outf + (size_t)r * D) + lane;
#pragma unroll
            for (int j = 0; j < 4; ++j) xr[64 * j] = v[j] * rs * mA[j];
        } else {
            unsigned long long* x8 = (unsigned long long*)(xlb + (size_t)r * D) + lane;
            unsigned long long* o8 = (unsigned long long*)(act + (size_t)r * D) + lane;
#pragma unroll
            for (int j = 0; j < 4; ++j) { x8[64 * j] = (unsigned long long)pk2(v[j].x, v[j].y) | ((unsigned long long)pk2(v[j].z, v[j].w) << 32);
                const f32x4 o = v[j] * rs * mA[j] + mB[j];
                o8[64 * j] = (unsigned long long)pk2(o.x, o.y) | ((unsigned long long)pk2(o.z, o.w) << 32); }
        }
    }
}

__device__ __forceinline__ void ph_sc_glue(const Frame& F, const bf16_t* gb, const bf16_t* uu, const float* cw  , bf16_t* act) {
    const int gw_ = F.vcu * NWAVES + F.wave, NGW = F.G * NWAVES, lane = F.lane;
    float w0[16], w1[16], w2[16];
#pragma unroll
    for (int hh = 0; hh < 2; ++hh)
#pragma unroll
        for (int q = 0; q < 8; ++q) { const int c = hh * 512 + 8 * lane + q; w0[hh * 8 + q] = cw[c]; w1[hh * 8 + q] = cw[D + c]; w2[hh * 8 + q] = cw[2 * D + c]; }
    const u32x4 zero4 = (u32x4){0u, 0u, 0u, 0u};
    for (int blk = gw_; blk < M_LAT / 16; blk += NGW) {
        const int r0 = blk * 16, t0 = r0 & (SEQ - 1);
        u32x4 up[2], uc[2];
#pragma unroll
        for (int hh = 0; hh < 2; ++hh) { const int c = hh * 512 + 8 * lane;
            up[hh] = t0 > 0 ? *(const u32x4*)(uu + (size_t)(r0 - 1) * D + c) : zero4; uc[hh] = *(const u32x4*)(uu + (size_t)r0 * D + c); }
#pragma unroll 1
        for (int i0 = 0; i0 < 16; i0 += 4) {
            u32x4 gq[4][2], un[4][2];
#pragma unroll
            for (int i = 0; i < 4; ++i)
#pragma unroll
                for (int hh = 0; hh < 2; ++hh) { const int r = r0 + i0 + i, c = hh * 512 + 8 * lane;
                    gq[i][hh] = *(const u32x4*)(gb + (size_t)r * D + c);
                    un[i][hh] = (t0 + i0 + i + 1 < SEQ) ? *(const u32x4*)(uu + (size_t)(r + 1) * D + c) : zero4; }
#pragma unroll
            for (int i = 0; i < 4; ++i) {
#pragma unroll
                for (int hh = 0; hh < 2; ++hh) {
                    u32x4 o;
#pragma unroll
                    for (int q = 0; q < 4; ++q) {
                        const float lo = bf_lo(gq[i][hh][q]) * (w0[hh * 8 + 2 * q] * bf_lo(up[hh][q]) + w1[hh * 8 + 2 * q] * bf_lo(uc[hh][q]) + w2[hh * 8 + 2 * q] * bf_lo(un[i][hh][q]));
                        const float hi = bf_hi(gq[i][hh][q]) * (w0[hh * 8 + 2 * q + 1] * bf_hi(up[hh][q]) + w1[hh * 8 + 2 * q + 1] * bf_hi(uc[hh][q]) + w2[hh * 8 + 2 * q + 1] * bf_hi(un[i][hh][q]));
                        o[q] = pk2(lo, hi);
                    }
                    *(u32x4*)(act + (size_t)(r0 + i0 + i) * D + hh * 512 + 8 * lane) = o;
                    up[hh] = uc[hh]; uc[hh] = un[i][hh];
                }
            }
        }
    }
}

constexpr int NSLOT = 132;
constexpr int NCHAIN = BATCH * NH;
__device__ __forceinline__ int kperm(int s, int g, int j) { return 16 * (2 * s + (j >> 2)) + 4 * g + (j & 3); }

struct ScanPtrs { unsigned char* QN; unsigned char* KT; unsigned char* NWK; unsigned char* QK; unsigned char* U; float* SCL; };
__device__ __forceinline__ size_t so_shared(int chain, int slot) { return ((size_t)chain * NSLOT + slot) * 16384; }
__device__ __forceinline__ size_t so_dir(int dir, int chain, int slot) { return (((size_t)dir * NCHAIN + chain) * NSLOT + slot); }

__device__ __forceinline__ void ph_chunk_prep(const Frame& F, const bf16_t* QKV, const bf16_t* CKV, const float* GATES, const float* cw  , const ScanPtrs P) {
    LAS unsigned char* L = F.lds;
    LAS bf16_t* kn = (LAS bf16_t*)(L);
    LAS bf16_t* qn = (LAS bf16_t*)(L + 17408);
    LAS float* vv = (LAS float*)(L + 34816);
    LAS float* KK = (LAS float*)(L + 68608);
    LAS float* QKr = (LAS float*)(L + 86016);
    LAS bf16_t* WKs = (LAS bf16_t*)(L + 68608);
    LAS float* NT = (LAS float*)(L + 103424);
    LAS float* gamP = (LAS float*)(L + 136192);
    LAS float* betP = gamP + 128;
    LAS float* begP = gamP + 256;
    const int wave = F.wave;
    for (int item = F.vcu; item < NCHAIN * NSLOT; item += F.G) {
        int tid = F.tid; asm volatile("" : "+v"(tid));
        const int lane = tid & 63;
        const int chain = item / NSLOT, slot = item % NSLOT, b = chain >> 2, h = chain & 3;
        const bool isctx = slot < 4;
        const int Lseq = isctx ? CTX : SEQ, t0 = isctx ? slot * 64 : (slot - 4) * 64;
        {
            const int i = tid >> 3, cg = tid & 7, t = t0 + i;
            const bf16_t* src; int ld, qoff, koff, voff;
            if (isctx) { src = CKV + (size_t)(b * CTX) * 1024; ld = 1024; qoff = -1; koff = h * 128; voff = 512 + h * 128; }
            else { src = QKV + (size_t)(b * SEQ) * 1536; ld = 1536; qoff = h * 128; koff = 512 + h * 128; voff = 1024 + h * 128; }
            float o[3][16];
#pragma unroll
            for (int w = 0; w < 3; ++w) {
                const int off = w == 0 ? qoff : (w == 1 ? koff : voff);
                if (off < 0) {
#pragma unroll
                    for (int c = 0; c < 16; ++c) o[w][c] = 0.f;
                    continue;
                }
                const int wcol = w * 512 + h * 128 + cg * 16;
#pragma unroll
                for (int c = 0; c < 16; ++c) o[w][c] = 0.f;
#pragma unroll
                for (int tap = 0; tap < 3; ++tap) {
                    const int tt = t + tap - 1;
                    if (tt < 0 || tt >= Lseq) continue;
                    const u32x4 a0 = *(const u32x4*)(src + (size_t)tt * ld + off + cg * 16), a1 = *(const u32x4*)(src + (size_t)tt * ld + off + cg * 16 + 8);
                    const float* wp = cw + tap * 1536 + wcol;
#pragma unroll
                    for (int q = 0; q < 4; ++q) { o[w][2 * q] += wp[2 * q] * bf_lo(a0[q]); o[w][2 * q + 1] += wp[2 * q + 1] * bf_hi(a0[q]);
                        o[w][8 + 2 * q] += wp[8 + 2 * q] * bf_lo(a1[q]); o[w][8 + 2 * q + 1] += wp[8 + 2 * q + 1] * bf_hi(a1[q]); }
                }
#pragma unroll
                for (int c = 0; c < 16; ++c) o[w][c] = silu1(o[w][c]);
            }
            float sq = 0.f, sk = 0.f;
#pragma unroll
            for (int c = 0; c < 16; ++c) { sq += o[0][c] * o[0][c]; sk += o[1][c] * o[1][c]; }
            sq += __shfl_xor(sq, 1); sq += __shfl_xor(sq, 2); sq += __shfl_xor(sq, 4);
            sk += __shfl_xor(sk, 1); sk += __shfl_xor(sk, 2); sk += __shfl_xor(sk, 4);
            const float rq = rsqrtf(sq + EPS) * 0.08838834764831845f, rk = rsqrtf(sk + EPS);
#pragma unroll
            for (int c = 0; c < 16; c += 2) {
                *(LAS unsigned*)(qn + i * 136 + cg * 16 + c) = pk2(o[0][c] * rq, o[0][c + 1] * rq);
                *(LAS unsigned*)(kn + i * 136 + cg * 16 + c) = pk2(o[1][c] * rk, o[1][c + 1] * rk);
                vv[i * 132 + cg * 16 + c] = o[2][c]; vv[i * 132 + cg * 16 + c + 1] = o[2][c + 1];
            }
        }
        if (wave < 2) {
            const int dir = wave, i = dir ? 63 - lane : lane;
            const size_t grow = isctx ? (size_t)M_LAT + b * CTX + t0 + i : (size_t)b * SEQ + t0 + i;
            float g = GATES[grow * 16 + 8 + dir * 4 + h];
#pragma unroll
            for (int o2 = 1; o2 < 64; o2 <<= 1) { const float x = __shfl_up(g, o2); if (lane >= o2) g += x; }
            gamP[dir * 64 + lane] = g; const float bt0 = GATES[grow * 16 + dir * 4 + h]; betP[dir * 64 + lane] = bt0; begP[dir * 64 + lane] = bt0 * __expf(g);
        }
        lds_barrier();
        {
            const int fr = lane & 15, fq = lane >> 4;
#pragma unroll
            for (int tt = 0; tt < 4; ++tt) {
                const int tile = wave * 4 + tt, which = tile >> 4, mt = (tile >> 2) & 3, nt = tile & 3;
                LAS bf16_t* Am = which ? qn : kn;
                f32x4 acc = (f32x4){0.f, 0.f, 0.f, 0.f};
#pragma unroll
                for (int s = 0; s < 4; ++s) {
                    const bf16x8 a = *(const LAS bf16x8*)(Am + (16 * mt + fr) * 136 + 32 * s + 8 * fq);
                    const bf16x8 bb = *(const LAS bf16x8*)(kn + (16 * nt + fr) * 136 + 32 * s + 8 * fq);
                    acc = __builtin_amdgcn_mfma_f32_16x16x32_bf16(a, bb, acc, 0, 0, 0);
                }
                LAS float* Om = which ? QKr : KK;
#pragma unroll
                for (int r = 0; r < 4; ++r) Om[(16 * mt + 4 * fq + r) * 68 + 16 * nt + fr] = acc[r];
            }
        }
        lds_barrier();
        {
#pragma unroll 2
            for (int it = 0; it < 16; ++it) {
                const int idx = tid + 512 * it, dir = idx >> 12, pp = (idx >> 6) & 63, p = idx & 63;
                float val = 0.f;
                if (p > pp) { const int ip = dir ? 63 - p : p, ipp = dir ? 63 - pp : pp;
                    val = betP[dir * 64 + p] * KK[ip * 68 + ipp] * __expf(gamP[dir * 64 + p] - gamP[dir * 64 + pp]); }
                NT[idx] = val;
            }
            const int f = tid >> 6, l2 = tid & 63, g = l2 >> 4;
            if (!isctx) {
#pragma unroll
                for (int dir = 0; dir < 2; ++dir) {
                    const int m = f >> 1, s = f & 1, io = 16 * m + (l2 & 15);
                    const float gi = gamP[dir * 64 + (dir ? 63 - io : io)];
                    float vals[8];
#pragma unroll
                    for (int e = 0; e < 8; ++e) { const int j = kperm(s, g, e); const bool keep = dir ? (j >= io) : (j <= io);
                        vals[e] = keep ? QKr[io * 68 + j] * __expf(gi - gamP[dir * 64 + (dir ? 63 - j : j)]) : 0.f; }
                    u32x4 w; w.x = pk2(vals[0], vals[1]); w.y = pk2(vals[2], vals[3]); w.z = pk2(vals[4], vals[5]); w.w = pk2(vals[6], vals[7]);
                    *(u32x4*)(P.QK + so_dir(dir, chain, slot) * 8192 + (size_t)tid * 16) = w;
                }
#pragma unroll
                for (int it = 0; it < 2; ++it) {
                    const int q = tid + 512 * it, ff = q >> 6, m = ff >> 2, s = ff & 3, row = 16 * m + (l2 & 15);
                    const u32x2 lo = *(const LAS u32x2*)(qn + row * 136 + 32 * s + 4 * g), hi = *(const LAS u32x2*)(qn + row * 136 + 32 * s + 16 + 4 * g);
                    *(u32x4*)(P.QN + so_shared(chain, slot) + (size_t)q * 16) = (u32x4){lo.x, lo.y, hi.x, hi.y};
                }
            }
#pragma unroll
            for (int it = 0; it < 2; ++it) {
                const int q = tid + 512 * it, ff = q >> 6, mp = ff >> 1, s = ff & 1, dk = 16 * mp + (l2 & 15);
                unsigned short e8[8];
#pragma unroll
                for (int e = 0; e < 8; ++e) e8[e] = kn[kperm(s, g, e) * 136 + dk];
                u32x4 w; w.x = e8[0] | ((unsigned)e8[1] << 16); w.y = e8[2] | ((unsigned)e8[3] << 16); w.z = e8[4] | ((unsigned)e8[5] << 16); w.w = e8[6] | ((unsigned)e8[7] << 16);
                *(u32x4*)(P.KT + so_shared(chain, slot) + (size_t)q * 16) = w;
            }
            if (tid < 128) { const int dir = tid >> 6, i = tid & 63, p = dir ? 63 - i : i;
                const float gl = gamP[dir * 64 + 63], gi = gamP[dir * 64 + p];
                float* sc = P.SCL + so_dir(dir, chain, slot) * 256;
                sc[i] = __expf(gi); sc[64 + i] = __expf(gl - gi); if (i == 0) sc[128] = __expf(gl); }
        }
        lds_barrier();
        {
            const int dir = wave >> 2, kind = (wave >> 1) & 1, c = (wave & 1) * 64 + lane;
            float Y[64];
            if (kind) {
#pragma unroll
                for (int p = 0; p < 64; ++p) { const int i = dir ? 63 - p : p; Y[p] = begP[dir * 64 + p] * bf_lo((unsigned)kn[i * 136 + c]); }
            } else {
#pragma unroll
                for (int p = 0; p < 64; ++p) { const int i = dir ? 63 - p : p; Y[p] = betP[dir * 64 + p] * vv[i * 132 + c]; }
            }
            const LAS float* nt = NT + dir * 4096;
#pragma unroll
            for (int pp = 0; pp < 63; ++pp) {
                const float y = Y[pp];
                int zdep; asm("v_and_b32 %0, 0, %1" : "=v"(zdep) : "v"(y));
                const LAS float* ntp = nt + zdep;
#pragma unroll
                for (int q4 = (pp + 1) & ~3; q4 < 64; q4 += 4) {
                    const f32x4 n4 = *(const LAS f32x4*)(ntp + pp * 64 + q4);
                    if (q4 + 0 > pp) Y[q4 + 0] -= n4.x * y;
                    if (q4 + 1 > pp) Y[q4 + 1] -= n4.y * y;
                    if (q4 + 2 > pp) Y[q4 + 2] -= n4.z * y;
                    if (q4 + 3 > pp) Y[q4 + 3] -= n4.w * y;
                }
            }
            lds_barrier();
            if (kind == 0) {
                const int T = c >> 4;
                unsigned char* ub = P.U + so_dir(dir, chain, slot) * 16384;
#pragma unroll
                for (int m = 0; m < 4; ++m)
#pragma unroll
                    for (int g = 0; g < 4; ++g) { const int i0 = 16 * m + 4 * g;
                        const float y0 = Y[dir ? 63 - i0 : i0], y1 = Y[dir ? 62 - i0 : i0 + 1], y2 = Y[dir ? 61 - i0 : i0 + 2], y3 = Y[dir ? 60 - i0 : i0 + 3];
                        *(u32x2*)(ub + (size_t)(((T * 4 + m) * 64) + g * 16 + (c & 15)) * 8) = (u32x2){pk2(y0, y1), pk2(y2, y3)}; }
            } else {
#pragma unroll
                for (int p = 0; p < 64; ++p) { const int i = dir ? 63 - p : p; WKs[(dir * 64 + i) * 136 + c] = (bf16_t)f2bf(-Y[p]); }
            }
        }
        lds_barrier();
#pragma unroll
        for (int it = 0; it < 4; ++it) {
            const int q = tid + 512 * it, dir = q >> 10, q1 = q & 1023, ff = q1 >> 6, l2 = q1 & 63, g = l2 >> 4, m = ff >> 2, s = ff & 3, row = 16 * m + (l2 & 15);
            const LAS bf16_t* wt = WKs + (dir * 64 + row) * 136;
            const u32x2 lo = *(const LAS u32x2*)(wt + 32 * s + 4 * g), hi = *(const LAS u32x2*)(wt + 32 * s + 16 + 4 * g);
            *(u32x4*)(P.NWK + so_dir(dir, chain, slot) * 16384 + (size_t)q1 * 16) = (u32x4){lo.x, lo.y, hi.x, hi.y};
        }
        lds_barrier();
    }
}

constexpr int SC_NWK = 0, SC_QN = 16384, SC_KT = 32768, SC_QK = 49152, SC_U = 57344, SC_SCL = 65536, SC_STAGE = 66560;
constexpr int SC_HS = 2 * SC_STAGE  , SC_HW = SC_HS + 16384  ;
static_assert(SC_HW + 8192 <= MISC_OFF, "scan LDS map");
__device__ __forceinline__ void ph_scan(const Frame& F, const ScanPtrs P, bf16_t* OF, bf16_t* OB, unsigned* prog) {
    const int xg = F.vcu >> 5, xj = F.vcu & 31;
    if (xj >= 8 || xg >= 8) return;
    const int sb = xg * 8 + xj, half = sb & 1, dir = (sb >> 1) & 1, chain = sb >> 2, b = chain >> 2, h = chain & 3;
    LAS unsigned char* L = F.lds;
    const int lane = F.lane, wave = F.wave, g = lane >> 4, tile = wave & 3;
    const bool isR = wave < 4;
    bf16_t* O = dir ? OB : OF;
    const unsigned lbase = (unsigned)(unsigned long long)(L);
    auto slot_of = [&](int step) { return dir ? (step < 4 ? 3 - step : 135 - step) : step; };
    auto issue = [&](int step) {
        const int slot = slot_of(step); const unsigned sbase = (unsigned)(step & 1) * SC_STAGE; const bool emit = slot >= 4;
        const unsigned char* nwk = P.NWK + so_dir(dir, chain, slot) * 16384; const unsigned char* kt = P.KT + so_shared(chain, slot);
        const unsigned char* qn = P.QN + so_shared(chain, slot); const unsigned char* qk = P.QK + so_dir(dir, chain, slot) * 8192;
        const unsigned char* uu = P.U + so_dir(dir, chain, slot) * 16384 + half * 8192; const unsigned char* sc = (const unsigned char*)(P.SCL + so_dir(dir, chain, slot) * 256);
#pragma unroll
        for (int i = 0; i < 2; ++i) { const int pc = wave * 2 + i;
            __builtin_amdgcn_global_load_lds((const unsigned*)(nwk + pc * 1024 + lane * 16), (LAS unsigned*)(L + sbase + SC_NWK + pc * 1024), 16, 0, 0); }
        __builtin_amdgcn_global_load_lds((const unsigned*)(uu + wave * 1024 + lane * 16), (LAS unsigned*)(L + sbase + SC_U + wave * 1024), 16, 0, 0);
        if (wave == 7) __builtin_amdgcn_global_load_lds((const unsigned*)(sc + lane * 16), (LAS unsigned*)(L + sbase + SC_SCL), 16, 0, 0);
        if (emit) {
#pragma unroll
            for (int i = 0; i < 2; ++i) { const int pc = wave * 2 + i;
                __builtin_amdgcn_global_load_lds((const unsigned*)(qn + pc * 1024 + lane * 16), (LAS unsigned*)(L + sbase + SC_QN + pc * 1024), 16, 0, 0); }
        }
#pragma unroll
        for (int i = 0; i < 2; ++i) { const int pc = wave * 2 + i;
            __builtin_amdgcn_global_load_lds((const unsigned*)(kt + pc * 1024 + lane * 16), (LAS unsigned*)(L + sbase + SC_KT + pc * 1024), 16, 0, 0); }
        if (emit) __builtin_amdgcn_global_load_lds((const unsigned*)(qk + wave * 1024 + lane * 16), (LAS unsigned*)(L + sbase + SC_QK + wave * 1024), 16, 0, 0);
    };
#define SC_RD128(dst, addr, off) asm volatile("ds_read_b128 %0, %1 offset:%2" : "=v"(dst) : "v"(addr), "n"(off))
#define SC_WR128(addr, off, src) asm volatile("ds_write_b128 %0, %1 offset:%2\n\ts_nop 3" :: "v"(addr), "v"(src), "n"(off) : "memory")
#define SC_LOAD(dst, base, first) do { _Pragma("unroll") for (int i_ = 0; i_ < 8; ++i_) SC_RD128(dst[i_], sva, (base) + ((first) + i_) * 1024); } while (0)
#define SC_WAIT0(a) do { asm volatile("s_waitcnt lgkmcnt(0)" : "+v"(a[0]), "+v"(a[1]), "+v"(a[2]), "+v"(a[3]), "+v"(a[4]), "+v"(a[5]), "+v"(a[6]), "+v"(a[7])); __builtin_amdgcn_sched_barrier(0); } while (0)
    const unsigned hsa = lbase + SC_HS + (unsigned)tile * 4096u + (unsigned)lane * 16u;
    const unsigned hwa = lbase + SC_HW + (unsigned)tile * 2048u + (unsigned)lane * 16u;
    f32x4 accS[8];
#pragma unroll
    for (int m = 0; m < 8; ++m) accS[m] = (f32x4){0.f, 0.f, 0.f, 0.f};
    bf16x8 bS[4];
#pragma unroll
    for (int s = 0; s < 4; ++s) bS[s] = (bf16x8){0, 0, 0, 0, 0, 0, 0, 0};
    if (isR) {
#pragma unroll
        for (int s = 0; s < 4; ++s) SC_WR128(hsa, s * 1024, bS[s]);
    }
    issue(0); asm volatile("s_waitcnt vmcnt(0)" ::: "memory");
    lds_barrier();
    for (int step = 0; step < NSLOT; ++step) {
        const int slot = slot_of(step); const bool emit = slot >= 4;
        if (half == 0 && F.tid == 0) __hip_atomic_store(prog + 16 * (sb >> 1), (unsigned)(step + 1), __ATOMIC_RELAXED, __HIP_MEMORY_SCOPE_AGENT);
        const unsigned sva = lbase + (unsigned)(step & 1) * SC_STAGE + (unsigned)lane * 16u;
        const unsigned ssa = sva - (unsigned)lane * 16u + SC_SCL + (unsigned)g * 16u;
#if PROBE_SEL >= 0
        const bool pw = (sb == 0 && wave == PROBE_WAVE);
        unsigned long long t0_ = 0, t1_ = 0, t2_ = 0, t3_ = 0, t4_ = 0, t5_ = 0;
        if (pw) t0_ = __builtin_amdgcn_s_memrealtime();
#endif
        if (step + 1 < NSLOT) issue(step + 1);
#if PROBE_SEL >= 0
        if (pw) t1_ = __builtin_amdgcn_s_memrealtime();
#endif
        bf16x8 fa[8], fb[8];
        f32x4 acco[4]; bf16x8 bWx[2];
        if (isR) {
            const unsigned sua = sva - (unsigned)lane * 8u + SC_U + (unsigned)tile * 2048u;
            f32x4 accw[4], ek4[4]; u32x2 uv[4]; float cd;
#pragma unroll
            for (int m = 0; m < 4; ++m) asm volatile("ds_read_b64 %0, %1 offset:%2" : "=v"(uv[m]) : "v"(sua), "n"(m * 512));
            SC_LOAD(fa, SC_NWK, 0);
            asm volatile("s_waitcnt lgkmcnt(0)" : "+v"(uv[0]), "+v"(uv[1]), "+v"(uv[2]), "+v"(uv[3]),
                         "+v"(fa[0]), "+v"(fa[1]), "+v"(fa[2]), "+v"(fa[3]), "+v"(fa[4]), "+v"(fa[5]), "+v"(fa[6]), "+v"(fa[7])); __builtin_amdgcn_sched_barrier(0);
            SC_LOAD(fb, SC_NWK, 8);
#pragma unroll
            for (int m = 0; m < 4; ++m) SC_RD128(ek4[m], ssa, 256 + m * 64);
            asm volatile("ds_read_b32 %0, %1 offset:512" : "=v"(cd) : "v"(ssa - (unsigned)g * 16u));
#pragma unroll
            for (int m = 0; m < 4; ++m) accw[m] = (f32x4){bf_lo(uv[m].x), bf_hi(uv[m].x), bf_lo(uv[m].y), bf_hi(uv[m].y)};
#pragma unroll
            for (int f = 0; f < 8; ++f) accw[f >> 2] = __builtin_amdgcn_mfma_f32_16x16x32_bf16(fa[f], bS[f & 3], accw[f >> 2], 0, 0, 0);
            asm volatile("s_waitcnt lgkmcnt(0)" : "+v"(ek4[0]), "+v"(ek4[1]), "+v"(ek4[2]), "+v"(ek4[3]), "+v"(cd),
                         "+v"(fb[0]), "+v"(fb[1]), "+v"(fb[2]), "+v"(fb[3]), "+v"(fb[4]), "+v"(fb[5]), "+v"(fb[6]), "+v"(fb[7])); __builtin_amdgcn_sched_barrier(0);
            SC_LOAD(fa, SC_KT, 0);
#pragma unroll
            for (int f = 0; f < 8; ++f) accw[2 + (f >> 2)] = __builtin_amdgcn_mfma_f32_16x16x32_bf16(fb[f], bS[f & 3], accw[2 + (f >> 2)], 0, 0, 0);
            SC_WAIT0(fa);
            SC_LOAD(fb, SC_KT, 8);
            bf16x8 bWs[2];
#pragma unroll
            for (int s = 0; s < 2; ++s) {
                const f32x4 w0 = accw[2 * s], w1 = accw[2 * s + 1], e0 = ek4[2 * s], e1 = ek4[2 * s + 1];
                u32x4 a, c2;
                a.x = cvt_pk_bf16(w0[0], w0[1]); a.y = cvt_pk_bf16(w0[2], w0[3]); a.z = cvt_pk_bf16(w1[0], w1[1]); a.w = cvt_pk_bf16(w1[2], w1[3]);
                c2.x = cvt_pk_bf16(w0[0] * e0[0], w0[1] * e0[1]); c2.y = cvt_pk_bf16(w0[2] * e0[2], w0[3] * e0[3]); c2.z = cvt_pk_bf16(w1[0] * e1[0], w1[1] * e1[1]); c2.w = cvt_pk_bf16(w1[2] * e1[2], w1[3] * e1[3]);
                bWx[s] = __builtin_bit_cast(bf16x8, a); bWs[s] = __builtin_bit_cast(bf16x8, c2);
                if (emit) SC_WR128(hwa, s * 1024, bWx[s]);
            }
#pragma unroll
            for (int m = 0; m < 8; ++m) accS[m] = accS[m] * cd;
#if PROBE_SEL >= 0
            if (pw) t2_ = __builtin_amdgcn_s_memrealtime();
#endif
            lds_barrier();
#if PROBE_SEL >= 0
            if (pw) t3_ = __builtin_amdgcn_s_memrealtime();
#endif
            SC_WAIT0(fb);
#pragma unroll
            for (int f = 0; f < 8; ++f) accS[f >> 1] = __builtin_amdgcn_mfma_f32_16x16x32_bf16(fa[f], bWs[f & 1], accS[f >> 1], 0, 0, 0);
#pragma unroll
            for (int f = 0; f < 8; ++f) accS[4 + (f >> 1)] = __builtin_amdgcn_mfma_f32_16x16x32_bf16(fb[f], bWs[f & 1], accS[4 + (f >> 1)], 0, 0, 0);
#pragma unroll
            for (int s = 0; s < 4; ++s) {
                const f32x4 s0 = accS[2 * s], s1 = accS[2 * s + 1];
                u32x4 a; a.x = cvt_pk_bf16(s0[0], s0[1]); a.y = cvt_pk_bf16(s0[2], s0[3]); a.z = cvt_pk_bf16(s1[0], s1[1]); a.w = cvt_pk_bf16(s1[2], s1[3]);
                bS[s] = __builtin_bit_cast(bf16x8, a);
                SC_WR128(hsa, s * 1024, bS[s]);
            }
        } else {
            f32x4 eg4[4];
            if (emit) {
#pragma unroll
                for (int s = 0; s < 4; ++s) SC_RD128(bS[s], hsa, s * 1024);
                SC_LOAD(fa, SC_QN, 0);
                asm volatile("s_waitcnt lgkmcnt(0)" : "+v"(bS[0]), "+v"(bS[1]), "+v"(bS[2]), "+v"(bS[3]),
                             "+v"(fa[0]), "+v"(fa[1]), "+v"(fa[2]), "+v"(fa[3]), "+v"(fa[4]), "+v"(fa[5]), "+v"(fa[6]), "+v"(fa[7])); __builtin_amdgcn_sched_barrier(0);
                SC_LOAD(fb, SC_QN, 8);
#pragma unroll
                for (int m = 0; m < 4; ++m) SC_RD128(eg4[m], ssa, m * 64);
#pragma unroll
                for (int m = 0; m < 4; ++m) acco[m] = (f32x4){0.f, 0.f, 0.f, 0.f};
#pragma unroll
                for (int f = 0; f < 8; ++f) acco[f >> 2] = __builtin_amdgcn_mfma_f32_16x16x32_bf16(fa[f], bS[f & 3], acco[f >> 2], 0, 0, 0);
                asm volatile("s_waitcnt lgkmcnt(0)" : "+v"(eg4[0]), "+v"(eg4[1]), "+v"(eg4[2]), "+v"(eg4[3]),
                             "+v"(fb[0]), "+v"(fb[1]), "+v"(fb[2]), "+v"(fb[3]), "+v"(fb[4]), "+v"(fb[5]), "+v"(fb[6]), "+v"(fb[7])); __builtin_amdgcn_sched_barrier(0);
                SC_LOAD(fa, SC_QK, 0);
#pragma unroll
                for (int f = 0; f < 8; ++f) acco[2 + (f >> 2)] = __builtin_amdgcn_mfma_f32_16x16x32_bf16(fb[f], bS[f & 3], acco[2 + (f >> 2)], 0, 0, 0);
#pragma unroll
                for (int m = 0; m < 4; ++m) acco[m] = acco[m] * eg4[m];
            }
#if PROBE_SEL >= 0
            if (pw) t2_ = __builtin_amdgcn_s_memrealtime();
#endif
            lds_barrier();
#if PROBE_SEL >= 0
            if (pw) t3_ = __builtin_amdgcn_s_memrealtime();
#endif
            if (emit) {
                SC_RD128(bWx[0], hwa, 0); SC_RD128(bWx[1], hwa, 1024);
                asm volatile("s_waitcnt lgkmcnt(0)" : "+v"(bWx[0]), "+v"(bWx[1]), "+v"(fa[0]), "+v"(fa[1]), "+v"(fa[2]), "+v"(fa[3]), "+v"(fa[4]), "+v"(fa[5]), "+v"(fa[6]), "+v"(fa[7])); __builtin_amdgcn_sched_barrier(0);
#pragma unroll
                for (int f = 0; f < 8; ++f) acco[f >> 1] = __builtin_amdgcn_mfma_f32_16x16x32_bf16(fa[f], bWx[f & 1], acco[f >> 1], 0, 0, 0);
                bf16_t* orow = O + ((size_t)b * SEQ + (slot - 4) * 64) * 512 + h * 128 + half * 64 + tile * 16 + (lane & 15);
#pragma unroll
                for (int m = 0; m < 4; ++m) { const unsigned p01 = cvt_pk_bf16(acco[m][0], acco[m][1]), p23 = cvt_pk_bf16(acco[m][2], acco[m][3]);
                    bf16_t* q = orow + (size_t)(16 * m + 4 * g) * 512;
                    q[0] = (bf16_t)(p01 & 0xffffu); q[512] = (bf16_t)(p01 >> 16); q[1024] = (bf16_t)(p23 & 0xffffu); q[1536] = (bf16_t)(p23 >> 16); }
            }
        }
#if PROBE_SEL >= 0
        if (pw) t4_ = __builtin_amdgcn_s_memrealtime();
#endif
        asm volatile("s_waitcnt vmcnt(0)" ::: "memory");
#if PROBE_SEL >= 0
        if (pw) t5_ = __builtin_amdgcn_s_memrealtime();
#endif
        lds_barrier();
#if PROBE_SEL >= 0
        if (pw && lane == 0) { const unsigned long long t6_ = __builtin_amdgcn_s_memrealtime(); unsigned long long* ts = (unsigned long long*)(prog - CW_PROG + CW_TS);
            ts[0] += t1_ - t0_; ts[1] += t2_ - t1_; ts[2] += t3_ - t2_; ts[3] += t4_ - t3_; ts[4] += t5_ - t4_; ts[5] += t6_ - t5_; ts[6] += t6_ - t0_; }
#endif
    }
#undef SC_LOAD
#undef SC_WAIT0
#undef SC_RD128
#undef SC_WR128
}

__device__ __forceinline__ void scan_l2_warm(const Frame& F, const ScanPtrs P, int stream, int quarter, unsigned* prog) {
    const int dir = stream & 1, chain = stream >> 1, lane = F.lane;
    const int wq = quarter * NWAVES + F.wave;
    constexpr int AHEAD = 6;
    int done = 0;
    u32x4 junk = (u32x4){0u, 0u, 0u, 0u};
    for (unsigned spins = 0; spins < (1u << 20); ++spins) {
        const int cur = (int)__hip_atomic_load(prog + 16 * stream, __ATOMIC_RELAXED, __HIP_MEMORY_SCOPE_AGENT);
        int tgt = cur + AHEAD; if (tgt > NSLOT) tgt = NSLOT;
        for (int s = done > cur ? done : cur; s < tgt; ++s) {
            const int slot = dir ? (s < 4 ? 3 - s : 135 - s) : s;
#pragma unroll
            for (int i = 0; i < 3; ++i) { const int p = wq + 32 * i;
                const unsigned char* src = nullptr;
                if (p < 16) src = P.NWK + so_dir(dir, chain, slot) * 16384 + p * 1024;
                else if (p < 32) src = P.KT + so_shared(chain, slot) + (p - 16) * 1024;
                else if (p < 48) src = P.U + so_dir(dir, chain, slot) * 16384 + (p - 32) * 1024;
                else if (p < 64) { if (slot >= 4) src = P.QN + so_shared(chain, slot) + (p - 48) * 1024; }
                else if (p < 72) { if (slot >= 4) src = P.QK + so_dir(dir, chain, slot) * 8192 + (p - 64) * 1024; }
                else if (p == 72) src = (const unsigned char*)(P.SCL + so_dir(dir, chain, slot) * 256);
                if (src) asm volatile("global_load_dwordx4 %0, %1, off" : "+v"(junk) : "v"(src + lane * 16)); }
        }
        if (tgt > done) done = tgt;
        if (done >= NSLOT) break;
        __builtin_amdgcn_s_sleep(16);
    }
    asm volatile("s_waitcnt vmcnt(0)" : "+v"(junk) :: "memory");
}

__device__ __forceinline__ void ph_even_A(const Frame& F, const bf16_t* OF, const bf16_t* OB, const bf16_t* Z, const bf16_t* POOL, const float* onorm, bf16_t* act) {
    LAS unsigned char* L = F.lds;
    for (int seg = F.vcu; seg < M_LAT / 64; seg += F.G) {
        int tid = F.tid; asm volatile("" : "+v"(tid));
        const int lane = tid & 63;
        const size_t row0 = (size_t)seg * 64;
#pragma unroll
        for (int i = 0; i < 8; ++i) { const int q = tid + 512 * i;
            *(LAS u32x4*)(L + q * 16) = *(const u32x4*)(POOL + row0 * 512 + (size_t)q * 8); }
        __syncthreads();
#pragma unroll 1
        for (int i0 = 0; i0 < 8; i0 += 4) {
            u32x4 av[4], bv[4], zv[4];
#pragma unroll
            for (int i = 0; i < 4; ++i) { const size_t r = row0 + F.wave * 8 + i0 + i;
                av[i] = *(const u32x4*)(OF + r * 512 + 8 * lane); bv[i] = *(const u32x4*)(OB + r * 512 + 8 * lane); zv[i] = *(const u32x4*)(Z + r * 512 + 8 * lane); }
#pragma unroll
            for (int i = 0; i < 4; ++i) {
                const int pos = F.wave * 8 + i0 + i; const size_t r = row0 + pos;
                const u32x4 a = av[i], b2 = bv[i], z = zv[i];
                float o[8]; float s = 0.f;
#pragma unroll
                for (int q = 0; q < 4; ++q) { o[2 * q] = bf_lo(a[q]) + bf_lo(b2[q]); o[2 * q + 1] = bf_hi(a[q]) + bf_hi(b2[q]); s += o[2 * q] * o[2 * q] + o[2 * q + 1] * o[2 * q + 1]; }
                s += __shfl_xor(s, 1); s += __shfl_xor(s, 2); s += __shfl_xor(s, 4); s += __shfl_xor(s, 8);
                const float rs = rsqrtf(s * (1.f / 128.f) + EPS);
                const float* gn = onorm + ((8 * lane) & 127);
                u32x4 w;
#pragma unroll
                for (int q = 0; q < 4; ++q) w[q] = pk2(o[2 * q] * rs * gn[2 * q] * silu1(bf_lo(z[q])), o[2 * q + 1] * rs * gn[2 * q + 1] * silu1(bf_hi(z[q])));
                *(u32x4*)(act + r * D + 8 * lane) = w;
                const int grp = lane >> 4, win = 2 << grp;
                int lo = pos - win / 2; if (lo < 0) lo = 0; int hi = pos + win - win / 2; if (hi > 64) hi = 64;
                float m[8];
#pragma unroll
                for (int q = 0; q < 8; ++q) m[q] = 0.f;
#pragma unroll
                for (int p = 0; p < 16; ++p) { const int rr = lo + p; const bool ok = rr < hi;
                    const u32x4 pv = *(const LAS u32x4*)(L + (ok ? rr : pos) * 1024 + lane * 16);
                    if (ok) {
#pragma unroll
                        for (int q = 0; q < 4; ++q) { m[2 * q] += bf_lo(pv[q]); m[2 * q + 1] += bf_hi(pv[q]); } } }
                const float inv = 1.f / (float)(hi - lo);
                const u32x4 self = *(const LAS u32x4*)(L + pos * 1024 + lane * 16);
#pragma unroll
                for (int q = 0; q < 4; ++q) w[q] = pk2(m[2 * q] * inv - bf_lo(self[q]), m[2 * q + 1] * inv - bf_hi(self[q]));
                *(u32x4*)(act + r * D + 512 + 8 * lane) = w;
            }
        }
        __syncthreads();
    }
}

struct TItem { const float* W; bf16_t* WT; int ldn, n0, k0, Kd, drow0; };
constexpr int N_LATE_T = 2304 + 2 * NE * 768;
__device__ __forceinline__ TItem late_item(const Args& args, int it, bf16_t* WOUT, bf16_t* SCIN, bf16_t* SCOUT, bf16_t* WGU, bf16_t* WDN) {
    TItem t;
    if (it < 256) { const int kb = it >> 5, nb = it & 31; t = TItem{args.in[16], WOUT, D, 32 * nb, 64 * kb, D, 32 * nb}; }
    else if (it < 1792) { const int q = it - 256, kb = q / 96, nb = q % 96, n0 = 32 * nb; int drow;
        if (n0 < D) drow = n0; else if (n0 < 2 * D) drow = D + ((n0 - D) >> 7) * 256 + (n0 & 127); else drow = D + ((n0 - 2 * D) >> 7) * 256 + 128 + (n0 & 127);
        t = TItem{args.in[17], SCIN, 3 * D, n0, 64 * kb, D, drow}; }
    else if (it < 2304) { const int q = it - 1792, kb = q >> 5, nb = q & 31; t = TItem{args.in[19], SCOUT, D, 32 * nb, 64 * kb, D, 32 * nb}; }
    else { const int q0 = it - 2304, le = q0 / 768, r = q0 % 768;
        if (r < 512) { const int up = r >> 8, q = r & 255, kb = q >> 4, nb = q & 15, n0 = 32 * nb;
            t = TItem{(up ? args.in[22] : args.in[21]) + (size_t)le * D * DE, WGU + (size_t)le * 1024 * D, DE, n0, 64 * kb, D, (n0 >> 7) * 256 + up * 128 + (n0 & 127)}; }
        else { const int q = r - 512, kb = q >> 5, nb = q & 31; t = TItem{args.in[23] + (size_t)le * DE * D, WDN + (size_t)le * D * DE, D, 32 * nb, 64 * kb, DE, 32 * nb}; } }
    return t;
}
__device__ __forceinline__ void t_load(const TItem& t, float (&tv)[32], int lane) {
#pragma unroll
    for (int i = 0; i < 32; ++i) tv[i] = __builtin_nontemporal_load(t.W + (size_t)(t.k0 + 2 * i + (lane >> 5)) * t.ldn + t.n0 + (lane & 31));
}
__device__ __forceinline__ void t_store(const TItem& t, const float (&tv)[32], LAS float* scr, int lane) {
#pragma unroll
    for (int i = 0; i < 32; ++i) scr[(2 * i + (lane >> 5)) * 33 + (lane & 31)] = tv[i];
    asm volatile("s_waitcnt lgkmcnt(0)" ::: "memory");
    const int c = lane & 7;
#pragma unroll
    for (int j = 0; j < 4; ++j) { const int n = (lane >> 3) + 8 * j; const LAS float* s = scr + (8 * c) * 33 + n;
        u32x4 o; o.x = pk2(s[0 * 33], s[1 * 33]); o.y = pk2(s[2 * 33], s[3 * 33]); o.z = pk2(s[4 * 33], s[5 * 33]); o.w = pk2(s[6 * 33], s[7 * 33]);
        __builtin_nontemporal_store(o, (u32x4*)(t.WT + (size_t)(t.drow0 + n) * t.Kd + t.k0 + 8 * c)); }
    asm volatile("s_waitcnt lgkmcnt(0)" ::: "memory");
}
__device__ __forceinline__ void prep_late(const Frame& F, const Args& args, int widx, int nw, bf16_t* WOUT, bf16_t* SCIN, bf16_t* SCOUT, bf16_t* WGU, bf16_t* WDN) {
    LAS float* scr = (LAS float*)(F.lds + F.wave * 16384);
    for (int it = widx; it < 4 * 128 * 16; it += nw) { const int gq = it >> 11, c = (it >> 4) & 127, n = (it & 15) * 64 + F.lane;
        const float* pw = args.in[14] + ((size_t)gq * 128 + c) * 128; const float* ps = args.in[15] + gq * 128; const float* wo = args.in[16] + (size_t)(512 + gq * 128) * D + n;
        float acc = 0.f;
#pragma unroll 1
        for (int d0 = 0; d0 < 128; d0 += 32) { float wv[32];
#pragma unroll
            for (int d = 0; d < 32; ++d) wv[d] = wo[(size_t)(d0 + d) * D];
#pragma unroll
            for (int d = 0; d < 32; ++d) acc += pw[d0 + d] * ps[d0 + d] * wv[d]; }
        WOUT[(size_t)n * D + 512 + gq * 128 + c] = (bf16_t)f2bf(acc); }
    float ta[32], tb[32];
    int it0 = widx;
    TItem A = late_item(args, it0 < N_LATE_T ? it0 : 0, WOUT, SCIN, SCOUT, WGU, WDN), B = A;
    if (it0 < N_LATE_T) t_load(A, ta, F.lane);
    while (it0 < N_LATE_T) {
        const int it1 = it0 + nw;
        if (it1 < N_LATE_T) { B = late_item(args, it1, WOUT, SCIN, SCOUT, WGU, WDN); t_load(B, tb, F.lane); }
        t_store(A, ta, scr, F.lane);
        it0 = it1 + nw;
        if (it0 < N_LATE_T) { A = late_item(args, it0, WOUT, SCIN, SCOUT, WGU, WDN); t_load(A, ta, F.lane); }
        if (it1 < N_LATE_T) t_store(B, tb, scr, F.lane);
        __builtin_amdgcn_s_sleep(127); __builtin_amdgcn_s_sleep(127);
    }
}

enum { PH_PREP = 0, PH_E1, PH_E2, PH_E3, PH_E4, PH_E5, PH_E6, PH_M1_0, PH_M2_0, PH_M3_0, PH_M4_0, PH_M5_0, PH_X1, PH_X2, PH_X3, PH_M1_1, PH_M2_1, PH_M3_1, PH_M4_1, PH_M5_1, PH_COUNT };

__global__ void __launch_bounds__(NTHREADS, 2) mega(Args args) {
    extern __shared__ __attribute__((aligned(16))) unsigned char lds_raw[];
    Frame F;
    F.lds = (LAS unsigned char*)lds_raw;
    F.tid = threadIdx.x; F.lane = F.tid & 63; F.wave = __builtin_amdgcn_readfirstlane(F.tid >> 6);
    F.G = gridDim.x; { const int bx = blockIdx.x; F.vcu = (F.G % 8 == 0) ? (bx % 8) * (F.G / 8) + bx / 8 : bx; }
    volatile LAS unsigned* MISC = (volatile LAS unsigned*)(F.lds + MISC_OFF);
    if (F.tid < 64) MISC[F.tid] = 0u;
    __syncthreads();
    unsigned char* ws = args.ws;
    XcdBarrier bar = xcd_barrier_post((unsigned*)(ws + WS_CTL) + CW_BAR + args.li * XCD_BAR_WORDS, MISC + 8);
    const int lo = args.ph_lo, hi = args.ph_hi;
#define IN(k) (lo <= (k) && (k) < hi)
#define SEAM(k) do { if (IN(k) && IN((k) + 1)) xcd_barrier(bar); } while (0)
    const float* ADA = (const float*)(ws + WS_ADA); float* ADAw = (float*)(ws + WS_ADA);
    float* AFF = (float*)(ws + WS_AFF); int* IDX = (int*)(ws + WS_IDX); float* GATE = (float*)(ws + WS_GATE); int* SEL = (int*)(ws + WS_SEL);
    bf16_t* WGU = (bf16_t*)(ws + WS_WGU); bf16_t* WDN = (bf16_t*)(ws + WS_WDN); bf16_t* SCIN = (bf16_t*)(ws + WS_SCIN); bf16_t* SCOUT = (bf16_t*)(ws + WS_SCOUT);
    bf16_t* GBp = (bf16_t*)(ws + WS_GB); bf16_t* UUp = (bf16_t*)(ws + WS_UU);
    bf16_t* WIN = (bf16_t*)(ws + WS_WIN); bf16_t* WOUT = (bf16_t*)(ws + WS_WOUT); float* GATES = (float*)(ws + WS_GATES);
    const ScanPtrs SP{ws + WS_QN, ws + WS_KT, ws + WS_NWK, (unsigned char*)args.out + 66 * MiB, (unsigned char*)args.out, (float*)(ws + WS_SCL)};
    bf16_t* OFp = (bf16_t*)(ws + WS_OF); bf16_t* OBp = (bf16_t*)(ws + WS_OB);
    bf16_t* QKV = (bf16_t*)(ws + WS_QKV); bf16_t* Zp = (bf16_t*)(ws + WS_Z); bf16_t* POOLp = (bf16_t*)(ws + WS_POOL); bf16_t* CKV = (bf16_t*)(ws + WS_CKV);
    bf16_t* ACT = (bf16_t*)(ws + WS_ACT); bf16_t* HID = (bf16_t*)(ws + WS_HID); bf16_t* Y = (bf16_t*)(ws + WS_Y);
    float* xl = args.out; (void)xl;
    bf16_t* XLB = (bf16_t*)(ws + WS_XLB);

    if (IN(PH_PREP)) {
        LAS float* scr = (LAS float*)(F.lds + F.wave * 16384);
        const int gw_ = F.vcu * NWAVES + F.wave, NGW = F.G * NWAVES;
        for (int it = F.vcu; it < 192; it += F.G) { const int l = it / 96, n = (it % 96) * 64 + F.lane;
            const float* w = args.in[4] + (size_t)l * D * 6 * D + (size_t)(128 * F.wave) * 6 * D + n; float acc[5] = {0.f, 0.f, 0.f, 0.f, 0.f};
#pragma unroll 8
            for (int k2 = 0; k2 < 128; ++k2) { const float wv = w[(size_t)k2 * 6 * D]; const int kk = 128 * F.wave + k2;
#pragma unroll
                for (int r = 0; r < 5; ++r) { const float cv = r < 4 ? args.in[1][r * D + kk] : args.in[3][kk]; acc[r] += silu1(cv) * wv; } }
            LAS float* red = (LAS float*)(F.lds + 8 * 16384);
#pragma unroll
            for (int r = 0; r < 5; ++r) red[(F.wave * 5 + r) * 64 + F.lane] = acc[r];
            __syncthreads();
            if (F.tid < 320) { const int r = F.tid >> 6, ln = F.tid & 63; float sacc = 0.f;
#pragma unroll
                for (int w2 = 0; w2 < 8; ++w2) sacc += red[(w2 * 5 + r) * 64 + ln];
                const int n2 = (it % 96) * 64 + ln;
                ADAw[((size_t)l * 5 + r) * 6 * D + n2] = sacc + args.in[5][l * 6 * D + n2]; }
            __syncthreads(); }
        for (int it = gw_; it < 1280; it += NGW) { const int kb = it / 80, nb = it % 80, n0 = 32 * nb;
            transpose_item(args.in[9], D, EVEN_IN, n0 < 2048 ? n0 : n0 + 16, 64 * kb, WIN, n0, scr, F.lane); }
    }
    SEAM(PH_PREP);
    if (IN(PH_E1)) ph_norm16<1>(F, args.in[0], args.in[2], ACT, args.in[6], ADA, args.in[9] + 2048, EVEN_IN, GATES, args.in[11], args.in[12]);
    SEAM(PH_E1);
    if (IN(PH_E2)) { SchedProj S{F.vcu, F.G}; EpiProj E{QKV, Zp, POOLp, CKV}; gemm_phase<EpiProj, SchedProj, false>(F.lds, ACT, WIN, D, S, E); }
    SEAM(PH_E2);
    if (IN(PH_E3)) ph_chunk_prep(F, QKV, CKV, GATES, args.in[10], SP);
    SEAM(PH_E3);
#if PROBE_SEL >= 0
    unsigned long long* tsq = (unsigned long long*)((unsigned*)(ws + WS_CTL) + CW_TS);
    const unsigned long long te0_ = __builtin_amdgcn_s_memrealtime();
#endif
    if (IN(PH_E4)) {
        unsigned* prog = (unsigned*)(ws + WS_CTL) + CW_PROG;
        const int xj = F.vcu & 31, xg = F.vcu >> 5;
        if (xj < 8) ph_scan(F, SP, OFp, OBp, prog);
        else prep_late(F, args, (xg * 24 + (xj - 8)) * NWAVES + F.wave, 192 * NWAVES, WOUT, SCIN, SCOUT, WGU, WDN);
    }
#if PROBE_SEL >= 0
    const unsigned long long te1_ = __builtin_amdgcn_s_memrealtime();
    if (F.tid == 0 && blockIdx.x == 0) tsq[8] = te1_ - te0_;
    if (F.tid == 0 && blockIdx.x == 64) tsq[9] = te1_ - te0_;
    if (F.tid == 0 && blockIdx.x == 255) tsq[10] = te1_ - te0_;
#endif
    SEAM(PH_E4);
#if PROBE_SEL >= 0
    if (F.tid == 0 && blockIdx.x == 0) tsq[11] = __builtin_amdgcn_s_memrealtime() - te0_;
#endif
    if (IN(PH_E5)) ph_even_A(F, OFp, OBp, Zp, POOLp, args.in[13], ACT);
    SEAM(PH_E5);
    if (IN(PH_E6)) { SchedDense<4, 256> S{F.vcu, F.G, 128 * 4}; EpiResid<false> E{args.in[0], XLB, ADA + 2 * D}; gemm_phase<EpiResid<false>, SchedDense<4, 256>, false>(F.lds, ACT, WOUT, D, S, E); }
    SEAM(PH_E6);
#define MOE_SEGMENT(l, p0) do { \
        const float* ada_l = ADA + (size_t)(l) * 5 * 6 * D; \
        if (IN(p0)) ph_norm16<0>(F, XLB, nullptr, ACT, args.in[7] + (l) * D, ada_l, args.in[20] + (size_t)(l) * D * NE, NE, AFF, nullptr, nullptr, SEL); \
        SEAM(p0); \
        if (IN((p0) + 1)) ph_topk(F, AFF, IDX, GATE, SEL); \
        SEAM((p0) + 1); \
        if (IN((p0) + 2)) { SchedMoeUp S{F.vcu, (l), IDX}; EpiSiluMul E{HID, DE}; gemm_phase<EpiSiluMul, SchedMoeUp, true>(F.lds, ACT, WGU, D, S, E); } \
        SEAM((p0) + 2); \
        if (IN((p0) + 3)) { SchedMoeDown S{F.vcu, (l)}; EpiRowScale E{Y, D, GATE}; gemm_phase<EpiRowScale, SchedMoeDown, false>(F.lds, HID, WDN, DE, S, E); } \
        SEAM((p0) + 3); \
        if (IN((p0) + 4)) { \
            if ((l) == 0) ph_combine<false>(F, XLB, nullptr, Y, SEL, ada_l, args.in[6] + D, ADA + (size_t)5 * 6 * D, ACT); \
            else ph_combine<true>(F, XLB, args.out, Y, SEL, ada_l, args.in[8], nullptr, nullptr); \
        } \
    } while (0)
    MOE_SEGMENT(0, PH_M1_0);
    SEAM(PH_M5_0);
    if (IN(PH_X1)) { SchedDense<12, 1> S{F.vcu, F.G, 128 * 12}; EpiScIn E{GBp, UUp}; gemm_phase<EpiScIn, SchedDense<12, 1>, false>(F.lds, ACT, SCIN, D, S, E); }
    SEAM(PH_X1);
    if (IN(PH_X2)) ph_sc_glue(F, GBp, UUp, args.in[18], ACT);
    SEAM(PH_X2);
    if (IN(PH_X3)) { SchedDense<4, 256> S{F.vcu, F.G, 128 * 4}; EpiResid<true> E{XLB, XLB, ADA + (size_t)5 * 6 * D + 2 * D}; gemm_phase<EpiResid<true>, SchedDense<4, 256>, false>(F.lds, ACT, SCOUT, D, S, E); }
    SEAM(PH_X3);
    MOE_SEGMENT(1, PH_M1_1);
#undef MOE_SEGMENT
#if PROBE_SEL >= 0
    if (blockIdx.x == 0 && F.tid == 0) { asm volatile("s_waitcnt vmcnt(0)" ::: "memory");
        const unsigned long long v = __hip_atomic_load((unsigned long long*)((unsigned*)(ws + WS_CTL) + CW_TS) + PROBE_SEL, __ATOMIC_RELAXED, __HIP_MEMORY_SCOPE_AGENT);
        const unsigned long long t0 = __builtin_amdgcn_s_memrealtime();
        while (__builtin_amdgcn_s_memrealtime() - t0 < 4ull * v) __builtin_amdgcn_s_sleep(8); }
#endif
#undef IN
#undef SEAM
}
}

}

extern "C" void kernel_launch(void* const* d_in, const int* in_sizes, int n_in, void* d_out, int out_size, void* d_ws, size_t ws_size, hipStream_t st) {
    static int grid = 0;
    if (grid == 0) {
        int dev = 0, cus = 0;
        if (hipGetDevice(&dev) != hipSuccess || hipDeviceGetAttribute(&cus, hipDeviceAttributeMultiprocessorCount, dev) != hipSuccess) { grid = -1; return; }
        if (hipFuncSetAttribute((const void*)mk::mega, hipFuncAttributeMaxDynamicSharedMemorySize, mk::LDS_BYTES) != hipSuccess) { fprintf(stderr, "hipFuncSetAttribute failed\n"); grid = -1; return; }
        if (ws_size < mk::WS_END) { fprintf(stderr, "workspace too small: %zu < %zu\n", ws_size, (size_t)mk::WS_END); grid = -1; return; }
        grid = cus;
    }
    if (grid < 0) return;
    (void)hipMemsetAsync((char*)d_ws + mk::WS_CTL, 0, mk::MiB, st);
    mk::Args a{};
    for (int i = 0; i < 24; ++i) a.in[i] = (const float*)d_in[i];
    a.out = (float*)d_out; a.ws = (unsigned char*)d_ws;
    int n_mega = 0;
    auto mega = [&](int lo, int hi) { a.ph_lo = lo; a.ph_hi = hi; a.li = n_mega++; hipLaunchKernelGGL(mk::mega, dim3(grid), dim3(mk::NTHREADS), mk::LDS_BYTES, st, a); };
    mega(0, mk::PH_COUNT);
}
```

```cpp
#include <hip/hip_runtime.h>
#include <cstdio>
#include <cstdint>

namespace {
constexpr int D = 1024, BATCH = 4, SEQ = 8192, CTX = 256, NH = 4, DK = 128, DV = 128;
constexpr int EVEN_IN = 2576, NE = 16, DE = 512, CAP = 1024;
constexpr float EPS = 1e-6f;

__device__ __forceinline__ float silu_f(float x) { return x / (1.f + __expf(-x)); }
__device__ __forceinline__ float sigmoid_f(float x) { return 1.f / (1.f + __expf(-x)); }
__device__ __forceinline__ float softplus_f(float x) { return x > 20.f ? x : log1pf(__expf(x)); }
__device__ __forceinline__ float wave_sum(float v) {
#pragma unroll
    for (int o = 1; o < 64; o <<= 1) v += __shfl_xor(v, o);
    return v;
}


namespace mk {
#define LAS __attribute__((address_space(3)))
#define GAS __attribute__((address_space(1)))
typedef unsigned short bf16_t;
typedef short bf16x8 __attribute__((ext_vector_type(8)));
typedef float f32x4 __attribute__((ext_vector_type(4)));
typedef float f32x2 __attribute__((ext_vector_type(2)));
typedef unsigned u32x4 __attribute__((ext_vector_type(4)));
typedef unsigned u32x2 __attribute__((ext_vector_type(2)));
constexpr int M_LAT = BATCH * SEQ;
constexpr int BM = 256, BK = 64, HALF = 128, HTB = HALF * BK * 2, STAGE_BYTES = 8 * HTB;
constexpr int LDS_BYTES = 163840, GTAB_OFF = 131072  , MISC_OFF = LDS_BYTES - 256;
constexpr int NTHREADS = 512, NWAVES = 8;

__device__ __forceinline__ unsigned f2bf(float f) { unsigned u = __builtin_bit_cast(unsigned, f); return (u + 0x7fffu + ((u >> 16) & 1u)) >> 16; }
__device__ __forceinline__ unsigned pk2(float lo, float hi) { return f2bf(lo) | (f2bf(hi) << 16); }
typedef __bf16 bf16x2_t __attribute__((ext_vector_type(2)));
__device__ __forceinline__ unsigned cvt_pk_bf16(float lo, float hi) { const f32x2 v = {lo, hi}; const bf16x2_t b2 = __builtin_convertvector(v, bf16x2_t); return __builtin_bit_cast(unsigned, b2); }
__device__ __forceinline__ float bf_lo(unsigned w) { return __uint_as_float(w << 16); }
__device__ __forceinline__ float bf_hi(unsigned w) { return __uint_as_float(w & 0xffff0000u); }

__device__ __forceinline__ void lds_barrier() { asm volatile("s_waitcnt lgkmcnt(0)" ::: "memory"); __builtin_amdgcn_s_barrier(); asm volatile("" ::: "memory"); }

#define XB_TMO      128
#define XB_XCNT(j)  (256  + 64 * (j))
#define XB_XSUB(j)  (1280 + 64 * (j))
#define XB_XGEN(j)  (2304 + 64 * (j))
#define XB_TOP      3328
#define XB_TOPGEN   3392
#define XCD_BAR_WORDS 3456
#define XB_SPIN_CAP (1u << 18)
__device__ __forceinline__ unsigned xb_ld(unsigned* p)              { return __hip_atomic_load(p, __ATOMIC_RELAXED, __HIP_MEMORY_SCOPE_AGENT); }
__device__ __forceinline__ unsigned xb_add(unsigned* p, unsigned v) { return __hip_atomic_fetch_add(p, v, __ATOMIC_RELAXED, __HIP_MEMORY_SCOPE_AGENT); }
__device__ __forceinline__ unsigned xb_xcc_id() { return (unsigned)__builtin_amdgcn_s_getreg((3 << 11) | 20) & 0xFu; }
#define XB_SPIN(cond, bar) do { unsigned _sp = 0; while (cond) { __builtin_amdgcn_s_sleep(1); \
    if ((++_sp & 255u) == 0u) { if (xb_ld(&(bar)[XB_TMO])) break; if (_sp > XB_SPIN_CAP) { atomicAdd(&(bar)[XB_TMO], 1u); break; } } } } while (0)
struct XcdBarrier { unsigned* bar; unsigned x; volatile LAS unsigned* st; };
__device__ __forceinline__ XcdBarrier xcd_barrier_post(unsigned* bar, volatile LAS unsigned* st) {
    XcdBarrier b; b.bar = bar; b.x = xb_xcc_id(); b.st = st;
    if (threadIdx.x == 0) (void)xb_add(&bar[XB_XCNT(b.x)], 1u);
    return b;
}
__device__ __forceinline__ void xcd_barrier_complete(unsigned* bar, unsigned x, unsigned& nloc, unsigned& nx) {
    const unsigned G = gridDim.x * gridDim.y * gridDim.z;
    unsigned sum, cnt, mine, sp = 0u;
    for (;;) {
        sum = 0u; cnt = 0u; mine = 0u;
#pragma unroll
        for (unsigned j = 0; j < 16; ++j) { const unsigned c = xb_ld(&bar[XB_XCNT(j)]); sum += c; cnt += (c > 0u) ? 1u : 0u; mine = (j == x) ? c : mine; }
        if (sum == G) break;
        __builtin_amdgcn_s_sleep(1);
        if ((++sp & 255u) == 0u) { if (xb_ld(&bar[XB_TMO])) break; if (sp > XB_SPIN_CAP) { atomicAdd(&bar[XB_TMO], 1u); break; } }
    }
    nloc = mine > 0u ? mine : 1u; nx = cnt > 0u ? cnt : 1u;
}
__device__ __forceinline__ void xcd_barrier(const XcdBarrier& b) {
    asm volatile("s_waitcnt vmcnt(0)" ::: "memory");
    __syncthreads();
    if (threadIdx.x == 0) {
        unsigned* bar = b.bar;
        __builtin_amdgcn_s_waitcnt(0);
        unsigned nloc = b.st[0], nx = b.st[1];
        if (nloc == 0u) { xcd_barrier_complete(bar, b.x, nloc, nx); b.st[0] = nloc; b.st[1] = nx; }
        const unsigned old = xb_add(&bar[XB_XSUB(b.x)], 1u);
        const unsigned gen = old / nloc;
        if (old + 1u == (gen + 1u) * nloc) {
            __builtin_amdgcn_fence(__ATOMIC_RELEASE, "agent");
            asm volatile("s_waitcnt vmcnt(0)" ::: "memory");
            const unsigned og = xb_add(&bar[XB_TOP], 1u);
            const unsigned tg = og / nx;
            if (og + 1u == (tg + 1u) * nx) xb_add(&bar[XB_TOPGEN], 1u);
            else XB_SPIN(xb_ld(&bar[XB_TOPGEN]) == tg, bar);
            __builtin_amdgcn_fence(__ATOMIC_ACQUIRE, "agent");
            xb_add(&bar[XB_XGEN(b.x)], 1u);
            asm volatile("s_waitcnt vmcnt(0)" ::: "memory");
        } else {
            XB_SPIN(xb_ld(&bar[XB_XGEN(b.x)]) == gen, bar);
            __builtin_amdgcn_fence(__ATOMIC_ACQUIRE, "agent");
            asm volatile("s_waitcnt vmcnt(0)" ::: "memory");
        }
    }
    __syncthreads();
}

__host__ __device__ __forceinline__ int lds_byte(int r, int c) { const int st = (r >> 4) * 2 + (c >> 5), rr = r & 15, cc = c & 31, ob = rr * 64 + cc * 2; return st * 1024 + (ob ^ (((ob >> 9) & 1) << 5)); }
__host__ __device__ __forceinline__ void stage_rc(int b, int& R, int& C) { const int st = b / 1024, sb = b % 1024, swz = sb ^ (((sb >> 9) & 1) << 5); R = (st >> 1) * 16 + swz / 64; C = (st & 1) * 32 + (swz % 64) / 2; }
__host__ __device__ __forceinline__ int perm32(int rho) { const int n = rho >> 4, i = rho & 15; return 8 * (i >> 2) + 4 * n + (i & 3); }

struct Unit { int arow, brow, orow, ocol; };

template <class Epi, class Sched, bool GATHER>
__device__ __forceinline__ void gemm_phase(LAS unsigned char* lds, const bf16_t* Abase, const bf16_t* Btbase, const int K, const Sched& S, const Epi& E) {
    const int tid = threadIdx.x, wid = __builtin_amdgcn_readfirstlane(tid >> 6), lane = tid & 63, wr = wid >> 2, wc = wid & 3, fr = lane & 15, fq = lane >> 4;
    const int nt = K / BK;
    unsigned voffA[2], voffB[2];
#pragma unroll
    for (int i = 0; i < 2; ++i) { int R, C; stage_rc(tid * 16 + i * 8192, R, C); const int Rb = Epi::PERM ? ((R & ~31) + perm32(R & 31)) : R;
        voffA[i] = (unsigned)(R * K + C) * 2u; voffB[i] = (unsigned)(Rb * K + C) * 2u; }
    const size_t kstep = (size_t)(BK * 2);
    const size_t hstep = (size_t)HALF * K * 2;
    const unsigned ldsw = (unsigned)wid * 1024u;
    const int aoff = lds_byte(wr * 64 + fr, fq * 8), boff = lds_byte(wc * 32 + fr, fq * 8);
    LAS const int* gtab = (LAS const int*)(lds + GTAB_OFF);
    unsigned goff[2][2];
#define PG8_SA(b, h) (((b) * 2 + (h)) * HTB)
#define PG8_SB(b, h) ((4 + (b) * 2 + (h)) * HTB)
#define PG8_STAGE(bufoff, gbase, voff) do { _Pragma("unroll") for (int _i = 0; _i < 2; ++_i) \
        __builtin_amdgcn_global_load_lds((const unsigned*)((const char*)(gbase) + (voff)[_i]), (LAS unsigned*)(lds + (bufoff) + ldsw + _i * 8192), 16, 0, 0); } while (0)
#define PG8_STAGE_A(bufoff, abase, h) do { if constexpr (GATHER) { PG8_STAGE(bufoff, abase, goff[h]); } else { PG8_STAGE(bufoff, (abase) + (h) * hstep, voffA); } } while (0)
#define PG8_LDA(dst, b, h) do { _Pragma("unroll") for (int m = 0; m < 4; ++m) _Pragma("unroll") for (int k = 0; k < 2; ++k) dst[m][k] = *(const LAS bf16x8*)(lds + PG8_SA(b, h) + aoff + m * 2048 + k * 1024); } while (0)
#define PG8_LDB(dst, b, h) do { _Pragma("unroll") for (int n = 0; n < 2; ++n) _Pragma("unroll") for (int k = 0; k < 2; ++k) dst[n][k] = *(const LAS bf16x8*)(lds + PG8_SB(b, h) + boff + n * 2048 + k * 1024); } while (0)
#define PG8_MMA(ai, bj, At, Bt) do { __builtin_amdgcn_s_setprio(1); _Pragma("unroll") for (int m = 0; m < 4; ++m) _Pragma("unroll") for (int n = 0; n < 2; ++n) _Pragma("unroll") for (int k = 0; k < 2; ++k) \
        acc[ai][bj][m][n] = __builtin_amdgcn_mfma_f32_16x16x32_bf16(Bt[n][k], At[m][k], acc[ai][bj][m][n], 0, 0, 0); __builtin_amdgcn_s_setprio(0); } while (0)
#define PG8_WAIT_V(n) asm volatile("s_waitcnt vmcnt(" #n ")" ::: "memory")
#define PG8_WAIT_L(n) asm volatile("s_waitcnt lgkmcnt(" #n ")" ::: "memory")
#define PG8_BAR __builtin_amdgcn_s_barrier()
#define PG8_SCHED __builtin_amdgcn_sched_barrier(0)
#define PG8_GLOAD(ui_) do { if constexpr (GATHER) { _Pragma("unroll") for (int _i = 0; _i < 2; ++_i) { int _R, _C; stage_rc(tid * 16 + _i * 8192, _R, _C); _Pragma("unroll") for (int _h = 0; _h < 2; ++_h) \
        goff[_h][_i] = (unsigned)(gtab[((ui_) & 3) * 256 + _h * HALF + _R] * K * 2 + _C * 2); } } } while (0)
    Unit cur, nxt; int ui = 0;
    if (!S.next(0, cur)) return;
    if constexpr (GATHER) {
        Unit t;
        for (int j = 0; j < 4; ++j) if (S.next(j, t)) { if (tid < 256) ((LAS int*)(lds + GTAB_OFF))[j * 256 + tid] = S.gidx(t, tid); }
        __syncthreads();
    }
    f32x4 acc[2][2][4][2];
#pragma unroll
    for (int a = 0; a < 2; ++a)
#pragma unroll
        for (int b = 0; b < 2; ++b)
#pragma unroll
            for (int m = 0; m < 4; ++m)
#pragma unroll
                for (int n = 0; n < 2; ++n) acc[a][b][m][n] = (f32x4){0.f, 0.f, 0.f, 0.f};
    bf16x8 At[4][2], B0[2][2], B1[2][2];
    const char* cA = (const char*)Abase + (size_t)cur.arow * K * 2; const char* cB = (const char*)Btbase + (size_t)cur.brow * K * 2;
    PG8_GLOAD(0);
    PG8_STAGE(PG8_SB(0, 0), cB, voffB); PG8_STAGE(PG8_SB(0, 1), cB + hstep, voffB); PG8_STAGE_A(PG8_SA(0, 0), cA, 0); PG8_STAGE_A(PG8_SA(0, 1), cA, 1);
    if (wr == 1) PG8_BAR;
    PG8_WAIT_V(2); PG8_BAR;
    PG8_STAGE(PG8_SB(1, 0), cB + kstep, voffB); PG8_STAGE_A(PG8_SA(1, 0), cA + kstep, 0); PG8_STAGE(PG8_SB(1, 1), cB + hstep + kstep, voffB);
    PG8_WAIT_V(6); PG8_BAR;
    for (;;) {
        const bool has_next = S.next(ui + 1, nxt);
        const char* nA = has_next ? (const char*)Abase + (size_t)nxt.arow * K * 2 : cA; const char* nB = has_next ? (const char*)Btbase + (size_t)nxt.brow * K * 2 : cB;
        for (int t = 0; t < nt; t += 2) {
            const bool last = (t == nt - 2);
            const char* a1 = cA + (size_t)(t + 1) * kstep;
            const char* a2 = last ? nA : cA + (size_t)(t + 2) * kstep; const char* b2 = last ? nB : cB + (size_t)(t + 2) * kstep;
            const char* a3 = a2 + kstep; const char* b3 = b2 + kstep;
            PG8_LDB(B0, 0, 0); PG8_LDB(B1, 0, 1); PG8_SCHED; PG8_LDA(At, 0, 0); PG8_STAGE_A(PG8_SA(1, 1), a1, 1);
            if constexpr (GATHER) { if (last && has_next) PG8_GLOAD(ui + 1); }
            PG8_WAIT_V(8); PG8_WAIT_L(0); PG8_BAR; PG8_MMA(0, 0, At, B0); PG8_MMA(0, 1, At, B1); PG8_BAR; PG8_SCHED;
            PG8_LDA(At, 0, 1); PG8_STAGE(PG8_SB(0, 0), b2, voffB); PG8_STAGE(PG8_SB(0, 1), b2 + hstep, voffB); PG8_STAGE_A(PG8_SA(0, 0), a2, 0);
            PG8_WAIT_V(8); PG8_WAIT_L(0); PG8_BAR; PG8_MMA(1, 0, At, B0); PG8_MMA(1, 1, At, B1); PG8_BAR; PG8_SCHED;
            PG8_LDB(B0, 1, 0); PG8_LDB(B1, 1, 1); PG8_SCHED; PG8_LDA(At, 1, 0); PG8_STAGE_A(PG8_SA(0, 1), a2, 1);
            PG8_WAIT_V(8); PG8_WAIT_L(0); PG8_BAR; PG8_MMA(0, 0, At, B0); PG8_MMA(0, 1, At, B1); PG8_BAR; PG8_SCHED;
            PG8_LDA(At, 1, 1); PG8_STAGE(PG8_SB(1, 0), b3, voffB); PG8_STAGE(PG8_SB(1, 1), b3 + hstep, voffB); PG8_STAGE_A(PG8_SA(1, 0), a3, 0);
            PG8_WAIT_V(8); PG8_WAIT_L(0); PG8_BAR; PG8_MMA(1, 0, At, B0); PG8_MMA(1, 1, At, B1); PG8_BAR; PG8_SCHED;
        }
        if (wr == 0) PG8_BAR;
        E(acc, cur, wr, wc, fr, fq);
        if (!has_next) break;
#pragma unroll
        for (int a = 0; a < 2; ++a)
#pragma unroll
            for (int b = 0; b < 2; ++b)
#pragma unroll
                for (int m = 0; m < 4; ++m)
#pragma unroll
                    for (int n = 0; n < 2; ++n) acc[a][b][m][n] = (f32x4){0.f, 0.f, 0.f, 0.f};
        cur = nxt; cA = nA; cB = nB; ++ui;
        if (wr == 1) PG8_BAR;
    }
    PG8_WAIT_V(0);
    PG8_BAR;
#undef PG8_SA
#undef PG8_SB
#undef PG8_STAGE
#undef PG8_STAGE_A
#undef PG8_LDA
#undef PG8_LDB
#undef PG8_MMA
#undef PG8_WAIT_V
#undef PG8_WAIT_L
#undef PG8_BAR
#undef PG8_SCHED
#undef PG8_GLOAD
}

__device__ __forceinline__ float silu1(float x) { return x * __builtin_amdgcn_rcpf(1.f + __expf(-x)); }
struct EpiSiluMul {
    static constexpr bool PERM = true;
    bf16_t* O; int ldo;
    __device__ __forceinline__ void operator()(const f32x4 (&acc)[2][2][4][2], const Unit& u, int wr, int wc, int fr, int fq) const {
        const int row0 = u.orow + wr * 64 + fr, col0 = u.ocol + wc * 32 + 8 * fq;
#pragma unroll
        for (int ai = 0; ai < 2; ++ai)
#pragma unroll
            for (int m = 0; m < 4; ++m) { bf16_t* rowp = O + (size_t)(row0 + ai * HALF + m * 16) * ldo + col0;
                const f32x4 g0 = acc[ai][0][m][0], g1 = acc[ai][0][m][1], u0 = acc[ai][1][m][0], u1 = acc[ai][1][m][1];
                u32x4 w; w.x = cvt_pk_bf16(silu1(g0[0]) * u0[0], silu1(g0[1]) * u0[1]); w.y = cvt_pk_bf16(silu1(g0[2]) * u0[2], silu1(g0[3]) * u0[3]);
                w.z = cvt_pk_bf16(silu1(g1[0]) * u1[0], silu1(g1[1]) * u1[1]); w.w = cvt_pk_bf16(silu1(g1[2]) * u1[2], silu1(g1[3]) * u1[3]);
                *(u32x4*)rowp = w; }
    }
};
struct EpiRowScale {
    static constexpr bool PERM = true;
    bf16_t* O; int ldo; const float* rowscale;
    __device__ __forceinline__ void operator()(const f32x4 (&acc)[2][2][4][2], const Unit& u, int wr, int wc, int fr, int fq) const {
        const int row0 = u.orow + wr * 64 + fr, col0 = u.ocol + wc * 32 + 8 * fq;
#pragma unroll
        for (int ai = 0; ai < 2; ++ai)
#pragma unroll
            for (int m = 0; m < 4; ++m) { const int row = row0 + ai * HALF + m * 16; const float sc = rowscale[row]; bf16_t* rowp = O + (size_t)row * ldo + col0;
#pragma unroll
                for (int bj = 0; bj < 2; ++bj) { const f32x4 v0 = acc[ai][bj][m][0] * sc, v1 = acc[ai][bj][m][1] * sc;
                    u32x4 w; w.x = cvt_pk_bf16(v0[0], v0[1]); w.y = cvt_pk_bf16(v0[2], v0[3]); w.z = cvt_pk_bf16(v1[0], v1[1]); w.w = cvt_pk_bf16(v1[2], v1[3]);
                    *(u32x4*)(rowp + bj * HALF) = w; } }
    }
};


struct EpiScIn {
    static constexpr bool PERM = true;
    bf16_t* GB; bf16_t* UU;
    __device__ __forceinline__ void operator()(const f32x4 (&acc)[2][2][4][2], const Unit& u, int wr, int wc, int fr, int fq) const {
        const int row0 = u.orow + wr * 64 + fr;
        if (u.ocol < 4) {
            const int col0 = u.ocol * 256 + wc * 32 + 8 * fq;
#pragma unroll
            for (int ai = 0; ai < 2; ++ai)
#pragma unroll
                for (int m = 0; m < 4; ++m) { bf16_t* rowp = GB + (size_t)(row0 + ai * HALF + m * 16) * D + col0;
#pragma unroll
                    for (int bj = 0; bj < 2; ++bj) { const f32x4 v0 = acc[ai][bj][m][0], v1 = acc[ai][bj][m][1];
                        u32x4 w; w.x = cvt_pk_bf16(v0[0], v0[1]); w.y = cvt_pk_bf16(v0[2], v0[3]); w.z = cvt_pk_bf16(v1[0], v1[1]); w.w = cvt_pk_bf16(v1[2], v1[3]);
                        *(u32x4*)(rowp + bj * HALF) = w; } }
        } else {
            const int col0 = (u.ocol - 4) * 128 + wc * 32 + 8 * fq;
#pragma unroll
            for (int ai = 0; ai < 2; ++ai)
#pragma unroll
                for (int m = 0; m < 4; ++m) { bf16_t* rowp = UU + (size_t)(row0 + ai * HALF + m * 16) * D + col0;
                    const f32x4 v0 = acc[ai][0][m][0] * acc[ai][1][m][0], v1 = acc[ai][0][m][1] * acc[ai][1][m][1];
                    u32x4 w; w.x = cvt_pk_bf16(v0[0], v0[1]); w.y = cvt_pk_bf16(v0[2], v0[3]); w.z = cvt_pk_bf16(v1[0], v1[1]); w.w = cvt_pk_bf16(v1[2], v1[3]);
                    *(u32x4*)rowp = w; }
        }
    }
};
template <bool BASE_BF16>
struct EpiResid {
    static constexpr bool PERM = true;
    const void* base; bf16_t* out; const float* gada;
    __device__ __forceinline__ void operator()(const f32x4 (&acc)[2][2][4][2], const Unit& u, int wr, int wc, int fr, int fq) const {
        const int row0 = u.orow + wr * 64 + fr, col0 = u.ocol + wc * 32 + 8 * fq;
        const float* g = gada + (size_t)(u.orow >> 13) * 6 * D + col0;
        f32x4 gv[2][2];
#pragma unroll
        for (int bj = 0; bj < 2; ++bj)
#pragma unroll
            for (int n = 0; n < 2; ++n) gv[bj][n] = *(const f32x4*)(g + bj * HALF + n * 4);
#pragma unroll
        for (int ai = 0; ai < 2; ++ai)
#pragma unroll
            for (int m = 0; m < 4; ++m) { const size_t off = (size_t)(row0 + ai * HALF + m * 16) * D + col0;
#pragma unroll
                for (int bj = 0; bj < 2; ++bj) {
                    f32x4 b0, b1;
                    if constexpr (BASE_BF16) { const u32x4 bw = *(const u32x4*)((const bf16_t*)base + off + bj * HALF);
                        b0 = (f32x4){bf_lo(bw.x), bf_hi(bw.x), bf_lo(bw.y), bf_hi(bw.y)}; b1 = (f32x4){bf_lo(bw.z), bf_hi(bw.z), bf_lo(bw.w), bf_hi(bw.w)}; }
                    else { b0 = *(const f32x4*)((const float*)base + off + bj * HALF); b1 = *(const f32x4*)((const float*)base + off + bj * HALF + 4); }
                    const f32x4 v0 = b0 + gv[bj][0] * acc[ai][bj][m][0], v1 = b1 + gv[bj][1] * acc[ai][bj][m][1];
                    u32x4 w; w.x = cvt_pk_bf16(v0[0], v0[1]); w.y = cvt_pk_bf16(v0[2], v0[3]); w.z = cvt_pk_bf16(v1[0], v1[1]); w.w = cvt_pk_bf16(v1[2], v1[3]);
                    *(u32x4*)(out + off + bj * HALF) = w; } }
    }
};

struct EpiProj {
    static constexpr bool PERM = true;
    bf16_t* QKV; bf16_t* Z; bf16_t* POOL; bf16_t* CKV;
    __device__ __forceinline__ void operator()(const f32x4 (&acc)[2][2][4][2], const Unit& u, int wr, int wc, int fr, int fq) const {
        bf16_t* base; int ld;
        if (u.ocol < 6) { base = QKV + (size_t)u.orow * 1536 + u.ocol * 256; ld = 1536; }
        else if (u.ocol < 8) { base = Z + (size_t)u.orow * 512 + (u.ocol - 6) * 256; ld = 512; }
        else if (u.ocol < 10) { base = POOL + (size_t)u.orow * 512 + (u.ocol - 8) * 256; ld = 512; }
        else { base = CKV + (size_t)(u.orow - M_LAT) * 1024 + (u.ocol - 16) * 256; ld = 1024; }
        base += (size_t)(wr * 64 + fr) * ld + wc * 32 + 8 * fq;
#pragma unroll
        for (int ai = 0; ai < 2; ++ai)
#pragma unroll
            for (int m = 0; m < 4; ++m) { bf16_t* rowp = base + (size_t)(ai * HALF + m * 16) * ld;
#pragma unroll
                for (int bj = 0; bj < 2; ++bj) { const f32x4 v0 = acc[ai][bj][m][0], v1 = acc[ai][bj][m][1];
                    u32x4 w; w.x = cvt_pk_bf16(v0[0], v0[1]); w.y = cvt_pk_bf16(v0[2], v0[3]); w.z = cvt_pk_bf16(v1[0], v1[1]); w.w = cvt_pk_bf16(v1[2], v1[3]);
                    *(u32x4*)(rowp + bj * HALF) = w; } }
    }
};
struct SchedProj {
    int vcu, G;
    __device__ __forceinline__ bool next(int i, Unit& u) const {
        const int L = i * G + vcu; if (L >= 1296) return false;
        if (L < 1280) { const int pm = L / 10, pn = L % 10; u.arow = pm * 256; u.brow = pn * 256; u.orow = pm * 256; u.ocol = pn; }
        else { const int q = L - 1280, pm = q >> 2, pn = q & 3; u.arow = M_LAT + pm * 256; u.brow = 512 + pn * 256; u.orow = M_LAT + pm * 256; u.ocol = 16 + pn; }
        return true;
    }
    __device__ __forceinline__ int gidx(const Unit&, int) const { return 0; }
};

template <int NT, int COLMUL>
struct SchedDense {
    int vcu, G, nunits;
    __device__ __forceinline__ bool next(int i, Unit& u) const {
        const int L = i * G + vcu; if (L >= nunits) return false;
        const int pm = L / NT, pn = L % NT;
        u.arow = pm * 256; u.brow = pn * 256; u.orow = pm * 256; u.ocol = pn * COLMUL;
        return true;
    }
    __device__ __forceinline__ int gidx(const Unit&, int) const { return 0; }
};

constexpr size_t MiB = 1u << 20;
constexpr size_t WS_CTL = 0;
constexpr size_t WS_ADA = 1 * MiB;
constexpr size_t WS_AFF = 2 * MiB;
constexpr size_t WS_IDX = 4 * MiB;
constexpr size_t WS_GATE = 4 * MiB + 512 * 1024;
constexpr size_t WS_SEL = 5 * MiB;
constexpr size_t WS_GATES = 7 * MiB;
constexpr size_t WS_WGU = 16 * MiB;
constexpr size_t WS_WDN = 80 * MiB;
constexpr size_t WS_SCIN = 112 * MiB;
constexpr size_t WS_SCOUT = 118 * MiB;
constexpr size_t WS_WIN = 120 * MiB;
constexpr size_t WS_WOUT = 125 * MiB;
constexpr size_t WS_TMP = 128 * MiB;
constexpr size_t WS_ACT = WS_TMP;
constexpr size_t WS_QKV = 194 * MiB;
constexpr size_t WS_Z = 290 * MiB;
constexpr size_t WS_POOL = 322 * MiB;
constexpr size_t WS_CKV = 354 * MiB;
constexpr size_t WS_QN = 356 * MiB;
constexpr size_t WS_KT = 389 * MiB;
constexpr size_t WS_NWK = 422 * MiB;
constexpr size_t WS_SCL = 488 * MiB;
constexpr size_t WS_XLB = WS_NWK;
constexpr size_t WS_OF = WS_QKV;
constexpr size_t WS_OB = WS_QKV + 32 * MiB;
constexpr size_t WS_HID = 194 * MiB;
constexpr size_t WS_Y = 258 * MiB;
constexpr size_t WS_GB = WS_HID;
constexpr size_t WS_UU = WS_Y;
constexpr size_t WS_END = 512 * MiB;
constexpr int CW_BAR = 4096;
#ifndef PROBE_SEL
#define PROBE_SEL -1
#endif
#ifndef PROBE_WAVE
#define PROBE_WAVE 0
#endif
constexpr int CW_TS = 32768;
constexpr int CW_PROG = 16384;

struct Args {
    const float* in[24]; float* out; unsigned char* ws; int ph_lo, ph_hi, li, pad;
};

struct Frame {
    LAS unsigned char* lds; int tid, lane, wave, G, vcu;
};

__device__ __forceinline__ void transpose_item(const float* W, int K, int ldn, int n0, int k0, bf16_t* WT, int drow0, LAS float* scr, int lane, int dcol0 = 0) {
    float tv[32];
#pragma unroll
    for (int i = 0; i < 32; ++i) tv[i] = __builtin_nontemporal_load(W + (size_t)(k0 + 2 * i + (lane >> 5)) * ldn + n0 + (lane & 31));
#pragma unroll
    for (int i = 0; i < 32; ++i) scr[(2 * i + (lane >> 5)) * 33 + (lane & 31)] = tv[i];
    asm volatile("s_waitcnt lgkmcnt(0)" ::: "memory");
    const int c = lane & 7;
#pragma unroll
    for (int j = 0; j < 4; ++j) { const int n = (lane >> 3) + 8 * j; const LAS float* s = scr + (8 * c) * 33 + n;
        u32x4 o; o.x = pk2(s[0 * 33], s[1 * 33]); o.y = pk2(s[2 * 33], s[3 * 33]); o.z = pk2(s[4 * 33], s[5 * 33]); o.w = pk2(s[6 * 33], s[7 * 33]);
        __builtin_nontemporal_store(o, (u32x4*)(WT + (size_t)(drow0 + n) * K + dcol0 + k0 + 8 * c)); }
    asm volatile("s_waitcnt lgkmcnt(0)" ::: "memory");
}

struct SchedMoeUp {
    int vcu, layer; const int* idx;
    __device__ __forceinline__ bool next(int i, Unit& u) const {
        const int L = i * 256 + vcu; if (L >= 1024) return false;
        const int g = L >> 4, pm = (L >> 2) & 3, pn = L & 3, b = g >> 4, e = g & 15;
        u.arow = b * SEQ; u.brow = ((layer * NE + e) * 4 + pn) * 256; u.orow = g * CAP + pm * 256; u.ocol = pn * 128;
        return true;
    }
    __device__ __forceinline__ int gidx(const Unit& u, int r) const { return idx[u.orow + r]; }
};
struct SchedMoeDown {
    int vcu, layer;
    __device__ __forceinline__ bool next(int i, Unit& u) const {
        const int L = i * 256 + vcu; if (L >= 1024) return false;
        const int g = L >> 4, pm = (L >> 2) & 3, pn = L & 3, e = g & 15;
        u.arow = g * CAP + pm * 256; u.brow = ((layer * NE + e) * 4 + pn) * 256; u.orow = g * CAP + pm * 256; u.ocol = pn * 256;
        return true;
    }
    __device__ __forceinline__ int gidx(const Unit&, int) const { return 0; }
};

__device__ __forceinline__ float wsum(float v) {
#pragma unroll
    for (int o = 1; o < 64; o <<= 1) v += __shfl_xor(v, o);
    return v;
}

template <int MODE>
__device__ __forceinline__ void ph_norm16(const Frame& F, const void* xlv, const float* xctx, bf16_t* act, const float* gw, const float* ada  , const float* w16, int ldw,
                                          float* out16, const float* a_log, const float* dt_bias, int* selfill = nullptr) {
    constexpr int WLD = 1032;
    LAS bf16_t* wt = (LAS bf16_t*)F.lds;
    LAS float* mod = (LAS float*)(F.lds + 16 * WLD * 2);
    if (selfill) { u32x4* p = (u32x4*)selfill; const u32x4 m1 = (u32x4){~0u, ~0u, ~0u, ~0u};
        for (int i = F.vcu * NTHREADS + F.tid; i < M_LAT * NE / 4; i += F.G * NTHREADS) p[i] = m1; }
    { float wv[32];
#pragma unroll
        for (int q = 0; q < 32; ++q) { const int i = F.tid + NTHREADS * q; wv[q] = w16[(size_t)(i >> 4) * ldw + (i & 15)]; }
#pragma unroll
        for (int q = 0; q < 32; ++q) { const int i = F.tid + NTHREADS * q; wt[(i & 15) * WLD + (i >> 4)] = (bf16_t)f2bf(wv[q]); } }
#pragma unroll
    for (int i = F.tid; i < 5 * D; i += NTHREADS) { const int b = i >> 10, c = i & (D - 1);
        const float* sh = ada + (size_t)b * 6 * D + (MODE == 0 ? 3 * D : 0);
        mod[(b * 2) * D + c] = gw[c] * (sh[D + c] + 1.f); mod[(b * 2 + 1) * D + c] = sh[c]; }
    __syncthreads();
    const int gw_ = F.vcu * NWAVES + F.wave, NGW = F.G * NWAVES, lane = F.lane, rr = lane & 15, kq = lane >> 4;
    const int ntiles = (MODE == 0 ? M_LAT : M_LAT + BATCH * CTX) / 16;
    for (int tw = gw_; tw < ntiles; tw += NGW) {
        const int r0 = tw * 16, row = r0 + rr;
        const bool lat = r0 < M_LAT;
        const int b = lat ? (r0 >> 13) : 4;
        const char* src; size_t rowbytes;
        if constexpr (MODE == 0) { src = (const char*)xlv + (size_t)row * D * 2 + kq * 16; rowbytes = 0; }
        else { src = (const char*)(lat ? (const float*)xlv + (size_t)row * D : xctx + (size_t)(row - M_LAT) * D) + kq * 32; rowbytes = 0; }
        (void)rowbytes;
        float ss = 0.f;
#pragma unroll 1
        for (int s0 = 0; s0 < 32; s0 += 8) {
            if constexpr (MODE == 0) { u32x4 xv[8];
#pragma unroll
                for (int s = 0; s < 8; ++s) xv[s] = *(const u32x4*)(src + (s0 + s) * 64);
#pragma unroll
                for (int s = 0; s < 8; ++s)
#pragma unroll
                    for (int q = 0; q < 4; ++q) { const float a = bf_lo(xv[s][q]), c2 = bf_hi(xv[s][q]); ss += a * a + c2 * c2; } }
            else { f32x4 xv[8][2];
#pragma unroll
                for (int s = 0; s < 8; ++s) { xv[s][0] = *(const f32x4*)(src + (s0 + s) * 128); xv[s][1] = *(const f32x4*)(src + (s0 + s) * 128 + 16); }
#pragma unroll
                for (int s = 0; s < 8; ++s) ss += (xv[s][0].x * xv[s][0].x + xv[s][0].y * xv[s][0].y) + (xv[s][0].z * xv[s][0].z + xv[s][0].w * xv[s][0].w)
                                                + (xv[s][1].x * xv[s][1].x + xv[s][1].y * xv[s][1].y) + (xv[s][1].z * xv[s][1].z + xv[s][1].w * xv[s][1].w); }
        }
        ss += __shfl_xor(ss, 16); ss += __shfl_xor(ss, 32);
        const float rs = rsqrtf(ss * (1.f / D) + EPS);
        f32x4 acc = (f32x4){0.f, 0.f, 0.f, 0.f};
        const LAS float* mAp = mod + (b * 2) * D + kq * 8; const LAS float* mBp = mAp + D;
        const LAS bf16_t* wp = wt + rr * WLD + kq * 8;
        bf16_t* dst = act + (size_t)row * D + kq * 8;
#pragma unroll 1
        for (int s0 = 0; s0 < 32; s0 += 4) {
            float xf[4][8];
            if constexpr (MODE == 0) {
#pragma unroll
                for (int s = 0; s < 4; ++s) { const u32x4 w = *(const u32x4*)(src + (s0 + s) * 64);
#pragma unroll
                    for (int q = 0; q < 4; ++q) { xf[s][2 * q] = bf_lo(w[q]); xf[s][2 * q + 1] = bf_hi(w[q]); } }
            } else {
#pragma unroll
                for (int s = 0; s < 4; ++s) { const f32x4 a = *(const f32x4*)(src + (s0 + s) * 128), c2 = *(const f32x4*)(src + (s0 + s) * 128 + 16);
                    xf[s][0] = a.x; xf[s][1] = a.y; xf[s][2] = a.z; xf[s][3] = a.w; xf[s][4] = c2.x; xf[s][5] = c2.y; xf[s][6] = c2.z; xf[s][7] = c2.w; }
            }
#pragma unroll
            for (int s = 0; s < 4; ++s) {
                const f32x4 a0 = *(const LAS f32x4*)(mAp + (s0 + s) * 32), a1 = *(const LAS f32x4*)(mAp + (s0 + s) * 32 + 4);
                const f32x4 b0 = *(const LAS f32x4*)(mBp + (s0 + s) * 32), b1 = *(const LAS f32x4*)(mBp + (s0 + s) * 32 + 4);
                const float h0 = xf[s][0] * rs * a0.x + b0.x, h1 = xf[s][1] * rs * a0.y + b0.y, h2 = xf[s][2] * rs * a0.z + b0.z, h3 = xf[s][3] * rs * a0.w + b0.w;
                const float h4 = xf[s][4] * rs * a1.x + b1.x, h5 = xf[s][5] * rs * a1.y + b1.y, h6 = xf[s][6] * rs * a1.z + b1.z, h7 = xf[s][7] * rs * a1.w + b1.w;
                u32x4 hw; hw.x = cvt_pk_bf16(h0, h1); hw.y = cvt_pk_bf16(h2, h3); hw.z = cvt_pk_bf16(h4, h5); hw.w = cvt_pk_bf16(h6, h7);
                *(u32x4*)(dst + (s0 + s) * 32) = hw;
                const bf16x8 bfrag = *(const LAS bf16x8*)(wp + (s0 + s) * 32);
                acc = __builtin_amdgcn_mfma_f32_16x16x32_bf16(__builtin_bit_cast(bf16x8, hw), bfrag, acc, 0, 0, 0);
            }
        }
        if constexpr (MODE == 0) {
            f32x4 mx = acc;
#pragma unroll
            for (int o = 1; o < 16; o <<= 1) { mx.x = fmaxf(mx.x, __shfl_xor(mx.x, o)); mx.y = fmaxf(mx.y, __shfl_xor(mx.y, o)); mx.z = fmaxf(mx.z, __shfl_xor(mx.z, o)); mx.w = fmaxf(mx.w, __shfl_xor(mx.w, o)); }
            f32x4 ex; ex.x = __expf(acc.x - mx.x); ex.y = __expf(acc.y - mx.y); ex.z = __expf(acc.z - mx.z); ex.w = __expf(acc.w - mx.w);
            f32x4 sm = ex;
#pragma unroll
            for (int o = 1; o < 16; o <<= 1) { sm.x += __shfl_xor(sm.x, o); sm.y += __shfl_xor(sm.y, o); sm.z += __shfl_xor(sm.z, o); sm.w += __shfl_xor(sm.w, o); }
            const int t = (r0 & (SEQ - 1)) + 4 * kq;
            *(f32x4*)(out16 + ((size_t)b * NE + rr) * SEQ + t) = (f32x4){ex.x / sm.x, ex.y / sm.y, ex.z / sm.z, ex.w / sm.w};
        } else {
#pragma unroll
            for (int q = 0; q < 4; ++q) { const float x = acc[q]; float o;
                if (rr < 8) o = 1.f / (1.f + __expf(-x));
                else { const float y = x + dt_bias[rr - 8]; const float sp = y > 20.f ? y : log1pf(__expf(y)); o = -__expf(a_log[rr - 8]) * sp; }
                out16[(size_t)(r0 + 4 * kq + q) * 16 + rr] = o; }
        }
    }
    __syncthreads();
}

__device__ __forceinline__ void ph_topk(const Frame& F, const float* aff, int* idx, float* gate, int* sel) {
    LAS unsigned* keys = (LAS unsigned*)F.lds;
    LAS unsigned* hist = keys + SEQ;
    LAS unsigned* cg = hist + 256; LAS unsigned* ce = cg + 512;
    LAS unsigned* shv = ce + 512;
    const int tid = F.tid;
    for (int item = F.vcu; item < BATCH * NE; item += F.G) {
        const int b = item >> 4, e = item & 15;
        for (int i = tid; i < SEQ; i += NTHREADS) keys[i] = __float_as_uint(aff[(size_t)item * SEQ + i]);
        if (tid == 0) { shv[0] = 0u; shv[1] = CAP; }
        lds_barrier();
        unsigned mask = 0u;
        for (int pass = 0; pass < 4; ++pass) {
            const int shift = 24 - 8 * pass;
            if (tid < 256) hist[tid] = 0u;
            lds_barrier();
            const unsigned prefix = shv[0];
            for (int i = tid; i < SEQ; i += NTHREADS) { const unsigned kx = keys[i]; if ((kx & mask) == prefix) __hip_atomic_fetch_add(&hist[(kx >> shift) & 255u], 1u, __ATOMIC_RELAXED, __HIP_MEMORY_SCOPE_WORKGROUP); }
            lds_barrier();
            unsigned sfx = 0u;
            if (tid < 256) { sfx = hist[tid];
#pragma unroll
                for (int o2 = 1; o2 < 64; o2 <<= 1) { const unsigned x = __shfl_down(sfx, o2); if ((tid & 63) + o2 < 64) sfx += x; }
                if ((tid & 63) == 0) cg[tid >> 6] = sfx; }
            lds_barrier();
            if (tid < 256) { for (int w2 = (tid >> 6) + 1; w2 < 4; ++w2) sfx += cg[w2];
                const unsigned need = shv[1]; unsigned above = __shfl_down(sfx, 1); if ((tid & 63) == 63) { above = 0u; for (int w2 = (tid >> 6) + 1; w2 < 4; ++w2) above += cg[w2]; }
                if (sfx >= need && above < need) { shv[2] = prefix | ((unsigned)tid << shift); shv[3] = need - above; } }
            lds_barrier();
            if (tid == 0) { shv[0] = shv[2]; shv[1] = shv[3]; }
            mask |= 0xFFu << shift;
            lds_barrier();
        }
        const unsigned T = shv[0], need = shv[1];
        unsigned ng = 0u, nq = 0u; unsigned kk16[16];
#pragma unroll
        for (int q = 0; q < 4; ++q) { const u32x4 k4 = *(const LAS u32x4*)(keys + tid * 16 + 4 * q); kk16[4 * q] = k4.x; kk16[4 * q + 1] = k4.y; kk16[4 * q + 2] = k4.z; kk16[4 * q + 3] = k4.w; }
#pragma unroll
        for (int j = 0; j < 16; ++j) { const unsigned kx = kk16[j]; ng += kx > T; nq += kx == T; }
        unsigned ig = ng, iq = nq;
#pragma unroll
        for (int o2 = 1; o2 < 64; o2 <<= 1) { const unsigned xg = __shfl_up(ig, o2), xq = __shfl_up(iq, o2); if ((tid & 63) >= o2) { ig += xg; iq += xq; } }
        if ((tid & 63) == 63) { cg[tid >> 6] = ig; ce[tid >> 6] = iq; }
        lds_barrier();
        unsigned g0 = ig - ng, q0 = iq - nq;
        for (int w2 = 0; w2 < (tid >> 6); ++w2) { g0 += cg[w2]; q0 += ce[w2]; }
#pragma unroll
        for (int j = 0; j < 16; ++j) { const int t = tid * 16 + j; const unsigned kx = kk16[j]; int slot = -1;
            if (kx > T) { slot = (int)(g0 + (q0 < need ? q0 : need)); ++g0; }
            else if (kx == T) { if (q0 < need) slot = (int)(g0 + q0); ++q0; }
            if (slot >= 0) { sel[((size_t)b * SEQ + t) * NE + e] = slot; idx[item * CAP + slot] = t; gate[item * CAP + slot] = __uint_as_float(kx); } }
        lds_barrier();
    }
}

template <bool FINAL>
__device__ __forceinline__ void ph_combine(const Frame& F, bf16_t* xlb, float* outf, const bf16_t* y, const int* sel, const float* ada  , const float* gwn, const float* ada_next, bf16_t* act) {
    const int gw_ = F.vcu * NWAVES + F.wave, NGW = F.G * NWAVES, lane = F.lane;
    int curb = -1; f32x4 g2v[4], mA[4], mB[4];
#pragma unroll
    for (int j = 0; j < 4; ++j) { g2v[j] = (f32x4){0.f, 0.f, 0.f, 0.f}; mA[j] = g2v[j]; mB[j] = g2v[j]; }
    int nslot = -1; u32x2 nx[4];
    if (gw_ < M_LAT) { nslot = lane < NE ? sel[(size_t)gw_ * NE + lane] : -1; const u32x2* xr0 = (const u32x2*)(xlb + (size_t)gw_ * D) + lane;
#pragma unroll
        for (int j = 0; j < 4; ++j) nx[j] = xr0[64 * j]; }
    for (int r = gw_; r < M_LAT; r += NGW) {
        const int b = r >> 13;
        const int myslot = nslot; f32x4 xv[4];
#pragma unroll
        for (int j = 0; j < 4; ++j) xv[j] = (f32x4){bf_lo(nx[j].x), bf_hi(nx[j].x), bf_lo(nx[j].y), bf_hi(nx[j].y)};
        { const int rn = r + NGW; if (rn < M_LAT) { nslot = lane < NE ? sel[(size_t)rn * NE + lane] : -1; const u32x2* xrn = (const u32x2*)(xlb + (size_t)rn * D) + lane;
#pragma unroll
              for (int j = 0; j < 4; ++j) nx[j] = xrn[64 * j]; } }
        if (b != curb) { curb = b; const float* g2 = ada + (size_t)b * 6 * D + 5 * D;
#pragma unroll
            for (int j = 0; j < 4; ++j) { const int c = 256 * j + 4 * lane; g2v[j] = *(const f32x4*)(g2 + c);
                const f32x4 g4 = *(const f32x4*)(gwn + c);
                if constexpr (FINAL) { mA[j] = g4; } else { const float* sh = ada_next + (size_t)b * 6 * D; mA[j] = g4 * (*(const f32x4*)(sh + D + c) + 1.f); mB[j] = *(const f32x4*)(sh + c); } } }
        f32x4 a[4];
#pragma unroll
        for (int j = 0; j < 4; ++j) a[j] = (f32x4){0.f, 0.f, 0.f, 0.f};
        unsigned mask = (unsigned)(__ballot(myslot >= 0) & 0xFFFFull);
        while (mask) {
            const bf16_t* rp[4]; float wv[4];
#pragma unroll
            for (int q = 0; q < 4; ++q) { const bool ok = mask != 0u; const int e = ok ? __builtin_ctz(mask) : 0; mask &= mask - 1u;
                const int s = __builtin_amdgcn_readlane(myslot, e);
                rp[q] = ok ? y + ((size_t)(b * NE + e) * CAP + s) * D : y; wv[q] = ok ? 1.f : 0.f; }
            u32x2 w[4][4];
#pragma unroll
            for (int q = 0; q < 4; ++q)
#pragma unroll
                for (int j = 0; j < 4; ++j) w[q][j] = ((const u32x2*)rp[q] + lane)[64 * j];
#pragma unroll
            for (int q = 0; q < 4; ++q)
#pragma unroll
                for (int j = 0; j < 4; ++j) { a[j].x += wv[q] * bf_lo(w[q][j].x); a[j].y += wv[q] * bf_hi(w[q][j].x); a[j].z += wv[q] * bf_lo(w[q][j].y); a[j].w += wv[q] * bf_hi(w[q][j].y); }
        }
        f32x4 v[4]; float s = 0.f;
#pragma unroll
        for (int j = 0; j < 4; ++j) { v[j] = xv[j] + g2v[j] * a[j]; s += (v[j].x * v[j].x + v[j].y * v[j].y) + (v[j].z * v[j].z + v[j].w * v[j].w); }
        const float rs = rsqrtf(wsum(s) * (1.f / D) + EPS);
        if constexpr (FINAL) {
            f32x4* xr = (f32x4*)(outf + (size_t)r * D) + lane;
#pragma unroll
            for (int j = 0; j < 4; ++j) xr[64 * j] = v[j] * rs * mA[j];
        } else {
            unsigned long long* x8 = (unsigned long long*)(xlb + (size_t)r * D) + lane;
            unsigned long long* o8 = (unsigned long long*)(act + (size_t)r * D) + lane;
#pragma unroll
            for (int j = 0; j < 4; ++j) { x8[64 * j] = (unsigned long long)pk2(v[j].x, v[j].y) | ((unsigned long long)pk2(v[j].z, v[j].w) << 32);
                const f32x4 o = v[j] * rs * mA[j] + mB[j];
                o8[64 * j] = (unsigned long long)pk2(o.x, o.y) | ((unsigned long long)pk2(o.z, o.w) << 32); }
        }
    }
}

__device__ __forceinline__ void ph_sc_glue(const Frame& F, const bf16_t* gb, const bf16_t* uu, const float* cw  , bf16_t* act) {
    const int gw_ = F.vcu * NWAVES + F.wave, NGW = F.G * NWAVES, lane = F.lane;
    float w0[16], w1[16], w2[16];
#pragma unroll
    for (int hh = 0; hh < 2; ++hh)
#pragma unroll
        for (int q = 0; q < 8; ++q) { const int c = hh * 512 + 8 * lane + q; w0[hh * 8 + q] = cw[c]; w1[hh * 8 + q] = cw[D + c]; w2[hh * 8 + q] = cw[2 * D + c]; }
    const u32x4 zero4 = (u32x4){0u, 0u, 0u, 0u};
    for (int blk = gw_; blk < M_LAT / 16; blk += NGW) {
        const int r0 = blk * 16, t0 = r0 & (SEQ - 1);
        u32x4 up[2], uc[2];
#pragma unroll
        for (int hh = 0; hh < 2; ++hh) { const int c = hh * 512 + 8 * lane;
            up[hh] = t0 > 0 ? *(const u32x4*)(uu + (size_t)(r0 - 1) * D + c) : zero4; uc[hh] = *(const u32x4*)(uu + (size_t)r0 * D + c); }
#pragma unroll 1
        for (int i0 = 0; i0 < 16; i0 += 4) {
            u32x4 gq[4][2], un[4][2];
#pragma unroll
            for (int i = 0; i < 4; ++i)
#pragma unroll
                for (int hh = 0; hh < 2; ++hh) { const int r = r0 + i0 + i, c = hh * 512 + 8 * lane;
                    gq[i][hh] = *(const u32x4*)(gb + (size_t)r * D + c);
                    un[i][hh] = (t0 + i0 + i + 1 < SEQ) ? *(const u32x4*)(uu + (size_t)(r + 1) * D + c) : zero4; }
#pragma unroll
            for (int i = 0; i < 4; ++i) {
#pragma unroll
                for (int hh = 0; hh < 2; ++hh) {
                    u32x4 o;
#pragma unroll
                    for (int q = 0; q < 4; ++q) {
                        const float lo = bf_lo(gq[i][hh][q]) * (w0[hh * 8 + 2 * q] * bf_lo(up[hh][q]) + w1[hh * 8 + 2 * q] * bf_lo(uc[hh][q]) + w2[hh * 8 + 2 * q] * bf_lo(un[i][hh][q]));
                        const float hi = bf_hi(gq[i][hh][q]) * (w0[hh * 8 + 2 * q + 1] * bf_hi(up[hh][q]) + w1[hh * 8 + 2 * q + 1] * bf_hi(uc[hh][q]) + w2[hh * 8 + 2 * q + 1] * bf_hi(un[i][hh][q]));
                        o[q] = pk2(lo, hi);
                    }
                    *(u32x4*)(act + (size_t)(r0 + i0 + i) * D + hh * 512 + 8 * lane) = o;
                    up[hh] = uc[hh]; uc[hh] = un[i][hh];
                }
            }
        }
    }
}

constexpr int NSLOT = 132;
constexpr int NCHAIN = BATCH * NH;
__device__ __forceinline__ int kperm(int s, int g, int j) { return 16 * (2 * s + (j >> 2)) + 4 * g + (j & 3); }

struct ScanPtrs { unsigned char* QN; unsigned char* KT; unsigned char* NWK; unsigned char* QK; unsigned char* U; float* SCL; };
__device__ __forceinline__ size_t so_shared(int chain, int slot) { return ((size_t)chain * NSLOT + slot) * 16384; }
__device__ __forceinline__ size_t so_dir(int dir, int chain, int slot) { return (((size_t)dir * NCHAIN + chain) * NSLOT + slot); }


__device__ __forceinline__ f32x4 mm16(const LAS float* A, const LAS float* B, f32x4 acc, int rr, int kq) {
#pragma unroll
    for (int t = 0; t < 4; ++t) acc = __builtin_amdgcn_mfma_f32_16x16x4f32(A[rr * 17 + 4 * t + kq], B[(4 * t + kq) * 17 + rr], acc, 0, 0, 0);
    return acc;
}
__device__ __forceinline__ f32x4 ld16(const LAS float* C, int rr, int kq) { return (f32x4){C[(4 * kq + 0) * 17 + rr], C[(4 * kq + 1) * 17 + rr], C[(4 * kq + 2) * 17 + rr], C[(4 * kq + 3) * 17 + rr]}; }
__device__ __forceinline__ void st16(LAS float* C, f32x4 v, int rr, int kq) {
#pragma unroll
    for (int r = 0; r < 4; ++r) C[(4 * kq + r) * 17 + rr] = v[r];
}

__device__ __forceinline__ void ph_chunk_prep(const Frame& F, const bf16_t* QKV, const bf16_t* CKV, const float* GATES, const float* cw  , const ScanPtrs P) {
    LAS unsigned char* L = F.lds;
    LAS bf16_t* kn = (LAS bf16_t*)(L);
    LAS bf16_t* qn = (LAS bf16_t*)(L + 17408);
    LAS bf16_t* vT = (LAS bf16_t*)(L + 34816);
    LAS bf16_t* knT = (LAS bf16_t*)(L + 53248);
    LAS float* KK = (LAS float*)(L + 71680);
    LAS float* QKr = (LAS float*)(L + 89088);
    LAS bf16_t* XU = (LAS bf16_t*)(L + 71680);
    LAS bf16_t* XW = (LAS bf16_t*)(L + 71680 + 18432);
    LAS float* NBk = (LAS float*)(L + 108544);
    LAS float* XBk = (LAS float*)(L + 108544 + 21760);
    LAS float* TBk = (LAS float*)(L + 108544 + 43520);
    LAS float* SCRq = (LAS float*)(L + 17408);
    LAS float* gamP = (LAS float*)(L + 108544 + 52224);
    LAS float* betP = gamP + 128;
    LAS float* begP = gamP + 256;
    static_assert(108544 + 52224 + 1536 <= MISC_OFF, "E3 LDS map");
    const int wave = F.wave;
    for (int item = F.vcu; item < NCHAIN * NSLOT; item += F.G) {
        int tid = F.tid; asm volatile("" : "+v"(tid));
        const int lane = tid & 63;
        const int chain = item / NSLOT, slot = item % NSLOT, b = chain >> 2, h = chain & 3;
        const bool isctx = slot < 4;
        const int Lseq = isctx ? CTX : SEQ, t0 = isctx ? slot * 64 : (slot - 4) * 64;
        {
            const int i = tid >> 3, cg = tid & 7, t = t0 + i;
            const bf16_t* src; int ld, qoff, koff, voff;
            if (isctx) { src = CKV + (size_t)(b * CTX) * 1024; ld = 1024; qoff = -1; koff = h * 128; voff = 512 + h * 128; }
            else { src = QKV + (size_t)(b * SEQ) * 1536; ld = 1536; qoff = h * 128; koff = 512 + h * 128; voff = 1024 + h * 128; }
            float o[3][16];
#pragma unroll
            for (int w = 0; w < 3; ++w) {
                const int off = w == 0 ? qoff : (w == 1 ? koff : voff);
                if (off < 0) {
#pragma unroll
                    for (int c = 0; c < 16; ++c) o[w][c] = 0.f;
                    continue;
                }
                const int wcol = w * 512 + h * 128 + cg * 16;
#pragma unroll
                for (int c = 0; c < 16; ++c) o[w][c] = 0.f;
#pragma unroll
                for (int tap = 0; tap < 3; ++tap) {
                    const int tt = t + tap - 1;
                    if (tt < 0 || tt >= Lseq) continue;
                    const u32x4 a0 = *(const u32x4*)(src + (size_t)tt * ld + off + cg * 16), a1 = *(const u32x4*)(src + (size_t)tt * ld + off + cg * 16 + 8);
                    const float* wp = cw + tap * 1536 + wcol;
#pragma unroll
                    for (int q = 0; q < 4; ++q) { o[w][2 * q] += wp[2 * q] * bf_lo(a0[q]); o[w][2 * q + 1] += wp[2 * q + 1] * bf_hi(a0[q]);
                        o[w][8 + 2 * q] += wp[8 + 2 * q] * bf_lo(a1[q]); o[w][8 + 2 * q + 1] += wp[8 + 2 * q + 1] * bf_hi(a1[q]); }
                }
#pragma unroll
                for (int c = 0; c < 16; ++c) o[w][c] = silu1(o[w][c]);
            }
            float sq = 0.f, sk = 0.f;
#pragma unroll
            for (int c = 0; c < 16; ++c) { sq += o[0][c] * o[0][c]; sk += o[1][c] * o[1][c]; }
            sq += __shfl_xor(sq, 1); sq += __shfl_xor(sq, 2); sq += __shfl_xor(sq, 4);
            sk += __shfl_xor(sk, 1); sk += __shfl_xor(sk, 2); sk += __shfl_xor(sk, 4);
            const float rq = rsqrtf(sq + EPS) * 0.08838834764831845f, rk = rsqrtf(sk + EPS);
#pragma unroll
            for (int c = 0; c < 16; c += 2) {
                *(LAS unsigned*)(qn + i * 136 + cg * 16 + c) = pk2(o[0][c] * rq, o[0][c + 1] * rq);
                const unsigned kw = pk2(o[1][c] * rk, o[1][c + 1] * rk), vw = pk2(o[2][c], o[2][c + 1]);
                *(LAS unsigned*)(kn + i * 136 + cg * 16 + c) = kw;
                knT[(cg * 16 + c) * 72 + i] = (bf16_t)(kw & 0xffffu); knT[(cg * 16 + c + 1) * 72 + i] = (bf16_t)(kw >> 16);
                vT[(cg * 16 + c) * 72 + i] = (bf16_t)(vw & 0xffffu); vT[(cg * 16 + c + 1) * 72 + i] = (bf16_t)(vw >> 16);
            }
        }
        if (wave < 2) {
            const int dir = wave, i = dir ? 63 - lane : lane;
            const size_t grow = isctx ? (size_t)M_LAT + b * CTX + t0 + i : (size_t)b * SEQ + t0 + i;
            float g = GATES[grow * 16 + 8 + dir * 4 + h];
#pragma unroll
            for (int o2 = 1; o2 < 64; o2 <<= 1) { const float x = __shfl_up(g, o2); if (lane >= o2) g += x; }
            gamP[dir * 64 + lane] = g; const float bt0 = GATES[grow * 16 + dir * 4 + h]; betP[dir * 64 + lane] = bt0; begP[dir * 64 + lane] = bt0 * __expf(g);
        }
        lds_barrier();
        {
            const int fr = lane & 15, fq = lane >> 4;
#pragma unroll
            for (int tt = 0; tt < 4; ++tt) {
                const int tile = wave * 4 + tt, which = tile >> 4, mt = (tile >> 2) & 3, nt = tile & 3;
                LAS bf16_t* Am = which ? qn : kn;
                f32x4 acc = (f32x4){0.f, 0.f, 0.f, 0.f};
#pragma unroll
                for (int s = 0; s < 4; ++s) {
                    const bf16x8 a = *(const LAS bf16x8*)(Am + (16 * mt + fr) * 136 + 32 * s + 8 * fq);
                    const bf16x8 bb = *(const LAS bf16x8*)(kn + (16 * nt + fr) * 136 + 32 * s + 8 * fq);
                    acc = __builtin_amdgcn_mfma_f32_16x16x32_bf16(a, bb, acc, 0, 0, 0);
                }
                LAS float* Om = which ? QKr : KK;
#pragma unroll
                for (int r = 0; r < 4; ++r) Om[(16 * mt + 4 * fq + r) * 68 + 16 * nt + fr] = acc[r];
            }
        }
        lds_barrier();
        {
#pragma unroll 2
            for (int it = 0; it < 10; ++it) {
                const int idx = tid + 512 * it, dir = idx / 2560, rem = idx % 2560, blk = rem >> 8, e = rem & 255, r = e >> 4, c = e & 15;
                const int bi = blk < 1 ? 0 : (blk < 3 ? 1 : (blk < 6 ? 2 : 3)), bj = blk - bi * (bi + 1) / 2;
                const int p = 16 * bi + r, pp = 16 * bj + c;
                float val = 0.f;
                if (p > pp) { const int ip = dir ? 63 - p : p, ipp = dir ? 63 - pp : pp;
                    val = betP[dir * 64 + p] * KK[ip * 68 + ipp] * __expf(gamP[dir * 64 + p] - gamP[dir * 64 + pp]); }
                NBk[(dir * 10 + blk) * 272 + r * 17 + c] = val;
            }
            const int f = tid >> 6, l2 = tid & 63, g = l2 >> 4;
            if (!isctx) {
#pragma unroll
                for (int dir = 0; dir < 2; ++dir) {
                    const int m = f >> 1, s = f & 1, io = 16 * m + (l2 & 15);
                    const float gi = gamP[dir * 64 + (dir ? 63 - io : io)];
                    float vals[8];
#pragma unroll
                    for (int e = 0; e < 8; ++e) { const int j = kperm(s, g, e); const bool keep = dir ? (j >= io) : (j <= io);
                        vals[e] = keep ? QKr[io * 68 + j] * __expf(gi - gamP[dir * 64 + (dir ? 63 - j : j)]) : 0.f; }
                    u32x4 w; w.x = pk2(vals[0], vals[1]); w.y = pk2(vals[2], vals[3]); w.z = pk2(vals[4], vals[5]); w.w = pk2(vals[6], vals[7]);
                    *(u32x4*)(P.QK + so_dir(dir, chain, slot) * 8192 + (size_t)tid * 16) = w;
                }
#pragma unroll
                for (int it = 0; it < 2; ++it) {
                    const int q = tid + 512 * it, ff = q >> 6, m = ff >> 2, s = ff & 3, row = 16 * m + (l2 & 15);
                    const u32x2 lo = *(const LAS u32x2*)(qn + row * 136 + 32 * s + 4 * g), hi = *(const LAS u32x2*)(qn + row * 136 + 32 * s + 16 + 4 * g);
                    *(u32x4*)(P.QN + so_shared(chain, slot) + (size_t)q * 16) = (u32x4){lo.x, lo.y, hi.x, hi.y};
                }
            }
#pragma unroll
            for (int it = 0; it < 2; ++it) {
                const int q = tid + 512 * it, ff = q >> 6, mp = ff >> 1, s = ff & 1, dk = 16 * mp + (l2 & 15);
                unsigned short e8[8];
#pragma unroll
                for (int e = 0; e < 8; ++e) e8[e] = kn[kperm(s, g, e) * 136 + dk];
                u32x4 w; w.x = e8[0] | ((unsigned)e8[1] << 16); w.y = e8[2] | ((unsigned)e8[3] << 16); w.z = e8[4] | ((unsigned)e8[5] << 16); w.w = e8[6] | ((unsigned)e8[7] << 16);
                *(u32x4*)(P.KT + so_shared(chain, slot) + (size_t)q * 16) = w;
            }
            if (tid < 128) { const int dir = tid >> 6, i = tid & 63, p = dir ? 63 - i : i;
                const float gl = gamP[dir * 64 + 63], gi = gamP[dir * 64 + p];
                float* sc = P.SCL + so_dir(dir, chain, slot) * 256;
                sc[i] = __expf(gi); sc[64 + i] = __expf(gl - gi); if (i == 0) sc[128] = __expf(gl); }
        }
        lds_barrier();
        {
            const int rr = lane & 15, kq = lane >> 4, dir = wave >> 2, wq = wave & 3;
            const f32x4 z4 = (f32x4){0.f, 0.f, 0.f, 0.f};
#define NB_(d, bi, bj) (NBk + ((d) * 10 + (bi) * ((bi) + 1) / 2 + (bj)) * 272)
#define XB_(d, bi, bj) (XBk + ((d) * 10 + (bi) * ((bi) + 1) / 2 + (bj)) * 272)
#define SLOT_(g) ((g) < 16 ? SCRq + (g) * 272 : TBk + ((g) - 16) * 272)
            {
                const LAS float* M = NB_(dir, wq, wq);
                LAS float* S0 = SLOT_(wave * 3), *S1 = SLOT_(wave * 3 + 1), *Pb = SLOT_(wave * 3 + 2), *Xd = XB_(dir, wq, wq);
                const f32x4 m = ld16(M, rr, kq);
                f32x4 p0;
#pragma unroll
                for (int r = 0; r < 4; ++r) p0[r] = ((4 * kq + r) == rr ? 1.f : 0.f) - m[r];
                st16(Pb, p0, rr, kq);
                const f32x4 m2 = mm16(M, M, z4, rr, kq); st16(S0, m2, rr, kq);
                const f32x4 p1 = mm16(Pb, S0, p0, rr, kq); st16(Xd, p1, rr, kq);
                const f32x4 m4 = mm16(S0, S0, z4, rr, kq); st16(S1, m4, rr, kq);
                const f32x4 p2 = mm16(Xd, S1, p1, rr, kq); st16(Pb, p2, rr, kq);
                const f32x4 m8 = mm16(S1, S1, z4, rr, kq); st16(S0, m8, rr, kq);
                const f32x4 p3 = mm16(Pb, S0, p2, rr, kq); st16(Xd, p3, rr, kq);
            }
            lds_barrier();
            if (wave < 4) {
                const int d1 = wave >> 1, lo = (wave & 1) * 2, hi = lo + 1;
                LAS float* T1 = SLOT_(wave);
                st16(T1, mm16(NB_(d1, hi, lo), XB_(d1, lo, lo), z4, rr, kq), rr, kq);
                const f32x4 x = mm16(XB_(d1, hi, hi), T1, z4, rr, kq);
                st16(XB_(d1, hi, lo), -x, rr, kq);
            }
            lds_barrier();
            {
                const int bi = 2 + (wq >> 1), bj = wq & 1;
                f32x4 t = mm16(NB_(dir, bi, 1), XB_(dir, 1, bj), z4, rr, kq);
                if (bj == 0) t = mm16(NB_(dir, bi, 0), XB_(dir, 0, 0), t, rr, kq);
                st16(TBk + (dir * 4 + wq) * 272, t, rr, kq);
            }
            lds_barrier();
            {
                const int bi = 2 + (wq >> 1), bj = wq & 1;
                f32x4 x = mm16(XB_(dir, bi, 2), TBk + (dir * 4 + bj) * 272, z4, rr, kq);
                if (bi == 3) x = mm16(XB_(dir, 3, 3), TBk + (dir * 4 + 2 + bj) * 272, x, rr, kq);
                st16(XB_(dir, bi, bj), -x, rr, kq);
            }
            lds_barrier();
#pragma unroll 2
            for (int it = 0; it < 16; ++it) {
                const int idx = tid + 512 * it, d2 = idx >> 12, i = (idx >> 6) & 63, jx = idx & 63, p = d2 ? 63 - i : i, pp = d2 ? 63 - jx : jx;
                float val = 0.f;
                if (p >= pp) val = XB_(d2, p >> 4, pp >> 4)[(p & 15) * 17 + (pp & 15)];
                XU[(d2 * 64 + i) * 72 + jx] = (bf16_t)f2bf(val * betP[d2 * 64 + pp]); XW[(d2 * 64 + i) * 72 + jx] = (bf16_t)f2bf(val * begP[d2 * 64 + pp]);
            }
#undef NB_
#undef XB_
#undef SLOT_
        }
        lds_barrier();
        {
            const int dir = wave >> 2, wq = wave & 3, rr = lane & 15, kq = lane >> 4;
            const LAS bf16_t* xu = XU + (dir * 64 + 16 * wq + rr) * 72 + 8 * kq;
            const LAS bf16_t* xw = XW + (dir * 64 + 16 * wq + rr) * 72 + 8 * kq;
            const bf16x8 au0 = *(const LAS bf16x8*)(xu), au1 = *(const LAS bf16x8*)(xu + 32);
            const bf16x8 bw0 = *(const LAS bf16x8*)(xw), bw1 = *(const LAS bf16x8*)(xw + 32);
            unsigned char* ub = P.U + so_dir(dir, chain, slot) * 16384;
            unsigned char* nb = P.NWK + so_dir(dir, chain, slot) * 16384;
#pragma unroll
            for (int ct = 0; ct < 8; ++ct) {
                const LAS bf16_t* vp = vT + (16 * ct + rr) * 72 + 8 * kq;
                f32x4 acc = (f32x4){0.f, 0.f, 0.f, 0.f};
                acc = __builtin_amdgcn_mfma_f32_16x16x32_bf16(au0, *(const LAS bf16x8*)(vp), acc, 0, 0, 0);
                acc = __builtin_amdgcn_mfma_f32_16x16x32_bf16(au1, *(const LAS bf16x8*)(vp + 32), acc, 0, 0, 0);
                *(u32x2*)(ub + (size_t)((ct * 4 + wq) * 64 + lane) * 8) = (u32x2){cvt_pk_bf16(acc[0], acc[1]), cvt_pk_bf16(acc[2], acc[3])};
            }
#pragma unroll
            for (int s2 = 0; s2 < 4; ++s2) {
                f32x4 a2[2];
#pragma unroll
                for (int hh = 0; hh < 2; ++hh) { const LAS bf16_t* kp = knT + (16 * (2 * s2 + hh) + rr) * 72 + 8 * kq;
                    f32x4 acc = (f32x4){0.f, 0.f, 0.f, 0.f};
                    acc = __builtin_amdgcn_mfma_f32_16x16x32_bf16(*(const LAS bf16x8*)(kp), bw0, acc, 0, 0, 0);
                    acc = __builtin_amdgcn_mfma_f32_16x16x32_bf16(*(const LAS bf16x8*)(kp + 32), bw1, acc, 0, 0, 0);
                    a2[hh] = acc; }
                u32x4 w; w.x = cvt_pk_bf16(-a2[0][0], -a2[0][1]); w.y = cvt_pk_bf16(-a2[0][2], -a2[0][3]); w.z = cvt_pk_bf16(-a2[1][0], -a2[1][1]); w.w = cvt_pk_bf16(-a2[1][2], -a2[1][3]);
                *(u32x4*)(nb + (size_t)((wq * 4 + s2) * 64 + lane) * 16) = w;
            }
        }
        lds_barrier();
    }
}

constexpr int SC_NWK = 0, SC_QN = 16384, SC_KT = 32768, SC_QK = 49152, SC_U = 57344, SC_SCL = 65536, SC_STAGE = 66560;
constexpr int SC_HS = 2 * SC_STAGE  , SC_HW = SC_HS + 16384  ;
static_assert(SC_HW + 8192 <= MISC_OFF, "scan LDS map");
__device__ __forceinline__ void ph_scan(const Frame& F, const ScanPtrs P, bf16_t* OF, bf16_t* OB, unsigned* prog) {
    const int xg = F.vcu >> 5, xj = F.vcu & 31;
    if (xj >= 8 || xg >= 8) return;
    const int sb = xg * 8 + xj, half = sb & 1, dir = (sb >> 1) & 1, chain = sb >> 2, b = chain >> 2, h = chain & 3;
    LAS unsigned char* L = F.lds;
    const int lane = F.lane, wave = F.wave, g = lane >> 4, tile = wave & 3;
    const bool isR = wave < 4;
    bf16_t* O = dir ? OB : OF;
    const unsigned lbase = (unsigned)(unsigned long long)(L);
    auto slot_of = [&](int step) { return dir ? (step < 4 ? 3 - step : 135 - step) : step; };
    auto issue = [&](int step) {
        const int slot = slot_of(step); const unsigned sbase = (unsigned)(step & 1) * SC_STAGE; const bool emit = slot >= 4;
        const unsigned char* nwk = P.NWK + so_dir(dir, chain, slot) * 16384; const unsigned char* kt = P.KT + so_shared(chain, slot);
        const unsigned char* qn = P.QN + so_shared(chain, slot); const unsigned char* qk = P.QK + so_dir(dir, chain, slot) * 8192;
        const unsigned char* uu = P.U + so_dir(dir, chain, slot) * 16384 + half * 8192; const unsigned char* sc = (const unsigned char*)(P.SCL + so_dir(dir, chain, slot) * 256);
#pragma unroll
        for (int i = 0; i < 2; ++i) { const int pc = wave * 2 + i;
            __builtin_amdgcn_global_load_lds((const unsigned*)(nwk + pc * 1024 + lane * 16), (LAS unsigned*)(L + sbase + SC_NWK + pc * 1024), 16, 0, 0); }
        __builtin_amdgcn_global_load_lds((const unsigned*)(uu + wave * 1024 + lane * 16), (LAS unsigned*)(L + sbase + SC_U + wave * 1024), 16, 0, 0);
        if (wave == 7) __builtin_amdgcn_global_load_lds((const unsigned*)(sc + lane * 16), (LAS unsigned*)(L + sbase + SC_SCL), 16, 0, 0);
        if (emit) {
#pragma unroll
            for (int i = 0; i < 2; ++i) { const int pc = wave * 2 + i;
                __builtin_amdgcn_global_load_lds((const unsigned*)(qn + pc * 1024 + lane * 16), (LAS unsigned*)(L + sbase + SC_QN + pc * 1024), 16, 0, 0); }
        }
#pragma unroll
        for (int i = 0; i < 2; ++i) { const int pc = wave * 2 + i;
            __builtin_amdgcn_global_load_lds((const unsigned*)(kt + pc * 1024 + lane * 16), (LAS unsigned*)(L + sbase + SC_KT + pc * 1024), 16, 0, 0); }
        if (emit) __builtin_amdgcn_global_load_lds((const unsigned*)(qk + wave * 1024 + lane * 16), (LAS unsigned*)(L + sbase + SC_QK + wave * 1024), 16, 0, 0);
    };
#define SC_RD128(dst, addr, off) asm volatile("ds_read_b128 %0, %1 offset:%2" : "=v"(dst) : "v"(addr), "n"(off))
#define SC_WR128(addr, off, src) asm volatile("ds_write_b128 %0, %1 offset:%2\n\ts_nop 3" :: "v"(addr), "v"(src), "n"(off) : "memory")
#define SC_LOAD(dst, base, first) do { _Pragma("unroll") for (int i_ = 0; i_ < 8; ++i_) SC_RD128(dst[i_], sva, (base) + ((first) + i_) * 1024); } while (0)
#define SC_WAIT0(a) do { asm volatile("s_waitcnt lgkmcnt(0)" : "+v"(a[0]), "+v"(a[1]), "+v"(a[2]), "+v"(a[3]), "+v"(a[4]), "+v"(a[5]), "+v"(a[6]), "+v"(a[7])); __builtin_amdgcn_sched_barrier(0); } while (0)
    const unsigned hsa = lbase + SC_HS + (unsigned)tile * 4096u + (unsigned)lane * 16u;
    const unsigned hwa = lbase + SC_HW + (unsigned)tile * 2048u + (unsigned)lane * 16u;
    f32x4 accS[8];
#pragma unroll
    for (int m = 0; m < 8; ++m) accS[m] = (f32x4){0.f, 0.f, 0.f, 0.f};
    bf16x8 bS[4];
#pragma unroll
    for (int s = 0; s < 4; ++s) bS[s] = (bf16x8){0, 0, 0, 0, 0, 0, 0, 0};
    if (isR) {
#pragma unroll
        for (int s = 0; s < 4; ++s) SC_WR128(hsa, s * 1024, bS[s]);
    }
    issue(0); asm volatile("s_waitcnt vmcnt(0)" ::: "memory");
    lds_barrier();
    for (int step = 0; step < NSLOT; ++step) {
        const int slot = slot_of(step); const bool emit = slot >= 4;
        if (half == 0 && F.tid == 0) __hip_atomic_store(prog + 16 * (sb >> 1), (unsigned)(step + 1), __ATOMIC_RELAXED, __HIP_MEMORY_SCOPE_AGENT);
        const unsigned sva = lbase + (unsigned)(step & 1) * SC_STAGE + (unsigned)lane * 16u;
        const unsigned ssa = sva - (unsigned)lane * 16u + SC_SCL + (unsigned)g * 16u;
#if PROBE_SEL >= 0
        const bool pw = (sb == 0 && wave == PROBE_WAVE);
        unsigned long long t0_ = 0, t1_ = 0, t2_ = 0, t3_ = 0, t4_ = 0, t5_ = 0;
        if (pw) t0_ = __builtin_amdgcn_s_memrealtime();
#endif
        if (step + 1 < NSLOT) issue(step + 1);
#if PROBE_SEL >= 0
        if (pw) t1_ = __builtin_amdgcn_s_memrealtime();
#endif
        bf16x8 fa[8], fb[8];
        f32x4 acco[4]; bf16x8 bWx[2];
        if (isR) {
            const unsigned sua = sva - (unsigned)lane * 8u + SC_U + (unsigned)tile * 2048u;
            f32x4 accw[4], ek4[4]; u32x2 uv[4]; float cd;
#pragma unroll
            for (int m = 0; m < 4; ++m) asm volatile("ds_read_b64 %0, %1 offset:%2" : "=v"(uv[m]) : "v"(sua), "n"(m * 512));
            SC_LOAD(fa, SC_NWK, 0);
            asm volatile("s_waitcnt lgkmcnt(0)" : "+v"(uv[0]), "+v"(uv[1]), "+v"(uv[2]), "+v"(uv[3]),
                         "+v"(fa[0]), "+v"(fa[1]), "+v"(fa[2]), "+v"(fa[3]), "+v"(fa[4]), "+v"(fa[5]), "+v"(fa[6]), "+v"(fa[7])); __builtin_amdgcn_sched_barrier(0);
            SC_LOAD(fb, SC_NWK, 8);
#pragma unroll
            for (int m = 0; m < 4; ++m) SC_RD128(ek4[m], ssa, 256 + m * 64);
            asm volatile("ds_read_b32 %0, %1 offset:512" : "=v"(cd) : "v"(ssa - (unsigned)g * 16u));
#pragma unroll
            for (int m = 0; m < 4; ++m) accw[m] = (f32x4){bf_lo(uv[m].x), bf_hi(uv[m].x), bf_lo(uv[m].y), bf_hi(uv[m].y)};
#pragma unroll
            for (int f = 0; f < 8; ++f) accw[f >> 2] = __builtin_amdgcn_mfma_f32_16x16x32_bf16(fa[f], bS[f & 3], accw[f >> 2], 0, 0, 0);
            asm volatile("s_waitcnt lgkmcnt(0)" : "+v"(ek4[0]), "+v"(ek4[1]), "+v"(ek4[2]), "+v"(ek4[3]), "+v"(cd),
                         "+v"(fb[0]), "+v"(fb[1]), "+v"(fb[2]), "+v"(fb[3]), "+v"(fb[4]), "+v"(fb[5]), "+v"(fb[6]), "+v"(fb[7])); __builtin_amdgcn_sched_barrier(0);
            SC_LOAD(fa, SC_KT, 0);
#pragma unroll
            for (int f = 0; f < 8; ++f) accw[2 + (f >> 2)] = __builtin_amdgcn_mfma_f32_16x16x32_bf16(fb[f], bS[f & 3], accw[2 + (f >> 2)], 0, 0, 0);
            SC_WAIT0(fa);
            SC_LOAD(fb, SC_KT, 8);
            bf16x8 bWs[2];
#pragma unroll
            for (int s = 0; s < 2; ++s) {
                const f32x4 w0 = accw[2 * s], w1 = accw[2 * s + 1], e0 = ek4[2 * s], e1 = ek4[2 * s + 1];
                u32x4 a, c2;
                a.x = cvt_pk_bf16(w0[0], w0[1]); a.y = cvt_pk_bf16(w0[2], w0[3]); a.z = cvt_pk_bf16(w1[0], w1[1]); a.w = cvt_pk_bf16(w1[2], w1[3]);
                c2.x = cvt_pk_bf16(w0[0] * e0[0], w0[1] * e0[1]); c2.y = cvt_pk_bf16(w0[2] * e0[2], w0[3] * e0[3]); c2.z = cvt_pk_bf16(w1[0] * e1[0], w1[1] * e1[1]); c2.w = cvt_pk_bf16(w1[2] * e1[2], w1[3] * e1[3]);
                bWx[s] = __builtin_bit_cast(bf16x8, a); bWs[s] = __builtin_bit_cast(bf16x8, c2);
                if (emit) SC_WR128(hwa, s * 1024, bWx[s]);
            }
#pragma unroll
            for (int m = 0; m < 8; ++m) accS[m] = accS[m] * cd;
#if PROBE_SEL >= 0
            if (pw) t2_ = __builtin_amdgcn_s_memrealtime();
#endif
            lds_barrier();
#if PROBE_SEL >= 0
            if (pw) t3_ = __builtin_amdgcn_s_memrealtime();
#endif
            SC_WAIT0(fb);
#pragma unroll
            for (int f = 0; f < 8; ++f) accS[f >> 1] = __builtin_amdgcn_mfma_f32_16x16x32_bf16(fa[f], bWs[f & 1], accS[f >> 1], 0, 0, 0);
#pragma unroll
            for (int f = 0; f < 8; ++f) accS[4 + (f >> 1)] = __builtin_amdgcn_mfma_f32_16x16x32_bf16(fb[f], bWs[f & 1], accS[4 + (f >> 1)], 0, 0, 0);
#pragma unroll
            for (int s = 0; s < 4; ++s) {
                const f32x4 s0 = accS[2 * s], s1 = accS[2 * s + 1];
                u32x4 a; a.x = cvt_pk_bf16(s0[0], s0[1]); a.y = cvt_pk_bf16(s0[2], s0[3]); a.z = cvt_pk_bf16(s1[0], s1[1]); a.w = cvt_pk_bf16(s1[2], s1[3]);
                bS[s] = __builtin_bit_cast(bf16x8, a);
                SC_WR128(hsa, s * 1024, bS[s]);
            }
        } else {
            f32x4 eg4[4];
            if (emit) {
#pragma unroll
                for (int s = 0; s < 4; ++s) SC_RD128(bS[s], hsa, s * 1024);
                SC_LOAD(fa, SC_QN, 0);
                asm volatile("s_waitcnt lgkmcnt(0)" : "+v"(bS[0]), "+v"(bS[1]), "+v"(bS[2]), "+v"(bS[3]),
                             "+v"(fa[0]), "+v"(fa[1]), "+v"(fa[2]), "+v"(fa[3]), "+v"(fa[4]), "+v"(fa[5]), "+v"(fa[6]), "+v"(fa[7])); __builtin_amdgcn_sched_barrier(0);
                SC_LOAD(fb, SC_QN, 8);
#pragma unroll
                for (int m = 0; m < 4; ++m) SC_RD128(eg4[m], ssa, m * 64);
#pragma unroll
                for (int m = 0; m < 4; ++m) acco[m] = (f32x4){0.f, 0.f, 0.f, 0.f};
#pragma unroll
                for (int f = 0; f < 8; ++f) acco[f >> 2] = __builtin_amdgcn_mfma_f32_16x16x32_bf16(fa[f], bS[f & 3], acco[f >> 2], 0, 0, 0);
                asm volatile("s_waitcnt lgkmcnt(0)" : "+v"(eg4[0]), "+v"(eg4[1]), "+v"(eg4[2]), "+v"(eg4[3]),
                             "+v"(fb[0]), "+v"(fb[1]), "+v"(fb[2]), "+v"(fb[3]), "+v"(fb[4]), "+v"(fb[5]), "+v"(fb[6]), "+v"(fb[7])); __builtin_amdgcn_sched_barrier(0);
                SC_LOAD(fa, SC_QK, 0);
#pragma unroll
                for (int f = 0; f < 8; ++f) acco[2 + (f >> 2)] = __builtin_amdgcn_mfma_f32_16x16x32_bf16(fb[f], bS[f & 3], acco[2 + (f >> 2)], 0, 0, 0);
#pragma unroll
                for (int m = 0; m < 4; ++m) acco[m] = acco[m] * eg4[m];
            }
#if PROBE_SEL >= 0
            if (pw) t2_ = __builtin_amdgcn_s_memrealtime();
#endif
            lds_barrier();
#if PROBE_SEL >= 0
            if (pw) t3_ = __builtin_amdgcn_s_memrealtime();
#endif
            if (emit) {
                SC_RD128(bWx[0], hwa, 0); SC_RD128(bWx[1], hwa, 1024);
                asm volatile("s_waitcnt lgkmcnt(0)" : "+v"(bWx[0]), "+v"(bWx[1]), "+v"(fa[0]), "+v"(fa[1]), "+v"(fa[2]), "+v"(fa[3]), "+v"(fa[4]), "+v"(fa[5]), "+v"(fa[6]), "+v"(fa[7])); __builtin_amdgcn_sched_barrier(0);
#pragma unroll
                for (int f = 0; f < 8; ++f) acco[f >> 1] = __builtin_amdgcn_mfma_f32_16x16x32_bf16(fa[f], bWx[f & 1], acco[f >> 1], 0, 0, 0);
                bf16_t* orow = O + ((size_t)b * SEQ + (slot - 4) * 64) * 512 + h * 128 + half * 64 + tile * 16 + (lane & 15);
#pragma unroll
                for (int m = 0; m < 4; ++m) { const unsigned p01 = cvt_pk_bf16(acco[m][0], acco[m][1]), p23 = cvt_pk_bf16(acco[m][2], acco[m][3]);
                    bf16_t* q = orow + (size_t)(16 * m + 4 * g) * 512;
                    q[0] = (bf16_t)(p01 & 0xffffu); q[512] = (bf16_t)(p01 >> 16); q[1024] = (bf16_t)(p23 & 0xffffu); q[1536] = (bf16_t)(p23 >> 16); }
            }
        }
#if PROBE_SEL >= 0
        if (pw) t4_ = __builtin_amdgcn_s_memrealtime();
#endif
        asm volatile("s_waitcnt vmcnt(0)" ::: "memory");
#if PROBE_SEL >= 0
        if (pw) t5_ = __builtin_amdgcn_s_memrealtime();
#endif
        lds_barrier();
#if PROBE_SEL >= 0
        if (pw && lane == 0) { const unsigned long long t6_ = __builtin_amdgcn_s_memrealtime(); unsigned long long* ts = (unsigned long long*)(prog - CW_PROG + CW_TS);
            ts[0] += t1_ - t0_; ts[1] += t2_ - t1_; ts[2] += t3_ - t2_; ts[3] += t4_ - t3_; ts[4] += t5_ - t4_; ts[5] += t6_ - t5_; ts[6] += t6_ - t0_; }
#endif
    }
#undef SC_LOAD
#undef SC_WAIT0
#undef SC_RD128
#undef SC_WR128
}

__device__ __forceinline__ void scan_l2_warm(const Frame& F, const ScanPtrs P, int stream, int quarter, unsigned* prog) {
    const int dir = stream & 1, chain = stream >> 1, lane = F.lane;
    const int wq = quarter * NWAVES + F.wave;
    constexpr int AHEAD = 6;
    int done = 0;
    u32x4 junk = (u32x4){0u, 0u, 0u, 0u};
    for (unsigned spins = 0; spins < (1u << 20); ++spins) {
        const int cur = (int)__hip_atomic_load(prog + 16 * stream, __ATOMIC_RELAXED, __HIP_MEMORY_SCOPE_AGENT);
        int tgt = cur + AHEAD; if (tgt > NSLOT) tgt = NSLOT;
        for (int s = done > cur ? done : cur; s < tgt; ++s) {
            const int slot = dir ? (s < 4 ? 3 - s : 135 - s) : s;
#pragma unroll
            for (int i = 0; i < 3; ++i) { const int p = wq + 32 * i;
                const unsigned char* src = nullptr;
                if (p < 16) src = P.NWK + so_dir(dir, chain, slot) * 16384 + p * 1024;
                else if (p < 32) src = P.KT + so_shared(chain, slot) + (p - 16) * 1024;
                else if (p < 48) src = P.U + so_dir(dir, chain, slot) * 16384 + (p - 32) * 1024;
                else if (p < 64) { if (slot >= 4) src = P.QN + so_shared(chain, slot) + (p - 48) * 1024; }
                else if (p < 72) { if (slot >= 4) src = P.QK + so_dir(dir, chain, slot) * 8192 + (p - 64) * 1024; }
                else if (p == 72) src = (const unsigned char*)(P.SCL + so_dir(dir, chain, slot) * 256);
                if (src) asm volatile("global_load_dwordx4 %0, %1, off" : "+v"(junk) : "v"(src + lane * 16)); }
        }
        if (tgt > done) done = tgt;
        if (done >= NSLOT) break;
        __builtin_amdgcn_s_sleep(16);
    }
    asm volatile("s_waitcnt vmcnt(0)" : "+v"(junk) :: "memory");
}

__device__ __forceinline__ void ph_even_A(const Frame& F, const bf16_t* OF, const bf16_t* OB, const bf16_t* Z, const bf16_t* POOL, const float* onorm, bf16_t* act) {
    LAS unsigned char* L = F.lds;
    for (int seg = F.vcu; seg < M_LAT / 64; seg += F.G) {
        int tid = F.tid; asm volatile("" : "+v"(tid));
        const int lane = tid & 63;
        const size_t row0 = (size_t)seg * 64;
#pragma unroll
        for (int i = 0; i < 8; ++i) { const int q = tid + 512 * i;
            *(LAS u32x4*)(L + q * 16) = *(const u32x4*)(POOL + row0 * 512 + (size_t)q * 8); }
        __syncthreads();
#pragma unroll 1
        for (int i0 = 0; i0 < 8; i0 += 4) {
            u32x4 av[4], bv[4], zv[4];
#pragma unroll
            for (int i = 0; i < 4; ++i) { const size_t r = row0 + F.wave * 8 + i0 + i;
                av[i] = *(const u32x4*)(OF + r * 512 + 8 * lane); bv[i] = *(const u32x4*)(OB + r * 512 + 8 * lane); zv[i] = *(const u32x4*)(Z + r * 512 + 8 * lane); }
#pragma unroll
            for (int i = 0; i < 4; ++i) {
                const int pos = F.wave * 8 + i0 + i; const size_t r = row0 + pos;
                const u32x4 a = av[i], b2 = bv[i], z = zv[i];
                float o[8]; float s = 0.f;
#pragma unroll
                for (int q = 0; q < 4; ++q) { o[2 * q] = bf_lo(a[q]) + bf_lo(b2[q]); o[2 * q + 1] = bf_hi(a[q]) + bf_hi(b2[q]); s += o[2 * q] * o[2 * q] + o[2 * q + 1] * o[2 * q + 1]; }
                s += __shfl_xor(s, 1); s += __shfl_xor(s, 2); s += __shfl_xor(s, 4); s += __shfl_xor(s, 8);
                const float rs = rsqrtf(s * (1.f / 128.f) + EPS);
                const float* gn = onorm + ((8 * lane) & 127);
                u32x4 w;
#pragma unroll
                for (int q = 0; q < 4; ++q) w[q] = pk2(o[2 * q] * rs * gn[2 * q] * silu1(bf_lo(z[q])), o[2 * q + 1] * rs * gn[2 * q + 1] * silu1(bf_hi(z[q])));
                *(u32x4*)(act + r * D + 8 * lane) = w;
                const int grp = lane >> 4, win = 2 << grp;
                int lo = pos - win / 2; if (lo < 0) lo = 0; int hi = pos + win - win / 2; if (hi > 64) hi = 64;
                float m[8];
#pragma unroll
                for (int q = 0; q < 8; ++q) m[q] = 0.f;
#pragma unroll
                for (int p = 0; p < 16; ++p) { const int rr = lo + p; const bool ok = rr < hi;
                    const u32x4 pv = *(const LAS u32x4*)(L + (ok ? rr : pos) * 1024 + lane * 16);
                    if (ok) {
#pragma unroll
                        for (int q = 0; q < 4; ++q) { m[2 * q] += bf_lo(pv[q]); m[2 * q + 1] += bf_hi(pv[q]); } } }
                const float inv = 1.f / (float)(hi - lo);
                const u32x4 self = *(const LAS u32x4*)(L + pos * 1024 + lane * 16);
#pragma unroll
                for (int q = 0; q < 4; ++q) w[q] = pk2(m[2 * q] * inv - bf_lo(self[q]), m[2 * q + 1] * inv - bf_hi(self[q]));
                *(u32x4*)(act + r * D + 512 + 8 * lane) = w;
            }
        }
        __syncthreads();
    }
}

struct TItem { const float* W; bf16_t* WT; int ldn, n0, k0, Kd, drow0; };
constexpr int N_LATE_T = 2304 + 2 * NE * 768;
__device__ __forceinline__ TItem late_item(const Args& args, int it, bf16_t* WOUT, bf16_t* SCIN, bf16_t* SCOUT, bf16_t* WGU, bf16_t* WDN) {
    TItem t;
    if (it < 256) { const int kb = it >> 5, nb = it & 31; t = TItem{args.in[16], WOUT, D, 32 * nb, 64 * kb, D, 32 * nb}; }
    else if (it < 1792) { const int q = it - 256, kb = q / 96, nb = q % 96, n0 = 32 * nb; int drow;
        if (n0 < D) drow = n0; else if (n0 < 2 * D) drow = D + ((n0 - D) >> 7) * 256 + (n0 & 127); else drow = D + ((n0 - 2 * D) >> 7) * 256 + 128 + (n0 & 127);
        t = TItem{args.in[17], SCIN, 3 * D, n0, 64 * kb, D, drow}; }
    else if (it < 2304) { const int q = it - 1792, kb = q >> 5, nb = q & 31; t = TItem{args.in[19], SCOUT, D, 32 * nb, 64 * kb, D, 32 * nb}; }
    else { const int q0 = it - 2304, le = q0 / 768, r = q0 % 768;
        if (r < 512) { const int up = r >> 8, q = r & 255, kb = q >> 4, nb = q & 15, n0 = 32 * nb;
            t = TItem{(up ? args.in[22] : args.in[21]) + (size_t)le * D * DE, WGU + (size_t)le * 1024 * D, DE, n0, 64 * kb, D, (n0 >> 7) * 256 + up * 128 + (n0 & 127)}; }
        else { const int q = r - 512, kb = q >> 5, nb = q & 31; t = TItem{args.in[23] + (size_t)le * DE * D, WDN + (size_t)le * D * DE, D, 32 * nb, 64 * kb, DE, 32 * nb}; } }
    return t;
}
__device__ __forceinline__ void t_load(const TItem& t, float (&tv)[32], int lane) {
#pragma unroll
    for (int i = 0; i < 32; ++i) tv[i] = __builtin_nontemporal_load(t.W + (size_t)(t.k0 + 2 * i + (lane >> 5)) * t.ldn + t.n0 + (lane & 31));
}
__device__ __forceinline__ void t_store(const TItem& t, const float (&tv)[32], LAS float* scr, int lane) {
#pragma unroll
    for (int i = 0; i < 32; ++i) scr[(2 * i + (lane >> 5)) * 33 + (lane & 31)] = tv[i];
    asm volatile("s_waitcnt lgkmcnt(0)" ::: "memory");
    const int c = lane & 7;
#pragma unroll
    for (int j = 0; j < 4; ++j) { const int n = (lane >> 3) + 8 * j; const LAS float* s = scr + (8 * c) * 33 + n;
        u32x4 o; o.x = pk2(s[0 * 33], s[1 * 33]); o.y = pk2(s[2 * 33], s[3 * 33]); o.z = pk2(s[4 * 33], s[5 * 33]); o.w = pk2(s[6 * 33], s[7 * 33]);
        __builtin_nontemporal_store(o, (u32x4*)(t.WT + (size_t)(t.drow0 + n) * t.Kd + t.k0 + 8 * c)); }
    asm volatile("s_waitcnt lgkmcnt(0)" ::: "memory");
}
__device__ __forceinline__ void prep_late(const Frame& F, const Args& args, int widx, int nw, bf16_t* WOUT, bf16_t* SCIN, bf16_t* SCOUT, bf16_t* WGU, bf16_t* WDN) {
    LAS float* scr = (LAS float*)(F.lds + F.wave * 16384);
    for (int it = widx; it < 4 * 128 * 16; it += nw) { const int gq = it >> 11, c = (it >> 4) & 127, n = (it & 15) * 64 + F.lane;
        const float* pw = args.in[14] + ((size_t)gq * 128 + c) * 128; const float* ps = args.in[15] + gq * 128; const float* wo = args.in[16] + (size_t)(512 + gq * 128) * D + n;
        float acc = 0.f;
#pragma unroll 1
        for (int d0 = 0; d0 < 128; d0 += 32) { float wv[32];
#pragma unroll
            for (int d = 0; d < 32; ++d) wv[d] = wo[(size_t)(d0 + d) * D];
#pragma unroll
            for (int d = 0; d < 32; ++d) acc += pw[d0 + d] * ps[d0 + d] * wv[d]; }
        WOUT[(size_t)n * D + 512 + gq * 128 + c] = (bf16_t)f2bf(acc); }
    float ta[32], tb[32];
    int it0 = widx;
    TItem A = late_item(args, it0 < N_LATE_T ? it0 : 0, WOUT, SCIN, SCOUT, WGU, WDN), B = A;
    if (it0 < N_LATE_T) t_load(A, ta, F.lane);
    while (it0 < N_LATE_T) {
        const int it1 = it0 + nw;
        if (it1 < N_LATE_T) { B = late_item(args, it1, WOUT, SCIN, SCOUT, WGU, WDN); t_load(B, tb, F.lane); }
        t_store(A, ta, scr, F.lane);
        it0 = it1 + nw;
        if (it0 < N_LATE_T) { A = late_item(args, it0, WOUT, SCIN, SCOUT, WGU, WDN); t_load(A, ta, F.lane); }
        if (it1 < N_LATE_T) t_store(B, tb, scr, F.lane);
        __builtin_amdgcn_s_sleep(127); __builtin_amdgcn_s_sleep(127);
    }
}

enum { PH_PREP = 0, PH_E1, PH_E2, PH_E3, PH_E4, PH_E5, PH_E6, PH_M1_0, PH_M2_0, PH_M3_0, PH_M4_0, PH_M5_0, PH_X1, PH_X2, PH_X3, PH_M1_1, PH_M2_1, PH_M3_1, PH_M4_1, PH_M5_1, PH_COUNT };

__global__ void __launch_bounds__(NTHREADS, 2) mega(Args args) {
    extern __shared__ __attribute__((aligned(16))) unsigned char lds_raw[];
    Frame F;
    F.lds = (LAS unsigned char*)lds_raw;
    F.tid = threadIdx.x; F.lane = F.tid & 63; F.wave = __builtin_amdgcn_readfirstlane(F.tid >> 6);
    F.G = gridDim.x; { const int bx = blockIdx.x; F.vcu = (F.G % 8 == 0) ? (bx % 8) * (F.G / 8) + bx / 8 : bx; }
    volatile LAS unsigned* MISC = (volatile LAS unsigned*)(F.lds + MISC_OFF);
    if (F.tid < 64) MISC[F.tid] = 0u;
    __syncthreads();
    unsigned char* ws = args.ws;
    XcdBarrier bar = xcd_barrier_post((unsigned*)(ws + WS_CTL) + CW_BAR + args.li * XCD_BAR_WORDS, MISC + 8);
    const int lo = args.ph_lo, hi = args.ph_hi;
#define IN(k) (lo <= (k) && (k) < hi)
#define SEAM(k) do { if (IN(k) && IN((k) + 1)) xcd_barrier(bar); } while (0)
    const float* ADA = (const float*)(ws + WS_ADA); float* ADAw = (float*)(ws + WS_ADA);
    float* AFF = (float*)(ws + WS_AFF); int* IDX = (int*)(ws + WS_IDX); float* GATE = (float*)(ws + WS_GATE); int* SEL = (int*)(ws + WS_SEL);
    bf16_t* WGU = (bf16_t*)(ws + WS_WGU); bf16_t* WDN = (bf16_t*)(ws + WS_WDN); bf16_t* SCIN = (bf16_t*)(ws + WS_SCIN); bf16_t* SCOUT = (bf16_t*)(ws + WS_SCOUT);
    bf16_t* GBp = (bf16_t*)(ws + WS_GB); bf16_t* UUp = (bf16_t*)(ws + WS_UU);
    bf16_t* WIN = (bf16_t*)(ws + WS_WIN); bf16_t* WOUT = (bf16_t*)(ws + WS_WOUT); float* GATES = (float*)(ws + WS_GATES);
    const ScanPtrs SP{ws + WS_QN, ws + WS_KT, ws + WS_NWK, (unsigned char*)args.out + 66 * MiB, (unsigned char*)args.out, (float*)(ws + WS_SCL)};
    bf16_t* OFp = (bf16_t*)(ws + WS_OF); bf16_t* OBp = (bf16_t*)(ws + WS_OB);
    bf16_t* QKV = (bf16_t*)(ws + WS_QKV); bf16_t* Zp = (bf16_t*)(ws + WS_Z); bf16_t* POOLp = (bf16_t*)(ws + WS_POOL); bf16_t* CKV = (bf16_t*)(ws + WS_CKV);
    bf16_t* ACT = (bf16_t*)(ws + WS_ACT); bf16_t* HID = (bf16_t*)(ws + WS_HID); bf16_t* Y = (bf16_t*)(ws + WS_Y);
    float* xl = args.out; (void)xl;
    bf16_t* XLB = (bf16_t*)(ws + WS_XLB);

    if (IN(PH_PREP)) {
        LAS float* scr = (LAS float*)(F.lds + F.wave * 16384);
        const int gw_ = F.vcu * NWAVES + F.wave, NGW = F.G * NWAVES;
        for (int it = F.vcu; it < 192; it += F.G) { const int l = it / 96, n = (it % 96) * 64 + F.lane;
            const float* w = args.in[4] + (size_t)l * D * 6 * D + (size_t)(128 * F.wave) * 6 * D + n; float acc[5] = {0.f, 0.f, 0.f, 0.f, 0.f};
#pragma unroll 8
            for (int k2 = 0; k2 < 128; ++k2) { const float wv = w[(size_t)k2 * 6 * D]; const int kk = 128 * F.wave + k2;
#pragma unroll
                for (int r = 0; r < 5; ++r) { const float cv = r < 4 ? args.in[1][r * D + kk] : args.in[3][kk]; acc[r] += silu1(cv) * wv; } }
            LAS float* red = (LAS float*)(F.lds + 8 * 16384);
#pragma unroll
            for (int r = 0; r < 5; ++r) red[(F.wave * 5 + r) * 64 + F.lane] = acc[r];
            __syncthreads();
            if (F.tid < 320) { const int r = F.tid >> 6, ln = F.tid & 63; float sacc = 0.f;
#pragma unroll
                for (int w2 = 0; w2 < 8; ++w2) sacc += red[(w2 * 5 + r) * 64 + ln];
                const int n2 = (it % 96) * 64 + ln;
                ADAw[((size_t)l * 5 + r) * 6 * D + n2] = sacc + args.in[5][l * 6 * D + n2]; }
            __syncthreads(); }
        for (int it = gw_; it < 1280; it += NGW) { const int kb = it / 80, nb = it % 80, n0 = 32 * nb;
            transpose_item(args.in[9], D, EVEN_IN, n0 < 2048 ? n0 : n0 + 16, 64 * kb, WIN, n0, scr, F.lane); }
    }
    SEAM(PH_PREP);
    if (IN(PH_E1)) ph_norm16<1>(F, args.in[0], args.in[2], ACT, args.in[6], ADA, args.in[9] + 2048, EVEN_IN, GATES, args.in[11], args.in[12]);
    SEAM(PH_E1);
    if (IN(PH_E2)) { SchedProj S{F.vcu, F.G}; EpiProj E{QKV, Zp, POOLp, CKV}; gemm_phase<EpiProj, SchedProj, false>(F.lds, ACT, WIN, D, S, E); }
    SEAM(PH_E2);
    if (IN(PH_E3)) ph_chunk_prep(F, QKV, CKV, GATES, args.in[10], SP);
    SEAM(PH_E3);
#if PROBE_SEL >= 0
    unsigned long long* tsq = (unsigned long long*)((unsigned*)(ws + WS_CTL) + CW_TS);
    const unsigned long long te0_ = __builtin_amdgcn_s_memrealtime();
#endif
    if (IN(PH_E4)) {
        unsigned* prog = (unsigned*)(ws + WS_CTL) + CW_PROG;
        const int xj = F.vcu & 31, xg = F.vcu >> 5;
        if (xj < 8) ph_scan(F, SP, OFp, OBp, prog);
        else prep_late(F, args, (xg * 24 + (xj - 8)) * NWAVES + F.wave, 192 * NWAVES, WOUT, SCIN, SCOUT, WGU, WDN);
    }
#if PROBE_SEL >= 0
    const unsigned long long te1_ = __builtin_amdgcn_s_memrealtime();
    if (F.tid == 0 && blockIdx.x == 0) tsq[8] = te1_ - te0_;
    if (F.tid == 0 && blockIdx.x == 64) tsq[9] = te1_ - te0_;
    if (F.tid == 0 && blockIdx.x == 255) tsq[10] = te1_ - te0_;
#endif
    SEAM(PH_E4);
#if PROBE_SEL >= 0
    if (F.tid == 0 && blockIdx.x == 0) tsq[11] = __builtin_amdgcn_s_memrealtime() - te0_;
#endif
    if (IN(PH_E5)) ph_even_A(F, OFp, OBp, Zp, POOLp, args.in[13], ACT);
    SEAM(PH_E5);
    if (IN(PH_E6)) { SchedDense<4, 256> S{F.vcu, F.G, 128 * 4}; EpiResid<false> E{args.in[0], XLB, ADA + 2 * D}; gemm_phase<EpiResid<false>, SchedDense<4, 256>, false>(F.lds, ACT, WOUT, D, S, E); }
    SEAM(PH_E6);
#define MOE_SEGMENT(l, p0) do { \
        const float* ada_l = ADA + (size_t)(l) * 5 * 6 * D; \
        if (IN(p0)) ph_norm16<0>(F, XLB, nullptr, ACT, args.in[7] + (l) * D, ada_l, args.in[20] + (size_t)(l) * D * NE, NE, AFF, nullptr, nullptr, SEL); \
        SEAM(p0); \
        if (IN((p0) + 1)) ph_topk(F, AFF, IDX, GATE, SEL); \
        SEAM((p0) + 1); \
        if (IN((p0) + 2)) { SchedMoeUp S{F.vcu, (l), IDX}; EpiSiluMul E{HID, DE}; gemm_phase<EpiSiluMul, SchedMoeUp, true>(F.lds, ACT, WGU, D, S, E); } \
        SEAM((p0) + 2); \
        if (IN((p0) + 3)) { SchedMoeDown S{F.vcu, (l)}; EpiRowScale E{Y, D, GATE}; gemm_phase<EpiRowScale, SchedMoeDown, false>(F.lds, HID, WDN, DE, S, E); } \
        SEAM((p0) + 3); \
        if (IN((p0) + 4)) { \
            if ((l) == 0) ph_combine<false>(F, XLB, nullptr, Y, SEL, ada_l, args.in[6] + D, ADA + (size_t)5 * 6 * D, ACT); \
            else ph_combine<true>(F, XLB, args.out, Y, SEL, ada_l, args.in[8], nullptr, nullptr); \
        } \
    } while (0)
    MOE_SEGMENT(0, PH_M1_0);
    SEAM(PH_M5_0);
    if (IN(PH_X1)) { SchedDense<12, 1> S{F.vcu, F.G, 128 * 12}; EpiScIn E{GBp, UUp}; gemm_phase<EpiScIn, SchedDense<12, 1>, false>(F.lds, ACT, SCIN, D, S, E); }
    SEAM(PH_X1);
    if (IN(PH_X2)) ph_sc_glue(F, GBp, UUp, args.in[18], ACT);
    SEAM(PH_X2);
    if (IN(PH_X3)) { SchedDense<4, 256> S{F.vcu, F.G, 128 * 4}; EpiResid<true> E{XLB, XLB, ADA + (size_t)5 * 6 * D + 2 * D}; gemm_phase<EpiResid<true>, SchedDense<4, 256>, false>(F.lds, ACT, SCOUT, D, S, E); }
    SEAM(PH_X3);
    MOE_SEGMENT(1, PH_M1_1);
#undef MOE_SEGMENT
#if PROBE_SEL >= 0
    if (blockIdx.x == 0 && F.tid == 0) { asm volatile("s_waitcnt vmcnt(0)" ::: "memory");
        const unsigned long long v = __hip_atomic_load((unsigned long long*)((unsigned*)(ws + WS_CTL) + CW_TS) + PROBE_SEL, __ATOMIC_RELAXED, __HIP_MEMORY_SCOPE_AGENT);
        const unsigned long long t0 = __builtin_amdgcn_s_memrealtime();
        while (__builtin_amdgcn_s_memrealtime() - t0 < 4ull * v) __builtin_amdgcn_s_sleep(8); }
#endif
#undef IN
#undef SEAM
}
}

}

extern "C" void kernel_launch(void* const* d_in, const int* in_sizes, int n_in, void* d_out, int out_size, void* d_ws, size_t ws_size, hipStream_t st) {
    static int grid = 0;
    if (grid == 0) {
        int dev = 0, cus = 0;
        if (hipGetDevice(&dev) != hipSuccess || hipDeviceGetAttribute(&cus, hipDeviceAttributeMultiprocessorCount, dev) != hipSuccess) { grid = -1; return; }
        if (hipFuncSetAttribute((const void*)mk::mega, hipFuncAttributeMaxDynamicSharedMemorySize, mk::LDS_BYTES) != hipSuccess) { fprintf(stderr, "hipFuncSetAttribute failed\n"); grid = -1; return; }
        if (ws_size < mk::WS_END) { fprintf(stderr, "workspace too small: %zu < %zu\n", ws_size, (size_t)mk::WS_END); grid = -1; return; }
        grid = cus;
    }
    if (grid < 0) return;
    (void)hipMemsetAsync((char*)d_ws + mk::WS_CTL, 0, mk::MiB, st);
    mk::Args a{};
    for (int i = 0; i < 24; ++i) a.in[i] = (const float*)d_in[i];
    a.out = (float*)d_out; a.ws = (unsigned char*)d_ws;
    int n_mega = 0;
    auto mega = [&](int lo, int hi) { a.ph_lo = lo; a.ph_hi = hi; a.li = n_mega++; hipLaunchKernelGGL(mk::mega, dim3(grid), dim3(mk::NTHREADS), mk::LDS_BYTES, st, a); };
    mega(0, mk::PH_COUNT);
}
```

```cpp
#include <hip/hip_runtime.h>
#include <cstdio>
#include <cstdint>

namespace {
constexpr int D = 1024, BATCH = 4, SEQ = 8192, CTX = 256, NH = 4, DK = 128, DV = 128;
constexpr int EVEN_IN = 2576, NE = 16, DE = 512, CAP = 1024;
constexpr float EPS = 1e-6f;

__device__ __forceinline__ float silu_f(float x) { return x / (1.f + __expf(-x)); }
__device__ __forceinline__ float sigmoid_f(float x) { return 1.f / (1.f + __expf(-x)); }
__device__ __forceinline__ float softplus_f(float x) { return x > 20.f ? x : log1pf(__expf(x)); }
__device__ __forceinline__ float wave_sum(float v) {
#pragma unroll
    for (int o = 1; o < 64; o <<= 1) v += __shfl_xor(v, o);
    return v;
}


namespace mk {
#define LAS __attribute__((address_space(3)))
#define GAS __attribute__((address_space(1)))
typedef unsigned short bf16_t;
typedef short bf16x8 __attribute__((ext_vector_type(8)));
typedef float f32x4 __attribute__((ext_vector_type(4)));
typedef float f32x2 __attribute__((ext_vector_type(2)));
typedef unsigned u32x4 __attribute__((ext_vector_type(4)));
typedef unsigned u32x2 __attribute__((ext_vector_type(2)));
constexpr int M_LAT = BATCH * SEQ;
constexpr int BM = 256, BK = 64, HALF = 128, HTB = HALF * BK * 2, STAGE_BYTES = 8 * HTB;
constexpr int LDS_BYTES = 163840, GTAB_OFF = 131072  , MISC_OFF = LDS_BYTES - 256;
constexpr int NTHREADS = 512, NWAVES = 8;

__device__ __forceinline__ unsigned f2bf(float f) { unsigned u = __builtin_bit_cast(unsigned, f); return (u + 0x7fffu + ((u >> 16) & 1u)) >> 16; }
__device__ __forceinline__ unsigned pk2(float lo, float hi) { return f2bf(lo) | (f2bf(hi) << 16); }
typedef __bf16 bf16x2_t __attribute__((ext_vector_type(2)));
__device__ __forceinline__ unsigned cvt_pk_bf16(float lo, float hi) { const f32x2 v = {lo, hi}; const bf16x2_t b2 = __builtin_convertvector(v, bf16x2_t); return __builtin_bit_cast(unsigned, b2); }
__device__ __forceinline__ float bf_lo(unsigned w) { return __uint_as_float(w << 16); }
__device__ __forceinline__ float bf_hi(unsigned w) { return __uint_as_float(w & 0xffff0000u); }

__device__ __forceinline__ void lds_barrier() { asm volatile("s_waitcnt lgkmcnt(0)" ::: "memory"); __builtin_amdgcn_s_barrier(); asm volatile("" ::: "memory"); }

#define XB_TMO      128
#define XB_XCNT(j)  (256  + 64 * (j))
#define XB_XSUB(j)  (1280 + 64 * (j))
#define XB_XGEN(j)  (2304 + 64 * (j))
#define XB_TOP      3328
#define XB_TOPGEN   3392
#define XCD_BAR_WORDS 3456
#define XB_SPIN_CAP (1u << 18)
__device__ __forceinline__ unsigned xb_ld(unsigned* p)              { return __hip_atomic_load(p, __ATOMIC_RELAXED, __HIP_MEMORY_SCOPE_AGENT); }
__device__ __forceinline__ unsigned xb_add(unsigned* p, unsigned v) { return __hip_atomic_fetch_add(p, v, __ATOMIC_RELAXED, __HIP_MEMORY_SCOPE_AGENT); }
__device__ __forceinline__ unsigned xb_xcc_id() { return (unsigned)__builtin_amdgcn_s_getreg((3 << 11) | 20) & 0xFu; }
#define XB_SPIN(cond, bar) do { unsigned _sp = 0; while (cond) { __builtin_amdgcn_s_sleep(1); \
    if ((++_sp & 255u) == 0u) { if (xb_ld(&(bar)[XB_TMO])) break; if (_sp > XB_SPIN_CAP) { atomicAdd(&(bar)[XB_TMO], 1u); break; } } } } while (0)
struct XcdBarrier { unsigned* bar; unsigned x; volatile LAS unsigned* st; };
__device__ __forceinline__ XcdBarrier xcd_barrier_post(unsigned* bar, volatile LAS unsigned* st) {
    XcdBarrier b; b.bar = bar; b.x = xb_xcc_id(); b.st = st;
    if (threadIdx.x == 0) (void)xb_add(&bar[XB_XCNT(b.x)], 1u);
    return b;
}
__device__ __forceinline__ void xcd_barrier_complete(unsigned* bar, unsigned x, unsigned& nloc, unsigned& nx) {
    const unsigned G = gridDim.x * gridDim.y * gridDim.z;
    unsigned sum, cnt, mine, sp = 0u;
    for (;;) {
        sum = 0u; cnt = 0u; mine = 0u;
#pragma unroll
        for (unsigned j = 0; j < 16; ++j) { const unsigned c = xb_ld(&bar[XB_XCNT(j)]); sum += c; cnt += (c > 0u) ? 1u : 0u; mine = (j == x) ? c : mine; }
        if (sum == G) break;
        __builtin_amdgcn_s_sleep(1);
        if ((++sp & 255u) == 0u) { if (xb_ld(&bar[XB_TMO])) break; if (sp > XB_SPIN_CAP) { atomicAdd(&bar[XB_TMO], 1u); break; } }
    }
    nloc = mine > 0u ? mine : 1u; nx = cnt > 0u ? cnt : 1u;
}
__device__ __forceinline__ void xcd_barrier(const XcdBarrier& b) {
    asm volatile("s_waitcnt vmcnt(0)" ::: "memory");
    __syncthreads();
    if (threadIdx.x == 0) {
        unsigned* bar = b.bar;
        __builtin_amdgcn_s_waitcnt(0);
        unsigned nloc = b.st[0], nx = b.st[1];
        if (nloc == 0u) { xcd_barrier_complete(bar, b.x, nloc, nx); b.st[0] = nloc; b.st[1] = nx; }
        const unsigned old = xb_add(&bar[XB_XSUB(b.x)], 1u);
        const unsigned gen = old / nloc;
        if (old + 1u == (gen + 1u) * nloc) {
            __builtin_amdgcn_fence(__ATOMIC_RELEASE, "agent");
            asm volatile("s_waitcnt vmcnt(0)" ::: "memory");
            const unsigned og = xb_add(&bar[XB_TOP], 1u);
            const unsigned tg = og / nx;
            if (og + 1u == (tg + 1u) * nx) xb_add(&bar[XB_TOPGEN], 1u);
            else XB_SPIN(xb_ld(&bar[XB_TOPGEN]) == tg, bar);
            __builtin_amdgcn_fence(__ATOMIC_ACQUIRE, "agent");
            xb_add(&bar[XB_XGEN(b.x)], 1u);
            asm volatile("s_waitcnt vmcnt(0)" ::: "memory");
        } else {
            XB_SPIN(xb_ld(&bar[XB_XGEN(b.x)]) == gen, bar);
            __builtin_amdgcn_fence(__ATOMIC_ACQUIRE, "agent");
            asm volatile("s_waitcnt vmcnt(0)" ::: "memory");
        }
    }
    __syncthreads();
}

__host__ __device__ __forceinline__ int lds_byte(int r, int c) { const int st = (r >> 4) * 2 + (c >> 5), rr = r & 15, cc = c & 31, ob = rr * 64 + cc * 2; return st * 1024 + (ob ^ (((ob >> 9) & 1) << 5)); }
__host__ __device__ __forceinline__ void stage_rc(int b, int& R, int& C) { const int st = b / 1024, sb = b % 1024, swz = sb ^ (((sb >> 9) & 1) << 5); R = (st >> 1) * 16 + swz / 64; C = (st & 1) * 32 + (swz % 64) / 2; }
__host__ __device__ __forceinline__ int perm32(int rho) { const int n = rho >> 4, i = rho & 15; return 8 * (i >> 2) + 4 * n + (i & 3); }

struct Unit { int arow, brow, orow, ocol; };

template <class Epi, class Sched, bool GATHER>
__device__ __forceinline__ void gemm_phase(LAS unsigned char* lds, const bf16_t* Abase, const bf16_t* Btbase, const int K, const Sched& S, const Epi& E) {
    const int tid = threadIdx.x, wid = __builtin_amdgcn_readfirstlane(tid >> 6), lane = tid & 63, wr = wid >> 2, wc = wid & 3, fr = lane & 15, fq = lane >> 4;
    const int nt = K / BK;
    unsigned voffA[2], voffB[2];
#pragma unroll
    for (int i = 0; i < 2; ++i) { int R, C; stage_rc(tid * 16 + i * 8192, R, C); const int Rb = Epi::PERM ? ((R & ~31) + perm32(R & 31)) : R;
        voffA[i] = (unsigned)(R * K + C) * 2u; voffB[i] = (unsigned)(Rb * K + C) * 2u; }
    const size_t kstep = (size_t)(BK * 2);
    const size_t hstep = (size_t)HALF * K * 2;
    const unsigned ldsw = (unsigned)wid * 1024u;
    const int aoff = lds_byte(wr * 64 + fr, fq * 8), boff = lds_byte(wc * 32 + fr, fq * 8);
    LAS const int* gtab = (LAS const int*)(lds + GTAB_OFF);
    unsigned goff[2][2];
#define PG8_SA(b, h) (((b) * 2 + (h)) * HTB)
#define PG8_SB(b, h) ((4 + (b) * 2 + (h)) * HTB)
#define PG8_STAGE(bufoff, gbase, voff) do { _Pragma("unroll") for (int _i = 0; _i < 2; ++_i) \
        __builtin_amdgcn_global_load_lds((const unsigned*)((const char*)(gbase) + (voff)[_i]), (LAS unsigned*)(lds + (bufoff) + ldsw + _i * 8192), 16, 0, 0); } while (0)
#define PG8_STAGE_A(bufoff, abase, h) do { if constexpr (GATHER) { PG8_STAGE(bufoff, abase, goff[h]); } else { PG8_STAGE(bufoff, (abase) + (h) * hstep, voffA); } } while (0)
#define PG8_LDA(dst, b, h) do { _Pragma("unroll") for (int m = 0; m < 4; ++m) _Pragma("unroll") for (int k = 0; k < 2; ++k) dst[m][k] = *(const LAS bf16x8*)(lds + PG8_SA(b, h) + aoff + m * 2048 + k * 1024); } while (0)
#define PG8_LDB(dst, b, h) do { _Pragma("unroll") for (int n = 0; n < 2; ++n) _Pragma("unroll") for (int k = 0; k < 2; ++k) dst[n][k] = *(const LAS bf16x8*)(lds + PG8_SB(b, h) + boff + n * 2048 + k * 1024); } while (0)
#define PG8_MMA(ai, bj, At, Bt) do { __builtin_amdgcn_s_setprio(1); _Pragma("unroll") for (int m = 0; m < 4; ++m) _Pragma("unroll") for (int n = 0; n < 2; ++n) _Pragma("unroll") for (int k = 0; k < 2; ++k) \
        acc[ai][bj][m][n] = __builtin_amdgcn_mfma_f32_16x16x32_bf16(Bt[n][k], At[m][k], acc[ai][bj][m][n], 0, 0, 0); __builtin_amdgcn_s_setprio(0); } while (0)
#define PG8_WAIT_V(n) asm volatile("s_waitcnt vmcnt(" #n ")" ::: "memory")
#define PG8_WAIT_L(n) asm volatile("s_waitcnt lgkmcnt(" #n ")" ::: "memory")
#define PG8_BAR __builtin_amdgcn_s_barrier()
#define PG8_SCHED __builtin_amdgcn_sched_barrier(0)
#define PG8_GLOAD(ui_) do { if constexpr (GATHER) { _Pragma("unroll") for (int _i = 0; _i < 2; ++_i) { int _R, _C; stage_rc(tid * 16 + _i * 8192, _R, _C); _Pragma("unroll") for (int _h = 0; _h < 2; ++_h) \
        goff[_h][_i] = (unsigned)(gtab[((ui_) & 3) * 256 + _h * HALF + _R] * K * 2 + _C * 2); } } } while (0)
    Unit cur, nxt; int ui = 0;
    if (!S.next(0, cur)) return;
    if constexpr (GATHER) {
        Unit t;
        for (int j = 0; j < 4; ++j) if (S.next(j, t)) { if (tid < 256) ((LAS int*)(lds + GTAB_OFF))[j * 256 + tid] = S.gidx(t, tid); }
        __syncthreads();
    }
    f32x4 acc[2][2][4][2];
#pragma unroll
    for (int a = 0; a < 2; ++a)
#pragma unroll
        for (int b = 0; b < 2; ++b)
#pragma unroll
            for (int m = 0; m < 4; ++m)
#pragma unroll
                for (int n = 0; n < 2; ++n) acc[a][b][m][n] = (f32x4){0.f, 0.f, 0.f, 0.f};
    bf16x8 At[4][2], B0[2][2], B1[2][2];
    const char* cA = (const char*)Abase + (size_t)cur.arow * K * 2; const char* cB = (const char*)Btbase + (size_t)cur.brow * K * 2;
    PG8_GLOAD(0);
    PG8_STAGE(PG8_SB(0, 0), cB, voffB); PG8_STAGE(PG8_SB(0, 1), cB + hstep, voffB); PG8_STAGE_A(PG8_SA(0, 0), cA, 0); PG8_STAGE_A(PG8_SA(0, 1), cA, 1);
    if (wr == 1) PG8_BAR;
    PG8_WAIT_V(2); PG8_BAR;
    PG8_STAGE(PG8_SB(1, 0), cB + kstep, voffB); PG8_STAGE_A(PG8_SA(1, 0), cA + kstep, 0); PG8_STAGE(PG8_SB(1, 1), cB + hstep + kstep, voffB);
    PG8_WAIT_V(6); PG8_BAR;
    for (;;) {
        const bool has_next = S.next(ui + 1, nxt);
        const char* nA = has_next ? (const char*)Abase + (size_t)nxt.arow * K * 2 : cA; const char* nB = has_next ? (const char*)Btbase + (size_t)nxt.brow * K * 2 : cB;
        for (int t = 0; t < nt; t += 2) {
            const bool last = (t == nt - 2);
            const char* a1 = cA + (size_t)(t + 1) * kstep;
            const char* a2 = last ? nA : cA + (size_t)(t + 2) * kstep; const char* b2 = last ? nB : cB + (size_t)(t + 2) * kstep;
            const char* a3 = a2 + kstep; const char* b3 = b2 + kstep;
            PG8_LDB(B0, 0, 0); PG8_LDB(B1, 0, 1); PG8_SCHED; PG8_LDA(At, 0, 0); PG8_STAGE_A(PG8_SA(1, 1), a1, 1);
            if constexpr (GATHER) { if (last && has_next) PG8_GLOAD(ui + 1); }
            PG8_WAIT_V(8); PG8_WAIT_L(0); PG8_BAR; PG8_MMA(0, 0, At, B0); PG8_MMA(0, 1, At, B1); PG8_BAR; PG8_SCHED;
            PG8_LDA(At, 0, 1); PG8_STAGE(PG8_SB(0, 0), b2, voffB); PG8_STAGE(PG8_SB(0, 1), b2 + hstep, voffB); PG8_STAGE_A(PG8_SA(0, 0), a2, 0);
            PG8_WAIT_V(8); PG8_WAIT_L(0); PG8_BAR; PG8_MMA(1, 0, At, B0); PG8_MMA(1, 1, At, B1); PG8_BAR; PG8_SCHED;
            PG8_LDB(B0, 1, 0); PG8_LDB(B1, 1, 1); PG8_SCHED; PG8_LDA(At, 1, 0); PG8_STAGE_A(PG8_SA(0, 1), a2, 1);
            PG8_WAIT_V(8); PG8_WAIT_L(0); PG8_BAR; PG8_MMA(0, 0, At, B0); PG8_MMA(0, 1, At, B1); PG8_BAR; PG8_SCHED;
            PG8_LDA(At, 1, 1); PG8_STAGE(PG8_SB(1, 0), b3, voffB); PG8_STAGE(PG8_SB(1, 1), b3 + hstep, voffB); PG8_STAGE_A(PG8_SA(1, 0), a3, 0);
            PG8_WAIT_V(8); PG8_WAIT_L(0); PG8_BAR; PG8_MMA(1, 0, At, B0); PG8_MMA(1, 1, At, B1); PG8_BAR; PG8_SCHED;
        }
        if (wr == 0) PG8_BAR;
        E(acc, cur, wr, wc, fr, fq);
        if (!has_next) break;
#pragma unroll
        for (int a = 0; a < 2; ++a)
#pragma unroll
            for (int b = 0; b < 2; ++b)
#pragma unroll
                for (int m = 0; m < 4; ++m)
#pragma unroll
                    for (int n = 0; n < 2; ++n) acc[a][b][m][n] = (f32x4){0.f, 0.f, 0.f, 0.f};
        cur = nxt; cA = nA; cB = nB; ++ui;
        if (wr == 1) PG8_BAR;
    }
    PG8_WAIT_V(0);
    PG8_BAR;
#undef PG8_SA
#undef PG8_SB
#undef PG8_STAGE
#undef PG8_STAGE_A
#undef PG8_LDA
#undef PG8_LDB
#undef PG8_MMA
#undef PG8_WAIT_V
#undef PG8_WAIT_L
#undef PG8_BAR
#undef PG8_SCHED
#undef PG8_GLOAD
}

__device__ __forceinline__ float silu1(float x) { return x * __builtin_amdgcn_rcpf(1.f + __expf(-x)); }
struct EpiSiluMul {
    static constexpr bool PERM = true;
    bf16_t* O; int ldo;
    __device__ __forceinline__ void operator()(const f32x4 (&acc)[2][2][4][2], const Unit& u, int wr, int wc, int fr, int fq) const {
        const int row0 = u.orow + wr * 64 + fr, col0 = u.ocol + wc * 32 + 8 * fq;
#pragma unroll
        for (int ai = 0; ai < 2; ++ai)
#pragma unroll
            for (int m = 0; m < 4; ++m) { bf16_t* rowp = O + (size_t)(row0 + ai * HALF + m * 16) * ldo + col0;
                const f32x4 g0 = acc[ai][0][m][0], g1 = acc[ai][0][m][1], u0 = acc[ai][1][m][0], u1 = acc[ai][1][m][1];
                u32x4 w; w.x = cvt_pk_bf16(silu1(g0[0]) * u0[0], silu1(g0[1]) * u0[1]); w.y = cvt_pk_bf16(silu1(g0[2]) * u0[2], silu1(g0[3]) * u0[3]);
                w.z = cvt_pk_bf16(silu1(g1[0]) * u1[0], silu1(g1[1]) * u1[1]); w.w = cvt_pk_bf16(silu1(g1[2]) * u1[2], silu1(g1[3]) * u1[3]);
                *(u32x4*)rowp = w; }
    }
};
struct EpiRowScale {
    static constexpr bool PERM = true;
    bf16_t* O; int ldo; const float* rowscale;
    __device__ __forceinline__ void operator()(const f32x4 (&acc)[2][2][4][2], const Unit& u, int wr, int wc, int fr, int fq) const {
        const int row0 = u.orow + wr * 64 + fr, col0 = u.ocol + wc * 32 + 8 * fq;
#pragma unroll
        for (int ai = 0; ai < 2; ++ai)
#pragma unroll
            for (int m = 0; m < 4; ++m) { const int row = row0 + ai * HALF + m * 16; const float sc = rowscale[row]; bf16_t* rowp = O + (size_t)row * ldo + col0;
#pragma unroll
                for (int bj = 0; bj < 2; ++bj) { const f32x4 v0 = acc[ai][bj][m][0] * sc, v1 = acc[ai][bj][m][1] * sc;
                    u32x4 w; w.x = cvt_pk_bf16(v0[0], v0[1]); w.y = cvt_pk_bf16(v0[2], v0[3]); w.z = cvt_pk_bf16(v1[0], v1[1]); w.w = cvt_pk_bf16(v1[2], v1[3]);
                    *(u32x4*)(rowp + bj * HALF) = w; } }
    }
};


struct EpiScIn {
    static constexpr bool PERM = true;
    bf16_t* GB; bf16_t* UU;
    __device__ __forceinline__ void operator()(const f32x4 (&acc)[2][2][4][2], const Unit& u, int wr, int wc, int fr, int fq) const {
        const int row0 = u.orow + wr * 64 + fr;
        if (u.ocol < 4) {
            const int col0 = u.ocol * 256 + wc * 32 + 8 * fq;
#pragma unroll
            for (int ai = 0; ai < 2; ++ai)
#pragma unroll
                for (int m = 0; m < 4; ++m) { bf16_t* rowp = GB + (size_t)(row0 + ai * HALF + m * 16) * D + col0;
#pragma unroll
                    for (int bj = 0; bj < 2; ++bj) { const f32x4 v0 = acc[ai][bj][m][0], v1 = acc[ai][bj][m][1];
                        u32x4 w; w.x = cvt_pk_bf16(v0[0], v0[1]); w.y = cvt_pk_bf16(v0[2], v0[3]); w.z = cvt_pk_bf16(v1[0], v1[1]); w.w = cvt_pk_bf16(v1[2], v1[3]);
                        *(u32x4*)(rowp + bj * HALF) = w; } }
        } else {
            const int col0 = (u.ocol - 4) * 128 + wc * 32 + 8 * fq;
#pragma unroll
            for (int ai = 0; ai < 2; ++ai)
#pragma unroll
                for (int m = 0; m < 4; ++m) { bf16_t* rowp = UU + (size_t)(row0 + ai * HALF + m * 16) * D + col0;
                    const f32x4 v0 = acc[ai][0][m][0] * acc[ai][1][m][0], v1 = acc[ai][0][m][1] * acc[ai][1][m][1];
                    u32x4 w; w.x = cvt_pk_bf16(v0[0], v0[1]); w.y = cvt_pk_bf16(v0[2], v0[3]); w.z = cvt_pk_bf16(v1[0], v1[1]); w.w = cvt_pk_bf16(v1[2], v1[3]);
                    *(u32x4*)rowp = w; }
        }
    }
};
template <bool BASE_BF16>
struct EpiResid {
    static constexpr bool PERM = true;
    const void* base; bf16_t* out; const float* gada;
    __device__ __forceinline__ void operator()(const f32x4 (&acc)[2][2][4][2], const Unit& u, int wr, int wc, int fr, int fq) const {
        const int row0 = u.orow + wr * 64 + fr, col0 = u.ocol + wc * 32 + 8 * fq;
        const float* g = gada + (size_t)(u.orow >> 13) * 6 * D + col0;
        f32x4 gv[2][2];
#pragma unroll
        for (int bj = 0; bj < 2; ++bj)
#pragma unroll
            for (int n = 0; n < 2; ++n) gv[bj][n] = *(const f32x4*)(g + bj * HALF + n * 4);
#pragma unroll
        for (int ai = 0; ai < 2; ++ai)
#pragma unroll
            for (int m = 0; m < 4; ++m) { const size_t off = (size_t)(row0 + ai * HALF + m * 16) * D + col0;
#pragma unroll
                for (int bj = 0; bj < 2; ++bj) {
                    f32x4 b0, b1;
                    if constexpr (BASE_BF16) { const u32x4 bw = *(const u32x4*)((const bf16_t*)base + off + bj * HALF);
                        b0 = (f32x4){bf_lo(bw.x), bf_hi(bw.x), bf_lo(bw.y), bf_hi(bw.y)}; b1 = (f32x4){bf_lo(bw.z), bf_hi(bw.z), bf_lo(bw.w), bf_hi(bw.w)}; }
                    else { b0 = *(const f32x4*)((const float*)base + off + bj * HALF); b1 = *(const f32x4*)((const float*)base + off + bj * HALF + 4); }
                    const f32x4 v0 = b0 + gv[bj][0] * acc[ai][bj][m][0], v1 = b1 + gv[bj][1] * acc[ai][bj][m][1];
                    u32x4 w; w.x = cvt_pk_bf16(v0[0], v0[1]); w.y = cvt_pk_bf16(v0[2], v0[3]); w.z = cvt_pk_bf16(v1[0], v1[1]); w.w = cvt_pk_bf16(v1[2], v1[3]);
                    *(u32x4*)(out + off + bj * HALF) = w; } }
    }
};

struct EpiProj {
    static constexpr bool PERM = true;
    bf16_t* QKV; bf16_t* Z; bf16_t* POOL; bf16_t* CKV;
    __device__ __forceinline__ void operator()(const f32x4 (&acc)[2][2][4][2], const Unit& u, int wr, int wc, int fr, int fq) const {
        bf16_t* base; int ld;
        if (u.ocol < 6) { base = QKV + (size_t)u.orow * 1536 + u.ocol * 256; ld = 1536; }
        else if (u.ocol < 8) { base = Z + (size_t)u.orow * 512 + (u.ocol - 6) * 256; ld = 512; }
        else if (u.ocol < 10) { base = POOL + (size_t)u.orow * 512 + (u.ocol - 8) * 256; ld = 512; }
        else { base = CKV + (size_t)(u.orow - M_LAT) * 1024 + (u.ocol - 16) * 256; ld = 1024; }
        base += (size_t)(wr * 64 + fr) * ld + wc * 32 + 8 * fq;
#pragma unroll
        for (int ai = 0; ai < 2; ++ai)
#pragma unroll
            for (int m = 0; m < 4; ++m) { bf16_t* rowp = base + (size_t)(ai * HALF + m * 16) * ld;
#pragma unroll
                for (int bj = 0; bj < 2; ++bj) { const f32x4 v0 = acc[ai][bj][m][0], v1 = acc[ai][bj][m][1];
                    u32x4 w; w.x = cvt_pk_bf16(v0[0], v0[1]); w.y = cvt_pk_bf16(v0[2], v0[3]); w.z = cvt_pk_bf16(v1[0], v1[1]); w.w = cvt_pk_bf16(v1[2], v1[3]);
                    *(u32x4*)(rowp + bj * HALF) = w; } }
    }
};
struct SchedProj {
    int vcu, G;
    __device__ __forceinline__ bool next(int i, Unit& u) const {
        const int L = i * G + vcu; if (L >= 1296) return false;
        if (L < 1280) { const int pm = L / 10, pn = L % 10; u.arow = pm * 256; u.brow = pn * 256; u.orow = pm * 256; u.ocol = pn; }
        else { const int q = L - 1280, pm = q >> 2, pn = q & 3; u.arow = M_LAT + pm * 256; u.brow = 512 + pn * 256; u.orow = M_LAT + pm * 256; u.ocol = 16 + pn; }
        return true;
    }
    __device__ __forceinline__ int gidx(const Unit&, int) const { return 0; }
};

template <int NT, int COLMUL>
struct SchedDense {
    int vcu, G, nunits;
    __device__ __forceinline__ bool next(int i, Unit& u) const {
        const int L = i * G + vcu; if (L >= nunits) return false;
        const int pm = L / NT, pn = L % NT;
        u.arow = pm * 256; u.brow = pn * 256; u.orow = pm * 256; u.ocol = pn * COLMUL;
        return true;
    }
    __device__ __forceinline__ int gidx(const Unit&, int) const { return 0; }
};

constexpr size_t MiB = 1u << 20;
constexpr size_t WS_CTL = 0;
constexpr size_t WS_ADA = 1 * MiB;
constexpr size_t WS_AFF = 2 * MiB;
constexpr size_t WS_IDX = 4 * MiB;
constexpr size_t WS_GATE = 4 * MiB + 512 * 1024;
constexpr size_t WS_SEL = 5 * MiB;
constexpr size_t WS_GATES = 7 * MiB;
constexpr size_t WS_WGU = 16 * MiB;
constexpr size_t WS_WDN = 80 * MiB;
constexpr size_t WS_SCIN = 112 * MiB;
constexpr size_t WS_SCOUT = 118 * MiB;
constexpr size_t WS_WIN = 120 * MiB;
constexpr size_t WS_WOUT = 125 * MiB;
constexpr size_t WS_TMP = 128 * MiB;
constexpr size_t WS_ACT = WS_TMP;
constexpr size_t WS_QKV = 194 * MiB;
constexpr size_t WS_Z = 290 * MiB;
constexpr size_t WS_POOL = 322 * MiB;
constexpr size_t WS_CKV = 354 * MiB;
constexpr size_t WS_QN = 356 * MiB;
constexpr size_t WS_KT = 389 * MiB;
constexpr size_t WS_NWK = 422 * MiB;
constexpr size_t WS_SCL = 488 * MiB;
constexpr size_t WS_XLB = WS_NWK;
constexpr size_t WS_OF = WS_QKV;
constexpr size_t WS_OB = WS_QKV + 32 * MiB;
constexpr size_t WS_HID = 194 * MiB;
constexpr size_t WS_Y = 258 * MiB;
constexpr size_t WS_GB = WS_HID;
constexpr size_t WS_UU = WS_Y;
constexpr size_t WS_END = 512 * MiB;
constexpr int CW_BAR = 4096;
#ifndef PROBE_SEL
#define PROBE_SEL -1
#endif
#ifndef PROBE_WAVE
#define PROBE_WAVE 0
#endif
constexpr int CW_TS = 32768;
constexpr int CW_PROG = 16384;

struct Args {
    const float* in[24]; float* out; unsigned char* ws; int ph_lo, ph_hi, li, pad;
};

struct Frame {
    LAS unsigned char* lds; int tid, lane, wave, G, vcu;
};

__device__ __forceinline__ void transpose_item(const float* W, int K, int ldn, int n0, int k0, bf16_t* WT, int drow0, LAS float* scr, int lane, int dcol0 = 0) {
    float tv[32];
#pragma unroll
    for (int i = 0; i < 32; ++i) tv[i] = __builtin_nontemporal_load(W + (size_t)(k0 + 2 * i + (lane >> 5)) * ldn + n0 + (lane & 31));
#pragma unroll
    for (int i = 0; i < 32; ++i) scr[(2 * i + (lane >> 5)) * 33 + (lane & 31)] = tv[i];
    asm volatile("s_waitcnt lgkmcnt(0)" ::: "memory");
    const int c = lane & 7;
#pragma unroll
    for (int j = 0; j < 4; ++j) { const int n = (lane >> 3) + 8 * j; const LAS float* s = scr + (8 * c) * 33 + n;
        u32x4 o; o.x = pk2(s[0 * 33], s[1 * 33]); o.y = pk2(s[2 * 33], s[3 * 33]); o.z = pk2(s[4 * 33], s[5 * 33]); o.w = pk2(s[6 * 33], s[7 * 33]);
        __builtin_nontemporal_store(o, (u32x4*)(WT + (size_t)(drow0 + n) * K + dcol0 + k0 + 8 * c)); }
    asm volatile("s_waitcnt lgkmcnt(0)" ::: "memory");
}

struct SchedMoeUp {
    int vcu, layer; const int* idx;
    __device__ __forceinline__ bool next(int i, Unit& u) const {
        const int L = i * 256 + vcu; if (L >= 1024) return false;
        const int g = L >> 4, pm = (L >> 2) & 3, pn = L & 3, b = g >> 4, e = g & 15;
        u.arow = b * SEQ; u.brow = ((layer * NE + e) * 4 + pn) * 256; u.orow = g * CAP + pm * 256; u.ocol = pn * 128;
        return true;
    }
    __device__ __forceinline__ int gidx(const Unit& u, int r) const { return idx[u.orow + r]; }
};
struct SchedMoeDown {
    int vcu, layer;
    __device__ __forceinline__ bool next(int i, Unit& u) const {
        const int L = i * 256 + vcu; if (L >= 1024) return false;
        const int g = L >> 4, pm = (L >> 2) & 3, pn = L & 3, e = g & 15;
        u.arow = g * CAP + pm * 256; u.brow = ((layer * NE + e) * 4 + pn) * 256; u.orow = g * CAP + pm * 256; u.ocol = pn * 256;
        return true;
    }
    __device__ __forceinline__ int gidx(const Unit&, int) const { return 0; }
};

__device__ __forceinline__ float wsum(float v) {
#pragma unroll
    for (int o = 1; o < 64; o <<= 1) v += __shfl_xor(v, o);
    return v;
}

template <int MODE>
__device__ __forceinline__ void ph_norm16(const Frame& F, const void* xlv, const float* xctx, bf16_t* act, const float* gw, const float* ada  , const float* w16, int ldw,
                                          float* out16, const float* a_log, const float* dt_bias, int* selfill = nullptr) {
    constexpr int WLD = 1032;
    LAS bf16_t* wt = (LAS bf16_t*)F.lds;
    LAS float* mod = (LAS float*)(F.lds + 16 * WLD * 2);
    if (selfill) { u32x4* p = (u32x4*)selfill; const u32x4 m1 = (u32x4){~0u, ~0u, ~0u, ~0u};
        for (int i = F.vcu * NTHREADS + F.tid; i < M_LAT * NE / 4; i += F.G * NTHREADS) p[i] = m1; }
    { float wv[32];
#pragma unroll
        for (int q = 0; q < 32; ++q) { const int i = F.tid + NTHREADS * q; wv[q] = w16[(size_t)(i >> 4) * ldw + (i & 15)]; }
#pragma unroll
        for (int q = 0; q < 32; ++q) { const int i = F.tid + NTHREADS * q; wt[(i & 15) * WLD + (i >> 4)] = (bf16_t)f2bf(wv[q]); } }
#pragma unroll
    for (int i = F.tid; i < 5 * D; i += NTHREADS) { const int b = i >> 10, c = i & (D - 1);
        const float* sh = ada + (size_t)b * 6 * D + (MODE == 0 ? 3 * D : 0);
        mod[(b * 2) * D + c] = gw[c] * (sh[D + c] + 1.f); mod[(b * 2 + 1) * D + c] = sh[c]; }
    __syncthreads();
    const int gw_ = F.vcu * NWAVES + F.wave, NGW = F.G * NWAVES, lane = F.lane, rr = lane & 15, kq = lane >> 4;
    const int ntiles = MODE == 0 ? M_LAT / 16 : M_LAT / 16 + BATCH * CTX / 4;
    for (int tw = gw_; tw < ntiles; tw += NGW) {
        const bool quart = MODE == 1 && tw >= M_LAT / 16;
        const int r0 = quart ? M_LAT + 4 * (tw - M_LAT / 16) : tw * 16, row = r0 + (quart ? (rr & 3) : rr);
        const bool lat = r0 < M_LAT;
        const int b = lat ? (r0 >> 13) : 4;
        const char* src; size_t rowbytes;
        if constexpr (MODE == 0) { src = (const char*)xlv + (size_t)row * D * 2 + kq * 16; rowbytes = 0; }
        else { src = (const char*)(lat ? (const float*)xlv + (size_t)row * D : xctx + (size_t)(row - M_LAT) * D) + kq * 32; rowbytes = 0; }
        (void)rowbytes;
        u32x4 xq[32];
        float ss = 0.f;
        if constexpr (MODE == 0) {
#pragma unroll
            for (int s = 0; s < 32; ++s) xq[s] = *(const u32x4*)(src + s * 64);
#pragma unroll
            for (int s = 0; s < 32; ++s)
#pragma unroll
                for (int q = 0; q < 4; ++q) { const float a = bf_lo(xq[s][q]), c2 = bf_hi(xq[s][q]); ss += a * a + c2 * c2; }
        } else {
#pragma unroll
            for (int s0 = 0; s0 < 32; s0 += 4) { f32x4 xv[4][2];
#pragma unroll
                for (int s = 0; s < 4; ++s) { xv[s][0] = *(const f32x4*)(src + (s0 + s) * 128); xv[s][1] = *(const f32x4*)(src + (s0 + s) * 128 + 16); }
#pragma unroll
                for (int s = 0; s < 4; ++s) { const f32x4 a = xv[s][0], c2 = xv[s][1];
                    ss += (a.x * a.x + a.y * a.y) + (a.z * a.z + a.w * a.w) + (c2.x * c2.x + c2.y * c2.y) + (c2.z * c2.z + c2.w * c2.w);
                    xq[s0 + s] = (u32x4){cvt_pk_bf16(a.x, a.y), cvt_pk_bf16(a.z, a.w), cvt_pk_bf16(c2.x, c2.y), cvt_pk_bf16(c2.z, c2.w)}; } }
        }
        ss += __shfl_xor(ss, 16); ss += __shfl_xor(ss, 32);
        const float rs = rsqrtf(ss * (1.f / D) + EPS);
#pragma unroll
        for (int s = 0; s < 32; ++s) asm volatile("" : "+v"(xq[s]));
        f32x4 acc = (f32x4){0.f, 0.f, 0.f, 0.f};
        const LAS float* mAp = mod + (b * 2) * D + kq * 8; const LAS float* mBp = mAp + D;
        const LAS bf16_t* wp = wt + rr * WLD + kq * 8;
        bf16_t* dst = act + (size_t)row * D + kq * 8;
#pragma unroll
        for (int s = 0; s < 32; ++s) {
            if ((s & 1) == 0) asm volatile("" : "+v"(mAp), "+v"(mBp), "+v"(wp), "+v"(dst));
            const u32x4 w = xq[s];
            const f32x4 a0 = *(const LAS f32x4*)(mAp + s * 32), a1 = *(const LAS f32x4*)(mAp + s * 32 + 4);
            const f32x4 b0 = *(const LAS f32x4*)(mBp + s * 32), b1 = *(const LAS f32x4*)(mBp + s * 32 + 4);
            const float h0 = bf_lo(w.x) * rs * a0.x + b0.x, h1 = bf_hi(w.x) * rs * a0.y + b0.y, h2 = bf_lo(w.y) * rs * a0.z + b0.z, h3 = bf_hi(w.y) * rs * a0.w + b0.w;
            const float h4 = bf_lo(w.z) * rs * a1.x + b1.x, h5 = bf_hi(w.z) * rs * a1.y + b1.y, h6 = bf_lo(w.w) * rs * a1.z + b1.z, h7 = bf_hi(w.w) * rs * a1.w + b1.w;
            u32x4 hw; hw.x = cvt_pk_bf16(h0, h1); hw.y = cvt_pk_bf16(h2, h3); hw.z = cvt_pk_bf16(h4, h5); hw.w = cvt_pk_bf16(h6, h7);
            if (!quart || rr < 4) *(u32x4*)(dst + s * 32) = hw;
            const bf16x8 bfrag = *(const LAS bf16x8*)(wp + s * 32);
            acc = __builtin_amdgcn_mfma_f32_16x16x32_bf16(__builtin_bit_cast(bf16x8, hw), bfrag, acc, 0, 0, 0);
        }
        if constexpr (MODE == 0) {
            f32x4 mx = acc;
#pragma unroll
            for (int o = 1; o < 16; o <<= 1) { mx.x = fmaxf(mx.x, __shfl_xor(mx.x, o)); mx.y = fmaxf(mx.y, __shfl_xor(mx.y, o)); mx.z = fmaxf(mx.z, __shfl_xor(mx.z, o)); mx.w = fmaxf(mx.w, __shfl_xor(mx.w, o)); }
            f32x4 ex; ex.x = __expf(acc.x - mx.x); ex.y = __expf(acc.y - mx.y); ex.z = __expf(acc.z - mx.z); ex.w = __expf(acc.w - mx.w);
            f32x4 sm = ex;
#pragma unroll
            for (int o = 1; o < 16; o <<= 1) { sm.x += __shfl_xor(sm.x, o); sm.y += __shfl_xor(sm.y, o); sm.z += __shfl_xor(sm.z, o); sm.w += __shfl_xor(sm.w, o); }
            const int t = (r0 & (SEQ - 1)) + 4 * kq;
            *(f32x4*)(out16 + ((size_t)b * NE + rr) * SEQ + t) = (f32x4){ex.x / sm.x, ex.y / sm.y, ex.z / sm.z, ex.w / sm.w};
        } else {
            if (!quart || kq == 0)
#pragma unroll
            for (int q = 0; q < 4; ++q) { const float x = acc[q]; float o;
                if (rr < 8) o = 1.f / (1.f + __expf(-x));
                else { const float y = x + dt_bias[rr - 8]; const float sp = y > 20.f ? y : log1pf(__expf(y)); o = -__expf(a_log[rr - 8]) * sp; }
                out16[(size_t)(r0 + 4 * kq + q) * 16 + rr] = o; }
        }
    }
    __syncthreads();
}

__device__ __forceinline__ void ph_topk(const Frame& F, const float* aff, int* idx, float* gate, int* sel) {
    LAS unsigned* keys = (LAS unsigned*)F.lds;
    LAS unsigned* hist = keys + SEQ;
    LAS unsigned* cg = hist + 256; LAS unsigned* ce = cg + 512;
    LAS unsigned* shv = ce + 512;
    const int tid = F.tid;
    for (int item = F.vcu; item < BATCH * NE; item += F.G) {
        const int b = item >> 4, e = item & 15;
        for (int i = tid; i < SEQ; i += NTHREADS) keys[i] = __float_as_uint(aff[(size_t)item * SEQ + i]);
        if (tid == 0) { shv[0] = 0u; shv[1] = CAP; }
        lds_barrier();
        unsigned mask = 0u;
        for (int pass = 0; pass < 4; ++pass) {
            const int shift = 24 - 8 * pass;
            if (tid < 256) hist[tid] = 0u;
            lds_barrier();
            const unsigned prefix = shv[0];
            for (int i = tid; i < SEQ; i += NTHREADS) { const unsigned kx = keys[i]; if ((kx & mask) == prefix) __hip_atomic_fetch_add(&hist[(kx >> shift) & 255u], 1u, __ATOMIC_RELAXED, __HIP_MEMORY_SCOPE_WORKGROUP); }
            lds_barrier();
            unsigned sfx = 0u;
            if (tid < 256) { sfx = hist[tid];
#pragma unroll
                for (int o2 = 1; o2 < 64; o2 <<= 1) { const unsigned x = __shfl_down(sfx, o2); if ((tid & 63) + o2 < 64) sfx += x; }
                if ((tid & 63) == 0) cg[tid >> 6] = sfx; }
            lds_barrier();
            if (tid < 256) { for (int w2 = (tid >> 6) + 1; w2 < 4; ++w2) sfx += cg[w2];
                const unsigned need = shv[1]; unsigned above = __shfl_down(sfx, 1); if ((tid & 63) == 63) { above = 0u; for (int w2 = (tid >> 6) + 1; w2 < 4; ++w2) above += cg[w2]; }
                if (sfx >= need && above < need) { shv[2] = prefix | ((unsigned)tid << shift); shv[3] = need - above; } }
            lds_barrier();
            if (tid == 0) { shv[0] = shv[2]; shv[1] = shv[3]; }
            mask |= 0xFFu << shift;
            lds_barrier();
        }
        const unsigned T = shv[0], need = shv[1];
        unsigned ng = 0u, nq = 0u; unsigned kk16[16];
#pragma unroll
        for (int q = 0; q < 4; ++q) { const u32x4 k4 = *(const LAS u32x4*)(keys + tid * 16 + 4 * q); kk16[4 * q] = k4.x; kk16[4 * q + 1] = k4.y; kk16[4 * q + 2] = k4.z; kk16[4 * q + 3] = k4.w; }
#pragma unroll
        for (int j = 0; j < 16; ++j) { const unsigned kx = kk16[j]; ng += kx > T; nq += kx == T; }
        unsigned ig = ng, iq = nq;
#pragma unroll
        for (int o2 = 1; o2 < 64; o2 <<= 1) { const unsigned xg = __shfl_up(ig, o2), xq = __shfl_up(iq, o2); if ((tid & 63) >= o2) { ig += xg; iq += xq; } }
        if ((tid & 63) == 63) { cg[tid >> 6] = ig; ce[tid >> 6] = iq; }
        lds_barrier();
        unsigned g0 = ig - ng, q0 = iq - nq;
        for (int w2 = 0; w2 < (tid >> 6); ++w2) { g0 += cg[w2]; q0 += ce[w2]; }
#pragma unroll
        for (int j = 0; j < 16; ++j) { const int t = tid * 16 + j; const unsigned kx = kk16[j]; int slot = -1;
            if (kx > T) { slot = (int)(g0 + (q0 < need ? q0 : need)); ++g0; }
            else if (kx == T) { if (q0 < need) slot = (int)(g0 + q0); ++q0; }
            if (slot >= 0) { sel[((size_t)b * SEQ + t) * NE + e] = slot; idx[item * CAP + slot] = t; gate[item * CAP + slot] = __uint_as_float(kx); } }
        lds_barrier();
    }
}

template <bool FINAL>
__device__ __forceinline__ void ph_combine(const Frame& F, bf16_t* xlb, float* outf, const bf16_t* y, const int* sel, const float* ada  , const float* gwn, const float* ada_next, bf16_t* act) {
    const int gw_ = F.vcu * NWAVES + F.wave, NGW = F.G * NWAVES, lane = F.lane;
    int curb = -1; f32x4 g2v[4], mA[4], mB[4];
#pragma unroll
    for (int j = 0; j < 4; ++j) { g2v[j] = (f32x4){0.f, 0.f, 0.f, 0.f}; mA[j] = g2v[j]; mB[j] = g2v[j]; }
    int nslot = -1; u32x2 nx[4];
    if (gw_ < M_LAT) { nslot = lane < NE ? sel[(size_t)gw_ * NE + lane] : -1; const u32x2* xr0 = (const u32x2*)(xlb + (size_t)gw_ * D) + lane;
#pragma unroll
        for (int j = 0; j < 4; ++j) nx[j] = xr0[64 * j]; }
    for (int r = gw_; r < M_LAT; r += NGW) {
        const int b = r >> 13;
        const int myslot = nslot; f32x4 xv[4];
#pragma unroll
        for (int j = 0; j < 4; ++j) xv[j] = (f32x4){bf_lo(nx[j].x), bf_hi(nx[j].x), bf_lo(nx[j].y), bf_hi(nx[j].y)};
        { const int rn = r + NGW; if (rn < M_LAT) { nslot = lane < NE ? sel[(size_t)rn * NE + lane] : -1; const u32x2* xrn = (const u32x2*)(xlb + (size_t)rn * D) + lane;
#pragma unroll
              for (int j = 0; j < 4; ++j) nx[j] = xrn[64 * j]; } }
        if (b != curb) { curb = b; const float* g2 = ada + (size_t)b * 6 * D + 5 * D;
#pragma unroll
            for (int j = 0; j < 4; ++j) { const int c = 256 * j + 4 * lane; g2v[j] = *(const f32x4*)(g2 + c);
                const f32x4 g4 = *(const f32x4*)(gwn + c);
                if constexpr (FINAL) { mA[j] = g4; } else { const float* sh = ada_next + (size_t)b * 6 * D; mA[j] = g4 * (*(const f32x4*)(sh + D + c) + 1.f); mB[j] = *(const f32x4*)(sh + c); } } }
        f32x4 a[4];
#pragma unroll
        for (int j = 0; j < 4; ++j) a[j] = (f32x4){0.f, 0.f, 0.f, 0.f};
        unsigned mask = (unsigned)(__ballot(myslot >= 0) & 0xFFFFull);
        while (mask) {
            const bf16_t* rp[4]; float wv[4];
#pragma unroll
            for (int q = 0; q < 4; ++q) { const bool ok = mask != 0u; const int e = ok ? __builtin_ctz(mask) : 0; mask &= mask - 1u;
                const int s = __builtin_amdgcn_readlane(myslot, e);
                rp[q] = ok ? y + ((size_t)(b * NE + e) * CAP + s) * D : y; wv[q] = ok ? 1.f : 0.f; }
            u32x2 w[4][4];
#pragma unroll
            for (int q = 0; q < 4; ++q)
#pragma unroll
                for (int j = 0; j < 4; ++j) w[q][j] = ((const u32x2*)rp[q] + lane)[64 * j];
#pragma unroll
            for (int q = 0; q < 4; ++q)
#pragma unroll
                for (int j = 0; j < 4; ++j) { a[j].x += wv[q] * bf_lo(w[q][j].x); a[j].y += wv[q] * bf_hi(w[q][j].x); a[j].z += wv[q] * bf_lo(w[q][j].y); a[j].w += wv[q] * bf_hi(w[q][j].y); }
        }
        f32x4 v[4]; float s = 0.f;
#pragma unroll
        for (int j = 0; j < 4; ++j) { v[j] = xv[j] + g2v[j] * a[j]; s += (v[j].x * v[j].x + v[j].y * v[j].y) + (v[j].z * v[j].z + v[j].w * v[j].w); }
        const float rs = rsqrtf(wsum(s) * (1.f / D) + EPS);
        if constexpr (FINAL) {
            f32x4* xr = (f32x4*)(outf + (size_t)r * D) + lane;
#pragma unroll
            for (int j = 0; j < 4; ++j) xr[64 * j] = v[j] * rs * mA[j];
        } else {
            unsigned long long* x8 = (unsigned long long*)(xlb + (size_t)r * D) + lane;
            unsigned long long* o8 = (unsigned long long*)(act + (size_t)r * D) + lane;
#pragma unroll
            for (int j = 0; j < 4; ++j) { x8[64 * j] = (unsigned long long)pk2(v[j].x, v[j].y) | ((unsigned long long)pk2(v[j].z, v[j].w) << 32);
                const f32x4 o = v[j] * rs * mA[j] + mB[j];
                o8[64 * j] = (unsigned long long)pk2(o.x, o.y) | ((unsigned long long)pk2(o.z, o.w) << 32); }
        }
    }
}

__device__ __forceinline__ void ph_sc_glue(const Frame& F, const bf16_t* gb, const bf16_t* uu, const float* cw  , bf16_t* act) {
    const int gw_ = F.vcu * NWAVES + F.wave, NGW = F.G * NWAVES, lane = F.lane;
    float w0[16], w1[16], w2[16];
#pragma unroll
    for (int hh = 0; hh < 2; ++hh)
#pragma unroll
        for (int q = 0; q < 8; ++q) { const int c = hh * 512 + 8 * lane + q; w0[hh * 8 + q] = cw[c]; w1[hh * 8 + q] = cw[D + c]; w2[hh * 8 + q] = cw[2 * D + c]; }
    const u32x4 zero4 = (u32x4){0u, 0u, 0u, 0u};
    for (int blk = gw_; blk < M_LAT / 16; blk += NGW) {
        const int r0 = blk * 16, t0 = r0 & (SEQ - 1);
        u32x4 up[2], uc[2];
#pragma unroll
        for (int hh = 0; hh < 2; ++hh) { const int c = hh * 512 + 8 * lane;
            up[hh] = t0 > 0 ? *(const u32x4*)(uu + (size_t)(r0 - 1) * D + c) : zero4; uc[hh] = *(const u32x4*)(uu + (size_t)r0 * D + c); }
#pragma unroll 1
        for (int i0 = 0; i0 < 16; i0 += 4) {
            u32x4 gq[4][2], un[4][2];
#pragma unroll
            for (int i = 0; i < 4; ++i)
#pragma unroll
                for (int hh = 0; hh < 2; ++hh) { const int r = r0 + i0 + i, c = hh * 512 + 8 * lane;
                    gq[i][hh] = *(const u32x4*)(gb + (size_t)r * D + c);
                    un[i][hh] = (t0 + i0 + i + 1 < SEQ) ? *(const u32x4*)(uu + (size_t)(r + 1) * D + c) : zero4; }
#pragma unroll
            for (int i = 0; i < 4; ++i) {
#pragma unroll
                for (int hh = 0; hh < 2; ++hh) {
                    u32x4 o;
#pragma unroll
                    for (int q = 0; q < 4; ++q) {
                        const float lo = bf_lo(gq[i][hh][q]) * (w0[hh * 8 + 2 * q] * bf_lo(up[hh][q]) + w1[hh * 8 + 2 * q] * bf_lo(uc[hh][q]) + w2[hh * 8 + 2 * q] * bf_lo(un[i][hh][q]));
                        const float hi = bf_hi(gq[i][hh][q]) * (w0[hh * 8 + 2 * q + 1] * bf_hi(up[hh][q]) + w1[hh * 8 + 2 * q + 1] * bf_hi(uc[hh][q]) + w2[hh * 8 + 2 * q + 1] * bf_hi(un[i][hh][q]));
                        o[q] = pk2(lo, hi);
                    }
                    *(u32x4*)(act + (size_t)(r0 + i0 + i) * D + hh * 512 + 8 * lane) = o;
                    up[hh] = uc[hh]; uc[hh] = un[i][hh];
                }
            }
        }
    }
}

constexpr int NSLOT = 132;
constexpr int NCHAIN = BATCH * NH;
__device__ __forceinline__ int kperm(int s, int g, int j) { return 16 * (2 * s + (j >> 2)) + 4 * g + (j & 3); }

struct ScanPtrs { unsigned char* QN; unsigned char* KT; unsigned char* NWK; unsigned char* QK; unsigned char* U; float* SCL; };
__device__ __forceinline__ size_t so_shared(int chain, int slot) { return ((size_t)chain * NSLOT + slot) * 16384; }
__device__ __forceinline__ size_t so_dir(int dir, int chain, int slot) { return (((size_t)dir * NCHAIN + chain) * NSLOT + slot); }


__device__ __forceinline__ f32x4 mm16(const LAS float* A, const LAS float* B, f32x4 acc, int rr, int kq) {
#pragma unroll
    for (int t = 0; t < 4; ++t) acc = __builtin_amdgcn_mfma_f32_16x16x4f32(A[rr * 17 + 4 * t + kq], B[(4 * t + kq) * 17 + rr], acc, 0, 0, 0);
    return acc;
}
__device__ __forceinline__ f32x4 ld16(const LAS float* C, int rr, int kq) { return (f32x4){C[(4 * kq + 0) * 17 + rr], C[(4 * kq + 1) * 17 + rr], C[(4 * kq + 2) * 17 + rr], C[(4 * kq + 3) * 17 + rr]}; }
__device__ __forceinline__ void st16(LAS float* C, f32x4 v, int rr, int kq) {
#pragma unroll
    for (int r = 0; r < 4; ++r) C[(4 * kq + r) * 17 + rr] = v[r];
}

__device__ __forceinline__ void ph_chunk_prep(const Frame& F, const bf16_t* QKV, const bf16_t* CKV, const float* GATES, const float* cw  , const ScanPtrs P) {
    LAS unsigned char* L = F.lds;
    LAS bf16_t* kn = (LAS bf16_t*)(L);
    LAS bf16_t* qn = (LAS bf16_t*)(L + 17408);
    LAS bf16_t* vT = (LAS bf16_t*)(L + 34816);
    LAS bf16_t* knT = (LAS bf16_t*)(L + 53376);
    LAS float* KK = (LAS float*)(L + 71936);
    LAS float* QKr = (LAS float*)(L + 89344);
    LAS bf16_t* XU = (LAS bf16_t*)(L + 71936);
    LAS bf16_t* XW = (LAS bf16_t*)(L + 71936 + 18432);
    LAS float* NBk = (LAS float*)(L + 108800);
    LAS float* XBk = (LAS float*)(L + 108800 + 21760);
    LAS float* TBk = (LAS float*)(L + 108800 + 43520);
    LAS float* SCRq = (LAS float*)(L + 17408);
    LAS float* gamP = (LAS float*)(L + 108800 + 52224);
    LAS float* betP = gamP + 128;
    LAS float* begP = gamP + 256;
    static_assert(108800 + 52224 + 1536 <= MISC_OFF, "E3 LDS map");
    const int wave = F.wave;
    for (int item = F.vcu; item < NCHAIN * NSLOT; item += F.G) {
        int tid = F.tid; asm volatile("" : "+v"(tid));
        const int lane = tid & 63;
        const int chain = item / NSLOT, slot = item % NSLOT, b = chain >> 2, h = chain & 3;
        const bool isctx = slot < 4;
        const int Lseq = isctx ? CTX : SEQ, t0 = isctx ? slot * 64 : (slot - 4) * 64;
        {
            const int i = tid >> 3, cg = tid & 7, t = t0 + i;
            const bf16_t* src; int ld, qoff, koff, voff;
            if (isctx) { src = CKV + (size_t)(b * CTX) * 1024; ld = 1024; qoff = -1; koff = h * 128; voff = 512 + h * 128; }
            else { src = QKV + (size_t)(b * SEQ) * 1536; ld = 1536; qoff = h * 128; koff = 512 + h * 128; voff = 1024 + h * 128; }
            float o[3][16];
#pragma unroll
            for (int w = 0; w < 3; ++w) {
                const int off = w == 0 ? qoff : (w == 1 ? koff : voff);
                if (off < 0) {
#pragma unroll
                    for (int c = 0; c < 16; ++c) o[w][c] = 0.f;
                    continue;
                }
                const int wcol = w * 512 + h * 128 + cg * 16;
#pragma unroll
                for (int c = 0; c < 16; ++c) o[w][c] = 0.f;
#pragma unroll
                for (int tap = 0; tap < 3; ++tap) {
                    const int tt = t + tap - 1;
                    if (tt < 0 || tt >= Lseq) continue;
                    const u32x4 a0 = *(const u32x4*)(src + (size_t)tt * ld + off + cg * 16), a1 = *(const u32x4*)(src + (size_t)tt * ld + off + cg * 16 + 8);
                    const float* wp = cw + tap * 1536 + wcol;
#pragma unroll
                    for (int q = 0; q < 4; ++q) { o[w][2 * q] += wp[2 * q] * bf_lo(a0[q]); o[w][2 * q + 1] += wp[2 * q + 1] * bf_hi(a0[q]);
                        o[w][8 + 2 * q] += wp[8 + 2 * q] * bf_lo(a1[q]); o[w][8 + 2 * q + 1] += wp[8 + 2 * q + 1] * bf_hi(a1[q]); }
                }
#pragma unroll
                for (int c = 0; c < 16; ++c) o[w][c] = silu1(o[w][c]);
            }
            float sq = 0.f, sk = 0.f;
#pragma unroll
            for (int c = 0; c < 16; ++c) { sq += o[0][c] * o[0][c]; sk += o[1][c] * o[1][c]; }
            sq += __shfl_xor(sq, 1); sq += __shfl_xor(sq, 2); sq += __shfl_xor(sq, 4);
            sk += __shfl_xor(sk, 1); sk += __shfl_xor(sk, 2); sk += __shfl_xor(sk, 4);
            const float rq = rsqrtf(sq + EPS) * 0.08838834764831845f, rk = rsqrtf(sk + EPS);
#pragma unroll
            for (int c = 0; c < 16; c += 2) {
                *(LAS unsigned*)(qn + i * 136 + cg * 16 + c) = pk2(o[0][c] * rq, o[0][c + 1] * rq);
                const unsigned kw = pk2(o[1][c] * rk, o[1][c + 1] * rk), vw = pk2(o[2][c], o[2][c + 1]);
                *(LAS unsigned*)(kn + i * 136 + cg * 16 + c) = kw;
                knT[(cg * 16 + c) * 72 + cg * 8 + i] = (bf16_t)(kw & 0xffffu); knT[(cg * 16 + c + 1) * 72 + cg * 8 + i] = (bf16_t)(kw >> 16);
                vT[(cg * 16 + c) * 72 + cg * 8 + i] = (bf16_t)(vw & 0xffffu); vT[(cg * 16 + c + 1) * 72 + cg * 8 + i] = (bf16_t)(vw >> 16);
            }
        }
        if (wave < 2) {
            const int dir = wave, i = dir ? 63 - lane : lane;
            const size_t grow = isctx ? (size_t)M_LAT + b * CTX + t0 + i : (size_t)b * SEQ + t0 + i;
            float g = GATES[grow * 16 + 8 + dir * 4 + h];
#pragma unroll
            for (int o2 = 1; o2 < 64; o2 <<= 1) { const float x = __shfl_up(g, o2); if (lane >= o2) g += x; }
            gamP[dir * 64 + lane] = g; const float bt0 = GATES[grow * 16 + dir * 4 + h]; betP[dir * 64 + lane] = bt0; begP[dir * 64 + lane] = bt0 * __expf(g);
        }
        lds_barrier();
        {
            const int fr = lane & 15, fq = lane >> 4;
#pragma unroll
            for (int tt = 0; tt < 4; ++tt) {
                const int tile = wave * 4 + tt, which = tile >> 4, mt = (tile >> 2) & 3, nt = tile & 3;
                LAS bf16_t* Am = which ? qn : kn;
                f32x4 acc = (f32x4){0.f, 0.f, 0.f, 0.f};
#pragma unroll
                for (int s = 0; s < 4; ++s) {
                    const bf16x8 a = *(const LAS bf16x8*)(Am + (16 * mt + fr) * 136 + 32 * s + 8 * fq);
                    const bf16x8 bb = *(const LAS bf16x8*)(kn + (16 * nt + fr) * 136 + 32 * s + 8 * fq);
                    acc = __builtin_amdgcn_mfma_f32_16x16x32_bf16(a, bb, acc, 0, 0, 0);
                }
                LAS float* Om = which ? QKr : KK;
#pragma unroll
                for (int r = 0; r < 4; ++r) Om[(16 * mt + 4 * fq + r) * 68 + 16 * nt + fr] = acc[r];
            }
        }
        lds_barrier();
        {
#pragma unroll 2
            for (int it = 0; it < 10; ++it) {
                const int idx = tid + 512 * it, dir = idx / 2560, rem = idx % 2560, blk = rem >> 8, e = rem & 255, r = e >> 4, c = e & 15;
                const int bi = blk < 1 ? 0 : (blk < 3 ? 1 : (blk < 6 ? 2 : 3)), bj = blk - bi * (bi + 1) / 2;
                const int p = 16 * bi + r, pp = 16 * bj + c;
                float val = 0.f;
                if (p > pp) { const int ip = dir ? 63 - p : p, ipp = dir ? 63 - pp : pp;
                    val = betP[dir * 64 + p] * KK[ip * 68 + ipp] * __expf(gamP[dir * 64 + p] - gamP[dir * 64 + pp]); }
                NBk[(dir * 10 + blk) * 272 + r * 17 + c] = val;
            }
            const int f = tid >> 6, l2 = tid & 63, g = l2 >> 4;
            if (!isctx) {
#pragma unroll
                for (int dir = 0; dir < 2; ++dir) {
                    const int m = f >> 1, s = f & 1, io = 16 * m + (l2 & 15);
                    const float gi = gamP[dir * 64 + (dir ? 63 - io : io)];
                    float vals[8];
#pragma unroll
                    for (int e = 0; e < 8; ++e) { const int j = kperm(s, g, e); const bool keep = dir ? (j >= io) : (j <= io);
                        vals[e] = keep ? QKr[io * 68 + j] * __expf(gi - gamP[dir * 64 + (dir ? 63 - j : j)]) : 0.f; }
                    u32x4 w; w.x = pk2(vals[0], vals[1]); w.y = pk2(vals[2], vals[3]); w.z = pk2(vals[4], vals[5]); w.w = pk2(vals[6], vals[7]);
                    *(u32x4*)(P.QK + so_dir(dir, chain, slot) * 8192 + (size_t)tid * 16) = w;
                }
#pragma unroll
                for (int it = 0; it < 2; ++it) {
                    const int q = tid + 512 * it, ff = q >> 6, m = ff >> 2, s = ff & 3, row = 16 * m + (l2 & 15);
                    const u32x2 lo = *(const LAS u32x2*)(qn + row * 136 + 32 * s + 4 * g), hi = *(const LAS u32x2*)(qn + row * 136 + 32 * s + 16 + 4 * g);
                    *(u32x4*)(P.QN + so_shared(chain, slot) + (size_t)q * 16) = (u32x4){lo.x, lo.y, hi.x, hi.y};
                }
            }
#pragma unroll
            for (int it = 0; it < 2; ++it) {
                const int q = tid + 512 * it, ff = q >> 6, mp = ff >> 1, s = ff & 1, dk = 16 * mp + (l2 & 15);
                unsigned short e8[8];
#pragma unroll
                for (int e = 0; e < 8; ++e) e8[e] = kn[kperm(s, g, e) * 136 + dk];
                u32x4 w; w.x = e8[0] | ((unsigned)e8[1] << 16); w.y = e8[2] | ((unsigned)e8[3] << 16); w.z = e8[4] | ((unsigned)e8[5] << 16); w.w = e8[6] | ((unsigned)e8[7] << 16);
                *(u32x4*)(P.KT + so_shared(chain, slot) + (size_t)q * 16) = w;
            }
            if (tid < 128) { const int dir = tid >> 6, i = tid & 63, p = dir ? 63 - i : i;
                const float gl = gamP[dir * 64 + 63], gi = gamP[dir * 64 + p];
                float* sc = P.SCL + so_dir(dir, chain, slot) * 256;
                sc[i] = __expf(gi); sc[64 + i] = __expf(gl - gi); if (i == 0) sc[128] = __expf(gl); }
        }
        lds_barrier();
        {
            const int rr = lane & 15, kq = lane >> 4, dir = wave >> 2, wq = wave & 3;
            const f32x4 z4 = (f32x4){0.f, 0.f, 0.f, 0.f};
#define NB_(d, bi, bj) (NBk + ((d) * 10 + (bi) * ((bi) + 1) / 2 + (bj)) * 272)
#define XB_(d, bi, bj) (XBk + ((d) * 10 + (bi) * ((bi) + 1) / 2 + (bj)) * 272)
#define SLOT_(g) ((g) < 16 ? SCRq + (g) * 272 : TBk + ((g) - 16) * 272)
#define EMIT_X(d, bi, bj, v) do { const int pp_ = 16 * (bj) + rr, jx_ = (d) ? 63 - pp_ : pp_; const float bu_ = betP[(d) * 64 + pp_], bw_ = begP[(d) * 64 + pp_]; \
                _Pragma("unroll") for (int r_ = 0; r_ < 4; ++r_) { const int p_ = 16 * (bi) + 4 * kq + r_, i_ = (d) ? 63 - p_ : p_; \
                    XU[((d) * 64 + i_) * 72 + jx_] = (bf16_t)f2bf((v)[r_] * bu_); XW[((d) * 64 + i_) * 72 + jx_] = (bf16_t)f2bf((v)[r_] * bw_); } } while (0)
            { const u32x4 z = (u32x4){0u, 0u, 0u, 0u};
#pragma unroll
                for (int q = 0; q < 5; ++q) { const int o = (tid + 512 * q) * 16; if (o < 36864) *(LAS u32x4*)((LAS unsigned char*)XU + o) = z; } }
            lds_barrier();
            {
                const LAS float* M = NB_(dir, wq, wq);
                LAS float* S0 = SLOT_(wave * 3), *S1 = SLOT_(wave * 3 + 1), *Pb = SLOT_(wave * 3 + 2), *Xd = XB_(dir, wq, wq);
                const f32x4 m = ld16(M, rr, kq);
                f32x4 p0;
#pragma unroll
                for (int r = 0; r < 4; ++r) p0[r] = ((4 * kq + r) == rr ? 1.f : 0.f) - m[r];
                st16(Pb, p0, rr, kq);
                const f32x4 m2 = mm16(M, M, z4, rr, kq); st16(S0, m2, rr, kq);
                const f32x4 p1 = mm16(Pb, S0, p0, rr, kq); st16(Xd, p1, rr, kq);
                const f32x4 m4 = mm16(S0, S0, z4, rr, kq); st16(S1, m4, rr, kq);
                const f32x4 p2 = mm16(Xd, S1, p1, rr, kq); st16(Pb, p2, rr, kq);
                const f32x4 m8 = mm16(S1, S1, z4, rr, kq); st16(S0, m8, rr, kq);
                const f32x4 p3 = mm16(Pb, S0, p2, rr, kq); st16(Xd, p3, rr, kq); EMIT_X(dir, wq, wq, p3);
            }
            lds_barrier();
            if (wave < 4) {
                const int d1 = wave >> 1, lo = (wave & 1) * 2, hi = lo + 1;
                LAS float* T1 = SLOT_(wave);
                st16(T1, mm16(NB_(d1, hi, lo), XB_(d1, lo, lo), z4, rr, kq), rr, kq);
                const f32x4 x = mm16(XB_(d1, hi, hi), T1, z4, rr, kq);
                const f32x4 nx_ = -x; st16(XB_(d1, hi, lo), nx_, rr, kq); EMIT_X(d1, hi, lo, nx_);
            }
            lds_barrier();
            {
                const int bi = 2 + (wq >> 1), bj = wq & 1;
                f32x4 t = mm16(NB_(dir, bi, 1), XB_(dir, 1, bj), z4, rr, kq);
                if (bj == 0) t = mm16(NB_(dir, bi, 0), XB_(dir, 0, 0), t, rr, kq);
                st16(TBk + (dir * 4 + wq) * 272, t, rr, kq);
            }
            lds_barrier();
            {
                const int bi = 2 + (wq >> 1), bj = wq & 1;
                f32x4 x = mm16(XB_(dir, bi, 2), TBk + (dir * 4 + bj) * 272, z4, rr, kq);
                if (bi == 3) x = mm16(XB_(dir, 3, 3), TBk + (dir * 4 + 2 + bj) * 272, x, rr, kq);
                const f32x4 nx_ = -x; EMIT_X(dir, bi, bj, nx_);
            }
#undef NB_
#undef XB_
#undef SLOT_
#undef EMIT_X
        }
        lds_barrier();
        {
            const int dir = wave >> 2, wq = wave & 3, rr = lane & 15, kq = lane >> 4;
            const LAS bf16_t* xu = XU + (dir * 64 + 16 * wq + rr) * 72 + 8 * kq;
            const LAS bf16_t* xw = XW + (dir * 64 + 16 * wq + rr) * 72 + 8 * kq;
            const bf16x8 au0 = *(const LAS bf16x8*)(xu), au1 = *(const LAS bf16x8*)(xu + 32);
            const bf16x8 bw0 = *(const LAS bf16x8*)(xw), bw1 = *(const LAS bf16x8*)(xw + 32);
            unsigned char* ub = P.U + so_dir(dir, chain, slot) * 16384;
            unsigned char* nb = P.NWK + so_dir(dir, chain, slot) * 16384;
#pragma unroll
            for (int ct = 0; ct < 8; ++ct) {
                const LAS bf16_t* vp = vT + (16 * ct + rr) * 72 + ct * 8 + 8 * kq;
                f32x4 acc = (f32x4){0.f, 0.f, 0.f, 0.f};
                acc = __builtin_amdgcn_mfma_f32_16x16x32_bf16(au0, *(const LAS bf16x8*)(vp), acc, 0, 0, 0);
                acc = __builtin_amdgcn_mfma_f32_16x16x32_bf16(au1, *(const LAS bf16x8*)(vp + 32), acc, 0, 0, 0);
                *(u32x2*)(ub + (size_t)((ct * 4 + wq) * 64 + lane) * 8) = (u32x2){cvt_pk_bf16(acc[0], acc[1]), cvt_pk_bf16(acc[2], acc[3])};
            }
#pragma unroll
            for (int s2 = 0; s2 < 4; ++s2) {
                f32x4 a2[2];
#pragma unroll
                for (int hh = 0; hh < 2; ++hh) { const LAS bf16_t* kp = knT + (16 * (2 * s2 + hh) + rr) * 72 + (2 * s2 + hh) * 8 + 8 * kq;
                    f32x4 acc = (f32x4){0.f, 0.f, 0.f, 0.f};
                    acc = __builtin_amdgcn_mfma_f32_16x16x32_bf16(*(const LAS bf16x8*)(kp), bw0, acc, 0, 0, 0);
                    acc = __builtin_amdgcn_mfma_f32_16x16x32_bf16(*(const LAS bf16x8*)(kp + 32), bw1, acc, 0, 0, 0);
                    a2[hh] = acc; }
                u32x4 w; w.x = cvt_pk_bf16(-a2[0][0], -a2[0][1]); w.y = cvt_pk_bf16(-a2[0][2], -a2[0][3]); w.z = cvt_pk_bf16(-a2[1][0], -a2[1][1]); w.w = cvt_pk_bf16(-a2[1][2], -a2[1][3]);
                *(u32x4*)(nb + (size_t)((wq * 4 + s2) * 64 + lane) * 16) = w;
            }
        }
        lds_barrier();
    }
}

constexpr int SC_NWK = 0, SC_QN = 16384, SC_KT = 32768, SC_QK = 49152, SC_U = 57344, SC_SCL = 65536, SC_STAGE = 66560;
constexpr int SC_HS = 2 * SC_STAGE  , SC_HW = SC_HS + 16384  ;
static_assert(SC_HW + 8192 <= MISC_OFF, "scan LDS map");
__device__ __forceinline__ void ph_scan(const Frame& F, const ScanPtrs P, bf16_t* OF, bf16_t* OB, unsigned* prog) {
    const int xg = F.vcu >> 5, xj = F.vcu & 31;
    if (xj >= 8 || xg >= 8) return;
    const int sb = xg * 8 + xj, half = sb & 1, dir = (sb >> 1) & 1, chain = sb >> 2, b = chain >> 2, h = chain & 3;
    LAS unsigned char* L = F.lds;
    const int lane = F.lane, wave = F.wave, g = lane >> 4, tile = wave & 3;
    const bool isR = wave < 4;
    bf16_t* O = dir ? OB : OF;
    const unsigned lbase = (unsigned)(unsigned long long)(L);
    auto slot_of = [&](int step) { return dir ? (step < 4 ? 3 - step : 135 - step) : step; };
    auto issue = [&](int step) {
        const int slot = slot_of(step); const unsigned sbase = (unsigned)(step & 1) * SC_STAGE; const bool emit = slot >= 4;
        const unsigned char* nwk = P.NWK + so_dir(dir, chain, slot) * 16384; const unsigned char* kt = P.KT + so_shared(chain, slot);
        const unsigned char* qn = P.QN + so_shared(chain, slot); const unsigned char* qk = P.QK + so_dir(dir, chain, slot) * 8192;
        const unsigned char* uu = P.U + so_dir(dir, chain, slot) * 16384 + half * 8192; const unsigned char* sc = (const unsigned char*)(P.SCL + so_dir(dir, chain, slot) * 256);
#pragma unroll
        for (int i = 0; i < 2; ++i) { const int pc = wave * 2 + i;
            __builtin_amdgcn_global_load_lds((const unsigned*)(nwk + pc * 1024 + lane * 16), (LAS unsigned*)(L + sbase + SC_NWK + pc * 1024), 16, 0, 0); }
        __builtin_amdgcn_global_load_lds((const unsigned*)(uu + wave * 1024 + lane * 16), (LAS unsigned*)(L + sbase + SC_U + wave * 1024), 16, 0, 0);
        if (wave == 7) __builtin_amdgcn_global_load_lds((const unsigned*)(sc + lane * 16), (LAS unsigned*)(L + sbase + SC_SCL), 16, 0, 0);
        if (emit) {
#pragma unroll
            for (int i = 0; i < 2; ++i) { const int pc = wave * 2 + i;
                __builtin_amdgcn_global_load_lds((const unsigned*)(qn + pc * 1024 + lane * 16), (LAS unsigned*)(L + sbase + SC_QN + pc * 1024), 16, 0, 0); }
        }
#pragma unroll
        for (int i = 0; i < 2; ++i) { const int pc = wave * 2 + i;
            __builtin_amdgcn_global_load_lds((const unsigned*)(kt + pc * 1024 + lane * 16), (LAS unsigned*)(L + sbase + SC_KT + pc * 1024), 16, 0, 0); }
        if (emit) __builtin_amdgcn_global_load_lds((const unsigned*)(qk + wave * 1024 + lane * 16), (LAS unsigned*)(L + sbase + SC_QK + wave * 1024), 16, 0, 0);
    };
#define SC_RD128(dst, addr, off) asm volatile("ds_read_b128 %0, %1 offset:%2" : "=v"(dst) : "v"(addr), "n"(off))
#define SC_WR128(addr, off, src) asm volatile("ds_write_b128 %0, %1 offset:%2\n\ts_nop 3" :: "v"(addr), "v"(src), "n"(off) : "memory")
#define SC_LOAD(dst, base, first) do { _Pragma("unroll") for (int i_ = 0; i_ < 8; ++i_) SC_RD128(dst[i_], sva, (base) + ((first) + i_) * 1024); } while (0)
#define SC_WAIT0(a) do { asm volatile("s_waitcnt lgkmcnt(0)" : "+v"(a[0]), "+v"(a[1]), "+v"(a[2]), "+v"(a[3]), "+v"(a[4]), "+v"(a[5]), "+v"(a[6]), "+v"(a[7])); __builtin_amdgcn_sched_barrier(0); } while (0)
    const unsigned hsa = lbase + SC_HS + (unsigned)tile * 4096u + (unsigned)lane * 16u;
    const unsigned hwa = lbase + SC_HW + (unsigned)tile * 2048u + (unsigned)lane * 16u;
    f32x4 accS[8];
#pragma unroll
    for (int m = 0; m < 8; ++m) accS[m] = (f32x4){0.f, 0.f, 0.f, 0.f};
    bf16x8 bS[4];
#pragma unroll
    for (int s = 0; s < 4; ++s) bS[s] = (bf16x8){0, 0, 0, 0, 0, 0, 0, 0};
    if (isR) {
#pragma unroll
        for (int s = 0; s < 4; ++s) SC_WR128(hsa, s * 1024, bS[s]);
    }
    issue(0); asm volatile("s_waitcnt vmcnt(0)" ::: "memory");
    lds_barrier();
    for (int step = 0; step < NSLOT; ++step) {
        const int slot = slot_of(step); const bool emit = slot >= 4;
        if (half == 0 && F.tid == 0) __hip_atomic_store(prog + 16 * (sb >> 1), (unsigned)(step + 1), __ATOMIC_RELAXED, __HIP_MEMORY_SCOPE_AGENT);
        const unsigned sva = lbase + (unsigned)(step & 1) * SC_STAGE + (unsigned)lane * 16u;
        const unsigned ssa = sva - (unsigned)lane * 16u + SC_SCL + (unsigned)g * 16u;
#if PROBE_SEL >= 0
        const bool pw = (sb == 0 && wave == PROBE_WAVE);
        unsigned long long t0_ = 0, t1_ = 0, t2_ = 0, t3_ = 0, t4_ = 0, t5_ = 0;
        if (pw) t0_ = __builtin_amdgcn_s_memrealtime();
#endif
        if (step + 1 < NSLOT) issue(step + 1);
#if PROBE_SEL >= 0
        if (pw) t1_ = __builtin_amdgcn_s_memrealtime();
#endif
        bf16x8 fa[8], fb[8];
        f32x4 acco[4]; bf16x8 bWx[2];
        if (isR) {
            const unsigned sua = sva - (unsigned)lane * 8u + SC_U + (unsigned)tile * 2048u;
            f32x4 accw[4], ek4[4]; u32x2 uv[4]; float cd;
#pragma unroll
            for (int m = 0; m < 4; ++m) asm volatile("ds_read_b64 %0, %1 offset:%2" : "=v"(uv[m]) : "v"(sua), "n"(m * 512));
            SC_LOAD(fa, SC_NWK, 0);
            asm volatile("s_waitcnt lgkmcnt(0)" : "+v"(uv[0]), "+v"(uv[1]), "+v"(uv[2]), "+v"(uv[3]),
                         "+v"(fa[0]), "+v"(fa[1]), "+v"(fa[2]), "+v"(fa[3]), "+v"(fa[4]), "+v"(fa[5]), "+v"(fa[6]), "+v"(fa[7])); __builtin_amdgcn_sched_barrier(0);
            SC_LOAD(fb, SC_NWK, 8);
#pragma unroll
            for (int m = 0; m < 4; ++m) SC_RD128(ek4[m], ssa, 256 + m * 64);
            asm volatile("ds_read_b32 %0, %1 offset:512" : "=v"(cd) : "v"(ssa - (unsigned)g * 16u));
#pragma unroll
            for (int m = 0; m < 4; ++m) accw[m] = (f32x4){bf_lo(uv[m].x), bf_hi(uv[m].x), bf_lo(uv[m].y), bf_hi(uv[m].y)};
#pragma unroll
            for (int f = 0; f < 8; ++f) accw[f >> 2] = __builtin_amdgcn_mfma_f32_16x16x32_bf16(fa[f], bS[f & 3], accw[f >> 2], 0, 0, 0);
            asm volatile("s_waitcnt lgkmcnt(0)" : "+v"(ek4[0]), "+v"(ek4[1]), "+v"(ek4[2]), "+v"(ek4[3]), "+v"(cd),
                         "+v"(fb[0]), "+v"(fb[1]), "+v"(fb[2]), "+v"(fb[3]), "+v"(fb[4]), "+v"(fb[5]), "+v"(fb[6]), "+v"(fb[7])); __builtin_amdgcn_sched_barrier(0);
            SC_LOAD(fa, SC_KT, 0);
#pragma unroll
            for (int f = 0; f < 8; ++f) accw[2 + (f >> 2)] = __builtin_amdgcn_mfma_f32_16x16x32_bf16(fb[f], bS[f & 3], accw[2 + (f >> 2)], 0, 0, 0);
            SC_WAIT0(fa);
            SC_LOAD(fb, SC_KT, 8);
            bf16x8 bWs[2];
#pragma unroll
            for (int s = 0; s < 2; ++s) {
                const f32x4 w0 = accw[2 * s], w1 = accw[2 * s + 1], e0 = ek4[2 * s], e1 = ek4[2 * s + 1];
                u32x4 a, c2;
                a.x = cvt_pk_bf16(w0[0], w0[1]); a.y = cvt_pk_bf16(w0[2], w0[3]); a.z = cvt_pk_bf16(w1[0], w1[1]); a.w = cvt_pk_bf16(w1[2], w1[3]);
                c2.x = cvt_pk_bf16(w0[0] * e0[0], w0[1] * e0[1]); c2.y = cvt_pk_bf16(w0[2] * e0[2], w0[3] * e0[3]); c2.z = cvt_pk_bf16(w1[0] * e1[0], w1[1] * e1[1]); c2.w = cvt_pk_bf16(w1[2] * e1[2], w1[3] * e1[3]);
                bWx[s] = __builtin_bit_cast(bf16x8, a); bWs[s] = __builtin_bit_cast(bf16x8, c2);
                if (emit) SC_WR128(hwa, s * 1024, bWx[s]);
            }
#pragma unroll
            for (int m = 0; m < 8; ++m) accS[m] = accS[m] * cd;
#if PROBE_SEL >= 0
            if (pw) t2_ = __builtin_amdgcn_s_memrealtime();
#endif
            lds_barrier();
#if PROBE_SEL >= 0
            if (pw) t3_ = __builtin_amdgcn_s_memrealtime();
#endif
            SC_WAIT0(fb);
#pragma unroll
            for (int f = 0; f < 8; ++f) accS[f >> 1] = __builtin_amdgcn_mfma_f32_16x16x32_bf16(fa[f], bWs[f & 1], accS[f >> 1], 0, 0, 0);
#pragma unroll
            for (int f = 0; f < 8; ++f) accS[4 + (f >> 1)] = __builtin_amdgcn_mfma_f32_16x16x32_bf16(fb[f], bWs[f & 1], accS[4 + (f >> 1)], 0, 0, 0);
#pragma unroll
            for (int s = 0; s < 4; ++s) {
                const f32x4 s0 = accS[2 * s], s1 = accS[2 * s + 1];
                u32x4 a; a.x = cvt_pk_bf16(s0[0], s0[1]); a.y = cvt_pk_bf16(s0[2], s0[3]); a.z = cvt_pk_bf16(s1[0], s1[1]); a.w = cvt_pk_bf16(s1[2], s1[3]);
                bS[s] = __builtin_bit_cast(bf16x8, a);
                SC_WR128(hsa, s * 1024, bS[s]);
            }
        } else {
            f32x4 eg4[4];
            if (emit) {
#pragma unroll
                for (int s = 0; s < 4; ++s) SC_RD128(bS[s], hsa, s * 1024);
                SC_LOAD(fa, SC_QN, 0);
                asm volatile("s_waitcnt lgkmcnt(0)" : "+v"(bS[0]), "+v"(bS[1]), "+v"(bS[2]), "+v"(bS[3]),
                             "+v"(fa[0]), "+v"(fa[1]), "+v"(fa[2]), "+v"(fa[3]), "+v"(fa[4]), "+v"(fa[5]), "+v"(fa[6]), "+v"(fa[7])); __builtin_amdgcn_sched_barrier(0);
                SC_LOAD(fb, SC_QN, 8);
#pragma unroll
                for (int m = 0; m < 4; ++m) SC_RD128(eg4[m], ssa, m * 64);
#pragma unroll
                for (int m = 0; m < 4; ++m) acco[m] = (f32x4){0.f, 0.f, 0.f, 0.f};
#pragma unroll
                for (int f = 0; f < 8; ++f) acco[f >> 2] = __builtin_amdgcn_mfma_f32_16x16x32_bf16(fa[f], bS[f & 3], acco[f >> 2], 0, 0, 0);
                asm volatile("s_waitcnt lgkmcnt(0)" : "+v"(eg4[0]), "+v"(eg4[1]), "+v"(eg4[2]), "+v"(eg4[3]),
                             "+v"(fb[0]), "+v"(fb[1]), "+v"(fb[2]), "+v"(fb[3]), "+v"(fb[4]), "+v"(fb[5]), "+v"(fb[6]), "+v"(fb[7])); __builtin_amdgcn_sched_barrier(0);
                SC_LOAD(fa, SC_QK, 0);
#pragma unroll
                for (int f = 0; f < 8; ++f) acco[2 + (f >> 2)] = __builtin_amdgcn_mfma_f32_16x16x32_bf16(fb[f], bS[f & 3], acco[2 + (f >> 2)], 0, 0, 0);
#pragma unroll
                for (int m = 0; m < 4; ++m) acco[m] = acco[m] * eg4[m];
            }
#if PROBE_SEL >= 0
            if (pw) t2_ = __builtin_amdgcn_s_memrealtime();
#endif
            lds_barrier();
#if PROBE_SEL >= 0
            if (pw) t3_ = __builtin_amdgcn_s_memrealtime();
#endif
            if (emit) {
                SC_RD128(bWx[0], hwa, 0); SC_RD128(bWx[1], hwa, 1024);
                asm volatile("s_waitcnt lgkmcnt(0)" : "+v"(bWx[0]), "+v"(bWx[1]), "+v"(fa[0]), "+v"(fa[1]), "+v"(fa[2]), "+v"(fa[3]), "+v"(fa[4]), "+v"(fa[5]), "+v"(fa[6]), "+v"(fa[7])); __builtin_amdgcn_sched_barrier(0);
#pragma unroll
                for (int f = 0; f < 8; ++f) acco[f >> 1] = __builtin_amdgcn_mfma_f32_16x16x32_bf16(fa[f], bWx[f & 1], acco[f >> 1], 0, 0, 0);
                bf16_t* orow = O + ((size_t)b * SEQ + (slot - 4) * 64) * 512 + h * 128 + half * 64 + tile * 16 + (lane & 15);
#pragma unroll
                for (int m = 0; m < 4; ++m) { const unsigned p01 = cvt_pk_bf16(acco[m][0], acco[m][1]), p23 = cvt_pk_bf16(acco[m][2], acco[m][3]);
                    bf16_t* q = orow + (size_t)(16 * m + 4 * g) * 512;
                    q[0] = (bf16_t)(p01 & 0xffffu); q[512] = (bf16_t)(p01 >> 16); q[1024] = (bf16_t)(p23 & 0xffffu); q[1536] = (bf16_t)(p23 >> 16); }
            }
        }
#if PROBE_SEL >= 0
        if (pw) t4_ = __builtin_amdgcn_s_memrealtime();
#endif
        asm volatile("s_waitcnt vmcnt(0)" ::: "memory");
#if PROBE_SEL >= 0
        if (pw) t5_ = __builtin_amdgcn_s_memrealtime();
#endif
        lds_barrier();
#if PROBE_SEL >= 0
        if (pw && lane == 0) { const unsigned long long t6_ = __builtin_amdgcn_s_memrealtime(); unsigned long long* ts = (unsigned long long*)(prog - CW_PROG + CW_TS);
            ts[0] += t1_ - t0_; ts[1] += t2_ - t1_; ts[2] += t3_ - t2_; ts[3] += t4_ - t3_; ts[4] += t5_ - t4_; ts[5] += t6_ - t5_; ts[6] += t6_ - t0_; }
#endif
    }
#undef SC_LOAD
#undef SC_WAIT0
#undef SC_RD128
#undef SC_WR128
}

__device__ __forceinline__ void scan_l2_warm(const Frame& F, const ScanPtrs P, int stream, int quarter, unsigned* prog) {
    const int dir = stream & 1, chain = stream >> 1, lane = F.lane;
    const int wq = quarter * NWAVES + F.wave;
    constexpr int AHEAD = 6;
    int done = 0;
    u32x4 junk = (u32x4){0u, 0u, 0u, 0u};
    for (unsigned spins = 0; spins < (1u << 20); ++spins) {
        const int cur = (int)__hip_atomic_load(prog + 16 * stream, __ATOMIC_RELAXED, __HIP_MEMORY_SCOPE_AGENT);
        int tgt = cur + AHEAD; if (tgt > NSLOT) tgt = NSLOT;
        for (int s = done > cur ? done : cur; s < tgt; ++s) {
            const int slot = dir ? (s < 4 ? 3 - s : 135 - s) : s;
#pragma unroll
            for (int i = 0; i < 3; ++i) { const int p = wq + 32 * i;
                const unsigned char* src = nullptr;
                if (p < 16) src = P.NWK + so_dir(dir, chain, slot) * 16384 + p * 1024;
                else if (p < 32) src = P.KT + so_shared(chain, slot) + (p - 16) * 1024;
                else if (p < 48) src = P.U + so_dir(dir, chain, slot) * 16384 + (p - 32) * 1024;
                else if (p < 64) { if (slot >= 4) src = P.QN + so_shared(chain, slot) + (p - 48) * 1024; }
                else if (p < 72) { if (slot >= 4) src = P.QK + so_dir(dir, chain, slot) * 8192 + (p - 64) * 1024; }
                else if (p == 72) src = (const unsigned char*)(P.SCL + so_dir(dir, chain, slot) * 256);
                if (src) asm volatile("global_load_dwordx4 %0, %1, off" : "+v"(junk) : "v"(src + lane * 16)); }
        }
        if (tgt > done) done = tgt;
        if (done >= NSLOT) break;
        __builtin_amdgcn_s_sleep(16);
    }
    asm volatile("s_waitcnt vmcnt(0)" : "+v"(junk) :: "memory");
}

__device__ __forceinline__ void ph_even_A(const Frame& F, const bf16_t* OF, const bf16_t* OB, const bf16_t* Z, const bf16_t* POOL, const float* onorm, bf16_t* act) {
    LAS unsigned char* L = F.lds;
    for (int seg = F.vcu; seg < M_LAT / 64; seg += F.G) {
        int tid = F.tid; asm volatile("" : "+v"(tid));
        const int lane = tid & 63;
        const size_t row0 = (size_t)seg * 64;
#pragma unroll
        for (int i = 0; i < 8; ++i) { const int q = tid + 512 * i;
            *(LAS u32x4*)(L + q * 16) = *(const u32x4*)(POOL + row0 * 512 + (size_t)q * 8); }
        __syncthreads();
#pragma unroll 1
        for (int i0 = 0; i0 < 8; i0 += 4) {
            u32x4 av[4], bv[4], zv[4];
#pragma unroll
            for (int i = 0; i < 4; ++i) { const size_t r = row0 + F.wave * 8 + i0 + i;
                av[i] = *(const u32x4*)(OF + r * 512 + 8 * lane); bv[i] = *(const u32x4*)(OB + r * 512 + 8 * lane); zv[i] = *(const u32x4*)(Z + r * 512 + 8 * lane); }
#pragma unroll
            for (int i = 0; i < 4; ++i) {
                const int pos = F.wave * 8 + i0 + i; const size_t r = row0 + pos;
                const u32x4 a = av[i], b2 = bv[i], z = zv[i];
                float o[8]; float s = 0.f;
#pragma unroll
                for (int q = 0; q < 4; ++q) { o[2 * q] = bf_lo(a[q]) + bf_lo(b2[q]); o[2 * q + 1] = bf_hi(a[q]) + bf_hi(b2[q]); s += o[2 * q] * o[2 * q] + o[2 * q + 1] * o[2 * q + 1]; }
                s += __shfl_xor(s, 1); s += __shfl_xor(s, 2); s += __shfl_xor(s, 4); s += __shfl_xor(s, 8);
                const float rs = rsqrtf(s * (1.f / 128.f) + EPS);
                const float* gn = onorm + ((8 * lane) & 127);
                u32x4 w;
#pragma unroll
                for (int q = 0; q < 4; ++q) w[q] = pk2(o[2 * q] * rs * gn[2 * q] * silu1(bf_lo(z[q])), o[2 * q + 1] * rs * gn[2 * q + 1] * silu1(bf_hi(z[q])));
                *(u32x4*)(act + r * D + 8 * lane) = w;
                const int grp = lane >> 4, win = 2 << grp;
                int lo = pos - win / 2; if (lo < 0) lo = 0; int hi = pos + win - win / 2; if (hi > 64) hi = 64;
                float m[8];
#pragma unroll
                for (int q = 0; q < 8; ++q) m[q] = 0.f;
#pragma unroll
                for (int p = 0; p < 16; ++p) { const int rr = lo + p; const bool ok = rr < hi;
                    const u32x4 pv = *(const LAS u32x4*)(L + (ok ? rr : pos) * 1024 + lane * 16);
                    if (ok) {
#pragma unroll
                        for (int q = 0; q < 4; ++q) { m[2 * q] += bf_lo(pv[q]); m[2 * q + 1] += bf_hi(pv[q]); } } }
                const float inv = 1.f / (float)(hi - lo);
                const u32x4 self = *(const LAS u32x4*)(L + pos * 1024 + lane * 16);
#pragma unroll
                for (int q = 0; q < 4; ++q) w[q] = pk2(m[2 * q] * inv - bf_lo(self[q]), m[2 * q + 1] * inv - bf_hi(self[q]));
                *(u32x4*)(act + r * D + 512 + 8 * lane) = w;
            }
        }
        __syncthreads();
    }
}

struct TItem { const float* W; bf16_t* WT; int ldn, n0, k0, Kd, drow0; };
constexpr int N_LATE_T = 2304 + 2 * NE * 768;
__device__ __forceinline__ TItem late_item(const Args& args, int it, bf16_t* WOUT, bf16_t* SCIN, bf16_t* SCOUT, bf16_t* WGU, bf16_t* WDN) {
    TItem t;
    if (it < 256) { const int kb = it >> 5, nb = it & 31; t = TItem{args.in[16], WOUT, D, 32 * nb, 64 * kb, D, 32 * nb}; }
    else if (it < 1792) { const int q = it - 256, kb = q / 96, nb = q % 96, n0 = 32 * nb; int drow;
        if (n0 < D) drow = n0; else if (n0 < 2 * D) drow = D + ((n0 - D) >> 7) * 256 + (n0 & 127); else drow = D + ((n0 - 2 * D) >> 7) * 256 + 128 + (n0 & 127);
        t = TItem{args.in[17], SCIN, 3 * D, n0, 64 * kb, D, drow}; }
    else if (it < 2304) { const int q = it - 1792, kb = q >> 5, nb = q & 31; t = TItem{args.in[19], SCOUT, D, 32 * nb, 64 * kb, D, 32 * nb}; }
    else { const int q0 = it - 2304, le = q0 / 768, r = q0 % 768;
        if (r < 512) { const int up = r >> 8, q = r & 255, kb = q >> 4, nb = q & 15, n0 = 32 * nb;
            t = TItem{(up ? args.in[22] : args.in[21]) + (size_t)le * D * DE, WGU + (size_t)le * 1024 * D, DE, n0, 64 * kb, D, (n0 >> 7) * 256 + up * 128 + (n0 & 127)}; }
        else { const int q = r - 512, kb = q >> 5, nb = q & 31; t = TItem{args.in[23] + (size_t)le * DE * D, WDN + (size_t)le * D * DE, D, 32 * nb, 64 * kb, DE, 32 * nb}; } }
    return t;
}
__device__ __forceinline__ void t_load(const TItem& t, float (&tv)[32], int lane) {
#pragma unroll
    for (int i = 0; i < 32; ++i) tv[i] = __builtin_nontemporal_load(t.W + (size_t)(t.k0 + 2 * i + (lane >> 5)) * t.ldn + t.n0 + (lane & 31));
}
__device__ __forceinline__ void t_store(const TItem& t, const float (&tv)[32], LAS float* scr, int lane) {
#pragma unroll
    for (int i = 0; i < 32; ++i) scr[(2 * i + (lane >> 5)) * 33 + (lane & 31)] = tv[i];
    asm volatile("s_waitcnt lgkmcnt(0)" ::: "memory");
    const int c = lane & 7;
#pragma unroll
    for (int j = 0; j < 4; ++j) { const int n = (lane >> 3) + 8 * j; const LAS float* s = scr + (8 * c) * 33 + n;
        u32x4 o; o.x = pk2(s[0 * 33], s[1 * 33]); o.y = pk2(s[2 * 33], s[3 * 33]); o.z = pk2(s[4 * 33], s[5 * 33]); o.w = pk2(s[6 * 33], s[7 * 33]);
        __builtin_nontemporal_store(o, (u32x4*)(t.WT + (size_t)(t.drow0 + n) * t.Kd + t.k0 + 8 * c)); }
    asm volatile("s_waitcnt lgkmcnt(0)" ::: "memory");
}
__device__ __forceinline__ void prep_late(const Frame& F, const Args& args, int widx, int nw, bf16_t* WOUT, bf16_t* SCIN, bf16_t* SCOUT, bf16_t* WGU, bf16_t* WDN) {
    LAS float* scr = (LAS float*)(F.lds + F.wave * 16384);
    for (int it = widx; it < 4 * 128 * 16; it += nw) { const int gq = it >> 11, c = (it >> 4) & 127, n = (it & 15) * 64 + F.lane;
        const float* pw = args.in[14] + ((size_t)gq * 128 + c) * 128; const float* ps = args.in[15] + gq * 128; const float* wo = args.in[16] + (size_t)(512 + gq * 128) * D + n;
        float acc = 0.f;
#pragma unroll 1
        for (int d0 = 0; d0 < 128; d0 += 32) { float wv[32];
#pragma unroll
            for (int d = 0; d < 32; ++d) wv[d] = wo[(size_t)(d0 + d) * D];
#pragma unroll
            for (int d = 0; d < 32; ++d) acc += pw[d0 + d] * ps[d0 + d] * wv[d]; }
        WOUT[(size_t)n * D + 512 + gq * 128 + c] = (bf16_t)f2bf(acc); }
    float ta[32], tb[32];
    int it0 = widx;
    TItem A = late_item(args, it0 < N_LATE_T ? it0 : 0, WOUT, SCIN, SCOUT, WGU, WDN), B = A;
    if (it0 < N_LATE_T) t_load(A, ta, F.lane);
    while (it0 < N_LATE_T) {
        const int it1 = it0 + nw;
        if (it1 < N_LATE_T) { B = late_item(args, it1, WOUT, SCIN, SCOUT, WGU, WDN); t_load(B, tb, F.lane); }
        t_store(A, ta, scr, F.lane);
        it0 = it1 + nw;
        if (it0 < N_LATE_T) { A = late_item(args, it0, WOUT, SCIN, SCOUT, WGU, WDN); t_load(A, ta, F.lane); }
        if (it1 < N_LATE_T) t_store(B, tb, scr, F.lane);
        __builtin_amdgcn_s_sleep(127); __builtin_amdgcn_s_sleep(127);
    }
}

enum { PH_PREP = 0, PH_E1, PH_E2, PH_E3, PH_E4, PH_E5, PH_E6, PH_M1_0, PH_M2_0, PH_M3_0, PH_M4_0, PH_M5_0, PH_X1, PH_X2, PH_X3, PH_M1_1, PH_M2_1, PH_M3_1, PH_M4_1, PH_M5_1, PH_COUNT };

__global__ void __launch_bounds__(NTHREADS, 2) mega(Args args) {
    extern __shared__ __attribute__((aligned(16))) unsigned char lds_raw[];
    Frame F;
    F.lds = (LAS unsigned char*)lds_raw;
    F.tid = threadIdx.x; F.lane = F.tid & 63; F.wave = __builtin_amdgcn_readfirstlane(F.tid >> 6);
    F.G = gridDim.x; { const int bx = blockIdx.x; F.vcu = (F.G % 8 == 0) ? (bx % 8) * (F.G / 8) + bx / 8 : bx; }
    volatile LAS unsigned* MISC = (volatile LAS unsigned*)(F.lds + MISC_OFF);
    if (F.tid < 64) MISC[F.tid] = 0u;
    __syncthreads();
    unsigned char* ws = args.ws;
    XcdBarrier bar = xcd_barrier_post((unsigned*)(ws + WS_CTL) + CW_BAR + args.li * XCD_BAR_WORDS, MISC + 8);
    const int lo = args.ph_lo, hi = args.ph_hi;
#define IN(k) (lo <= (k) && (k) < hi)
#define SEAM(k) do { if (IN(k) && IN((k) + 1)) xcd_barrier(bar); } while (0)
    const float* ADA = (const float*)(ws + WS_ADA); float* ADAw = (float*)(ws + WS_ADA);
    float* AFF = (float*)(ws + WS_AFF); int* IDX = (int*)(ws + WS_IDX); float* GATE = (float*)(ws + WS_GATE); int* SEL = (int*)(ws + WS_SEL);
    bf16_t* WGU = (bf16_t*)(ws + WS_WGU); bf16_t* WDN = (bf16_t*)(ws + WS_WDN); bf16_t* SCIN = (bf16_t*)(ws + WS_SCIN); bf16_t* SCOUT = (bf16_t*)(ws + WS_SCOUT);
    bf16_t* GBp = (bf16_t*)(ws + WS_GB); bf16_t* UUp = (bf16_t*)(ws + WS_UU);
    bf16_t* WIN = (bf16_t*)(ws + WS_WIN); bf16_t* WOUT = (bf16_t*)(ws + WS_WOUT); float* GATES = (float*)(ws + WS_GATES);
    const ScanPtrs SP{ws + WS_QN, ws + WS_KT, ws + WS_NWK, (unsigned char*)args.out + 66 * MiB, (unsigned char*)args.out, (float*)(ws + WS_SCL)};
    bf16_t* OFp = (bf16_t*)(ws + WS_OF); bf16_t* OBp = (bf16_t*)(ws + WS_OB);
    bf16_t* QKV = (bf16_t*)(ws + WS_QKV); bf16_t* Zp = (bf16_t*)(ws + WS_Z); bf16_t* POOLp = (bf16_t*)(ws + WS_POOL); bf16_t* CKV = (bf16_t*)(ws + WS_CKV);
    bf16_t* ACT = (bf16_t*)(ws + WS_ACT); bf16_t* HID = (bf16_t*)(ws + WS_HID); bf16_t* Y = (bf16_t*)(ws + WS_Y);
    float* xl = args.out; (void)xl;
    bf16_t* XLB = (bf16_t*)(ws + WS_XLB);

    if (IN(PH_PREP)) {
        LAS float* scr = (LAS float*)(F.lds + F.wave * 16384);
        const int gw_ = F.vcu * NWAVES + F.wave, NGW = F.G * NWAVES;
        for (int it = F.vcu; it < 192; it += F.G) { const int l = it / 96, n = (it % 96) * 64 + F.lane;
            const float* w = args.in[4] + (size_t)l * D * 6 * D + (size_t)(128 * F.wave) * 6 * D + n; float acc[5] = {0.f, 0.f, 0.f, 0.f, 0.f};
#pragma unroll 8
            for (int k2 = 0; k2 < 128; ++k2) { const float wv = w[(size_t)k2 * 6 * D]; const int kk = 128 * F.wave + k2;
#pragma unroll
                for (int r = 0; r < 5; ++r) { const float cv = r < 4 ? args.in[1][r * D + kk] : args.in[3][kk]; acc[r] += silu1(cv) * wv; } }
            LAS float* red = (LAS float*)(F.lds + 8 * 16384);
#pragma unroll
            for (int r = 0; r < 5; ++r) red[(F.wave * 5 + r) * 64 + F.lane] = acc[r];
            __syncthreads();
            if (F.tid < 320) { const int r = F.tid >> 6, ln = F.tid & 63; float sacc = 0.f;
#pragma unroll
                for (int w2 = 0; w2 < 8; ++w2) sacc += red[(w2 * 5 + r) * 64 + ln];
                const int n2 = (it % 96) * 64 + ln;
                ADAw[((size_t)l * 5 + r) * 6 * D + n2] = sacc + args.in[5][l * 6 * D + n2]; }
            __syncthreads(); }
        for (int it = gw_; it < 1280; it += NGW) { const int kb = it / 80, nb = it % 80, n0 = 32 * nb;
            transpose_item(args.in[9], D, EVEN_IN, n0 < 2048 ? n0 : n0 + 16, 64 * kb, WIN, n0, scr, F.lane); }
    }
    SEAM(PH_PREP);
    if (IN(PH_E1)) ph_norm16<1>(F, args.in[0], args.in[2], ACT, args.in[6], ADA, args.in[9] + 2048, EVEN_IN, GATES, args.in[11], args.in[12]);
    SEAM(PH_E1);
    if (IN(PH_E2)) { SchedProj S{F.vcu, F.G}; EpiProj E{QKV, Zp, POOLp, CKV}; gemm_phase<EpiProj, SchedProj, false>(F.lds, ACT, WIN, D, S, E); }
    SEAM(PH_E2);
    if (IN(PH_E3)) ph_chunk_prep(F, QKV, CKV, GATES, args.in[10], SP);
    SEAM(PH_E3);
#if PROBE_SEL >= 0
    unsigned long long* tsq = (unsigned long long*)((unsigned*)(ws + WS_CTL) + CW_TS);
    const unsigned long long te0_ = __builtin_amdgcn_s_memrealtime();
#endif
    if (IN(PH_E4)) {
        unsigned* prog = (unsigned*)(ws + WS_CTL) + CW_PROG;
        const int xj = F.vcu & 31, xg = F.vcu >> 5;
        if (xj < 8) ph_scan(F, SP, OFp, OBp, prog);
        else prep_late(F, args, (xg * 24 + (xj - 8)) * NWAVES + F.wave, 192 * NWAVES, WOUT, SCIN, SCOUT, WGU, WDN);
    }
#if PROBE_SEL >= 0
    const unsigned long long te1_ = __builtin_amdgcn_s_memrealtime();
    if (F.tid == 0 && blockIdx.x == 0) tsq[8] = te1_ - te0_;
    if (F.tid == 0 && blockIdx.x == 64) tsq[9] = te1_ - te0_;
    if (F.tid == 0 && blockIdx.x == 255) tsq[10] = te1_ - te0_;
#endif
    SEAM(PH_E4);
#if PROBE_SEL >= 0
    if (F.tid == 0 && blockIdx.x == 0) tsq[11] = __builtin_amdgcn_s_memrealtime() - te0_;
#endif
    if (IN(PH_E5)) ph_even_A(F, OFp, OBp, Zp, POOLp, args.in[13], ACT);
    SEAM(PH_E5);
    if (IN(PH_E6)) { SchedDense<4, 256> S{F.vcu, F.G, 128 * 4}; EpiResid<false> E{args.in[0], XLB, ADA + 2 * D}; gemm_phase<EpiResid<false>, SchedDense<4, 256>, false>(F.lds, ACT, WOUT, D, S, E); }
    SEAM(PH_E6);
#define MOE_SEGMENT(l, p0) do { \
        const float* ada_l = ADA + (size_t)(l) * 5 * 6 * D; \
        if (IN(p0)) ph_norm16<0>(F, XLB, nullptr, ACT, args.in[7] + (l) * D, ada_l, args.in[20] + (size_t)(l) * D * NE, NE, AFF, nullptr, nullptr, SEL); \
        SEAM(p0); \
        if (IN((p0) + 1)) ph_topk(F, AFF, IDX, GATE, SEL); \
        SEAM((p0) + 1); \
        if (IN((p0) + 2)) { SchedMoeUp S{F.vcu, (l), IDX}; EpiSiluMul E{HID, DE}; gemm_phase<EpiSiluMul, SchedMoeUp, true>(F.lds, ACT, WGU, D, S, E); } \
        SEAM((p0) + 2); \
        if (IN((p0) + 3)) { SchedMoeDown S{F.vcu, (l)}; EpiRowScale E{Y, D, GATE}; gemm_phase<EpiRowScale, SchedMoeDown, false>(F.lds, HID, WDN, DE, S, E); } \
        SEAM((p0) + 3); \
        if (IN((p0) + 4)) { \
            if ((l) == 0) ph_combine<false>(F, XLB, nullptr, Y, SEL, ada_l, args.in[6] + D, ADA + (size_t)5 * 6 * D, ACT); \
            else ph_combine<true>(F, XLB, args.out, Y, SEL, ada_l, args.in[8], nullptr, nullptr); \
        } \
    } while (0)
    MOE_SEGMENT(0, PH_M1_0);
    SEAM(PH_M5_0);
    if (IN(PH_X1)) { SchedDense<12, 1> S{F.vcu, F.G, 128 * 12}; EpiScIn E{GBp, UUp}; gemm_phase<EpiScIn, SchedDense<12, 1>, false>(F.lds, ACT, SCIN, D, S, E); }
    SEAM(PH_X1);
    if (IN(PH_X2)) ph_sc_glue(F, GBp, UUp, args.in[18], ACT);
    SEAM(PH_X2);
    if (IN(PH_X3)) { SchedDense<4, 256> S{F.vcu, F.G, 128 * 4}; EpiResid<true> E{XLB, XLB, ADA + (size_t)5 * 6 * D + 2 * D}; gemm_phase<EpiResid<true>, SchedDense<4, 256>, false>(F.lds, ACT, SCOUT, D, S, E); }
    SEAM(PH_X3);
    MOE_SEGMENT(1, PH_M1_1);
#undef MOE_SEGMENT
#if PROBE_SEL >= 0
    if (blockIdx.x == 0 && F.tid == 0) { asm volatile("s_waitcnt vmcnt(0)" ::: "memory");
        const unsigned long long v = __hip_atomic_load((unsigned long long*)((unsigned*)(ws + WS_CTL) + CW_TS) + PROBE_SEL, __ATOMIC_RELAXED, __HIP_MEMORY_SCOPE_AGENT);
        const unsigned long long t0 = __builtin_amdgcn_s_memrealtime();
        while (__builtin_amdgcn_s_memrealtime() - t0 < 4ull * v) __builtin_amdgcn_s_sleep(8); }
#endif
#undef IN
#undef SEAM
}
}

}

extern "C" void kernel_launch(void* const* d_in, const int* in_sizes, int n_in, void* d_out, int out_size, void* d_ws, size_t ws_size, hipStream_t st) {
    static int grid = 0;
    if (grid == 0) {
        int dev = 0, cus = 0;
        if (hipGetDevice(&dev) != hipSuccess || hipDeviceGetAttribute(&cus, hipDeviceAttributeMultiprocessorCount, dev) != hipSuccess) { grid = -1; return; }
        if (hipFuncSetAttribute((const void*)mk::mega, hipFuncAttributeMaxDynamicSharedMemorySize, mk::LDS_BYTES) != hipSuccess) { fprintf(stderr, "hipFuncSetAttribute failed\n"); grid = -1; return; }
        if (ws_size < mk::WS_END) { fprintf(stderr, "workspace too small: %zu < %zu\n", ws_size, (size_t)mk::WS_END); grid = -1; return; }
        grid = cus;
    }
    if (grid < 0) return;
    (void)hipMemsetAsync((char*)d_ws + mk::WS_CTL, 0, mk::MiB, st);
    mk::Args a{};
    for (int i = 0; i < 24; ++i) a.in[i] = (const float*)d_in[i];
    a.out = (float*)d_out; a.ws = (unsigned char*)d_ws;
    int n_mega = 0;
    auto mega = [&](int lo, int hi) { a.ph_lo = lo; a.ph_hi = hi; a.li = n_mega++; hipLaunchKernelGGL(mk::mega, dim3(grid), dim3(mk::NTHREADS), mk::LDS_BYTES, st, a); };
    mega(0, mk::PH_COUNT);
}
```

```cpp
#include <hip/hip_runtime.h>
#include <cstdio>
#include <cstdint>

namespace {
constexpr int D = 1024, BATCH = 4, SEQ = 8192, CTX = 256, NH = 4, DK = 128, DV = 128;
constexpr int EVEN_IN = 2576, NE = 16, DE = 512, CAP = 1024;
constexpr float EPS = 1e-6f;

__device__ __forceinline__ float silu_f(float x) { return x / (1.f + __expf(-x)); }
__device__ __forceinline__ float sigmoid_f(float x) { return 1.f / (1.f + __expf(-x)); }
__device__ __forceinline__ float softplus_f(float x) { return x > 20.f ? x : log1pf(__expf(x)); }
__device__ __forceinline__ float wave_sum(float v) {
#pragma unroll
    for (int o = 1; o < 64; o <<= 1) v += __shfl_xor(v, o);
    return v;
}


namespace mk {
#define LAS __attribute__((address_space(3)))
#define GAS __attribute__((address_space(1)))
typedef unsigned short bf16_t;
typedef short bf16x8 __attribute__((ext_vector_type(8)));
typedef float f32x4 __attribute__((ext_vector_type(4)));
typedef float f32x2 __attribute__((ext_vector_type(2)));
typedef unsigned u32x4 __attribute__((ext_vector_type(4)));
typedef unsigned u32x2 __attribute__((ext_vector_type(2)));
constexpr int M_LAT = BATCH * SEQ;
constexpr int BM = 256, BK = 64, HALF = 128, HTB = HALF * BK * 2, STAGE_BYTES = 8 * HTB;
constexpr int LDS_BYTES = 163840, GTAB_OFF = 131072  , MISC_OFF = LDS_BYTES - 256;
constexpr int NTHREADS = 512, NWAVES = 8;

__device__ __forceinline__ unsigned f2bf(float f) { unsigned u = __builtin_bit_cast(unsigned, f); return (u + 0x7fffu + ((u >> 16) & 1u)) >> 16; }
__device__ __forceinline__ unsigned pk2(float lo, float hi) { return f2bf(lo) | (f2bf(hi) << 16); }
typedef __bf16 bf16x2_t __attribute__((ext_vector_type(2)));
__device__ __forceinline__ unsigned cvt_pk_bf16(float lo, float hi) { const f32x2 v = {lo, hi}; const bf16x2_t b2 = __builtin_convertvector(v, bf16x2_t); return __builtin_bit_cast(unsigned, b2); }
__device__ __forceinline__ float bf_lo(unsigned w) { return __uint_as_float(w << 16); }
__device__ __forceinline__ float bf_hi(unsigned w) { return __uint_as_float(w & 0xffff0000u); }

__device__ __forceinline__ void lds_barrier() { asm volatile("s_waitcnt lgkmcnt(0)" ::: "memory"); __builtin_amdgcn_s_barrier(); asm volatile("" ::: "memory"); }

#define XB_TMO      128
#define XB_XCNT(j)  (256  + 64 * (j))
#define XB_XSUB(j)  (1280 + 64 * (j))
#define XB_XGEN(j)  (2304 + 64 * (j))
#define XB_TOP      3328
#define XB_TOPGEN   3392
#define XCD_BAR_WORDS 3456
#define XB_SPIN_CAP (1u << 18)
__device__ __forceinline__ unsigned xb_ld(unsigned* p)              { return __hip_atomic_load(p, __ATOMIC_RELAXED, __HIP_MEMORY_SCOPE_AGENT); }
__device__ __forceinline__ unsigned xb_add(unsigned* p, unsigned v) { return __hip_atomic_fetch_add(p, v, __ATOMIC_RELAXED, __HIP_MEMORY_SCOPE_AGENT); }
__device__ __forceinline__ unsigned xb_xcc_id() { return (unsigned)__builtin_amdgcn_s_getreg((3 << 11) | 20) & 0xFu; }
#define XB_SPIN(cond, bar) do { unsigned _sp = 0; while (cond) { __builtin_amdgcn_s_sleep(1); \
    if ((++_sp & 255u) == 0u) { if (xb_ld(&(bar)[XB_TMO])) break; if (_sp > XB_SPIN_CAP) { atomicAdd(&(bar)[XB_TMO], 1u); break; } } } } while (0)
struct XcdBarrier { unsigned* bar; unsigned x; volatile LAS unsigned* st; };
__device__ __forceinline__ XcdBarrier xcd_barrier_post(unsigned* bar, volatile LAS unsigned* st) {
    XcdBarrier b; b.bar = bar; b.x = xb_xcc_id(); b.st = st;
    if (threadIdx.x == 0) (void)xb_add(&bar[XB_XCNT(b.x)], 1u);
    return b;
}
__device__ __forceinline__ void xcd_barrier_complete(unsigned* bar, unsigned x, unsigned& nloc, unsigned& nx) {
    const unsigned G = gridDim.x * gridDim.y * gridDim.z;
    unsigned sum, cnt, mine, sp = 0u;
    for (;;) {
        sum = 0u; cnt = 0u; mine = 0u;
#pragma unroll
        for (unsigned j = 0; j < 16; ++j) { const unsigned c = xb_ld(&bar[XB_XCNT(j)]); sum += c; cnt += (c > 0u) ? 1u : 0u; mine = (j == x) ? c : mine; }
        if (sum == G) break;
        __builtin_amdgcn_s_sleep(1);
        if ((++sp & 255u) == 0u) { if (xb_ld(&bar[XB_TMO])) break; if (sp > XB_SPIN_CAP) { atomicAdd(&bar[XB_TMO], 1u); break; } }
    }
    nloc = mine > 0u ? mine : 1u; nx = cnt > 0u ? cnt : 1u;
}
__device__ __forceinline__ void xcd_barrier(const XcdBarrier& b) {
    asm volatile("s_waitcnt vmcnt(0)" ::: "memory");
    __syncthreads();
    if (threadIdx.x == 0) {
        unsigned* bar = b.bar;
        __builtin_amdgcn_s_waitcnt(0);
        unsigned nloc = b.st[0], nx = b.st[1];
        if (nloc == 0u) { xcd_barrier_complete(bar, b.x, nloc, nx); b.st[0] = nloc; b.st[1] = nx; }
        const unsigned old = xb_add(&bar[XB_XSUB(b.x)], 1u);
        const unsigned gen = old / nloc;
        if (old + 1u == (gen + 1u) * nloc) {
            __builtin_amdgcn_fence(__ATOMIC_RELEASE, "agent");
            asm volatile("s_waitcnt vmcnt(0)" ::: "memory");
            const unsigned og = xb_add(&bar[XB_TOP], 1u);
            const unsigned tg = og / nx;
            if (og + 1u == (tg + 1u) * nx) xb_add(&bar[XB_TOPGEN], 1u);
            else XB_SPIN(xb_ld(&bar[XB_TOPGEN]) == tg, bar);
            __builtin_amdgcn_fence(__ATOMIC_ACQUIRE, "agent");
            xb_add(&bar[XB_XGEN(b.x)], 1u);
            asm volatile("s_waitcnt vmcnt(0)" ::: "memory");
        } else {
            XB_SPIN(xb_ld(&bar[XB_XGEN(b.x)]) == gen, bar);
            __builtin_amdgcn_fence(__ATOMIC_ACQUIRE, "agent");
            asm volatile("s_waitcnt vmcnt(0)" ::: "memory");
        }
    }
    __syncthreads();
}

__host__ __device__ __forceinline__ int lds_byte(int r, int c) { const int st = (r >> 4) * 2 + (c >> 5), rr = r & 15, cc = c & 31, ob = rr * 64 + cc * 2; return st * 1024 + (ob ^ (((ob >> 9) & 1) << 5)); }
__host__ __device__ __forceinline__ void stage_rc(int b, int& R, int& C) { const int st = b / 1024, sb = b % 1024, swz = sb ^ (((sb >> 9) & 1) << 5); R = (st >> 1) * 16 + swz / 64; C = (st & 1) * 32 + (swz % 64) / 2; }
__host__ __device__ __forceinline__ int perm32(int rho) { const int n = rho >> 4, i = rho & 15; return 8 * (i >> 2) + 4 * n + (i & 3); }

struct Unit { int arow, brow, orow, ocol; };

template <class Epi, class Sched, bool GATHER>
__device__ __forceinline__ void gemm_phase(LAS unsigned char* lds, const bf16_t* Abase, const bf16_t* Btbase, const int K, const Sched& S, const Epi& E) {
    const int tid = threadIdx.x, wid = __builtin_amdgcn_readfirstlane(tid >> 6), lane = tid & 63, wr = wid >> 2, wc = wid & 3, fr = lane & 15, fq = lane >> 4;
    const int nt = K / BK;
    unsigned voffA[2], voffB[2];
#pragma unroll
    for (int i = 0; i < 2; ++i) { int R, C; stage_rc(tid * 16 + i * 8192, R, C); const int Rb = Epi::PERM ? ((R & ~31) + perm32(R & 31)) : R;
        voffA[i] = (unsigned)(R * K + C) * 2u; voffB[i] = (unsigned)(Rb * K + C) * 2u; }
    const size_t kstep = (size_t)(BK * 2);
    const size_t hstep = (size_t)HALF * K * 2;
    const unsigned ldsw = (unsigned)wid * 1024u;
    const int aoff = lds_byte(wr * 64 + fr, fq * 8), boff = lds_byte(wc * 32 + fr, fq * 8);
    LAS const int* gtab = (LAS const int*)(lds + GTAB_OFF);
    unsigned goff[2][2];
#define PG8_SA(b, h) (((b) * 2 + (h)) * HTB)
#define PG8_SB(b, h) ((4 + (b) * 2 + (h)) * HTB)
#define PG8_STAGE(bufoff, gbase, voff) do { _Pragma("unroll") for (int _i = 0; _i < 2; ++_i) \
        __builtin_amdgcn_global_load_lds((const unsigned*)((const char*)(gbase) + (voff)[_i]), (LAS unsigned*)(lds + (bufoff) + ldsw + _i * 8192), 16, 0, 0); } while (0)
#define PG8_STAGE_A(bufoff, abase, h) do { if constexpr (GATHER) { PG8_STAGE(bufoff, abase, goff[h]); } else { PG8_STAGE(bufoff, (abase) + (h) * hstep, voffA); } } while (0)
#define PG8_LDA(dst, b, h) do { _Pragma("unroll") for (int m = 0; m < 4; ++m) _Pragma("unroll") for (int k = 0; k < 2; ++k) dst[m][k] = *(const LAS bf16x8*)(lds + PG8_SA(b, h) + aoff + m * 2048 + k * 1024); } while (0)
#define PG8_LDB(dst, b, h) do { _Pragma("unroll") for (int n = 0; n < 2; ++n) _Pragma("unroll") for (int k = 0; k < 2; ++k) dst[n][k] = *(const LAS bf16x8*)(lds + PG8_SB(b, h) + boff + n * 2048 + k * 1024); } while (0)
#define PG8_MMA(ai, bj, At, Bt) do { __builtin_amdgcn_s_setprio(1); _Pragma("unroll") for (int m = 0; m < 4; ++m) _Pragma("unroll") for (int n = 0; n < 2; ++n) _Pragma("unroll") for (int k = 0; k < 2; ++k) \
        acc[ai][bj][m][n] = __builtin_amdgcn_mfma_f32_16x16x32_bf16(Bt[n][k], At[m][k], acc[ai][bj][m][n], 0, 0, 0); __builtin_amdgcn_s_setprio(0); } while (0)
#define PG8_WAIT_V(n) asm volatile("s_waitcnt vmcnt(" #n ")" ::: "memory")
#define PG8_WAIT_L(n) asm volatile("s_waitcnt lgkmcnt(" #n ")" ::: "memory")
#define PG8_BAR __builtin_amdgcn_s_barrier()
#define PG8_SCHED __builtin_amdgcn_sched_barrier(0)
#define PG8_GLOAD(ui_) do { if constexpr (GATHER) { _Pragma("unroll") for (int _i = 0; _i < 2; ++_i) { int _R, _C; stage_rc(tid * 16 + _i * 8192, _R, _C); _Pragma("unroll") for (int _h = 0; _h < 2; ++_h) \
        goff[_h][_i] = (unsigned)(gtab[((ui_) & 3) * 256 + _h * HALF + _R] * K * 2 + _C * 2); } } } while (0)
    Unit cur, nxt; int ui = 0;
    if (!S.next(0, cur)) return;
    if constexpr (GATHER) {
        Unit t;
        for (int j = 0; j < 4; ++j) if (S.next(j, t)) { if (tid < 256) ((LAS int*)(lds + GTAB_OFF))[j * 256 + tid] = S.gidx(t, tid); }
        __syncthreads();
    }
    f32x4 acc[2][2][4][2];
#pragma unroll
    for (int a = 0; a < 2; ++a)
#pragma unroll
        for (int b = 0; b < 2; ++b)
#pragma unroll
            for (int m = 0; m < 4; ++m)
#pragma unroll
                for (int n = 0; n < 2; ++n) acc[a][b][m][n] = (f32x4){0.f, 0.f, 0.f, 0.f};
    bf16x8 At[4][2], B0[2][2], B1[2][2];
    const char* cA = (const char*)Abase + (size_t)cur.arow * K * 2; const char* cB = (const char*)Btbase + (size_t)cur.brow * K * 2;
    PG8_GLOAD(0);
    PG8_STAGE(PG8_SB(0, 0), cB, voffB); PG8_STAGE(PG8_SB(0, 1), cB + hstep, voffB); PG8_STAGE_A(PG8_SA(0, 0), cA, 0); PG8_STAGE_A(PG8_SA(0, 1), cA, 1);
    if (wr == 1) PG8_BAR;
    PG8_WAIT_V(2); PG8_BAR;
    PG8_STAGE(PG8_SB(1, 0), cB + kstep, voffB); PG8_STAGE_A(PG8_SA(1, 0), cA + kstep, 0); PG8_STAGE(PG8_SB(1, 1), cB + hstep + kstep, voffB);
    PG8_WAIT_V(6); PG8_BAR;
    for (;;) {
        const bool has_next = S.next(ui + 1, nxt);
        const char* nA = has_next ? (const char*)Abase + (size_t)nxt.arow * K * 2 : cA; const char* nB = has_next ? (const char*)Btbase + (size_t)nxt.brow * K * 2 : cB;
        for (int t = 0; t < nt; t += 2) {
            const bool last = (t == nt - 2);
            const char* a1 = cA + (size_t)(t + 1) * kstep;
            const char* a2 = last ? nA : cA + (size_t)(t + 2) * kstep; const char* b2 = last ? nB : cB + (size_t)(t + 2) * kstep;
            const char* a3 = a2 + kstep; const char* b3 = b2 + kstep;
            PG8_LDB(B0, 0, 0); PG8_LDB(B1, 0, 1); PG8_SCHED; PG8_LDA(At, 0, 0); PG8_STAGE_A(PG8_SA(1, 1), a1, 1);
            if constexpr (GATHER) { if (last && has_next) PG8_GLOAD(ui + 1); }
            PG8_WAIT_V(8); PG8_WAIT_L(0); PG8_BAR; PG8_MMA(0, 0, At, B0); PG8_MMA(0, 1, At, B1); PG8_BAR; PG8_SCHED;
            PG8_LDA(At, 0, 1); PG8_STAGE(PG8_SB(0, 0), b2, voffB); PG8_STAGE(PG8_SB(0, 1), b2 + hstep, voffB); PG8_STAGE_A(PG8_SA(0, 0), a2, 0);
            PG8_WAIT_V(8); PG8_WAIT_L(0); PG8_BAR; PG8_MMA(1, 0, At, B0); PG8_MMA(1, 1, At, B1); PG8_BAR; PG8_SCHED;
            PG8_LDB(B0, 1, 0); PG8_LDB(B1, 1, 1); PG8_SCHED; PG8_LDA(At, 1, 0); PG8_STAGE_A(PG8_SA(0, 1), a2, 1);
            PG8_WAIT_V(8); PG8_WAIT_L(0); PG8_BAR; PG8_MMA(0, 0, At, B0); PG8_MMA(0, 1, At, B1); PG8_BAR; PG8_SCHED;
            PG8_LDA(At, 1, 1); PG8_STAGE(PG8_SB(1, 0), b3, voffB); PG8_STAGE(PG8_SB(1, 1), b3 + hstep, voffB); PG8_STAGE_A(PG8_SA(1, 0), a3, 0);
            PG8_WAIT_V(8); PG8_WAIT_L(0); PG8_BAR; PG8_MMA(1, 0, At, B0); PG8_MMA(1, 1, At, B1); PG8_BAR; PG8_SCHED;
        }
        if (wr == 0) PG8_BAR;
        E(acc, cur, wr, wc, fr, fq);
        if (!has_next) break;
#pragma unroll
        for (int a = 0; a < 2; ++a)
#pragma unroll
            for (int b = 0; b < 2; ++b)
#pragma unroll
                for (int m = 0; m < 4; ++m)
#pragma unroll
                    for (int n = 0; n < 2; ++n) acc[a][b][m][n] = (f32x4){0.f, 0.f, 0.f, 0.f};
        cur = nxt; cA = nA; cB = nB; ++ui;
        if (wr == 1) PG8_BAR;
    }
    PG8_WAIT_V(0);
    PG8_BAR;
#undef PG8_SA
#undef PG8_SB
#undef PG8_STAGE
#undef PG8_STAGE_A
#undef PG8_LDA
#undef PG8_LDB
#undef PG8_MMA
#undef PG8_WAIT_V
#undef PG8_WAIT_L
#undef PG8_BAR
#undef PG8_SCHED
#undef PG8_GLOAD
}

__device__ __forceinline__ float silu1(float x) { return x * __builtin_amdgcn_rcpf(1.f + __expf(-x)); }
struct EpiSiluMul {
    static constexpr bool PERM = true;
    bf16_t* O; int ldo;
    __device__ __forceinline__ void operator()(const f32x4 (&acc)[2][2][4][2], const Unit& u, int wr, int wc, int fr, int fq) const {
        const int row0 = u.orow + wr * 64 + fr, col0 = u.ocol + wc * 32 + 8 * fq;
#pragma unroll
        for (int ai = 0; ai < 2; ++ai)
#pragma unroll
            for (int m = 0; m < 4; ++m) { bf16_t* rowp = O + (size_t)(row0 + ai * HALF + m * 16) * ldo + col0;
                const f32x4 g0 = acc[ai][0][m][0], g1 = acc[ai][0][m][1], u0 = acc[ai][1][m][0], u1 = acc[ai][1][m][1];
                u32x4 w; w.x = cvt_pk_bf16(silu1(g0[0]) * u0[0], silu1(g0[1]) * u0[1]); w.y = cvt_pk_bf16(silu1(g0[2]) * u0[2], silu1(g0[3]) * u0[3]);
                w.z = cvt_pk_bf16(silu1(g1[0]) * u1[0], silu1(g1[1]) * u1[1]); w.w = cvt_pk_bf16(silu1(g1[2]) * u1[2], silu1(g1[3]) * u1[3]);
                *(u32x4*)rowp = w; }
    }
};
struct EpiRowScale {
    static constexpr bool PERM = true;
    bf16_t* O; int ldo; const float* rowscale;
    __device__ __forceinline__ void operator()(const f32x4 (&acc)[2][2][4][2], const Unit& u, int wr, int wc, int fr, int fq) const {
        const int row0 = u.orow + wr * 64 + fr, col0 = u.ocol + wc * 32 + 8 * fq;
#pragma unroll
        for (int ai = 0; ai < 2; ++ai)
#pragma unroll
            for (int m = 0; m < 4; ++m) { const int row = row0 + ai * HALF + m * 16; const float sc = rowscale[row]; bf16_t* rowp = O + (size_t)row * ldo + col0;
#pragma unroll
                for (int bj = 0; bj < 2; ++bj) { const f32x4 v0 = acc[ai][bj][m][0] * sc, v1 = acc[ai][bj][m][1] * sc;
                    u32x4 w; w.x = cvt_pk_bf16(v0[0], v0[1]); w.y = cvt_pk_bf16(v0[2], v0[3]); w.z = cvt_pk_bf16(v1[0], v1[1]); w.w = cvt_pk_bf16(v1[2], v1[3]);
                    *(u32x4*)(rowp + bj * HALF) = w; } }
    }
};


struct EpiScIn {
    static constexpr bool PERM = true;
    bf16_t* GB; bf16_t* UU;
    __device__ __forceinline__ void operator()(const f32x4 (&acc)[2][2][4][2], const Unit& u, int wr, int wc, int fr, int fq) const {
        const int row0 = u.orow + wr * 64 + fr;
        if (u.ocol < 4) {
            const int col0 = u.ocol * 256 + wc * 32 + 8 * fq;
#pragma unroll
            for (int ai = 0; ai < 2; ++ai)
#pragma unroll
                for (int m = 0; m < 4; ++m) { bf16_t* rowp = GB + (size_t)(row0 + ai * HALF + m * 16) * D + col0;
#pragma unroll
                    for (int bj = 0; bj < 2; ++bj) { const f32x4 v0 = acc[ai][bj][m][0], v1 = acc[ai][bj][m][1];
                        u32x4 w; w.x = cvt_pk_bf16(v0[0], v0[1]); w.y = cvt_pk_bf16(v0[2], v0[3]); w.z = cvt_pk_bf16(v1[0], v1[1]); w.w = cvt_pk_bf16(v1[2], v1[3]);
                        *(u32x4*)(rowp + bj * HALF) = w; } }
        } else {
            const int col0 = (u.ocol - 4) * 128 + wc * 32 + 8 * fq;
#pragma unroll
            for (int ai = 0; ai < 2; ++ai)
#pragma unroll
                for (int m = 0; m < 4; ++m) { bf16_t* rowp = UU + (size_t)(row0 + ai * HALF + m * 16) * D + col0;
                    const f32x4 v0 = acc[ai][0][m][0] * acc[ai][1][m][0], v1 = acc[ai][0][m][1] * acc[ai][1][m][1];
                    u32x4 w; w.x = cvt_pk_bf16(v0[0], v0[1]); w.y = cvt_pk_bf16(v0[2], v0[3]); w.z = cvt_pk_bf16(v1[0], v1[1]); w.w = cvt_pk_bf16(v1[2], v1[3]);
                    *(u32x4*)rowp = w; }
        }
    }
};
template <bool BASE_BF16>
struct EpiResid {
    static constexpr bool PERM = true;
    const void* base; bf16_t* out; const float* gada;
    __device__ __forceinline__ void operator()(const f32x4 (&acc)[2][2][4][2], const Unit& u, int wr, int wc, int fr, int fq) const {
        const int row0 = u.orow + wr * 64 + fr, col0 = u.ocol + wc * 32 + 8 * fq;
        const float* g = gada + (size_t)(u.orow >> 13) * 6 * D + col0;
        f32x4 gv[2][2];
#pragma unroll
        for (int bj = 0; bj < 2; ++bj)
#pragma unroll
            for (int n = 0; n < 2; ++n) gv[bj][n] = *(const f32x4*)(g + bj * HALF + n * 4);
#pragma unroll
        for (int ai = 0; ai < 2; ++ai)
#pragma unroll
            for (int m = 0; m < 4; ++m) { const size_t off = (size_t)(row0 + ai * HALF + m * 16) * D + col0;
#pragma unroll
                for (int bj = 0; bj < 2; ++bj) {
                    f32x4 b0, b1;
                    if constexpr (BASE_BF16) { const u32x4 bw = *(const u32x4*)((const bf16_t*)base + off + bj * HALF);
                        b0 = (f32x4){bf_lo(bw.x), bf_hi(bw.x), bf_lo(bw.y), bf_hi(bw.y)}; b1 = (f32x4){bf_lo(bw.z), bf_hi(bw.z), bf_lo(bw.w), bf_hi(bw.w)}; }
                    else { b0 = *(const f32x4*)((const float*)base + off + bj * HALF); b1 = *(const f32x4*)((const float*)base + off + bj * HALF + 4); }
                    const f32x4 v0 = b0 + gv[bj][0] * acc[ai][bj][m][0], v1 = b1 + gv[bj][1] * acc[ai][bj][m][1];
                    u32x4 w; w.x = cvt_pk_bf16(v0[0], v0[1]); w.y = cvt_pk_bf16(v0[2], v0[3]); w.z = cvt_pk_bf16(v1[0], v1[1]); w.w = cvt_pk_bf16(v1[2], v1[3]);
                    *(u32x4*)(out + off + bj * HALF) = w; } }
    }
};

struct EpiProj {
    static constexpr bool PERM = true;
    bf16_t* QKV; bf16_t* Z; bf16_t* POOL; bf16_t* CKV;
    __device__ __forceinline__ void operator()(const f32x4 (&acc)[2][2][4][2], const Unit& u, int wr, int wc, int fr, int fq) const {
        bf16_t* base; int ld;
        if (u.ocol < 6) { base = QKV + (size_t)u.orow * 1536 + u.ocol * 256; ld = 1536; }
        else if (u.ocol < 8) { base = Z + (size_t)u.orow * 512 + (u.ocol - 6) * 256; ld = 512; }
        else if (u.ocol < 10) { base = POOL + (size_t)u.orow * 512 + (u.ocol - 8) * 256; ld = 512; }
        else { base = CKV + (size_t)(u.orow - M_LAT) * 1024 + (u.ocol - 16) * 256; ld = 1024; }
        base += (size_t)(wr * 64 + fr) * ld + wc * 32 + 8 * fq;
#pragma unroll
        for (int ai = 0; ai < 2; ++ai)
#pragma unroll
            for (int m = 0; m < 4; ++m) { bf16_t* rowp = base + (size_t)(ai * HALF + m * 16) * ld;
#pragma unroll
                for (int bj = 0; bj < 2; ++bj) { const f32x4 v0 = acc[ai][bj][m][0], v1 = acc[ai][bj][m][1];
                    u32x4 w; w.x = cvt_pk_bf16(v0[0], v0[1]); w.y = cvt_pk_bf16(v0[2], v0[3]); w.z = cvt_pk_bf16(v1[0], v1[1]); w.w = cvt_pk_bf16(v1[2], v1[3]);
                    *(u32x4*)(rowp + bj * HALF) = w; } }
    }
};
struct SchedProj {
    int vcu, G;
    __device__ __forceinline__ bool next(int i, Unit& u) const {
        const int L = i * G + vcu; if (L >= 1296) return false;
        if (L < 1280) { const int pm = L / 10, pn = L % 10; u.arow = pm * 256; u.brow = pn * 256; u.orow = pm * 256; u.ocol = pn; }
        else { const int q = L - 1280, pm = q >> 2, pn = q & 3; u.arow = M_LAT + pm * 256; u.brow = 512 + pn * 256; u.orow = M_LAT + pm * 256; u.ocol = 16 + pn; }
        return true;
    }
    __device__ __forceinline__ int gidx(const Unit&, int) const { return 0; }
};

template <int NT, int COLMUL>
struct SchedDense {
    int vcu, G, nunits;
    __device__ __forceinline__ bool next(int i, Unit& u) const {
        const int L = i * G + vcu; if (L >= nunits) return false;
        const int pm = L / NT, pn = L % NT;
        u.arow = pm * 256; u.brow = pn * 256; u.orow = pm * 256; u.ocol = pn * COLMUL;
        return true;
    }
    __device__ __forceinline__ int gidx(const Unit&, int) const { return 0; }
};

constexpr size_t MiB = 1u << 20;
constexpr size_t WS_CTL = 0;
constexpr size_t WS_ADA = 1 * MiB;
constexpr size_t WS_AFF = 2 * MiB;
constexpr size_t WS_IDX = 4 * MiB;
constexpr size_t WS_GATE = 4 * MiB + 512 * 1024;
constexpr size_t WS_SEL = 5 * MiB;
constexpr size_t WS_GATES = 7 * MiB;
constexpr size_t WS_WGU = 16 * MiB;
constexpr size_t WS_WDN = 80 * MiB;
constexpr size_t WS_SCIN = 112 * MiB;
constexpr size_t WS_SCOUT = 118 * MiB;
constexpr size_t WS_WIN = 120 * MiB;
constexpr size_t WS_WOUT = 125 * MiB;
constexpr size_t WS_TMP = 128 * MiB;
constexpr size_t WS_ACT = WS_TMP;
constexpr size_t WS_QKV = 194 * MiB;
constexpr size_t WS_Z = 290 * MiB;
constexpr size_t WS_POOL = 322 * MiB;
constexpr size_t WS_CKV = 354 * MiB;
constexpr size_t WS_QN = 356 * MiB;
constexpr size_t WS_KT = 389 * MiB;
constexpr size_t WS_NWK = 422 * MiB;
constexpr size_t WS_SCL = 488 * MiB;
constexpr size_t WS_XLB = WS_NWK;
constexpr size_t WS_OF = WS_ACT;
constexpr size_t WS_OB = WS_ACT + 32 * MiB;
constexpr size_t WS_ACT2 = WS_QKV;
constexpr size_t WS_HID = 194 * MiB;
constexpr size_t WS_Y = 258 * MiB;
constexpr size_t WS_GB = WS_HID;
constexpr size_t WS_UU = WS_Y;
constexpr size_t WS_END = 512 * MiB;
constexpr int CW_BAR = 4096;
#ifndef PROBE_SEL
#define PROBE_SEL -1
#endif
#ifndef PROBE_WAVE
#define PROBE_WAVE 0
#endif
constexpr int CW_TS = 32768;
constexpr int CW_FLAG = 65536;
constexpr int CW_PROG = 16384;

struct Args {
    const float* in[24]; float* out; unsigned char* ws; int ph_lo, ph_hi, li, pad;
};

struct Frame {
    LAS unsigned char* lds; int tid, lane, wave, G, vcu;
};

__device__ __forceinline__ void transpose_item(const float* W, int K, int ldn, int n0, int k0, bf16_t* WT, int drow0, LAS float* scr, int lane, int dcol0 = 0) {
    float tv[32];
#pragma unroll
    for (int i = 0; i < 32; ++i) tv[i] = __builtin_nontemporal_load(W + (size_t)(k0 + 2 * i + (lane >> 5)) * ldn + n0 + (lane & 31));
#pragma unroll
    for (int i = 0; i < 32; ++i) scr[(2 * i + (lane >> 5)) * 33 + (lane & 31)] = tv[i];
    asm volatile("s_waitcnt lgkmcnt(0)" ::: "memory");
    const int c = lane & 7;
#pragma unroll
    for (int j = 0; j < 4; ++j) { const int n = (lane >> 3) + 8 * j; const LAS float* s = scr + (8 * c) * 33 + n;
        u32x4 o; o.x = pk2(s[0 * 33], s[1 * 33]); o.y = pk2(s[2 * 33], s[3 * 33]); o.z = pk2(s[4 * 33], s[5 * 33]); o.w = pk2(s[6 * 33], s[7 * 33]);
        __builtin_nontemporal_store(o, (u32x4*)(WT + (size_t)(drow0 + n) * K + dcol0 + k0 + 8 * c)); }
    asm volatile("s_waitcnt lgkmcnt(0)" ::: "memory");
}

struct SchedMoeUp {
    int vcu, layer; const int* idx;
    __device__ __forceinline__ bool next(int i, Unit& u) const {
        const int L = i * 256 + vcu; if (L >= 1024) return false;
        const int g = L >> 4, pm = (L >> 2) & 3, pn = L & 3, b = g >> 4, e = g & 15;
        u.arow = b * SEQ; u.brow = ((layer * NE + e) * 4 + pn) * 256; u.orow = g * CAP + pm * 256; u.ocol = pn * 128;
        return true;
    }
    __device__ __forceinline__ int gidx(const Unit& u, int r) const { return idx[u.orow + r]; }
};
struct SchedMoeDown {
    int vcu, layer;
    __device__ __forceinline__ bool next(int i, Unit& u) const {
        const int L = i * 256 + vcu; if (L >= 1024) return false;
        const int g = L >> 4, pm = (L >> 2) & 3, pn = L & 3, e = g & 15;
        u.arow = g * CAP + pm * 256; u.brow = ((layer * NE + e) * 4 + pn) * 256; u.orow = g * CAP + pm * 256; u.ocol = pn * 256;
        return true;
    }
    __device__ __forceinline__ int gidx(const Unit&, int) const { return 0; }
};

__device__ __forceinline__ float wsum(float v) {
#pragma unroll
    for (int o = 1; o < 64; o <<= 1) v += __shfl_xor(v, o);
    return v;
}

template <int MODE>
__device__ __forceinline__ void ph_norm16(const Frame& F, const void* xlv, const float* xctx, bf16_t* act, const float* gw, const float* ada  , const float* w16, int ldw,
                                          float* out16, const float* a_log, const float* dt_bias, int* selfill = nullptr) {
    constexpr int WLD = 1032;
    LAS bf16_t* wt = (LAS bf16_t*)F.lds;
    LAS float* mod = (LAS float*)(F.lds + 16 * WLD * 2);
    if (selfill) { u32x4* p = (u32x4*)selfill; const u32x4 m1 = (u32x4){~0u, ~0u, ~0u, ~0u};
        for (int i = F.vcu * NTHREADS + F.tid; i < M_LAT * NE / 4; i += F.G * NTHREADS) p[i] = m1; }
    { float wv[32];
#pragma unroll
        for (int q = 0; q < 32; ++q) { const int i = F.tid + NTHREADS * q; wv[q] = w16[(size_t)(i >> 4) * ldw + (i & 15)]; }
#pragma unroll
        for (int q = 0; q < 32; ++q) { const int i = F.tid + NTHREADS * q; wt[(i & 15) * WLD + (i >> 4)] = (bf16_t)f2bf(wv[q]); } }
#pragma unroll
    for (int i = F.tid; i < 5 * D; i += NTHREADS) { const int b = i >> 10, c = i & (D - 1);
        const float* sh = ada + (size_t)b * 6 * D + (MODE == 0 ? 3 * D : 0);
        mod[(b * 2) * D + c] = gw[c] * (sh[D + c] + 1.f); mod[(b * 2 + 1) * D + c] = sh[c]; }
    __syncthreads();
    const int gw_ = F.vcu * NWAVES + F.wave, NGW = F.G * NWAVES, lane = F.lane, rr = lane & 15, kq = lane >> 4;
    const int ntiles = MODE == 0 ? M_LAT / 16 : M_LAT / 16 + BATCH * CTX / 4;
    for (int tw = gw_; tw < ntiles; tw += NGW) {
        const bool quart = MODE == 1 && tw >= M_LAT / 16;
        const int r0 = quart ? M_LAT + 4 * (tw - M_LAT / 16) : tw * 16, row = r0 + (quart ? (rr & 3) : rr);
        const bool lat = r0 < M_LAT;
        const int b = lat ? (r0 >> 13) : 4;
        const char* src; size_t rowbytes;
        if constexpr (MODE == 0) { src = (const char*)xlv + (size_t)row * D * 2 + kq * 16; rowbytes = 0; }
        else { src = (const char*)(lat ? (const float*)xlv + (size_t)row * D : xctx + (size_t)(row - M_LAT) * D) + kq * 32; rowbytes = 0; }
        (void)rowbytes;
        u32x4 xq[32];
        float ss = 0.f;
        if constexpr (MODE == 0) {
#pragma unroll
            for (int s = 0; s < 32; ++s) xq[s] = *(const u32x4*)(src + s * 64);
#pragma unroll
            for (int s = 0; s < 32; ++s)
#pragma unroll
                for (int q = 0; q < 4; ++q) { const float a = bf_lo(xq[s][q]), c2 = bf_hi(xq[s][q]); ss += a * a + c2 * c2; }
        } else {
#pragma unroll
            for (int s0 = 0; s0 < 32; s0 += 4) { f32x4 xv[4][2];
#pragma unroll
                for (int s = 0; s < 4; ++s) { xv[s][0] = *(const f32x4*)(src + (s0 + s) * 128); xv[s][1] = *(const f32x4*)(src + (s0 + s) * 128 + 16); }
#pragma unroll
                for (int s = 0; s < 4; ++s) { const f32x4 a = xv[s][0], c2 = xv[s][1];
                    ss += (a.x * a.x + a.y * a.y) + (a.z * a.z + a.w * a.w) + (c2.x * c2.x + c2.y * c2.y) + (c2.z * c2.z + c2.w * c2.w);
                    xq[s0 + s] = (u32x4){cvt_pk_bf16(a.x, a.y), cvt_pk_bf16(a.z, a.w), cvt_pk_bf16(c2.x, c2.y), cvt_pk_bf16(c2.z, c2.w)}; } }
        }
        ss += __shfl_xor(ss, 16); ss += __shfl_xor(ss, 32);
        const float rs = rsqrtf(ss * (1.f / D) + EPS);
#pragma unroll
        for (int s = 0; s < 32; ++s) asm volatile("" : "+v"(xq[s]));
        f32x4 acc = (f32x4){0.f, 0.f, 0.f, 0.f};
        const LAS float* mAp = mod + (b * 2) * D + kq * 8; const LAS float* mBp = mAp + D;
        const LAS bf16_t* wp = wt + rr * WLD + kq * 8;
        bf16_t* dst = act + (size_t)row * D + kq * 8;
#pragma unroll
        for (int s = 0; s < 32; ++s) {
            if ((s & 1) == 0) asm volatile("" : "+v"(mAp), "+v"(mBp), "+v"(wp), "+v"(dst));
            const u32x4 w = xq[s];
            const f32x4 a0 = *(const LAS f32x4*)(mAp + s * 32), a1 = *(const LAS f32x4*)(mAp + s * 32 + 4);
            const f32x4 b0 = *(const LAS f32x4*)(mBp + s * 32), b1 = *(const LAS f32x4*)(mBp + s * 32 + 4);
            const float h0 = bf_lo(w.x) * rs * a0.x + b0.x, h1 = bf_hi(w.x) * rs * a0.y + b0.y, h2 = bf_lo(w.y) * rs * a0.z + b0.z, h3 = bf_hi(w.y) * rs * a0.w + b0.w;
            const float h4 = bf_lo(w.z) * rs * a1.x + b1.x, h5 = bf_hi(w.z) * rs * a1.y + b1.y, h6 = bf_lo(w.w) * rs * a1.z + b1.z, h7 = bf_hi(w.w) * rs * a1.w + b1.w;
            u32x4 hw; hw.x = cvt_pk_bf16(h0, h1); hw.y = cvt_pk_bf16(h2, h3); hw.z = cvt_pk_bf16(h4, h5); hw.w = cvt_pk_bf16(h6, h7);
            if (!quart || rr < 4) *(u32x4*)(dst + s * 32) = hw;
            const bf16x8 bfrag = *(const LAS bf16x8*)(wp + s * 32);
            acc = __builtin_amdgcn_mfma_f32_16x16x32_bf16(__builtin_bit_cast(bf16x8, hw), bfrag, acc, 0, 0, 0);
        }
        if constexpr (MODE == 0) {
            f32x4 mx = acc;
#pragma unroll
            for (int o = 1; o < 16; o <<= 1) { mx.x = fmaxf(mx.x, __shfl_xor(mx.x, o)); mx.y = fmaxf(mx.y, __shfl_xor(mx.y, o)); mx.z = fmaxf(mx.z, __shfl_xor(mx.z, o)); mx.w = fmaxf(mx.w, __shfl_xor(mx.w, o)); }
            f32x4 ex; ex.x = __expf(acc.x - mx.x); ex.y = __expf(acc.y - mx.y); ex.z = __expf(acc.z - mx.z); ex.w = __expf(acc.w - mx.w);
            f32x4 sm = ex;
#pragma unroll
            for (int o = 1; o < 16; o <<= 1) { sm.x += __shfl_xor(sm.x, o); sm.y += __shfl_xor(sm.y, o); sm.z += __shfl_xor(sm.z, o); sm.w += __shfl_xor(sm.w, o); }
            const int t = (r0 & (SEQ - 1)) + 4 * kq;
            *(f32x4*)(out16 + ((size_t)b * NE + rr) * SEQ + t) = (f32x4){ex.x / sm.x, ex.y / sm.y, ex.z / sm.z, ex.w / sm.w};
        } else {
            if (!quart || kq == 0)
#pragma unroll
            for (int q = 0; q < 4; ++q) { const float x = acc[q]; float o;
                if (rr < 8) o = 1.f / (1.f + __expf(-x));
                else { const float y = x + dt_bias[rr - 8]; const float sp = y > 20.f ? y : log1pf(__expf(y)); o = -__expf(a_log[rr - 8]) * sp; }
                out16[(size_t)(r0 + 4 * kq + q) * 16 + rr] = o; }
        }
    }
    __syncthreads();
}

__device__ __forceinline__ void ph_topk(const Frame& F, const float* aff, int* idx, float* gate, int* sel) {
    LAS unsigned* keys = (LAS unsigned*)F.lds;
    LAS unsigned* hist = keys + SEQ;
    LAS unsigned* cg = hist + 256; LAS unsigned* ce = cg + 512;
    LAS unsigned* shv = ce + 512;
    const int tid = F.tid;
    for (int item = F.vcu; item < BATCH * NE; item += F.G) {
        const int b = item >> 4, e = item & 15;
        for (int i = tid; i < SEQ; i += NTHREADS) keys[i] = __float_as_uint(aff[(size_t)item * SEQ + i]);
        if (tid == 0) { shv[0] = 0u; shv[1] = CAP; }
        lds_barrier();
        unsigned mask = 0u;
        for (int pass = 0; pass < 4; ++pass) {
            const int shift = 24 - 8 * pass;
            if (tid < 256) hist[tid] = 0u;
            lds_barrier();
            const unsigned prefix = shv[0];
            for (int i = tid; i < SEQ; i += NTHREADS) { const unsigned kx = keys[i]; if ((kx & mask) == prefix) __hip_atomic_fetch_add(&hist[(kx >> shift) & 255u], 1u, __ATOMIC_RELAXED, __HIP_MEMORY_SCOPE_WORKGROUP); }
            lds_barrier();
            unsigned sfx = 0u;
            if (tid < 256) { sfx = hist[tid];
#pragma unroll
                for (int o2 = 1; o2 < 64; o2 <<= 1) { const unsigned x = __shfl_down(sfx, o2); if ((tid & 63) + o2 < 64) sfx += x; }
                if ((tid & 63) == 0) cg[tid >> 6] = sfx; }
            lds_barrier();
            if (tid < 256) { for (int w2 = (tid >> 6) + 1; w2 < 4; ++w2) sfx += cg[w2];
                const unsigned need = shv[1]; unsigned above = __shfl_down(sfx, 1); if ((tid & 63) == 63) { above = 0u; for (int w2 = (tid >> 6) + 1; w2 < 4; ++w2) above += cg[w2]; }
                if (sfx >= need && above < need) { shv[2] = prefix | ((unsigned)tid << shift); shv[3] = need - above; } }
            lds_barrier();
            if (tid == 0) { shv[0] = shv[2]; shv[1] = shv[3]; }
            mask |= 0xFFu << shift;
            lds_barrier();
        }
        const unsigned T = shv[0], need = shv[1];
        unsigned ng = 0u, nq = 0u; unsigned kk16[16];
#pragma unroll
        for (int q = 0; q < 4; ++q) { const u32x4 k4 = *(const LAS u32x4*)(keys + tid * 16 + 4 * q); kk16[4 * q] = k4.x; kk16[4 * q + 1] = k4.y; kk16[4 * q + 2] = k4.z; kk16[4 * q + 3] = k4.w; }
#pragma unroll
        for (int j = 0; j < 16; ++j) { const unsigned kx = kk16[j]; ng += kx > T; nq += kx == T; }
        unsigned ig = ng, iq = nq;
#pragma unroll
        for (int o2 = 1; o2 < 64; o2 <<= 1) { const unsigned xg = __shfl_up(ig, o2), xq = __shfl_up(iq, o2); if ((tid & 63) >= o2) { ig += xg; iq += xq; } }
        if ((tid & 63) == 63) { cg[tid >> 6] = ig; ce[tid >> 6] = iq; }
        lds_barrier();
        unsigned g0 = ig - ng, q0 = iq - nq;
        for (int w2 = 0; w2 < (tid >> 6); ++w2) { g0 += cg[w2]; q0 += ce[w2]; }
#pragma unroll
        for (int j = 0; j < 16; ++j) { const int t = tid * 16 + j; const unsigned kx = kk16[j]; int slot = -1;
            if (kx > T) { slot = (int)(g0 + (q0 < need ? q0 : need)); ++g0; }
            else if (kx == T) { if (q0 < need) slot = (int)(g0 + q0); ++q0; }
            if (slot >= 0) { sel[((size_t)b * SEQ + t) * NE + e] = slot; idx[item * CAP + slot] = t; gate[item * CAP + slot] = __uint_as_float(kx); } }
        lds_barrier();
    }
}

template <bool FINAL>
__device__ __forceinline__ void ph_combine(const Frame& F, bf16_t* xlb, float* outf, const bf16_t* y, const int* sel, const float* ada  , const float* gwn, const float* ada_next, bf16_t* act) {
    const int gw_ = F.vcu * NWAVES + F.wave, NGW = F.G * NWAVES, lane = F.lane;
    int curb = -1; f32x4 g2v[4], mA[4], mB[4];
#pragma unroll
    for (int j = 0; j < 4; ++j) { g2v[j] = (f32x4){0.f, 0.f, 0.f, 0.f}; mA[j] = g2v[j]; mB[j] = g2v[j]; }
    int nslot = -1; u32x2 nx[4];
    if (gw_ < M_LAT) { nslot = lane < NE ? sel[(size_t)gw_ * NE + lane] : -1; const u32x2* xr0 = (const u32x2*)(xlb + (size_t)gw_ * D) + lane;
#pragma unroll
        for (int j = 0; j < 4; ++j) nx[j] = xr0[64 * j]; }
    for (int r = gw_; r < M_LAT; r += NGW) {
        const int b = r >> 13;
        const int myslot = nslot; f32x4 xv[4];
#pragma unroll
        for (int j = 0; j < 4; ++j) xv[j] = (f32x4){bf_lo(nx[j].x), bf_hi(nx[j].x), bf_lo(nx[j].y), bf_hi(nx[j].y)};
        { const int rn = r + NGW; if (rn < M_LAT) { nslot = lane < NE ? sel[(size_t)rn * NE + lane] : -1; const u32x2* xrn = (const u32x2*)(xlb + (size_t)rn * D) + lane;
#pragma unroll
              for (int j = 0; j < 4; ++j) nx[j] = xrn[64 * j]; } }
        if (b != curb) { curb = b; const float* g2 = ada + (size_t)b * 6 * D + 5 * D;
#pragma unroll
            for (int j = 0; j < 4; ++j) { const int c = 256 * j + 4 * lane; g2v[j] = *(const f32x4*)(g2 + c);
                const f32x4 g4 = *(const f32x4*)(gwn + c);
                if constexpr (FINAL) { mA[j] = g4; } else { const float* sh = ada_next + (size_t)b * 6 * D; mA[j] = g4 * (*(const f32x4*)(sh + D + c) + 1.f); mB[j] = *(const f32x4*)(sh + c); } } }
        f32x4 a[4];
#pragma unroll
        for (int j = 0; j < 4; ++j) a[j] = (f32x4){0.f, 0.f, 0.f, 0.f};
        unsigned mask = (unsigned)(__ballot(myslot >= 0) & 0xFFFFull);
        while (mask) {
            const bf16_t* rp[4]; float wv[4];
#pragma unroll
            for (int q = 0; q < 4; ++q) { const bool ok = mask != 0u; const int e = ok ? __builtin_ctz(mask) : 0; mask &= mask - 1u;
                const int s = __builtin_amdgcn_readlane(myslot, e);
                rp[q] = ok ? y + ((size_t)(b * NE + e) * CAP + s) * D : y; wv[q] = ok ? 1.f : 0.f; }
            u32x2 w[4][4];
#pragma unroll
            for (int q = 0; q < 4; ++q)
#pragma unroll
                for (int j = 0; j < 4; ++j) w[q][j] = ((const u32x2*)rp[q] + lane)[64 * j];
#pragma unroll
            for (int q = 0; q < 4; ++q)
#pragma unroll
                for (int j = 0; j < 4; ++j) { a[j].x += wv[q] * bf_lo(w[q][j].x); a[j].y += wv[q] * bf_hi(w[q][j].x); a[j].z += wv[q] * bf_lo(w[q][j].y); a[j].w += wv[q] * bf_hi(w[q][j].y); }
        }
        f32x4 v[4]; float s = 0.f;
#pragma unroll
        for (int j = 0; j < 4; ++j) { v[j] = xv[j] + g2v[j] * a[j]; s += (v[j].x * v[j].x + v[j].y * v[j].y) + (v[j].z * v[j].z + v[j].w * v[j].w); }
        const float rs = rsqrtf(wsum(s) * (1.f / D) + EPS);
        if constexpr (FINAL) {
            f32x4* xr = (f32x4*)(outf + (size_t)r * D) + lane;
#pragma unroll
            for (int j = 0; j < 4; ++j) xr[64 * j] = v[j] * rs * mA[j];
        } else {
            unsigned long long* x8 = (unsigned long long*)(xlb + (size_t)r * D) + lane;
            unsigned long long* o8 = (unsigned long long*)(act + (size_t)r * D) + lane;
#pragma unroll
            for (int j = 0; j < 4; ++j) { x8[64 * j] = (unsigned long long)pk2(v[j].x, v[j].y) | ((unsigned long long)pk2(v[j].z, v[j].w) << 32);
                const f32x4 o = v[j] * rs * mA[j] + mB[j];
                o8[64 * j] = (unsigned long long)pk2(o.x, o.y) | ((unsigned long long)pk2(o.z, o.w) << 32); }
        }
    }
}

__device__ __forceinline__ void ph_sc_glue(const Frame& F, const bf16_t* gb, const bf16_t* uu, const float* cw  , bf16_t* act) {
    const int gw_ = F.vcu * NWAVES + F.wave, NGW = F.G * NWAVES, lane = F.lane;
    float w0[16], w1[16], w2[16];
#pragma unroll
    for (int hh = 0; hh < 2; ++hh)
#pragma unroll
        for (int q = 0; q < 8; ++q) { const int c = hh * 512 + 8 * lane + q; w0[hh * 8 + q] = cw[c]; w1[hh * 8 + q] = cw[D + c]; w2[hh * 8 + q] = cw[2 * D + c]; }
    const u32x4 zero4 = (u32x4){0u, 0u, 0u, 0u};
    for (int blk = gw_; blk < M_LAT / 16; blk += NGW) {
        const int r0 = blk * 16, t0 = r0 & (SEQ - 1);
        u32x4 up[2], uc[2];
#pragma unroll
        for (int hh = 0; hh < 2; ++hh) { const int c = hh * 512 + 8 * lane;
            up[hh] = t0 > 0 ? *(const u32x4*)(uu + (size_t)(r0 - 1) * D + c) : zero4; uc[hh] = *(const u32x4*)(uu + (size_t)r0 * D + c); }
#pragma unroll 1
        for (int i0 = 0; i0 < 16; i0 += 4) {
            u32x4 gq[4][2], un[4][2];
#pragma unroll
            for (int i = 0; i < 4; ++i)
#pragma unroll
                for (int hh = 0; hh < 2; ++hh) { const int r = r0 + i0 + i, c = hh * 512 + 8 * lane;
                    gq[i][hh] = *(const u32x4*)(gb + (size_t)r * D + c);
                    un[i][hh] = (t0 + i0 + i + 1 < SEQ) ? *(const u32x4*)(uu + (size_t)(r + 1) * D + c) : zero4; }
#pragma unroll
            for (int i = 0; i < 4; ++i) {
#pragma unroll
                for (int hh = 0; hh < 2; ++hh) {
                    u32x4 o;
#pragma unroll
                    for (int q = 0; q < 4; ++q) {
                        const float lo = bf_lo(gq[i][hh][q]) * (w0[hh * 8 + 2 * q] * bf_lo(up[hh][q]) + w1[hh * 8 + 2 * q] * bf_lo(uc[hh][q]) + w2[hh * 8 + 2 * q] * bf_lo(un[i][hh][q]));
                        const float hi = bf_hi(gq[i][hh][q]) * (w0[hh * 8 + 2 * q + 1] * bf_hi(up[hh][q]) + w1[hh * 8 + 2 * q + 1] * bf_hi(uc[hh][q]) + w2[hh * 8 + 2 * q + 1] * bf_hi(un[i][hh][q]));
                        o[q] = pk2(lo, hi);
                    }
                    *(u32x4*)(act + (size_t)(r0 + i0 + i) * D + hh * 512 + 8 * lane) = o;
                    up[hh] = uc[hh]; uc[hh] = un[i][hh];
                }
            }
        }
    }
}

constexpr int NSLOT = 132;
constexpr int NCHAIN = BATCH * NH;
__device__ __forceinline__ int kperm(int s, int g, int j) { return 16 * (2 * s + (j >> 2)) + 4 * g + (j & 3); }

struct ScanPtrs { unsigned char* QN; unsigned char* KT; unsigned char* NWK; unsigned char* QK; unsigned char* U; float* SCL; };
__device__ __forceinline__ size_t so_shared(int chain, int slot) { return ((size_t)chain * NSLOT + slot) * 16384; }
__device__ __forceinline__ size_t so_dir(int dir, int chain, int slot) { return (((size_t)dir * NCHAIN + chain) * NSLOT + slot); }


__device__ __forceinline__ f32x4 mm16(const LAS float* A, const LAS float* B, f32x4 acc, int rr, int kq) {
#pragma unroll
    for (int t = 0; t < 4; ++t) acc = __builtin_amdgcn_mfma_f32_16x16x4f32(A[rr * 17 + 4 * t + kq], B[(4 * t + kq) * 17 + rr], acc, 0, 0, 0);
    return acc;
}
__device__ __forceinline__ f32x4 ld16(const LAS float* C, int rr, int kq) { return (f32x4){C[(4 * kq + 0) * 17 + rr], C[(4 * kq + 1) * 17 + rr], C[(4 * kq + 2) * 17 + rr], C[(4 * kq + 3) * 17 + rr]}; }
__device__ __forceinline__ void st16(LAS float* C, f32x4 v, int rr, int kq) {
#pragma unroll
    for (int r = 0; r < 4; ++r) C[(4 * kq + r) * 17 + rr] = v[r];
}

__device__ __forceinline__ int order_slot(int j) { if (j < 4) return (0x2130 >> (4 * j)) & 15; const int i = (j - 4) >> 1; return ((j - 4) & 1) ? 131 - i : 4 + i; }
__device__ __forceinline__ void ph_chunk_prep(const Frame& F, const bf16_t* QKV, const bf16_t* CKV, const float* GATES, const float* cw  , const ScanPtrs P, int pidx, int np, unsigned* flags) {
    const __amdgpu_buffer_rsrc_t rW = __builtin_amdgcn_make_buffer_rsrc(P.QN, 0, (int)(WS_END - WS_QN), 0x00020000);
    const __amdgpu_buffer_rsrc_t rO = __builtin_amdgcn_make_buffer_rsrc(P.U, 0, (int)(100 * MiB), 0x00020000);
    const unsigned oKT = (unsigned)(P.KT - P.QN), oNWK = (unsigned)(P.NWK - P.QN), oSCL = (unsigned)((unsigned char*)P.SCL - P.QN), oQK = (unsigned)(P.QK - P.U);
    LAS unsigned char* L = F.lds;
    LAS bf16_t* kn = (LAS bf16_t*)(L);
    LAS bf16_t* qn = (LAS bf16_t*)(L + 17408);
    LAS bf16_t* vT = (LAS bf16_t*)(L + 34816);
    LAS bf16_t* knT = (LAS bf16_t*)(L + 53376);
    LAS float* KK = (LAS float*)(L + 71936);
    LAS float* QKr = (LAS float*)(L + 89344);
    LAS bf16_t* XU = (LAS bf16_t*)(L + 71936);
    LAS bf16_t* XW = (LAS bf16_t*)(L + 71936 + 18432);
    LAS float* NBk = (LAS float*)(L + 108800);
    LAS float* XBk = (LAS float*)(L + 108800 + 21760);
    LAS float* TBk = (LAS float*)(L + 108800 + 43520);
    LAS float* SCRq = (LAS float*)(L + 17408);
    LAS float* gamP = (LAS float*)(L + 108800 + 52224);
    LAS float* betP = gamP + 128;
    LAS float* begP = gamP + 256;
    static_assert(108800 + 52224 + 1536 <= MISC_OFF, "E3 LDS map");
    const int wave = F.wave;
    for (int item = pidx; item < NCHAIN * NSLOT; item += np) {
        int tid = F.tid; asm volatile("" : "+v"(tid));
        const int lane = tid & 63;
        const int chain = item & 15, slot = order_slot(item >> 4), b = chain >> 2, h = chain & 3;
        const bool isctx = slot < 4;
        const int Lseq = isctx ? CTX : SEQ, t0 = isctx ? slot * 64 : (slot - 4) * 64;
        {
            const int i = tid >> 3, cg = tid & 7, t = t0 + i;
            const bf16_t* src; int ld, qoff, koff, voff;
            if (isctx) { src = CKV + (size_t)(b * CTX) * 1024; ld = 1024; qoff = -1; koff = h * 128; voff = 512 + h * 128; }
            else { src = QKV + (size_t)(b * SEQ) * 1536; ld = 1536; qoff = h * 128; koff = 512 + h * 128; voff = 1024 + h * 128; }
            float o[3][16];
#pragma unroll
            for (int w = 0; w < 3; ++w) {
                const int off = w == 0 ? qoff : (w == 1 ? koff : voff);
                if (off < 0) {
#pragma unroll
                    for (int c = 0; c < 16; ++c) o[w][c] = 0.f;
                    continue;
                }
                const int wcol = w * 512 + h * 128 + cg * 16;
#pragma unroll
                for (int c = 0; c < 16; ++c) o[w][c] = 0.f;
#pragma unroll
                for (int tap = 0; tap < 3; ++tap) {
                    const int tt = t + tap - 1;
                    if (tt < 0 || tt >= Lseq) continue;
                    const u32x4 a0 = *(const u32x4*)(src + (size_t)tt * ld + off + cg * 16), a1 = *(const u32x4*)(src + (size_t)tt * ld + off + cg * 16 + 8);
                    const float* wp = cw + tap * 1536 + wcol;
#pragma unroll
                    for (int q = 0; q < 4; ++q) { o[w][2 * q] += wp[2 * q] * bf_lo(a0[q]); o[w][2 * q + 1] += wp[2 * q + 1] * bf_hi(a0[q]);
                        o[w][8 + 2 * q] += wp[8 + 2 * q] * bf_lo(a1[q]); o[w][8 + 2 * q + 1] += wp[8 + 2 * q + 1] * bf_hi(a1[q]); }
                }
#pragma unroll
                for (int c = 0; c < 16; ++c) o[w][c] = silu1(o[w][c]);
            }
            float sq = 0.f, sk = 0.f;
#pragma unroll
            for (int c = 0; c < 16; ++c) { sq += o[0][c] * o[0][c]; sk += o[1][c] * o[1][c]; }
            sq += __shfl_xor(sq, 1); sq += __shfl_xor(sq, 2); sq += __shfl_xor(sq, 4);
            sk += __shfl_xor(sk, 1); sk += __shfl_xor(sk, 2); sk += __shfl_xor(sk, 4);
            const float rq = rsqrtf(sq + EPS) * 0.08838834764831845f, rk = rsqrtf(sk + EPS);
#pragma unroll
            for (int c = 0; c < 16; c += 2) {
                *(LAS unsigned*)(qn + i * 136 + cg * 16 + c) = pk2(o[0][c] * rq, o[0][c + 1] * rq);
                const unsigned kw = pk2(o[1][c] * rk, o[1][c + 1] * rk), vw = pk2(o[2][c], o[2][c + 1]);
                *(LAS unsigned*)(kn + i * 136 + cg * 16 + c) = kw;
                knT[(cg * 16 + c) * 72 + cg * 8 + i] = (bf16_t)(kw & 0xffffu); knT[(cg * 16 + c + 1) * 72 + cg * 8 + i] = (bf16_t)(kw >> 16);
                vT[(cg * 16 + c) * 72 + cg * 8 + i] = (bf16_t)(vw & 0xffffu); vT[(cg * 16 + c + 1) * 72 + cg * 8 + i] = (bf16_t)(vw >> 16);
            }
        }
        if (wave < 2) {
            const int dir = wave, i = dir ? 63 - lane : lane;
            const size_t grow = isctx ? (size_t)M_LAT + b * CTX + t0 + i : (size_t)b * SEQ + t0 + i;
            float g = GATES[grow * 16 + 8 + dir * 4 + h];
#pragma unroll
            for (int o2 = 1; o2 < 64; o2 <<= 1) { const float x = __shfl_up(g, o2); if (lane >= o2) g += x; }
            gamP[dir * 64 + lane] = g; const float bt0 = GATES[grow * 16 + dir * 4 + h]; betP[dir * 64 + lane] = bt0; begP[dir * 64 + lane] = bt0 * __expf(g);
        }
        lds_barrier();
        {
            const int fr = lane & 15, fq = lane >> 4;
#pragma unroll
            for (int tt = 0; tt < 4; ++tt) {
                const int tile = wave * 4 + tt, which = tile >> 4, mt = (tile >> 2) & 3, nt = tile & 3;
                LAS bf16_t* Am = which ? qn : kn;
                f32x4 acc = (f32x4){0.f, 0.f, 0.f, 0.f};
#pragma unroll
                for (int s = 0; s < 4; ++s) {
                    const bf16x8 a = *(const LAS bf16x8*)(Am + (16 * mt + fr) * 136 + 32 * s + 8 * fq);
                    const bf16x8 bb = *(const LAS bf16x8*)(kn + (16 * nt + fr) * 136 + 32 * s + 8 * fq);
                    acc = __builtin_amdgcn_mfma_f32_16x16x32_bf16(a, bb, acc, 0, 0, 0);
                }
                LAS float* Om = which ? QKr : KK;
#pragma unroll
                for (int r = 0; r < 4; ++r) Om[(16 * mt + 4 * fq + r) * 68 + 16 * nt + fr] = acc[r];
            }
        }
        lds_barrier();
        {
#pragma unroll 2
            for (int it = 0; it < 10; ++it) {
                const int idx = tid + 512 * it, dir = idx / 2560, rem = idx % 2560, blk = rem >> 8, e = rem & 255, r = e >> 4, c = e & 15;
                const int bi = blk < 1 ? 0 : (blk < 3 ? 1 : (blk < 6 ? 2 : 3)), bj = blk - bi * (bi + 1) / 2;
                const int p = 16 * bi + r, pp = 16 * bj + c;
                float val = 0.f;
                if (p > pp) { const int ip = dir ? 63 - p : p, ipp = dir ? 63 - pp : pp;
                    val = betP[dir * 64 + p] * KK[ip * 68 + ipp] * __expf(gamP[dir * 64 + p] - gamP[dir * 64 + pp]); }
                NBk[(dir * 10 + blk) * 272 + r * 17 + c] = val;
            }
            const int f = tid >> 6, l2 = tid & 63, g = l2 >> 4;
            if (!isctx) {
#pragma unroll
                for (int dir = 0; dir < 2; ++dir) {
                    const int m = f >> 1, s = f & 1, io = 16 * m + (l2 & 15);
                    const float gi = gamP[dir * 64 + (dir ? 63 - io : io)];
                    float vals[8];
#pragma unroll
                    for (int e = 0; e < 8; ++e) { const int j = kperm(s, g, e); const bool keep = dir ? (j >= io) : (j <= io);
                        vals[e] = keep ? QKr[io * 68 + j] * __expf(gi - gamP[dir * 64 + (dir ? 63 - j : j)]) : 0.f; }
                    u32x4 w; w.x = pk2(vals[0], vals[1]); w.y = pk2(vals[2], vals[3]); w.z = pk2(vals[4], vals[5]); w.w = pk2(vals[6], vals[7]);
                    __builtin_amdgcn_raw_buffer_store_b128(w, rO, oQK + (unsigned)(so_dir(dir, chain, slot) * 8192) + (unsigned)tid * 16u, 0, 16);
                }
#pragma unroll
                for (int it = 0; it < 2; ++it) {
                    const int q = tid + 512 * it, ff = q >> 6, m = ff >> 2, s = ff & 3, row = 16 * m + (l2 & 15);
                    const u32x2 lo = *(const LAS u32x2*)(qn + row * 136 + 32 * s + 4 * g), hi = *(const LAS u32x2*)(qn + row * 136 + 32 * s + 16 + 4 * g);
                    __builtin_amdgcn_raw_buffer_store_b128((u32x4){lo.x, lo.y, hi.x, hi.y}, rW, (unsigned)so_shared(chain, slot) + (unsigned)q * 16u, 0, 16);
                }
            }
#pragma unroll
            for (int it = 0; it < 2; ++it) {
                const int q = tid + 512 * it, ff = q >> 6, mp = ff >> 1, s = ff & 1, dk = 16 * mp + (l2 & 15);
                unsigned short e8[8];
#pragma unroll
                for (int e = 0; e < 8; ++e) e8[e] = kn[kperm(s, g, e) * 136 + dk];
                u32x4 w; w.x = e8[0] | ((unsigned)e8[1] << 16); w.y = e8[2] | ((unsigned)e8[3] << 16); w.z = e8[4] | ((unsigned)e8[5] << 16); w.w = e8[6] | ((unsigned)e8[7] << 16);
                __builtin_amdgcn_raw_buffer_store_b128(w, rW, oKT + (unsigned)so_shared(chain, slot) + (unsigned)q * 16u, 0, 16);
            }
            if (tid < 128) { const int dir = tid >> 6, i = tid & 63, p = dir ? 63 - i : i;
                const float gl = gamP[dir * 64 + 63], gi = gamP[dir * 64 + p];
                const unsigned sc = oSCL + (unsigned)(so_dir(dir, chain, slot) * 1024) + (unsigned)i * 4u;
                __builtin_amdgcn_raw_buffer_store_b32(__builtin_bit_cast(unsigned, __expf(gi)), rW, sc, 0, 16); __builtin_amdgcn_raw_buffer_store_b32(__builtin_bit_cast(unsigned, __expf(gl - gi)), rW, sc + 256u, 0, 16);
                if (i == 0) __builtin_amdgcn_raw_buffer_store_b32(__builtin_bit_cast(unsigned, __expf(gl)), rW, sc + 512u, 0, 16); }
        }
        lds_barrier();
        {
            const int rr = lane & 15, kq = lane >> 4, dir = wave >> 2, wq = wave & 3;
            const f32x4 z4 = (f32x4){0.f, 0.f, 0.f, 0.f};
#define NB_(d, bi, bj) (NBk + ((d) * 10 + (bi) * ((bi) + 1) / 2 + (bj)) * 272)
#define XB_(d, bi, bj) (XBk + ((d) * 10 + (bi) * ((bi) + 1) / 2 + (bj)) * 272)
#define SLOT_(g) ((g) < 16 ? SCRq + (g) * 272 : TBk + ((g) - 16) * 272)
#define EMIT_X(d, bi, bj, v) do { const int pp_ = 16 * (bj) + rr, jx_ = (d) ? 63 - pp_ : pp_; const float bu_ = betP[(d) * 64 + pp_], bw_ = begP[(d) * 64 + pp_]; \
                _Pragma("unroll") for (int r_ = 0; r_ < 4; ++r_) { const int p_ = 16 * (bi) + 4 * kq + r_, i_ = (d) ? 63 - p_ : p_; \
                    XU[((d) * 64 + i_) * 72 + jx_] = (bf16_t)f2bf((v)[r_] * bu_); XW[((d) * 64 + i_) * 72 + jx_] = (bf16_t)f2bf((v)[r_] * bw_); } } while (0)
            { const u32x4 z = (u32x4){0u, 0u, 0u, 0u};
#pragma unroll
                for (int q = 0; q < 5; ++q) { const int o = (tid + 512 * q) * 16; if (o < 36864) *(LAS u32x4*)((LAS unsigned char*)XU + o) = z; } }
            lds_barrier();
            {
                const LAS float* M = NB_(dir, wq, wq);
                LAS float* S0 = SLOT_(wave * 3), *S1 = SLOT_(wave * 3 + 1), *Pb = SLOT_(wave * 3 + 2), *Xd = XB_(dir, wq, wq);
                const f32x4 m = ld16(M, rr, kq);
                f32x4 p0;
#pragma unroll
                for (int r = 0; r < 4; ++r) p0[r] = ((4 * kq + r) == rr ? 1.f : 0.f) - m[r];
                st16(Pb, p0, rr, kq);
                const f32x4 m2 = mm16(M, M, z4, rr, kq); st16(S0, m2, rr, kq);
                const f32x4 p1 = mm16(Pb, S0, p0, rr, kq); st16(Xd, p1, rr, kq);
                const f32x4 m4 = mm16(S0, S0, z4, rr, kq); st16(S1, m4, rr, kq);
                const f32x4 p2 = mm16(Xd, S1, p1, rr, kq); st16(Pb, p2, rr, kq);
                const f32x4 m8 = mm16(S1, S1, z4, rr, kq); st16(S0, m8, rr, kq);
                const f32x4 p3 = mm16(Pb, S0, p2, rr, kq); st16(Xd, p3, rr, kq); EMIT_X(dir, wq, wq, p3);
            }
            lds_barrier();
            if (wave < 4) {
                const int d1 = wave >> 1, lo = (wave & 1) * 2, hi = lo + 1;
                LAS float* T1 = SLOT_(wave);
                st16(T1, mm16(NB_(d1, hi, lo), XB_(d1, lo, lo), z4, rr, kq), rr, kq);
                const f32x4 x = mm16(XB_(d1, hi, hi), T1, z4, rr, kq);
                const f32x4 nx_ = -x; st16(XB_(d1, hi, lo), nx_, rr, kq); EMIT_X(d1, hi, lo, nx_);
            }
            lds_barrier();
            {
                const int bi = 2 + (wq >> 1), bj = wq & 1;
                f32x4 t = mm16(NB_(dir, bi, 1), XB_(dir, 1, bj), z4, rr, kq);
                if (bj == 0) t = mm16(NB_(dir, bi, 0), XB_(dir, 0, 0), t, rr, kq);
                st16(TBk + (dir * 4 + wq) * 272, t, rr, kq);
            }
            lds_barrier();
            {
                const int bi = 2 + (wq >> 1), bj = wq & 1;
                f32x4 x = mm16(XB_(dir, bi, 2), TBk + (dir * 4 + bj) * 272, z4, rr, kq);
                if (bi == 3) x = mm16(XB_(dir, 3, 3), TBk + (dir * 4 + 2 + bj) * 272, x, rr, kq);
                const f32x4 nx_ = -x; EMIT_X(dir, bi, bj, nx_);
            }
#undef NB_
#undef XB_
#undef SLOT_
#undef EMIT_X
        }
        lds_barrier();
        {
            const int dir = wave >> 2, wq = wave & 3, rr = lane & 15, kq = lane >> 4;
            const LAS bf16_t* xu = XU + (dir * 64 + 16 * wq + rr) * 72 + 8 * kq;
            const LAS bf16_t* xw = XW + (dir * 64 + 16 * wq + rr) * 72 + 8 * kq;
            const bf16x8 au0 = *(const LAS bf16x8*)(xu), au1 = *(const LAS bf16x8*)(xu + 32);
            const bf16x8 bw0 = *(const LAS bf16x8*)(xw), bw1 = *(const LAS bf16x8*)(xw + 32);
            const unsigned ub = (unsigned)(so_dir(dir, chain, slot) * 16384);
            const unsigned nb = oNWK + (unsigned)(so_dir(dir, chain, slot) * 16384);
#pragma unroll
            for (int ct = 0; ct < 8; ++ct) {
                const LAS bf16_t* vp = vT + (16 * ct + rr) * 72 + ct * 8 + 8 * kq;
                f32x4 acc = (f32x4){0.f, 0.f, 0.f, 0.f};
                acc = __builtin_amdgcn_mfma_f32_16x16x32_bf16(au0, *(const LAS bf16x8*)(vp), acc, 0, 0, 0);
                acc = __builtin_amdgcn_mfma_f32_16x16x32_bf16(au1, *(const LAS bf16x8*)(vp + 32), acc, 0, 0, 0);
                __builtin_amdgcn_raw_buffer_store_b64((u32x2){cvt_pk_bf16(acc[0], acc[1]), cvt_pk_bf16(acc[2], acc[3])}, rO, ub + (unsigned)((ct * 4 + wq) * 64 + lane) * 8u, 0, 16);
            }
#pragma unroll
            for (int s2 = 0; s2 < 4; ++s2) {
                f32x4 a2[2];
#pragma unroll
                for (int hh = 0; hh < 2; ++hh) { const LAS bf16_t* kp = knT + (16 * (2 * s2 + hh) + rr) * 72 + (2 * s2 + hh) * 8 + 8 * kq;
                    f32x4 acc = (f32x4){0.f, 0.f, 0.f, 0.f};
                    acc = __builtin_amdgcn_mfma_f32_16x16x32_bf16(*(const LAS bf16x8*)(kp), bw0, acc, 0, 0, 0);
                    acc = __builtin_amdgcn_mfma_f32_16x16x32_bf16(*(const LAS bf16x8*)(kp + 32), bw1, acc, 0, 0, 0);
                    a2[hh] = acc; }
                u32x4 w; w.x = cvt_pk_bf16(-a2[0][0], -a2[0][1]); w.y = cvt_pk_bf16(-a2[0][2], -a2[0][3]); w.z = cvt_pk_bf16(-a2[1][0], -a2[1][1]); w.w = cvt_pk_bf16(-a2[1][2], -a2[1][3]);
                __builtin_amdgcn_raw_buffer_store_b128(w, rW, nb + (unsigned)((wq * 4 + s2) * 64 + lane) * 16u, 0, 16);
            }
        }
        asm volatile("s_waitcnt vmcnt(0)" ::: "memory");
        lds_barrier();
        if (tid == 0) __hip_atomic_store(flags + 16 * (chain * NSLOT + slot), 1u, __ATOMIC_RELAXED, __HIP_MEMORY_SCOPE_AGENT);
    }
}

constexpr int SC_NWK = 0, SC_QN = 16384, SC_KT = 32768, SC_QK = 49152, SC_U = 57344, SC_SCL = 65536, SC_STAGE = 66560;
constexpr int SC_HS = 2 * SC_STAGE  , SC_HW = SC_HS + 16384  ;
static_assert(SC_HW + 8192 <= MISC_OFF, "scan LDS map");
__device__ __forceinline__ void ph_scan(const Frame& F, const ScanPtrs P, bf16_t* OF, bf16_t* OB, unsigned* prog, unsigned* flags) {
    const int xg = F.vcu >> 5, xj = F.vcu & 31;
    if (xj >= 8 || xg >= 8) return;
    const int sb = xg * 8 + xj, half = sb & 1, dir = (sb >> 1) & 1, chain = sb >> 2, b = chain >> 2, h = chain & 3;
    LAS unsigned char* L = F.lds;
    const int lane = F.lane, wave = F.wave, g = lane >> 4, tile = wave & 3;
    const bool isR = wave < 4;
    bf16_t* O = dir ? OB : OF;
    const unsigned lbase = (unsigned)(unsigned long long)(L);
    auto slot_of = [&](int step) { return dir ? (step < 4 ? 3 - step : 135 - step) : step; };
    auto issue = [&](int step) {
        const int slot = slot_of(step); const unsigned sbase = (unsigned)(step & 1) * SC_STAGE; const bool emit = slot >= 4;
        const unsigned char* nwk = P.NWK + so_dir(dir, chain, slot) * 16384; const unsigned char* kt = P.KT + so_shared(chain, slot);
        const unsigned char* qn = P.QN + so_shared(chain, slot); const unsigned char* qk = P.QK + so_dir(dir, chain, slot) * 8192;
        const unsigned char* uu = P.U + so_dir(dir, chain, slot) * 16384 + half * 8192; const unsigned char* sc = (const unsigned char*)(P.SCL + so_dir(dir, chain, slot) * 256);
#pragma unroll
        for (int i = 0; i < 2; ++i) { const int pc = wave * 2 + i;
            __builtin_amdgcn_global_load_lds((const unsigned*)(nwk + pc * 1024 + lane * 16), (LAS unsigned*)(L + sbase + SC_NWK + pc * 1024), 16, 0, 0); }
        __builtin_amdgcn_global_load_lds((const unsigned*)(uu + wave * 1024 + lane * 16), (LAS unsigned*)(L + sbase + SC_U + wave * 1024), 16, 0, 0);
        if (wave == 7) __builtin_amdgcn_global_load_lds((const unsigned*)(sc + lane * 16), (LAS unsigned*)(L + sbase + SC_SCL), 16, 0, 0);
        if (emit) {
#pragma unroll
            for (int i = 0; i < 2; ++i) { const int pc = wave * 2 + i;
                __builtin_amdgcn_global_load_lds((const unsigned*)(qn + pc * 1024 + lane * 16), (LAS unsigned*)(L + sbase + SC_QN + pc * 1024), 16, 0, 0); }
        }
#pragma unroll
        for (int i = 0; i < 2; ++i) { const int pc = wave * 2 + i;
            __builtin_amdgcn_global_load_lds((const unsigned*)(kt + pc * 1024 + lane * 16), (LAS unsigned*)(L + sbase + SC_KT + pc * 1024), 16, 0, 0); }
        if (emit) __builtin_amdgcn_global_load_lds((const unsigned*)(qk + wave * 1024 + lane * 16), (LAS unsigned*)(L + sbase + SC_QK + wave * 1024), 16, 0, 0);
    };
#define SC_RD128(dst, addr, off) asm volatile("ds_read_b128 %0, %1 offset:%2" : "=v"(dst) : "v"(addr), "n"(off))
#define SC_WR128(addr, off, src) asm volatile("ds_write_b128 %0, %1 offset:%2\n\ts_nop 3" :: "v"(addr), "v"(src), "n"(off) : "memory")
#define SC_LOAD(dst, base, first) do { _Pragma("unroll") for (int i_ = 0; i_ < 8; ++i_) SC_RD128(dst[i_], sva, (base) + ((first) + i_) * 1024); } while (0)
#define SC_WAIT0(a) do { asm volatile("s_waitcnt lgkmcnt(0)" : "+v"(a[0]), "+v"(a[1]), "+v"(a[2]), "+v"(a[3]), "+v"(a[4]), "+v"(a[5]), "+v"(a[6]), "+v"(a[7])); __builtin_amdgcn_sched_barrier(0); } while (0)
    const unsigned hsa = lbase + SC_HS + (unsigned)tile * 4096u + (unsigned)lane * 16u;
    const unsigned hwa = lbase + SC_HW + (unsigned)tile * 2048u + (unsigned)lane * 16u;
    f32x4 accS[8];
#pragma unroll
    for (int m = 0; m < 8; ++m) accS[m] = (f32x4){0.f, 0.f, 0.f, 0.f};
    bf16x8 bS[4];
#pragma unroll
    for (int s = 0; s < 4; ++s) bS[s] = (bf16x8){0, 0, 0, 0, 0, 0, 0, 0};
    if (isR) {
#pragma unroll
        for (int s = 0; s < 4; ++s) SC_WR128(hsa, s * 1024, bS[s]);
    }
#if PROBE_SEL >= 0
    const unsigned long long tscan0_ = __builtin_amdgcn_s_memrealtime();
#endif
    auto flag_of = [&](int step) { return flags + 16 * (chain * NSLOT + slot_of(step < NSLOT ? step : NSLOT - 1)); };
    auto wait_flag = [&](unsigned fv, int step) {
        while (__builtin_amdgcn_readfirstlane(fv) == 0u) { __builtin_amdgcn_s_sleep(4); fv = __hip_atomic_load(flag_of(step), __ATOMIC_RELAXED, __HIP_MEMORY_SCOPE_AGENT); }
    };
    wait_flag(0u, 0);
    issue(0);
    unsigned fnext = __hip_atomic_load(flag_of(1), __ATOMIC_RELAXED, __HIP_MEMORY_SCOPE_AGENT);
    asm volatile("s_waitcnt vmcnt(0)" ::: "memory");
    lds_barrier();
    for (int step = 0; step < NSLOT; ++step) {
        const int slot = slot_of(step); const bool emit = slot >= 4;
#if PROBE_SEL >= 0
        if (sb == 0 && F.tid == 0 && (step == 8 || step == 36 || step == 68)) { unsigned long long* ts = (unsigned long long*)(prog - CW_PROG + CW_TS); ts[step == 8 ? 14 : (step == 36 ? 15 : 12)] = __builtin_amdgcn_s_memrealtime() - tscan0_; }
#endif
        const unsigned sva = lbase + (unsigned)(step & 1) * SC_STAGE + (unsigned)lane * 16u;
        const unsigned ssa = sva - (unsigned)lane * 16u + SC_SCL + (unsigned)g * 16u;
#if PROBE_SEL >= 0
        const bool pw = (sb == 0 && wave == PROBE_WAVE);
        unsigned long long t0_ = 0, t1_ = 0, t2_ = 0, t3_ = 0, t4_ = 0, t5_ = 0;
        if (pw) t0_ = __builtin_amdgcn_s_memrealtime();
#endif
        if (step + 1 < NSLOT) { wait_flag(fnext, step + 1); issue(step + 1); }
        fnext = __hip_atomic_load(flag_of(step + 2), __ATOMIC_RELAXED, __HIP_MEMORY_SCOPE_AGENT);
#if PROBE_SEL >= 0
        if (pw) t1_ = __builtin_amdgcn_s_memrealtime();
#endif
        bf16x8 fa[8], fb[8];
        f32x4 acco[4]; bf16x8 bWx[2];
        if (isR) {
            const unsigned sua = sva - (unsigned)lane * 8u + SC_U + (unsigned)tile * 2048u;
            f32x4 accw[4], ek4[4]; u32x2 uv[4]; float cd;
#pragma unroll
            for (int m = 0; m < 4; ++m) asm volatile("ds_read_b64 %0, %1 offset:%2" : "=v"(uv[m]) : "v"(sua), "n"(m * 512));
            SC_LOAD(fa, SC_NWK, 0);
            asm volatile("s_waitcnt lgkmcnt(0)" : "+v"(uv[0]), "+v"(uv[1]), "+v"(uv[2]), "+v"(uv[3]),
                         "+v"(fa[0]), "+v"(fa[1]), "+v"(fa[2]), "+v"(fa[3]), "+v"(fa[4]), "+v"(fa[5]), "+v"(fa[6]), "+v"(fa[7])); __builtin_amdgcn_sched_barrier(0);
            SC_LOAD(fb, SC_NWK, 8);
#pragma unroll
            for (int m = 0; m < 4; ++m) SC_RD128(ek4[m], ssa, 256 + m * 64);
            asm volatile("ds_read_b32 %0, %1 offset:512" : "=v"(cd) : "v"(ssa - (unsigned)g * 16u));
#pragma unroll
            for (int m = 0; m < 4; ++m) accw[m] = (f32x4){bf_lo(uv[m].x), bf_hi(uv[m].x), bf_lo(uv[m].y), bf_hi(uv[m].y)};
#pragma unroll
            for (int f = 0; f < 8; ++f) accw[f >> 2] = __builtin_amdgcn_mfma_f32_16x16x32_bf16(fa[f], bS[f & 3], accw[f >> 2], 0, 0, 0);
            asm volatile("s_waitcnt lgkmcnt(0)" : "+v"(ek4[0]), "+v"(ek4[1]), "+v"(ek4[2]), "+v"(ek4[3]), "+v"(cd),
                         "+v"(fb[0]), "+v"(fb[1]), "+v"(fb[2]), "+v"(fb[3]), "+v"(fb[4]), "+v"(fb[5]), "+v"(fb[6]), "+v"(fb[7])); __builtin_amdgcn_sched_barrier(0);
            SC_LOAD(fa, SC_KT, 0);
#pragma unroll
            for (int f = 0; f < 8; ++f) accw[2 + (f >> 2)] = __builtin_amdgcn_mfma_f32_16x16x32_bf16(fb[f], bS[f & 3], accw[2 + (f >> 2)], 0, 0, 0);
            SC_WAIT0(fa);
            SC_LOAD(fb, SC_KT, 8);
            bf16x8 bWs[2];
#pragma unroll
            for (int s = 0; s < 2; ++s) {
                const f32x4 w0 = accw[2 * s], w1 = accw[2 * s + 1], e0 = ek4[2 * s], e1 = ek4[2 * s + 1];
                u32x4 a, c2;
                a.x = cvt_pk_bf16(w0[0], w0[1]); a.y = cvt_pk_bf16(w0[2], w0[3]); a.z = cvt_pk_bf16(w1[0], w1[1]); a.w = cvt_pk_bf16(w1[2], w1[3]);
                c2.x = cvt_pk_bf16(w0[0] * e0[0], w0[1] * e0[1]); c2.y = cvt_pk_bf16(w0[2] * e0[2], w0[3] * e0[3]); c2.z = cvt_pk_bf16(w1[0] * e1[0], w1[1] * e1[1]); c2.w = cvt_pk_bf16(w1[2] * e1[2], w1[3] * e1[3]);
                bWx[s] = __builtin_bit_cast(bf16x8, a); bWs[s] = __builtin_bit_cast(bf16x8, c2);
                if (emit) SC_WR128(hwa, s * 1024, bWx[s]);
            }
#pragma unroll
            for (int m = 0; m < 8; ++m) accS[m] = accS[m] * cd;
#if PROBE_SEL >= 0
            if (pw) t2_ = __builtin_amdgcn_s_memrealtime();
#endif
            lds_barrier();
#if PROBE_SEL >= 0
            if (pw) t3_ = __builtin_amdgcn_s_memrealtime();
#endif
            SC_WAIT0(fb);
#pragma unroll
            for (int f = 0; f < 8; ++f) accS[f >> 1] = __builtin_amdgcn_mfma_f32_16x16x32_bf16(fa[f], bWs[f & 1], accS[f >> 1], 0, 0, 0);
#pragma unroll
            for (int f = 0; f < 8; ++f) accS[4 + (f >> 1)] = __builtin_amdgcn_mfma_f32_16x16x32_bf16(fb[f], bWs[f & 1], accS[4 + (f >> 1)], 0, 0, 0);
#pragma unroll
            for (int s = 0; s < 4; ++s) {
                const f32x4 s0 = accS[2 * s], s1 = accS[2 * s + 1];
                u32x4 a; a.x = cvt_pk_bf16(s0[0], s0[1]); a.y = cvt_pk_bf16(s0[2], s0[3]); a.z = cvt_pk_bf16(s1[0], s1[1]); a.w = cvt_pk_bf16(s1[2], s1[3]);
                bS[s] = __builtin_bit_cast(bf16x8, a);
                SC_WR128(hsa, s * 1024, bS[s]);
            }
        } else {
            f32x4 eg4[4];
            if (emit) {
#pragma unroll
                for (int s = 0; s < 4; ++s) SC_RD128(bS[s], hsa, s * 1024);
                SC_LOAD(fa, SC_QN, 0);
                asm volatile("s_waitcnt lgkmcnt(0)" : "+v"(bS[0]), "+v"(bS[1]), "+v"(bS[2]), "+v"(bS[3]),
                             "+v"(fa[0]), "+v"(fa[1]), "+v"(fa[2]), "+v"(fa[3]), "+v"(fa[4]), "+v"(fa[5]), "+v"(fa[6]), "+v"(fa[7])); __builtin_amdgcn_sched_barrier(0);
                SC_LOAD(fb, SC_QN, 8);
#pragma unroll
                for (int m = 0; m < 4; ++m) SC_RD128(eg4[m], ssa, m * 64);
#pragma unroll
                for (int m = 0; m < 4; ++m) acco[m] = (f32x4){0.f, 0.f, 0.f, 0.f};
#pragma unroll
                for (int f = 0; f < 8; ++f) acco[f >> 2] = __builtin_amdgcn_mfma_f32_16x16x32_bf16(fa[f], bS[f & 3], acco[f >> 2], 0, 0, 0);
                asm volatile("s_waitcnt lgkmcnt(0)" : "+v"(eg4[0]), "+v"(eg4[1]), "+v"(eg4[2]), "+v"(eg4[3]),
                             "+v"(fb[0]), "+v"(fb[1]), "+v"(fb[2]), "+v"(fb[3]), "+v"(fb[4]), "+v"(fb[5]), "+v"(fb[6]), "+v"(fb[7])); __builtin_amdgcn_sched_barrier(0);
                SC_LOAD(fa, SC_QK, 0);
#pragma unroll
                for (int f = 0; f < 8; ++f) acco[2 + (f >> 2)] = __builtin_amdgcn_mfma_f32_16x16x32_bf16(fb[f], bS[f & 3], acco[2 + (f >> 2)], 0, 0, 0);
#pragma unroll
                for (int m = 0; m < 4; ++m) acco[m] = acco[m] * eg4[m];
            }
#if PROBE_SEL >= 0
            if (pw) t2_ = __builtin_amdgcn_s_memrealtime();
#endif
            lds_barrier();
#if PROBE_SEL >= 0
            if (pw) t3_ = __builtin_amdgcn_s_memrealtime();
#endif
            if (emit) {
                SC_RD128(bWx[0], hwa, 0); SC_RD128(bWx[1], hwa, 1024);
                asm volatile("s_waitcnt lgkmcnt(0)" : "+v"(bWx[0]), "+v"(bWx[1]), "+v"(fa[0]), "+v"(fa[1]), "+v"(fa[2]), "+v"(fa[3]), "+v"(fa[4]), "+v"(fa[5]), "+v"(fa[6]), "+v"(fa[7])); __builtin_amdgcn_sched_barrier(0);
#pragma unroll
                for (int f = 0; f < 8; ++f) acco[f >> 1] = __builtin_amdgcn_mfma_f32_16x16x32_bf16(fa[f], bWx[f & 1], acco[f >> 1], 0, 0, 0);
                bf16_t* orow = O + ((size_t)b * SEQ + (slot - 4) * 64) * 512 + h * 128 + half * 64 + tile * 16 + (lane & 15);
#pragma unroll
                for (int m = 0; m < 4; ++m) { const unsigned p01 = cvt_pk_bf16(acco[m][0], acco[m][1]), p23 = cvt_pk_bf16(acco[m][2], acco[m][3]);
                    bf16_t* q = orow + (size_t)(16 * m + 4 * g) * 512;
                    q[0] = (bf16_t)(p01 & 0xffffu); q[512] = (bf16_t)(p01 >> 16); q[1024] = (bf16_t)(p23 & 0xffffu); q[1536] = (bf16_t)(p23 >> 16); }
            }
        }
#if PROBE_SEL >= 0
        if (pw) t4_ = __builtin_amdgcn_s_memrealtime();
#endif
        asm volatile("s_waitcnt vmcnt(0)" ::: "memory");
#if PROBE_SEL >= 0
        if (pw) t5_ = __builtin_amdgcn_s_memrealtime();
#endif
        lds_barrier();
#if PROBE_SEL >= 0
        if (pw && lane == 0) { const unsigned long long t6_ = __builtin_amdgcn_s_memrealtime(); unsigned long long* ts = (unsigned long long*)(prog - CW_PROG + CW_TS);
            ts[0] += t1_ - t0_; ts[1] += t2_ - t1_; ts[2] += t3_ - t2_; ts[3] += t4_ - t3_; ts[4] += t5_ - t4_; ts[5] += t6_ - t5_; ts[6] += t6_ - t0_; }
#endif
    }
#undef SC_LOAD
#undef SC_WAIT0
#undef SC_RD128
#undef SC_WR128
}

__device__ __forceinline__ void scan_l2_warm(const Frame& F, const ScanPtrs P, int stream, int quarter, unsigned* prog) {
    const int dir = stream & 1, chain = stream >> 1, lane = F.lane;
    const int wq = quarter * NWAVES + F.wave;
    constexpr int AHEAD = 6;
    int done = 0;
    u32x4 junk = (u32x4){0u, 0u, 0u, 0u};
    for (unsigned spins = 0; spins < (1u << 20); ++spins) {
        const int cur = (int)__hip_atomic_load(prog + 16 * stream, __ATOMIC_RELAXED, __HIP_MEMORY_SCOPE_AGENT);
        int tgt = cur + AHEAD; if (tgt > NSLOT) tgt = NSLOT;
        for (int s = done > cur ? done : cur; s < tgt; ++s) {
            const int slot = dir ? (s < 4 ? 3 - s : 135 - s) : s;
#pragma unroll
            for (int i = 0; i < 3; ++i) { const int p = wq + 32 * i;
                const unsigned char* src = nullptr;
                if (p < 16) src = P.NWK + so_dir(dir, chain, slot) * 16384 + p * 1024;
                else if (p < 32) src = P.KT + so_shared(chain, slot) + (p - 16) * 1024;
                else if (p < 48) src = P.U + so_dir(dir, chain, slot) * 16384 + (p - 32) * 1024;
                else if (p < 64) { if (slot >= 4) src = P.QN + so_shared(chain, slot) + (p - 48) * 1024; }
                else if (p < 72) { if (slot >= 4) src = P.QK + so_dir(dir, chain, slot) * 8192 + (p - 64) * 1024; }
                else if (p == 72) src = (const unsigned char*)(P.SCL + so_dir(dir, chain, slot) * 256);
                if (src) asm volatile("global_load_dwordx4 %0, %1, off" : "+v"(junk) : "v"(src + lane * 16)); }
        }
        if (tgt > done) done = tgt;
        if (done >= NSLOT) break;
        __builtin_amdgcn_s_sleep(16);
    }
    asm volatile("s_waitcnt vmcnt(0)" : "+v"(junk) :: "memory");
}

__device__ __forceinline__ void ph_even_A(const Frame& F, const bf16_t* OF, const bf16_t* OB, const bf16_t* Z, const bf16_t* POOL, const float* onorm, bf16_t* act) {
    LAS unsigned char* L = F.lds;
    for (int seg = F.vcu; seg < M_LAT / 64; seg += F.G) {
        int tid = F.tid; asm volatile("" : "+v"(tid));
        const int lane = tid & 63;
        const size_t row0 = (size_t)seg * 64;
#pragma unroll
        for (int i = 0; i < 8; ++i) { const int q = tid + 512 * i;
            *(LAS u32x4*)(L + q * 16) = *(const u32x4*)(POOL + row0 * 512 + (size_t)q * 8); }
        __syncthreads();
#pragma unroll 1
        for (int i0 = 0; i0 < 8; i0 += 4) {
            u32x4 av[4], bv[4], zv[4];
#pragma unroll
            for (int i = 0; i < 4; ++i) { const size_t r = row0 + F.wave * 8 + i0 + i;
                av[i] = *(const u32x4*)(OF + r * 512 + 8 * lane); bv[i] = *(const u32x4*)(OB + r * 512 + 8 * lane); zv[i] = *(const u32x4*)(Z + r * 512 + 8 * lane); }
#pragma unroll
            for (int i = 0; i < 4; ++i) {
                const int pos = F.wave * 8 + i0 + i; const size_t r = row0 + pos;
                const u32x4 a = av[i], b2 = bv[i], z = zv[i];
                float o[8]; float s = 0.f;
#pragma unroll
                for (int q = 0; q < 4; ++q) { o[2 * q] = bf_lo(a[q]) + bf_lo(b2[q]); o[2 * q + 1] = bf_hi(a[q]) + bf_hi(b2[q]); s += o[2 * q] * o[2 * q] + o[2 * q + 1] * o[2 * q + 1]; }
                s += __shfl_xor(s, 1); s += __shfl_xor(s, 2); s += __shfl_xor(s, 4); s += __shfl_xor(s, 8);
                const float rs = rsqrtf(s * (1.f / 128.f) + EPS);
                const float* gn = onorm + ((8 * lane) & 127);
                u32x4 w;
#pragma unroll
                for (int q = 0; q < 4; ++q) w[q] = pk2(o[2 * q] * rs * gn[2 * q] * silu1(bf_lo(z[q])), o[2 * q + 1] * rs * gn[2 * q + 1] * silu1(bf_hi(z[q])));
                *(u32x4*)(act + r * D + 8 * lane) = w;
                const int grp = lane >> 4, win = 2 << grp;
                int lo = pos - win / 2; if (lo < 0) lo = 0; int hi = pos + win - win / 2; if (hi > 64) hi = 64;
                float m[8];
#pragma unroll
                for (int q = 0; q < 8; ++q) m[q] = 0.f;
#pragma unroll
                for (int p = 0; p < 16; ++p) { const int rr = lo + p; const bool ok = rr < hi;
                    const u32x4 pv = *(const LAS u32x4*)(L + (ok ? rr : pos) * 1024 + lane * 16);
                    if (ok) {
#pragma unroll
                        for (int q = 0; q < 4; ++q) { m[2 * q] += bf_lo(pv[q]); m[2 * q + 1] += bf_hi(pv[q]); } } }
                const float inv = 1.f / (float)(hi - lo);
                const u32x4 self = *(const LAS u32x4*)(L + pos * 1024 + lane * 16);
#pragma unroll
                for (int q = 0; q < 4; ++q) w[q] = pk2(m[2 * q] * inv - bf_lo(self[q]), m[2 * q + 1] * inv - bf_hi(self[q]));
                *(u32x4*)(act + r * D + 512 + 8 * lane) = w;
            }
        }
        __syncthreads();
    }
}

struct TItem { const float* W; bf16_t* WT; int ldn, n0, k0, Kd, drow0; };
constexpr int N_LATE_T = 2304 + 2 * NE * 768;
__device__ __forceinline__ TItem late_item(const Args& args, int it, bf16_t* WOUT, bf16_t* SCIN, bf16_t* SCOUT, bf16_t* WGU, bf16_t* WDN) {
    TItem t;
    if (it < 256) { const int kb = it >> 5, nb = it & 31; t = TItem{args.in[16], WOUT, D, 32 * nb, 64 * kb, D, 32 * nb}; }
    else if (it < 1792) { const int q = it - 256, kb = q / 96, nb = q % 96, n0 = 32 * nb; int drow;
        if (n0 < D) drow = n0; else if (n0 < 2 * D) drow = D + ((n0 - D) >> 7) * 256 + (n0 & 127); else drow = D + ((n0 - 2 * D) >> 7) * 256 + 128 + (n0 & 127);
        t = TItem{args.in[17], SCIN, 3 * D, n0, 64 * kb, D, drow}; }
    else if (it < 2304) { const int q = it - 1792, kb = q >> 5, nb = q & 31; t = TItem{args.in[19], SCOUT, D, 32 * nb, 64 * kb, D, 32 * nb}; }
    else { const int q0 = it - 2304, le = q0 / 768, r = q0 % 768;
        if (r < 512) { const int up = r >> 8, q = r & 255, kb = q >> 4, nb = q & 15, n0 = 32 * nb;
            t = TItem{(up ? args.in[22] : args.in[21]) + (size_t)le * D * DE, WGU + (size_t)le * 1024 * D, DE, n0, 64 * kb, D, (n0 >> 7) * 256 + up * 128 + (n0 & 127)}; }
        else { const int q = r - 512, kb = q >> 5, nb = q & 31; t = TItem{args.in[23] + (size_t)le * DE * D, WDN + (size_t)le * D * DE, D, 32 * nb, 64 * kb, DE, 32 * nb}; } }
    return t;
}
__device__ __forceinline__ void t_load(const TItem& t, float (&tv)[32], int lane) {
#pragma unroll
    for (int i = 0; i < 32; ++i) tv[i] = __builtin_nontemporal_load(t.W + (size_t)(t.k0 + 2 * i + (lane >> 5)) * t.ldn + t.n0 + (lane & 31));
}
__device__ __forceinline__ void t_store(const TItem& t, const float (&tv)[32], LAS float* scr, int lane) {
#pragma unroll
    for (int i = 0; i < 32; ++i) scr[(2 * i + (lane >> 5)) * 33 + (lane & 31)] = tv[i];
    asm volatile("s_waitcnt lgkmcnt(0)" ::: "memory");
    const int c = lane & 7;
#pragma unroll
    for (int j = 0; j < 4; ++j) { const int n = (lane >> 3) + 8 * j; const LAS float* s = scr + (8 * c) * 33 + n;
        u32x4 o; o.x = pk2(s[0 * 33], s[1 * 33]); o.y = pk2(s[2 * 33], s[3 * 33]); o.z = pk2(s[4 * 33], s[5 * 33]); o.w = pk2(s[6 * 33], s[7 * 33]);
        __builtin_nontemporal_store(o, (u32x4*)(t.WT + (size_t)(t.drow0 + n) * t.Kd + t.k0 + 8 * c)); }
    asm volatile("s_waitcnt lgkmcnt(0)" ::: "memory");
}
__device__ __forceinline__ void prep_late(const Frame& F, const Args& args, int widx, int nw, bf16_t* WOUT, bf16_t* SCIN, bf16_t* SCOUT, bf16_t* WGU, bf16_t* WDN) {
    LAS float* scr = (LAS float*)(F.lds + F.wave * 16384);
    for (int it = widx; it < 4 * 128 * 16; it += nw) { const int gq = it >> 11, c = (it >> 4) & 127, n = (it & 15) * 64 + F.lane;
        const float* pw = args.in[14] + ((size_t)gq * 128 + c) * 128; const float* ps = args.in[15] + gq * 128; const float* wo = args.in[16] + (size_t)(512 + gq * 128) * D + n;
        float acc = 0.f;
#pragma unroll 1
        for (int d0 = 0; d0 < 128; d0 += 32) { float wv[32];
#pragma unroll
            for (int d = 0; d < 32; ++d) wv[d] = wo[(size_t)(d0 + d) * D];
#pragma unroll
            for (int d = 0; d < 32; ++d) acc += pw[d0 + d] * ps[d0 + d] * wv[d]; }
        WOUT[(size_t)n * D + 512 + gq * 128 + c] = (bf16_t)f2bf(acc); }
    float ta[32], tb[32];
    int it0 = widx;
    TItem A = late_item(args, it0 < N_LATE_T ? it0 : 0, WOUT, SCIN, SCOUT, WGU, WDN), B = A;
    if (it0 < N_LATE_T) t_load(A, ta, F.lane);
    while (it0 < N_LATE_T) {
        const int it1 = it0 + nw;
        if (it1 < N_LATE_T) { B = late_item(args, it1, WOUT, SCIN, SCOUT, WGU, WDN); t_load(B, tb, F.lane); }
        t_store(A, ta, scr, F.lane);
        it0 = it1 + nw;
        if (it0 < N_LATE_T) { A = late_item(args, it0, WOUT, SCIN, SCOUT, WGU, WDN); t_load(A, ta, F.lane); }
        if (it1 < N_LATE_T) t_store(B, tb, scr, F.lane);
        __builtin_amdgcn_s_sleep(32);
    }
}

enum { PH_PREP = 0, PH_E1, PH_E2, PH_E4, PH_E5, PH_E6, PH_M1_0, PH_M2_0, PH_M3_0, PH_M4_0, PH_M5_0, PH_X1, PH_X2, PH_X3, PH_M1_1, PH_M2_1, PH_M3_1, PH_M4_1, PH_M5_1, PH_COUNT };

__global__ void __launch_bounds__(NTHREADS, 2) mega(Args args) {
    extern __shared__ __attribute__((aligned(16))) unsigned char lds_raw[];
    Frame F;
    F.lds = (LAS unsigned char*)lds_raw;
    F.tid = threadIdx.x; F.lane = F.tid & 63; F.wave = __builtin_amdgcn_readfirstlane(F.tid >> 6);
    F.G = gridDim.x; { const int bx = blockIdx.x; F.vcu = (F.G % 8 == 0) ? (bx % 8) * (F.G / 8) + bx / 8 : bx; }
    volatile LAS unsigned* MISC = (volatile LAS unsigned*)(F.lds + MISC_OFF);
    if (F.tid < 64) MISC[F.tid] = 0u;
    __syncthreads();
    unsigned char* ws = args.ws;
    XcdBarrier bar = xcd_barrier_post((unsigned*)(ws + WS_CTL) + CW_BAR + args.li * XCD_BAR_WORDS, MISC + 8);
    const int lo = args.ph_lo, hi = args.ph_hi;
#define IN(k) (lo <= (k) && (k) < hi)
#define SEAM(k) do { if (IN(k) && IN((k) + 1)) xcd_barrier(bar); } while (0)
    const float* ADA = (const float*)(ws + WS_ADA); float* ADAw = (float*)(ws + WS_ADA);
    float* AFF = (float*)(ws + WS_AFF); int* IDX = (int*)(ws + WS_IDX); float* GATE = (float*)(ws + WS_GATE); int* SEL = (int*)(ws + WS_SEL);
    bf16_t* WGU = (bf16_t*)(ws + WS_WGU); bf16_t* WDN = (bf16_t*)(ws + WS_WDN); bf16_t* SCIN = (bf16_t*)(ws + WS_SCIN); bf16_t* SCOUT = (bf16_t*)(ws + WS_SCOUT);
    bf16_t* GBp = (bf16_t*)(ws + WS_GB); bf16_t* UUp = (bf16_t*)(ws + WS_UU);
    bf16_t* WIN = (bf16_t*)(ws + WS_WIN); bf16_t* WOUT = (bf16_t*)(ws + WS_WOUT); float* GATES = (float*)(ws + WS_GATES);
    const ScanPtrs SP{ws + WS_QN, ws + WS_KT, ws + WS_NWK, (unsigned char*)args.out + 66 * MiB, (unsigned char*)args.out, (float*)(ws + WS_SCL)};
    bf16_t* OFp = (bf16_t*)(ws + WS_OF); bf16_t* OBp = (bf16_t*)(ws + WS_OB);
    bf16_t* QKV = (bf16_t*)(ws + WS_QKV); bf16_t* Zp = (bf16_t*)(ws + WS_Z); bf16_t* POOLp = (bf16_t*)(ws + WS_POOL); bf16_t* CKV = (bf16_t*)(ws + WS_CKV);
    bf16_t* ACT = (bf16_t*)(ws + WS_ACT); bf16_t* HID = (bf16_t*)(ws + WS_HID); bf16_t* Y = (bf16_t*)(ws + WS_Y);
    float* xl = args.out; (void)xl;
    bf16_t* XLB = (bf16_t*)(ws + WS_XLB);

    if (IN(PH_PREP)) {
        LAS float* scr = (LAS float*)(F.lds + F.wave * 16384);
        const int gw_ = F.vcu * NWAVES + F.wave, NGW = F.G * NWAVES;
        for (int it = F.vcu; it < 192; it += F.G) { const int l = it / 96, n = (it % 96) * 64 + F.lane;
            const float* w = args.in[4] + (size_t)l * D * 6 * D + (size_t)(128 * F.wave) * 6 * D + n; float acc[5] = {0.f, 0.f, 0.f, 0.f, 0.f};
#pragma unroll 8
            for (int k2 = 0; k2 < 128; ++k2) { const float wv = w[(size_t)k2 * 6 * D]; const int kk = 128 * F.wave + k2;
#pragma unroll
                for (int r = 0; r < 5; ++r) { const float cv = r < 4 ? args.in[1][r * D + kk] : args.in[3][kk]; acc[r] += silu1(cv) * wv; } }
            LAS float* red = (LAS float*)(F.lds + 8 * 16384);
#pragma unroll
            for (int r = 0; r < 5; ++r) red[(F.wave * 5 + r) * 64 + F.lane] = acc[r];
            __syncthreads();
            if (F.tid < 320) { const int r = F.tid >> 6, ln = F.tid & 63; float sacc = 0.f;
#pragma unroll
                for (int w2 = 0; w2 < 8; ++w2) sacc += red[(w2 * 5 + r) * 64 + ln];
                const int n2 = (it % 96) * 64 + ln;
                ADAw[((size_t)l * 5 + r) * 6 * D + n2] = sacc + args.in[5][l * 6 * D + n2]; }
            __syncthreads(); }
        for (int it = gw_; it < 1280; it += NGW) { const int kb = it / 80, nb = it % 80, n0 = 32 * nb;
            transpose_item(args.in[9], D, EVEN_IN, n0 < 2048 ? n0 : n0 + 16, 64 * kb, WIN, n0, scr, F.lane); }
    }
    SEAM(PH_PREP);
    if (IN(PH_E1)) ph_norm16<1>(F, args.in[0], args.in[2], ACT, args.in[6], ADA, args.in[9] + 2048, EVEN_IN, GATES, args.in[11], args.in[12]);
    SEAM(PH_E1);
    if (IN(PH_E2)) { SchedProj S{F.vcu, F.G}; EpiProj E{QKV, Zp, POOLp, CKV}; gemm_phase<EpiProj, SchedProj, false>(F.lds, ACT, WIN, D, S, E); }
    SEAM(PH_E2);
#if PROBE_SEL >= 0
    unsigned long long* tsq = (unsigned long long*)((unsigned*)(ws + WS_CTL) + CW_TS);
    const unsigned long long te0_ = __builtin_amdgcn_s_memrealtime();
#endif
    if (IN(PH_E4)) {
        unsigned* prog = (unsigned*)(ws + WS_CTL) + CW_PROG;
        const int xj = F.vcu & 31, xg = F.vcu >> 5;
        unsigned* flags = (unsigned*)(ws + WS_CTL) + CW_FLAG;
        if (xj < 8) ph_scan(F, SP, OFp, OBp, prog, flags);
        else { ph_chunk_prep(F, QKV, CKV, GATES, args.in[10], SP, xg * 24 + (xj - 8), 192, flags);
#if PROBE_SEL >= 0
            if (F.tid == 0 && blockIdx.x == 64) tsq[9] = __builtin_amdgcn_s_memrealtime() - te0_;
            if (F.tid == 0 && blockIdx.x == 255) tsq[13] = __builtin_amdgcn_s_memrealtime() - te0_;
#endif
            prep_late(F, args, (xg * 24 + (xj - 8)) * NWAVES + F.wave, 192 * NWAVES, WOUT, SCIN, SCOUT, WGU, WDN); }
    }
#if PROBE_SEL >= 0
    const unsigned long long te1_ = __builtin_amdgcn_s_memrealtime();
    if (F.tid == 0 && blockIdx.x == 0) tsq[8] = te1_ - te0_;
    if (F.tid == 0 && blockIdx.x == 64) tsq[10] = te1_ - te0_;
#endif
    SEAM(PH_E4);
#if PROBE_SEL >= 0
    if (F.tid == 0 && blockIdx.x == 0) tsq[11] = __builtin_amdgcn_s_memrealtime() - te0_;
#endif
    bf16_t* ACT2 = (bf16_t*)(ws + WS_ACT2);
    if (IN(PH_E5)) ph_even_A(F, OFp, OBp, Zp, POOLp, args.in[13], ACT2);
    SEAM(PH_E5);
    if (IN(PH_E6)) { SchedDense<4, 256> S{F.vcu, F.G, 128 * 4}; EpiResid<false> E{args.in[0], XLB, ADA + 2 * D}; gemm_phase<EpiResid<false>, SchedDense<4, 256>, false>(F.lds, ACT2, WOUT, D, S, E); }
    SEAM(PH_E6);
#define MOE_SEGMENT(l, p0) do { \
        const float* ada_l = ADA + (size_t)(l) * 5 * 6 * D; \
        if (IN(p0)) ph_norm16<0>(F, XLB, nullptr, ACT, args.in[7] + (l) * D, ada_l, args.in[20] + (size_t)(l) * D * NE, NE, AFF, nullptr, nullptr, SEL); \
        SEAM(p0); \
        if (IN((p0) + 1)) ph_topk(F, AFF, IDX, GATE, SEL); \
        SEAM((p0) + 1); \
        if (IN((p0) + 2)) { SchedMoeUp S{F.vcu, (l), IDX}; EpiSiluMul E{HID, DE}; gemm_phase<EpiSiluMul, SchedMoeUp, true>(F.lds, ACT, WGU, D, S, E); } \
        SEAM((p0) + 2); \
        if (IN((p0) + 3)) { SchedMoeDown S{F.vcu, (l)}; EpiRowScale E{Y, D, GATE}; gemm_phase<EpiRowScale, SchedMoeDown, false>(F.lds, HID, WDN, DE, S, E); } \
        SEAM((p0) + 3); \
        if (IN((p0) + 4)) { \
            if ((l) == 0) ph_combine<false>(F, XLB, nullptr, Y, SEL, ada_l, args.in[6] + D, ADA + (size_t)5 * 6 * D, ACT); \
            else ph_combine<true>(F, XLB, args.out, Y, SEL, ada_l, args.in[8], nullptr, nullptr); \
        } \
    } while (0)
    MOE_SEGMENT(0, PH_M1_0);
    SEAM(PH_M5_0);
    if (IN(PH_X1)) { SchedDense<12, 1> S{F.vcu, F.G, 128 * 12}; EpiScIn E{GBp, UUp}; gemm_phase<EpiScIn, SchedDense<12, 1>, false>(F.lds, ACT, SCIN, D, S, E); }
    SEAM(PH_X1);
    if (IN(PH_X2)) ph_sc_glue(F, GBp, UUp, args.in[18], ACT);
    SEAM(PH_X2);
    if (IN(PH_X3)) { SchedDense<4, 256> S{F.vcu, F.G, 128 * 4}; EpiResid<true> E{XLB, XLB, ADA + (size_t)5 * 6 * D + 2 * D}; gemm_phase<EpiResid<true>, SchedDense<4, 256>, false>(F.lds, ACT, SCOUT, D, S, E); }
    SEAM(PH_X3);
    MOE_SEGMENT(1, PH_M1_1);
#undef MOE_SEGMENT
#if PROBE_SEL >= 0
    if (blockIdx.x == 0 && F.tid == 0) { asm volatile("s_waitcnt vmcnt(0)" ::: "memory");
        const unsigned long long v = __hip_atomic_load((unsigned long long*)((unsigned*)(ws + WS_CTL) + CW_TS) + PROBE_SEL, __ATOMIC_RELAXED, __HIP_MEMORY_SCOPE_AGENT);
        const unsigned long long t0 = __builtin_amdgcn_s_memrealtime();
        while (__builtin_amdgcn_s_memrealtime() - t0 < 4ull * v) __builtin_amdgcn_s_sleep(8); }
#endif
#undef IN
#undef SEAM
}
}

}

extern "C" void kernel_launch(void* const* d_in, const int* in_sizes, int n_in, void* d_out, int out_size, void* d_ws, size_t ws_size, hipStream_t st) {
    static int grid = 0;
    if (grid == 0) {
        int dev = 0, cus = 0;
        if (hipGetDevice(&dev) != hipSuccess || hipDeviceGetAttribute(&cus, hipDeviceAttributeMultiprocessorCount, dev) != hipSuccess) { grid = -1; return; }
        if (hipFuncSetAttribute((const void*)mk::mega, hipFuncAttributeMaxDynamicSharedMemorySize, mk::LDS_BYTES) != hipSuccess) { fprintf(stderr, "hipFuncSetAttribute failed\n"); grid = -1; return; }
        if (ws_size < mk::WS_END) { fprintf(stderr, "workspace too small: %zu < %zu\n", ws_size, (size_t)mk::WS_END); grid = -1; return; }
        grid = cus;
    }
    if (grid < 0) return;
    (void)hipMemsetAsync((char*)d_ws + mk::WS_CTL, 0, mk::MiB, st);
    mk::Args a{};
    for (int i = 0; i < 24; ++i) a.in[i] = (const float*)d_in[i];
    a.out = (float*)d_out; a.ws = (unsigned char*)d_ws;
    int n_mega = 0;
    auto mega = [&](int lo, int hi) { a.ph_lo = lo; a.ph_hi = hi; a.li = n_mega++; hipLaunchKernelGGL(mk::mega, dim3(grid), dim3(mk::NTHREADS), mk::LDS_BYTES, st, a); };
    mega(0, mk::PH_COUNT);
}
```

```cpp
#include <hip/hip_runtime.h>
#include <cstdio>
#include <cstdint>

namespace {
constexpr int D = 1024, BATCH = 4, SEQ = 8192, CTX = 256, NH = 4, DK = 128, DV = 128;
constexpr int EVEN_IN = 2576, NE = 16, DE = 512, CAP = 1024;
constexpr float EPS = 1e-6f;

__device__ __forceinline__ float silu_f(float x) { return x / (1.f + __expf(-x)); }
__device__ __forceinline__ float sigmoid_f(float x) { return 1.f / (1.f + __expf(-x)); }
__device__ __forceinline__ float softplus_f(float x) { return x > 20.f ? x : log1pf(__expf(x)); }
__device__ __forceinline__ float wave_sum(float v) {
#pragma unroll
    for (int o = 1; o < 64; o <<= 1) v += __shfl_xor(v, o);
    return v;
}


namespace mk {
#define LAS __attribute__((address_space(3)))
#define GAS __attribute__((address_space(1)))
typedef unsigned short bf16_t;
typedef short bf16x8 __attribute__((ext_vector_type(8)));
typedef float f32x4 __attribute__((ext_vector_type(4)));
typedef float f32x2 __attribute__((ext_vector_type(2)));
typedef unsigned u32x4 __attribute__((ext_vector_type(4)));
typedef unsigned u32x2 __attribute__((ext_vector_type(2)));
constexpr int M_LAT = BATCH * SEQ;
constexpr int BM = 256, BK = 64, HALF = 128, HTB = HALF * BK * 2, STAGE_BYTES = 8 * HTB;
constexpr int LDS_BYTES = 163840, GTAB_OFF = 131072  , MISC_OFF = LDS_BYTES - 256;
constexpr int NTHREADS = 512, NWAVES = 8;

__device__ __forceinline__ unsigned f2bf(float f) { unsigned u = __builtin_bit_cast(unsigned, f); return (u + 0x7fffu + ((u >> 16) & 1u)) >> 16; }
__device__ __forceinline__ unsigned pk2(float lo, float hi) { return f2bf(lo) | (f2bf(hi) << 16); }
typedef __bf16 bf16x2_t __attribute__((ext_vector_type(2)));
__device__ __forceinline__ unsigned cvt_pk_bf16(float lo, float hi) { const f32x2 v = {lo, hi}; const bf16x2_t b2 = __builtin_convertvector(v, bf16x2_t); return __builtin_bit_cast(unsigned, b2); }
__device__ __forceinline__ float bf_lo(unsigned w) { return __uint_as_float(w << 16); }
__device__ __forceinline__ float bf_hi(unsigned w) { return __uint_as_float(w & 0xffff0000u); }

__device__ __forceinline__ void lds_barrier() { asm volatile("s_waitcnt lgkmcnt(0)" ::: "memory"); __builtin_amdgcn_s_barrier(); asm volatile("" ::: "memory"); }

#define XB_TMO      128
#define XB_XCNT(j)  (256  + 64 * (j))
#define XB_XSUB(j)  (1280 + 64 * (j))
#define XB_XGEN(j)  (2304 + 64 * (j))
#define XB_TOP      3328
#define XB_TOPGEN   3392
#define XCD_BAR_WORDS 3456
#define XB_SPIN_CAP (1u << 18)
__device__ __forceinline__ unsigned xb_ld(unsigned* p)              { return __hip_atomic_load(p, __ATOMIC_RELAXED, __HIP_MEMORY_SCOPE_AGENT); }
__device__ __forceinline__ unsigned xb_add(unsigned* p, unsigned v) { return __hip_atomic_fetch_add(p, v, __ATOMIC_RELAXED, __HIP_MEMORY_SCOPE_AGENT); }
__device__ __forceinline__ unsigned xb_xcc_id() { return (unsigned)__builtin_amdgcn_s_getreg((3 << 11) | 20) & 0xFu; }
#define XB_SPIN(cond, bar) do { unsigned _sp = 0; while (cond) { __builtin_amdgcn_s_sleep(1); \
    if ((++_sp & 255u) == 0u) { if (xb_ld(&(bar)[XB_TMO])) break; if (_sp > XB_SPIN_CAP) { atomicAdd(&(bar)[XB_TMO], 1u); break; } } } } while (0)
struct XcdBarrier { unsigned* bar; unsigned x; volatile LAS unsigned* st; };
__device__ __forceinline__ XcdBarrier xcd_barrier_post(unsigned* bar, volatile LAS unsigned* st) {
    XcdBarrier b; b.bar = bar; b.x = xb_xcc_id(); b.st = st;
    if (threadIdx.x == 0) (void)xb_add(&bar[XB_XCNT(b.x)], 1u);
    return b;
}
__device__ __forceinline__ void xcd_barrier_complete(unsigned* bar, unsigned x, unsigned& nloc, unsigned& nx) {
    const unsigned G = gridDim.x * gridDim.y * gridDim.z;
    unsigned sum, cnt, mine, sp = 0u;
    for (;;) {
        sum = 0u; cnt = 0u; mine = 0u;
#pragma unroll
        for (unsigned j = 0; j < 16; ++j) { const unsigned c = xb_ld(&bar[XB_XCNT(j)]); sum += c; cnt += (c > 0u) ? 1u : 0u; mine = (j == x) ? c : mine; }
        if (sum == G) break;
        __builtin_amdgcn_s_sleep(1);
        if ((++sp & 255u) == 0u) { if (xb_ld(&bar[XB_TMO])) break; if (sp > XB_SPIN_CAP) { atomicAdd(&bar[XB_TMO], 1u); break; } }
    }
    nloc = mine > 0u ? mine : 1u; nx = cnt > 0u ? cnt : 1u;
}
__device__ __forceinline__ void xcd_barrier(const XcdBarrier& b) {
    asm volatile("s_waitcnt vmcnt(0)" ::: "memory");
    __syncthreads();
    if (threadIdx.x == 0) {
        unsigned* bar = b.bar;
        __builtin_amdgcn_s_waitcnt(0);
        unsigned nloc = b.st[0], nx = b.st[1];
        if (nloc == 0u) { xcd_barrier_complete(bar, b.x, nloc, nx); b.st[0] = nloc; b.st[1] = nx; }
        const unsigned old = xb_add(&bar[XB_XSUB(b.x)], 1u);
        const unsigned gen = old / nloc;
        if (old + 1u == (gen + 1u) * nloc) {
            __builtin_amdgcn_fence(__ATOMIC_RELEASE, "agent");
            asm volatile("s_waitcnt vmcnt(0)" ::: "memory");
            const unsigned og = xb_add(&bar[XB_TOP], 1u);
            const unsigned tg = og / nx;
            if (og + 1u == (tg + 1u) * nx) xb_add(&bar[XB_TOPGEN], 1u);
            else XB_SPIN(xb_ld(&bar[XB_TOPGEN]) == tg, bar);
            __builtin_amdgcn_fence(__ATOMIC_ACQUIRE, "agent");
            xb_add(&bar[XB_XGEN(b.x)], 1u);
            asm volatile("s_waitcnt vmcnt(0)" ::: "memory");
        } else {
            XB_SPIN(xb_ld(&bar[XB_XGEN(b.x)]) == gen, bar);
            __builtin_amdgcn_fence(__ATOMIC_ACQUIRE, "agent");
            asm volatile("s_waitcnt vmcnt(0)" ::: "memory");
        }
    }
    __syncthreads();
}

__host__ __device__ __forceinline__ int lds_byte(int r, int c) { const int st = (r >> 4) * 2 + (c >> 5), rr = r & 15, cc = c & 31, ob = rr * 64 + cc * 2; return st * 1024 + (ob ^ (((ob >> 9) & 1) << 5)); }
__host__ __device__ __forceinline__ void stage_rc(int b, int& R, int& C) { const int st = b / 1024, sb = b % 1024, swz = sb ^ (((sb >> 9) & 1) << 5); R = (st >> 1) * 16 + swz / 64; C = (st & 1) * 32 + (swz % 64) / 2; }
__host__ __device__ __forceinline__ int perm32(int rho) { const int n = rho >> 4, i = rho & 15; return 8 * (i >> 2) + 4 * n + (i & 3); }

struct Unit { int arow, brow, orow, ocol; };

template <class Epi, class Sched, bool GATHER>
__device__ __forceinline__ void gemm_phase(LAS unsigned char* lds, const bf16_t* Abase, const bf16_t* Btbase, const int K, const Sched& S, const Epi& E) {
    const int tid = threadIdx.x, wid = __builtin_amdgcn_readfirstlane(tid >> 6), lane = tid & 63, wr = wid >> 2, wc = wid & 3, fr = lane & 15, fq = lane >> 4;
    const int nt = K / BK;
    unsigned voffA[2], voffB[2];
#pragma unroll
    for (int i = 0; i < 2; ++i) { int R, C; stage_rc(tid * 16 + i * 8192, R, C); const int Rb = Epi::PERM ? ((R & ~31) + perm32(R & 31)) : R;
        voffA[i] = (unsigned)(R * K + C) * 2u; voffB[i] = (unsigned)(Rb * K + C) * 2u; }
    const size_t kstep = (size_t)(BK * 2);
    const size_t hstep = (size_t)HALF * K * 2;
    const unsigned ldsw = (unsigned)wid * 1024u;
    const int aoff = lds_byte(wr * 64 + fr, fq * 8), boff = lds_byte(wc * 32 + fr, fq * 8);
    LAS const int* gtab = (LAS const int*)(lds + GTAB_OFF);
    unsigned goff[2][2];
#define PG8_SA(b, h) (((b) * 2 + (h)) * HTB)
#define PG8_SB(b, h) ((4 + (b) * 2 + (h)) * HTB)
#define PG8_STAGE(bufoff, gbase, voff) do { _Pragma("unroll") for (int _i = 0; _i < 2; ++_i) \
        __builtin_amdgcn_global_load_lds((const unsigned*)((const char*)(gbase) + (voff)[_i]), (LAS unsigned*)(lds + (bufoff) + ldsw + _i * 8192), 16, 0, 0); } while (0)
#define PG8_STAGE_A(bufoff, abase, h) do { if constexpr (GATHER) { PG8_STAGE(bufoff, abase, goff[h]); } else { PG8_STAGE(bufoff, (abase) + (h) * hstep, voffA); } } while (0)
#define PG8_LDA(dst, b, h) do { _Pragma("unroll") for (int m = 0; m < 4; ++m) _Pragma("unroll") for (int k = 0; k < 2; ++k) dst[m][k] = *(const LAS bf16x8*)(lds + PG8_SA(b, h) + aoff + m * 2048 + k * 1024); } while (0)
#define PG8_LDB(dst, b, h) do { _Pragma("unroll") for (int n = 0; n < 2; ++n) _Pragma("unroll") for (int k = 0; k < 2; ++k) dst[n][k] = *(const LAS bf16x8*)(lds + PG8_SB(b, h) + boff + n * 2048 + k * 1024); } while (0)
#define PG8_MMA(ai, bj, At, Bt) do { __builtin_amdgcn_s_setprio(1); _Pragma("unroll") for (int m = 0; m < 4; ++m) _Pragma("unroll") for (int n = 0; n < 2; ++n) _Pragma("unroll") for (int k = 0; k < 2; ++k) \
        acc[ai][bj][m][n] = __builtin_amdgcn_mfma_f32_16x16x32_bf16(Bt[n][k], At[m][k], acc[ai][bj][m][n], 0, 0, 0); __builtin_amdgcn_s_setprio(0); } while (0)
#define PG8_WAIT_V(n) asm volatile("s_waitcnt vmcnt(" #n ")" ::: "memory")
#define PG8_WAIT_L(n) asm volatile("s_waitcnt lgkmcnt(" #n ")" ::: "memory")
#define PG8_BAR __builtin_amdgcn_s_barrier()
#define PG8_SCHED __builtin_amdgcn_sched_barrier(0)
#define PG8_GLOAD(ui_) do { if constexpr (GATHER) { _Pragma("unroll") for (int _i = 0; _i < 2; ++_i) { int _R, _C; stage_rc(tid * 16 + _i * 8192, _R, _C); _Pragma("unroll") for (int _h = 0; _h < 2; ++_h) \
        goff[_h][_i] = (unsigned)(gtab[((ui_) & 3) * 256 + _h * HALF + _R] * K * 2 + _C * 2); } } } while (0)
    Unit cur, nxt; int ui = 0;
    if (!S.next(0, cur)) return;
    if constexpr (GATHER) {
        Unit t;
        for (int j = 0; j < 4; ++j) if (S.next(j, t)) { if (tid < 256) ((LAS int*)(lds + GTAB_OFF))[j * 256 + tid] = S.gidx(t, tid); }
        __syncthreads();
    }
    f32x4 acc[2][2][4][2];
#pragma unroll
    for (int a = 0; a < 2; ++a)
#pragma unroll
        for (int b = 0; b < 2; ++b)
#pragma unroll
            for (int m = 0; m < 4; ++m)
#pragma unroll
                for (int n = 0; n < 2; ++n) acc[a][b][m][n] = (f32x4){0.f, 0.f, 0.f, 0.f};
    bf16x8 At[4][2], B0[2][2], B1[2][2];
    const char* cA = (const char*)Abase + (size_t)cur.arow * K * 2; const char* cB = (const char*)Btbase + (size_t)cur.brow * K * 2;
    PG8_GLOAD(0);
    PG8_STAGE(PG8_SB(0, 0), cB, voffB); PG8_STAGE(PG8_SB(0, 1), cB + hstep, voffB); PG8_STAGE_A(PG8_SA(0, 0), cA, 0); PG8_STAGE_A(PG8_SA(0, 1), cA, 1);
    if (wr == 1) PG8_BAR;
    PG8_WAIT_V(2); PG8_BAR;
    PG8_STAGE(PG8_SB(1, 0), cB + kstep, voffB); PG8_STAGE_A(PG8_SA(1, 0), cA + kstep, 0); PG8_STAGE(PG8_SB(1, 1), cB + hstep + kstep, voffB);
    PG8_WAIT_V(6); PG8_BAR;
    for (;;) {
        const bool has_next = S.next(ui + 1, nxt);
        const char* nA = has_next ? (const char*)Abase + (size_t)nxt.arow * K * 2 : cA; const char* nB = has_next ? (const char*)Btbase + (size_t)nxt.brow * K * 2 : cB;
        for (int t = 0; t < nt; t += 2) {
            const bool last = (t == nt - 2);
            const char* a1 = cA + (size_t)(t + 1) * kstep;
            const char* a2 = last ? nA : cA + (size_t)(t + 2) * kstep; const char* b2 = last ? nB : cB + (size_t)(t + 2) * kstep;
            const char* a3 = a2 + kstep; const char* b3 = b2 + kstep;
            PG8_LDB(B0, 0, 0); PG8_LDB(B1, 0, 1); PG8_SCHED; PG8_LDA(At, 0, 0); PG8_STAGE_A(PG8_SA(1, 1), a1, 1);
            if constexpr (GATHER) { if (last && has_next) PG8_GLOAD(ui + 1); }
            PG8_WAIT_V(8); PG8_WAIT_L(0); PG8_BAR; PG8_MMA(0, 0, At, B0); PG8_MMA(0, 1, At, B1); PG8_BAR; PG8_SCHED;
            PG8_LDA(At, 0, 1); PG8_STAGE(PG8_SB(0, 0), b2, voffB); PG8_STAGE(PG8_SB(0, 1), b2 + hstep, voffB); PG8_STAGE_A(PG8_SA(0, 0), a2, 0);
            PG8_WAIT_V(8); PG8_WAIT_L(0); PG8_BAR; PG8_MMA(1, 0, At, B0); PG8_MMA(1, 1, At, B1); PG8_BAR; PG8_SCHED;
            PG8_LDB(B0, 1, 0); PG8_LDB(B1, 1, 1); PG8_SCHED; PG8_LDA(At, 1, 0); PG8_STAGE_A(PG8_SA(0, 1), a2, 1);
            PG8_WAIT_V(8); PG8_WAIT_L(0); PG8_BAR; PG8_MMA(0, 0, At, B0); PG8_MMA(0, 1, At, B1); PG8_BAR; PG8_SCHED;
            PG8_LDA(At, 1, 1); PG8_STAGE(PG8_SB(1, 0), b3, voffB); PG8_STAGE(PG8_SB(1, 1), b3 + hstep, voffB); PG8_STAGE_A(PG8_SA(1, 0), a3, 0);
            PG8_WAIT_V(8); PG8_WAIT_L(0); PG8_BAR; PG8_MMA(1, 0, At, B0); PG8_MMA(1, 1, At, B1); PG8_BAR; PG8_SCHED;
        }
        if (wr == 0) PG8_BAR;
        E(acc, cur, wr, wc, fr, fq);
        if (!has_next) break;
#pragma unroll
        for (int a = 0; a < 2; ++a)
#pragma unroll
            for (int b = 0; b < 2; ++b)
#pragma unroll
                for (int m = 0; m < 4; ++m)
#pragma unroll
                    for (int n = 0; n < 2; ++n) acc[a][b][m][n] = (f32x4){0.f, 0.f, 0.f, 0.f};
        cur = nxt; cA = nA; cB = nB; ++ui;
        if (wr == 1) PG8_BAR;
    }
    PG8_WAIT_V(0);
    PG8_BAR;
#undef PG8_SA
#undef PG8_SB
#undef PG8_STAGE
#undef PG8_STAGE_A
#undef PG8_LDA
#undef PG8_LDB
#undef PG8_MMA
#undef PG8_WAIT_V
#undef PG8_WAIT_L
#undef PG8_BAR
#undef PG8_SCHED
#undef PG8_GLOAD
}

__device__ __forceinline__ float silu1(float x) { return x * __builtin_amdgcn_rcpf(1.f + __expf(-x)); }
struct EpiSiluMul {
    static constexpr bool PERM = true;
    bf16_t* O; int ldo;
    __device__ __forceinline__ void operator()(const f32x4 (&acc)[2][2][4][2], const Unit& u, int wr, int wc, int fr, int fq) const {
        const int row0 = u.orow + wr * 64 + fr, col0 = u.ocol + wc * 32 + 8 * fq;
#pragma unroll
        for (int ai = 0; ai < 2; ++ai)
#pragma unroll
            for (int m = 0; m < 4; ++m) { bf16_t* rowp = O + (size_t)(row0 + ai * HALF + m * 16) * ldo + col0;
                const f32x4 g0 = acc[ai][0][m][0], g1 = acc[ai][0][m][1], u0 = acc[ai][1][m][0], u1 = acc[ai][1][m][1];
                u32x4 w; w.x = cvt_pk_bf16(silu1(g0[0]) * u0[0], silu1(g0[1]) * u0[1]); w.y = cvt_pk_bf16(silu1(g0[2]) * u0[2], silu1(g0[3]) * u0[3]);
                w.z = cvt_pk_bf16(silu1(g1[0]) * u1[0], silu1(g1[1]) * u1[1]); w.w = cvt_pk_bf16(silu1(g1[2]) * u1[2], silu1(g1[3]) * u1[3]);
                *(u32x4*)rowp = w; }
    }
};
struct EpiRowScale {
    static constexpr bool PERM = true;
    bf16_t* O; int ldo; const float* rowscale;
    __device__ __forceinline__ void operator()(const f32x4 (&acc)[2][2][4][2], const Unit& u, int wr, int wc, int fr, int fq) const {
        const int row0 = u.orow + wr * 64 + fr, col0 = u.ocol + wc * 32 + 8 * fq;
#pragma unroll
        for (int ai = 0; ai < 2; ++ai)
#pragma unroll
            for (int m = 0; m < 4; ++m) { const int row = row0 + ai * HALF + m * 16; bf16_t* rowp = O + (size_t)row * ldo + col0;
#pragma unroll
                for (int bj = 0; bj < 2; ++bj) { const f32x4 v0 = acc[ai][bj][m][0], v1 = acc[ai][bj][m][1];
                    u32x4 w; w.x = cvt_pk_bf16(v0[0], v0[1]); w.y = cvt_pk_bf16(v0[2], v0[3]); w.z = cvt_pk_bf16(v1[0], v1[1]); w.w = cvt_pk_bf16(v1[2], v1[3]);
                    *(u32x4*)(rowp + bj * HALF) = w; } }
    }
};


struct EpiScIn {
    static constexpr bool PERM = true;
    bf16_t* GB; bf16_t* UU;
    __device__ __forceinline__ void operator()(const f32x4 (&acc)[2][2][4][2], const Unit& u, int wr, int wc, int fr, int fq) const {
        const int row0 = u.orow + wr * 64 + fr;
        if (u.ocol < 4) {
            const int col0 = u.ocol * 256 + wc * 32 + 8 * fq;
#pragma unroll
            for (int ai = 0; ai < 2; ++ai)
#pragma unroll
                for (int m = 0; m < 4; ++m) { bf16_t* rowp = GB + (size_t)(row0 + ai * HALF + m * 16) * D + col0;
#pragma unroll
                    for (int bj = 0; bj < 2; ++bj) { const f32x4 v0 = acc[ai][bj][m][0], v1 = acc[ai][bj][m][1];
                        u32x4 w; w.x = cvt_pk_bf16(v0[0], v0[1]); w.y = cvt_pk_bf16(v0[2], v0[3]); w.z = cvt_pk_bf16(v1[0], v1[1]); w.w = cvt_pk_bf16(v1[2], v1[3]);
                        *(u32x4*)(rowp + bj * HALF) = w; } }
        } else {
            const int col0 = (u.ocol - 4) * 128 + wc * 32 + 8 * fq;
#pragma unroll
            for (int ai = 0; ai < 2; ++ai)
#pragma unroll
                for (int m = 0; m < 4; ++m) { bf16_t* rowp = UU + (size_t)(row0 + ai * HALF + m * 16) * D + col0;
                    const f32x4 v0 = acc[ai][0][m][0] * acc[ai][1][m][0], v1 = acc[ai][0][m][1] * acc[ai][1][m][1];
                    u32x4 w; w.x = cvt_pk_bf16(v0[0], v0[1]); w.y = cvt_pk_bf16(v0[2], v0[3]); w.z = cvt_pk_bf16(v1[0], v1[1]); w.w = cvt_pk_bf16(v1[2], v1[3]);
                    *(u32x4*)rowp = w; }
        }
    }
};
template <bool BASE_BF16>
struct EpiResid {
    static constexpr bool PERM = true;
    const void* base; bf16_t* out; const float* gada;
    __device__ __forceinline__ void operator()(const f32x4 (&acc)[2][2][4][2], const Unit& u, int wr, int wc, int fr, int fq) const {
        const int row0 = u.orow + wr * 64 + fr, col0 = u.ocol + wc * 32 + 8 * fq;
        const float* g = gada + (size_t)(u.orow >> 13) * 6 * D + col0;
        f32x4 gv[2][2];
#pragma unroll
        for (int bj = 0; bj < 2; ++bj)
#pragma unroll
            for (int n = 0; n < 2; ++n) gv[bj][n] = *(const f32x4*)(g + bj * HALF + n * 4);
#pragma unroll
        for (int ai = 0; ai < 2; ++ai) {
            if constexpr (BASE_BF16) {
                u32x4 bw[4][2];
#pragma unroll
                for (int m = 0; m < 4; ++m)
#pragma unroll
                    for (int bj = 0; bj < 2; ++bj) bw[m][bj] = *(const u32x4*)((const bf16_t*)base + (size_t)(row0 + ai * HALF + m * 16) * D + col0 + bj * HALF);
                asm volatile("" : "+v"(bw[0][0]), "+v"(bw[0][1]), "+v"(bw[1][0]), "+v"(bw[1][1]), "+v"(bw[2][0]), "+v"(bw[2][1]), "+v"(bw[3][0]), "+v"(bw[3][1]));
#pragma unroll
                for (int m = 0; m < 4; ++m)
#pragma unroll
                    for (int bj = 0; bj < 2; ++bj) { const u32x4 b = bw[m][bj];
                        const f32x4 b0 = (f32x4){bf_lo(b.x), bf_hi(b.x), bf_lo(b.y), bf_hi(b.y)}, b1 = (f32x4){bf_lo(b.z), bf_hi(b.z), bf_lo(b.w), bf_hi(b.w)};
                        const f32x4 v0 = b0 + gv[bj][0] * acc[ai][bj][m][0], v1 = b1 + gv[bj][1] * acc[ai][bj][m][1];
                        u32x4 w; w.x = cvt_pk_bf16(v0[0], v0[1]); w.y = cvt_pk_bf16(v0[2], v0[3]); w.z = cvt_pk_bf16(v1[0], v1[1]); w.w = cvt_pk_bf16(v1[2], v1[3]);
                        *(u32x4*)(out + (size_t)(row0 + ai * HALF + m * 16) * D + col0 + bj * HALF) = w; }
            } else {
                f32x4 bf[4][2][2];
#pragma unroll
                for (int m = 0; m < 4; ++m)
#pragma unroll
                    for (int bj = 0; bj < 2; ++bj)
#pragma unroll
                        for (int n = 0; n < 2; ++n) bf[m][bj][n] = *(const f32x4*)((const float*)base + (size_t)(row0 + ai * HALF + m * 16) * D + col0 + bj * HALF + n * 4);
                asm volatile("" : "+v"(bf[0][0][0]), "+v"(bf[0][0][1]), "+v"(bf[0][1][0]), "+v"(bf[0][1][1]), "+v"(bf[1][0][0]), "+v"(bf[1][0][1]), "+v"(bf[1][1][0]), "+v"(bf[1][1][1]),
                             "+v"(bf[2][0][0]), "+v"(bf[2][0][1]), "+v"(bf[2][1][0]), "+v"(bf[2][1][1]), "+v"(bf[3][0][0]), "+v"(bf[3][0][1]), "+v"(bf[3][1][0]), "+v"(bf[3][1][1]));
#pragma unroll
                for (int m = 0; m < 4; ++m)
#pragma unroll
                    for (int bj = 0; bj < 2; ++bj) {
                        const f32x4 v0 = bf[m][bj][0] + gv[bj][0] * acc[ai][bj][m][0], v1 = bf[m][bj][1] + gv[bj][1] * acc[ai][bj][m][1];
                        u32x4 w; w.x = cvt_pk_bf16(v0[0], v0[1]); w.y = cvt_pk_bf16(v0[2], v0[3]); w.z = cvt_pk_bf16(v1[0], v1[1]); w.w = cvt_pk_bf16(v1[2], v1[3]);
                        *(u32x4*)(out + (size_t)(row0 + ai * HALF + m * 16) * D + col0 + bj * HALF) = w; }
            }
        }
    }
};

struct EpiProj {
    static constexpr bool PERM = true;
    bf16_t* QKV; bf16_t* Z; bf16_t* POOL; bf16_t* CKV;
    __device__ __forceinline__ void operator()(const f32x4 (&acc)[2][2][4][2], const Unit& u, int wr, int wc, int fr, int fq) const {
        bf16_t* base; int ld;
        if (u.ocol < 6) { base = QKV + (size_t)u.orow * 1536 + u.ocol * 256; ld = 1536; }
        else if (u.ocol < 8) { base = Z + (size_t)u.orow * 512 + (u.ocol - 6) * 256; ld = 512; }
        else if (u.ocol < 10) { base = POOL + (size_t)u.orow * 512 + (u.ocol - 8) * 256; ld = 512; }
        else { base = CKV + (size_t)(u.orow - M_LAT) * 1024 + (u.ocol - 16) * 256; ld = 1024; }
        base += (size_t)(wr * 64 + fr) * ld + wc * 32 + 8 * fq;
#pragma unroll
        for (int ai = 0; ai < 2; ++ai)
#pragma unroll
            for (int m = 0; m < 4; ++m) { bf16_t* rowp = base + (size_t)(ai * HALF + m * 16) * ld;
#pragma unroll
                for (int bj = 0; bj < 2; ++bj) { const f32x4 v0 = acc[ai][bj][m][0], v1 = acc[ai][bj][m][1];
                    u32x4 w; w.x = cvt_pk_bf16(v0[0], v0[1]); w.y = cvt_pk_bf16(v0[2], v0[3]); w.z = cvt_pk_bf16(v1[0], v1[1]); w.w = cvt_pk_bf16(v1[2], v1[3]);
                    *(u32x4*)(rowp + bj * HALF) = w; } }
    }
};
struct SchedProj {
    int vcu, G;
    __device__ __forceinline__ bool next(int i, Unit& u) const {
        const int L = i * G + vcu; if (L >= 1280) return false;
        if (L < 1280) { const int pm = L / 10, pn = L % 10; u.arow = pm * 256; u.brow = pn * 256; u.orow = pm * 256; u.ocol = pn; }
        else { const int q = L - 1280, pm = q >> 2, pn = q & 3; u.arow = M_LAT + pm * 256; u.brow = 512 + pn * 256; u.orow = M_LAT + pm * 256; u.ocol = 16 + pn; }
        return true;
    }
    __device__ __forceinline__ int gidx(const Unit&, int) const { return 0; }
};

__device__ __forceinline__ void ctx_proj_tile(LAS unsigned char* lds, int tile, int tid, int wave, const bf16_t* A, const bf16_t* Bt, bf16_t* C) {
    if (tile >= 256) return;
    const int tm = tile >> 4, tn = tile & 15, lane = tid & 63, rr = lane & 15, kq = lane >> 4;
    const bf16_t* ap = A + (size_t)(tm * 64 + rr) * D + wave * 128 + kq * 8;
    const bf16_t* bp = Bt + (size_t)(tn * 64 + rr) * D + wave * 128 + kq * 8;
    f32x4 acc[4][4];
#pragma unroll
    for (int mi = 0; mi < 4; ++mi)
#pragma unroll
        for (int ni = 0; ni < 4; ++ni) acc[mi][ni] = (f32x4){0.f, 0.f, 0.f, 0.f};
#pragma unroll
    for (int ks = 0; ks < 4; ks += 2) {
        bf16x8 a[2][4], b[2][4];
#pragma unroll
        for (int s = 0; s < 2; ++s)
#pragma unroll
            for (int i = 0; i < 4; ++i) { a[s][i] = *(const bf16x8*)(ap + (size_t)i * 16 * D + (ks + s) * 32); b[s][i] = *(const bf16x8*)(bp + (size_t)i * 16 * D + (ks + s) * 32); }
#pragma unroll
        for (int s = 0; s < 2; ++s)
#pragma unroll
            for (int mi = 0; mi < 4; ++mi)
#pragma unroll
                for (int ni = 0; ni < 4; ++ni) acc[mi][ni] = __builtin_amdgcn_mfma_f32_16x16x32_bf16(a[s][mi], b[s][ni], acc[mi][ni], 0, 0, 0);
    }
    LAS float* red = (LAS float*)lds;
#pragma unroll
    for (int mi = 0; mi < 4; ++mi)
#pragma unroll
        for (int ni = 0; ni < 4; ++ni)
#pragma unroll
            for (int r = 0; r < 4; ++r) red[wave * 4352 + (mi * 16 + 4 * kq + r) * 68 + ni * 16 + rr] = acc[mi][ni][r];
    __syncthreads();
    const int row = tid >> 3, c0 = (tid & 7) * 8;
    f32x4 s0 = (f32x4){0.f, 0.f, 0.f, 0.f}, s1 = s0;
#pragma unroll
    for (int w2 = 0; w2 < 8; ++w2) { s0 += *(const LAS f32x4*)(red + w2 * 4352 + row * 68 + c0); s1 += *(const LAS f32x4*)(red + w2 * 4352 + row * 68 + c0 + 4); }
    u32x4 o; o.x = cvt_pk_bf16(s0[0], s0[1]); o.y = cvt_pk_bf16(s0[2], s0[3]); o.z = cvt_pk_bf16(s1[0], s1[1]); o.w = cvt_pk_bf16(s1[2], s1[3]);
    *(u32x4*)(C + (size_t)(tm * 64 + row) * 1024 + tn * 64 + c0) = o;
    __syncthreads();
}

struct SchedX1 {
    int vcu, G;
    __device__ __forceinline__ bool next(int i, Unit& u) const {
        if (i >= 6 || G != 256) { if (G == 256) return false; const int L = i * G + vcu; if (L >= 1536) return false; const int pm = L / 12, pn = L % 12; u.arow = pm * 256; u.brow = pn * 256; u.orow = pm * 256; u.ocol = pn; return true; }
        const int bid = i * 8 + (vcu >> 5), bm = bid / 3, bn = bid % 3, j = vcu & 31, pm = bm * 8 + (j >> 2), pn = bn * 4 + (j & 3);
        u.arow = pm * 256; u.brow = pn * 256; u.orow = pm * 256; u.ocol = pn;
        return true;
    }
    __device__ __forceinline__ int gidx(const Unit&, int) const { return 0; }
};
template <int NT, int COLMUL>
struct SchedDense {
    int vcu, G, nunits;
    __device__ __forceinline__ bool next(int i, Unit& u) const {
        const int L = i * G + vcu; if (L >= nunits) return false;
        const int pm = L / NT, pn = L % NT;
        u.arow = pm * 256; u.brow = pn * 256; u.orow = pm * 256; u.ocol = pn * COLMUL;
        return true;
    }
    __device__ __forceinline__ int gidx(const Unit&, int) const { return 0; }
};

constexpr size_t MiB = 1u << 20;
constexpr size_t WS_CTL = 0;
constexpr size_t WS_ADA = 1 * MiB;
constexpr size_t WS_AFF = 2 * MiB;
constexpr size_t WS_IDX = 4 * MiB;
constexpr size_t WS_GATE = 4 * MiB + 512 * 1024;
constexpr size_t WS_SEL = 5 * MiB;
constexpr size_t WS_GATES = 7 * MiB;
constexpr size_t WS_WGU = 16 * MiB;
constexpr size_t WS_WDN = 80 * MiB;
constexpr size_t WS_SCIN = 112 * MiB;
constexpr size_t WS_SCOUT = 118 * MiB;
constexpr size_t WS_WIN = 120 * MiB;
constexpr size_t WS_WOUT = 125 * MiB;
constexpr size_t WS_TMP = 128 * MiB;
constexpr size_t WS_ACT = WS_TMP;
constexpr size_t WS_QKV = 194 * MiB;
constexpr size_t WS_Z = 290 * MiB;
constexpr size_t WS_POOL = 322 * MiB;
constexpr size_t WS_CKV = 354 * MiB;
constexpr size_t WS_QN = 356 * MiB;
constexpr size_t WS_KT = 389 * MiB;
constexpr size_t WS_NWK = 422 * MiB;
constexpr size_t WS_SCL = 488 * MiB;
constexpr size_t WS_XLB = WS_NWK;
constexpr size_t WS_OF = WS_ACT;
constexpr size_t WS_OB = WS_ACT + 32 * MiB;
constexpr size_t WS_ACT2 = WS_QKV;
constexpr size_t WS_HID = 194 * MiB;
constexpr size_t WS_Y = 258 * MiB;
constexpr size_t WS_GB = WS_HID;
constexpr size_t WS_UU = WS_Y;
constexpr size_t WS_END = 512 * MiB;
constexpr int CW_BAR = 4096;
#ifndef PROBE_SEL
#define PROBE_SEL -1
#endif
#ifndef PROBE_WAVE
#define PROBE_WAVE 0
#endif
constexpr int CW_TS = 32768;
constexpr int CW_FLAG = 65536;
constexpr int CW_PROG = 16384;

struct Args {
    const float* in[24]; float* out; unsigned char* ws; int ph_lo, ph_hi, li, pad;
};

struct Frame {
    LAS unsigned char* lds; int tid, lane, wave, G, vcu;
};

__device__ __forceinline__ void transpose_item(const float* W, int K, int ldn, int n0, int k0, bf16_t* WT, int drow0, LAS float* scr, int lane, int dcol0 = 0) {
    float tv[32];
#pragma unroll
    for (int i = 0; i < 32; ++i) tv[i] = __builtin_nontemporal_load(W + (size_t)(k0 + 2 * i + (lane >> 5)) * ldn + n0 + (lane & 31));
#pragma unroll
    for (int i = 0; i < 32; ++i) scr[(2 * i + (lane >> 5)) * 33 + (lane & 31)] = tv[i];
    asm volatile("s_waitcnt lgkmcnt(0)" ::: "memory");
    const int c = lane & 7;
#pragma unroll
    for (int j = 0; j < 4; ++j) { const int n = (lane >> 3) + 8 * j; const LAS float* s = scr + (8 * c) * 33 + n;
        u32x4 o; o.x = pk2(s[0 * 33], s[1 * 33]); o.y = pk2(s[2 * 33], s[3 * 33]); o.z = pk2(s[4 * 33], s[5 * 33]); o.w = pk2(s[6 * 33], s[7 * 33]);
        __builtin_nontemporal_store(o, (u32x4*)(WT + (size_t)(drow0 + n) * K + dcol0 + k0 + 8 * c)); }
    asm volatile("s_waitcnt lgkmcnt(0)" ::: "memory");
}

struct SchedMoeUp {
    int vcu, layer; const int* idx;
    __device__ __forceinline__ bool next(int i, Unit& u) const {
        const int L = i * 256 + vcu; if (L >= 1024) return false;
        const int g = L >> 4, pm = (L >> 2) & 3, pn = L & 3, b = g >> 4, e = g & 15;
        u.arow = b * SEQ; u.brow = ((layer * NE + e) * 4 + pn) * 256; u.orow = g * CAP + pm * 256; u.ocol = pn * 128;
        return true;
    }
    __device__ __forceinline__ int gidx(const Unit& u, int r) const { return idx[u.orow + r]; }
};
struct SchedMoeDown {
    int vcu, layer;
    __device__ __forceinline__ bool next(int i, Unit& u) const {
        const int L = i * 256 + vcu; if (L >= 1024) return false;
        const int g = L >> 4, pm = (L >> 2) & 3, pn = L & 3, e = g & 15;
        u.arow = g * CAP + pm * 256; u.brow = ((layer * NE + e) * 4 + pn) * 256; u.orow = g * CAP + pm * 256; u.ocol = pn * 256;
        return true;
    }
    __device__ __forceinline__ int gidx(const Unit&, int) const { return 0; }
};

__device__ __forceinline__ float wsum(float v) {
#pragma unroll
    for (int o = 1; o < 64; o <<= 1) v += __shfl_xor(v, o);
    return v;
}

template <int MODE>
__device__ __forceinline__ void ph_norm16(const Frame& F, const void* xlv, const float* xctx, bf16_t* act, const float* gw, const float* ada  , const float* w16, int ldw,
                                          float* out16, const float* a_log, const float* dt_bias, int* selfill = nullptr, const float* rsc = nullptr) {
    constexpr int WLD = 1032;
    LAS bf16_t* wt = (LAS bf16_t*)F.lds;
    LAS float* mod = (LAS float*)(F.lds + 16 * WLD * 2);
    if (selfill) { u32x4* p = (u32x4*)selfill; const u32x4 m1 = (u32x4){~0u, ~0u, ~0u, ~0u};
        for (int i = F.vcu * NTHREADS + F.tid; i < M_LAT * NE / 4; i += F.G * NTHREADS) p[i] = m1; }
    { float wv[32];
#pragma unroll
        for (int q = 0; q < 32; ++q) { const int i = F.tid + NTHREADS * q; wv[q] = w16[(size_t)(i >> 4) * ldw + (i & 15)]; }
#pragma unroll
        for (int q = 0; q < 32; ++q) { const int i = F.tid + NTHREADS * q; wt[(i & 15) * WLD + (i >> 4)] = (bf16_t)f2bf(wv[q]); } }
#pragma unroll
    for (int i = F.tid; i < 5 * D; i += NTHREADS) { const int b = i >> 10, c = i & (D - 1);
        const float* sh = ada + (size_t)b * 6 * D + (MODE == 0 ? 3 * D : 0);
        mod[(b * 2) * D + c] = gw[c] * (sh[D + c] + 1.f); mod[(b * 2 + 1) * D + c] = sh[c]; }
    __syncthreads();
    const int gw_ = F.vcu * NWAVES + F.wave, NGW = F.G * NWAVES, lane = F.lane, rr = lane & 15, kq = lane >> 4;
    const int ntiles = MODE == 0 ? M_LAT / 16 : M_LAT / 16 + BATCH * CTX / 4;
    const int nun = (MODE == 1 && F.G == 256) ? (F.wave == 0 ? 2 : 1) : (ntiles - gw_ + NGW - 1) / NGW;
    for (int un = 0; un < nun; ++un) {
        const int tw = (MODE == 1 && F.G == 256) ? (un == 0 ? gw_ : M_LAT / 16 + F.vcu) : gw_ + un * NGW;
        const bool quart = MODE == 1 && tw >= M_LAT / 16;
        const int r0 = quart ? M_LAT + 4 * (tw - M_LAT / 16) : tw * 16, row = r0 + (quart ? (rr & 3) : rr);
        const bool lat = r0 < M_LAT;
        const int b = lat ? (r0 >> 13) : 4;
        const char* src; size_t rowbytes;
        if constexpr (MODE == 0) { src = (const char*)xlv + (size_t)row * D * 2 + kq * 16; rowbytes = 0; }
        else { src = lat ? (const char*)((const float*)xlv + (size_t)row * D) + kq * 32 : (const char*)xctx + (size_t)(row - M_LAT) * D * 2 + kq * 16; rowbytes = 0; }
        (void)rowbytes;
        u32x4 xq[32];
        float ss = 0.f;
        if constexpr (MODE == 0) {
#pragma unroll
            for (int s = 0; s < 32; ++s) xq[s] = *(const u32x4*)(src + s * 64);
#pragma unroll
            for (int s = 0; s < 32; ++s)
#pragma unroll
                for (int q = 0; q < 4; ++q) { const float a = bf_lo(xq[s][q]), c2 = bf_hi(xq[s][q]); ss += a * a + c2 * c2; }
        } else if (quart) {
#pragma unroll
            for (int s = 0; s < 32; ++s) xq[s] = *(const u32x4*)(src + s * 64);
        } else {
#pragma unroll
            for (int s0 = 0; s0 < 32; s0 += 8) { f32x4 xv[8][2];
#pragma unroll
                for (int s = 0; s < 8; ++s) { xv[s][0] = __builtin_nontemporal_load((const f32x4*)(src + (s0 + s) * 128)); xv[s][1] = __builtin_nontemporal_load((const f32x4*)(src + (s0 + s) * 128 + 16)); }
#pragma unroll
                for (int s = 0; s < 8; ++s) { const f32x4 a = xv[s][0], c2 = xv[s][1];
                    ss += (a.x * a.x + a.y * a.y) + (a.z * a.z + a.w * a.w) + (c2.x * c2.x + c2.y * c2.y) + (c2.z * c2.z + c2.w * c2.w);
                    xq[s0 + s] = (u32x4){cvt_pk_bf16(a.x, a.y), cvt_pk_bf16(a.z, a.w), cvt_pk_bf16(c2.x, c2.y), cvt_pk_bf16(c2.z, c2.w)}; } }
        }
        ss += __shfl_xor(ss, 16); ss += __shfl_xor(ss, 32);
        float rs = rsqrtf(ss * (1.f / D) + EPS);
        if (MODE == 1 && quart) rs = rsc[row - M_LAT];
#pragma unroll
        for (int s = 0; s < 32; ++s) asm volatile("" : "+v"(xq[s]));
        f32x4 acc = (f32x4){0.f, 0.f, 0.f, 0.f};
        const LAS float* mAp = mod + (b * 2) * D + kq * 8; const LAS float* mBp = mAp + D;
        const LAS bf16_t* wp = wt + rr * WLD + kq * 8;
        bf16_t* dst = act + (size_t)row * D + kq * 8;
#pragma unroll
        for (int s = 0; s < 32; ++s) {
            if ((s & 1) == 0) asm volatile("" : "+v"(mAp), "+v"(mBp), "+v"(wp), "+v"(dst));
            const u32x4 w = xq[s];
            const f32x4 a0 = *(const LAS f32x4*)(mAp + s * 32), a1 = *(const LAS f32x4*)(mAp + s * 32 + 4);
            const f32x4 b0 = *(const LAS f32x4*)(mBp + s * 32), b1 = *(const LAS f32x4*)(mBp + s * 32 + 4);
            const float h0 = bf_lo(w.x) * rs * a0.x + b0.x, h1 = bf_hi(w.x) * rs * a0.y + b0.y, h2 = bf_lo(w.y) * rs * a0.z + b0.z, h3 = bf_hi(w.y) * rs * a0.w + b0.w;
            const float h4 = bf_lo(w.z) * rs * a1.x + b1.x, h5 = bf_hi(w.z) * rs * a1.y + b1.y, h6 = bf_lo(w.w) * rs * a1.z + b1.z, h7 = bf_hi(w.w) * rs * a1.w + b1.w;
            u32x4 hw; hw.x = cvt_pk_bf16(h0, h1); hw.y = cvt_pk_bf16(h2, h3); hw.z = cvt_pk_bf16(h4, h5); hw.w = cvt_pk_bf16(h6, h7);
            if (!quart || rr < 4) *(u32x4*)(dst + s * 32) = hw;
            const bf16x8 bfrag = *(const LAS bf16x8*)(wp + s * 32);
            acc = __builtin_amdgcn_mfma_f32_16x16x32_bf16(__builtin_bit_cast(bf16x8, hw), bfrag, acc, 0, 0, 0);
        }
        if constexpr (MODE == 0) {
            f32x4 mx = acc;
#pragma unroll
            for (int o = 1; o < 16; o <<= 1) { mx.x = fmaxf(mx.x, __shfl_xor(mx.x, o)); mx.y = fmaxf(mx.y, __shfl_xor(mx.y, o)); mx.z = fmaxf(mx.z, __shfl_xor(mx.z, o)); mx.w = fmaxf(mx.w, __shfl_xor(mx.w, o)); }
            f32x4 ex; ex.x = __expf(acc.x - mx.x); ex.y = __expf(acc.y - mx.y); ex.z = __expf(acc.z - mx.z); ex.w = __expf(acc.w - mx.w);
            f32x4 sm = ex;
#pragma unroll
            for (int o = 1; o < 16; o <<= 1) { sm.x += __shfl_xor(sm.x, o); sm.y += __shfl_xor(sm.y, o); sm.z += __shfl_xor(sm.z, o); sm.w += __shfl_xor(sm.w, o); }
            const int t = (r0 & (SEQ - 1)) + 4 * kq;
            *(f32x4*)(out16 + ((size_t)b * NE + rr) * SEQ + t) = (f32x4){ex.x / sm.x, ex.y / sm.y, ex.z / sm.z, ex.w / sm.w};
        } else {
            if (!quart || kq == 0)
#pragma unroll
            for (int q = 0; q < 4; ++q) { const float x = acc[q]; float o;
                if (rr < 8) o = 1.f / (1.f + __expf(-x));
                else { const float y = x + dt_bias[rr - 8]; const float sp = y > 20.f ? y : log1pf(__expf(y)); o = -__expf(a_log[rr - 8]) * sp; }
                out16[(size_t)(r0 + 4 * kq + q) * 16 + rr] = o; }
        }
    }
    __syncthreads();
}

__device__ __forceinline__ void ph_topk(const Frame& F, const float* aff, int* idx, float* gate, int* sel) {
    LAS unsigned* hist = (LAS unsigned*)F.lds;
    LAS unsigned* cg = hist + 1024; LAS unsigned* ce = cg + 16;
    const int tid = F.tid, lane = tid & 63;
    for (int item = (F.G == 256 ? ((F.vcu & 3) == 0 ? F.vcu >> 2 : BATCH * NE) : F.vcu); item < BATCH * NE; item += F.G) {
        const int b = item >> 4, e = item & 15;
        unsigned kk16[16];
#pragma unroll
        for (int q = 0; q < 4; ++q) { const u32x4 k4 = *(const u32x4*)(aff + (size_t)item * SEQ + tid * 16 + 4 * q); kk16[4 * q] = k4.x; kk16[4 * q + 1] = k4.y; kk16[4 * q + 2] = k4.z; kk16[4 * q + 3] = k4.w; }
        hist[tid] = 0u; hist[512 + tid] = 0u;
        lds_barrier();
        unsigned prefix = 0u, need = CAP, mask = 0u;
#pragma unroll
        for (int pass = 0; pass < 4; ++pass) {
            const int shift = 24 - 8 * pass;
            LAS unsigned* h = hist + pass * 256;
#pragma unroll
            for (int j = 0; j < 16; ++j) { const unsigned kx = kk16[j]; const bool act = (kx & mask) == prefix; const unsigned bin = (kx >> shift) & 255u;
                if (pass == 0) {
                    unsigned long long todo = __ballot(act);
                    while (todo) { const int src = __builtin_ffsll((long long)todo) - 1; const unsigned lb = (unsigned)__builtin_amdgcn_readlane((int)bin, src);
                        const unsigned long long m = __ballot(act && bin == lb);
                        if (lane == src) __hip_atomic_fetch_add(&h[lb], (unsigned)__builtin_popcountll(m), __ATOMIC_RELAXED, __HIP_MEMORY_SCOPE_WORKGROUP);
                        todo &= ~m; }
                } else if (act) __hip_atomic_fetch_add(&h[bin], 1u, __ATOMIC_RELAXED, __HIP_MEMORY_SCOPE_WORKGROUP);
            }
            lds_barrier();
            const u32x4 c4 = *(const LAS u32x4*)(h + 4 * lane);
            const unsigned s3 = c4.w, s2 = s3 + c4.z, s1 = s2 + c4.y, s0 = s1 + c4.x;
            unsigned inc = s0;
#pragma unroll
            for (int o2 = 1; o2 < 64; o2 <<= 1) { const unsigned x = __shfl_down(inc, o2); if (lane + o2 < 64) inc += x; }
            const unsigned excl = inc - s0;
            const unsigned sf[5] = {excl + s0, excl + s1, excl + s2, excl + s3, excl};
            unsigned np = 0u, nn = 0u; bool found = false;
#pragma unroll
            for (int j = 0; j < 4; ++j) if (sf[j] >= need && sf[j + 1] < need) { found = true; np = prefix | ((unsigned)(4 * lane + j) << shift); nn = need - sf[j + 1]; }
            const unsigned long long fm = __ballot(found);
            const int src = __builtin_ffsll((long long)fm) - 1;
            prefix = (unsigned)__builtin_amdgcn_readlane((int)np, src); need = (unsigned)__builtin_amdgcn_readlane((int)nn, src);
            mask |= 0xFFu << shift;
        }
        const unsigned T = prefix;
        unsigned ng = 0u, nq = 0u;
#pragma unroll
        for (int j = 0; j < 16; ++j) { const unsigned kx = kk16[j]; ng += kx > T; nq += kx == T; }
        unsigned ig = ng, iq = nq;
#pragma unroll
        for (int o2 = 1; o2 < 64; o2 <<= 1) { const unsigned xg = __shfl_up(ig, o2), xq = __shfl_up(iq, o2); if ((tid & 63) >= o2) { ig += xg; iq += xq; } }
        if ((tid & 63) == 63) { cg[tid >> 6] = ig; ce[tid >> 6] = iq; }
        lds_barrier();
        unsigned g0 = ig - ng, q0 = iq - nq;
        for (int w2 = 0; w2 < (tid >> 6); ++w2) { g0 += cg[w2]; q0 += ce[w2]; }
#pragma unroll
        for (int j = 0; j < 16; ++j) { const int t = tid * 16 + j; const unsigned kx = kk16[j]; int slot = -1;
            if (kx > T) { slot = (int)(g0 + (q0 < need ? q0 : need)); ++g0; }
            else if (kx == T) { if (q0 < need) slot = (int)(g0 + q0); ++q0; }
            if (slot >= 0) { sel[((size_t)b * SEQ + t) * NE + e] = slot; idx[item * CAP + slot] = t; gate[item * CAP + slot] = __uint_as_float(kx); } }
        lds_barrier();
    }
}

template <bool FINAL>
__device__ __forceinline__ void ph_combine(const Frame& F, bf16_t* xlb, float* outf, const bf16_t* y, const int* sel, const float* gate, const float* ada  , const float* gwn, const float* ada_next, bf16_t* act) {
    const int gw_ = F.vcu * NWAVES + F.wave, NGW = F.G * NWAVES, lane = F.lane;
    int curb = -1; f32x4 g2v[4], mA[4], mB[4];
#pragma unroll
    for (int j = 0; j < 4; ++j) { g2v[j] = (f32x4){0.f, 0.f, 0.f, 0.f}; mA[j] = g2v[j]; mB[j] = g2v[j]; }
    const u32x2 z2 = (u32x2){0u, 0u};
    auto ld_row = [&](int rr_, int& sl, u32x2 (&xx)[4]) {
        sl = -1;
#pragma unroll
        for (int j = 0; j < 4; ++j) xx[j] = z2;
        if (rr_ < M_LAT) { sl = lane < NE ? sel[(size_t)rr_ * NE + lane] : -1; const u32x2* xr0 = (const u32x2*)(xlb + (size_t)rr_ * D) + lane;
#pragma unroll
            for (int j = 0; j < 4; ++j) xx[j] = xr0[64 * j]; } };
    auto ld_y = [&](int rr_, int sl, u32x2 (&yy)[4][4], float (&wv)[4], unsigned& rest) {
        const int b_ = rr_ >> 13; unsigned mask = rr_ < M_LAT ? (unsigned)(__ballot(sl >= 0) & 0xFFFFull) : 0u;
#pragma unroll
        for (int q = 0; q < 4; ++q) { const bool ok = mask != 0u; const int e_ = ok ? __builtin_ctz(mask) : 0; mask &= mask - 1u;
            const int s_ = __builtin_amdgcn_readlane(sl, e_);
            const bf16_t* rp = ok ? y + ((size_t)(b_ * NE + e_) * CAP + s_) * D : y; wv[q] = ok ? gate[(b_ * NE + e_) * CAP + s_] : 0.f;
#pragma unroll
            for (int j = 0; j < 4; ++j) yy[q][j] = ok ? __builtin_nontemporal_load((const u32x2*)rp + lane + 64 * j) : z2; }
        rest = mask; };
    int slotA, slotB; u32x2 xA[4], xB[4], yA[4][4]; float wvA[4]; unsigned restA;
    ld_row(gw_, slotA, xA); ld_row(gw_ + NGW, slotB, xB);
    ld_y(gw_, slotA, yA, wvA, restA);
    for (int r = gw_; r < M_LAT; r += NGW) {
        const int b = r >> 13;
        int slotC; u32x2 xC[4]; ld_row(r + 2 * NGW, slotC, xC);
        u32x2 yB[4][4]; float wvB[4]; unsigned restB; ld_y(r + NGW, slotB, yB, wvB, restB);
        const int myslot = slotA; f32x4 xv[4];
#pragma unroll
        for (int j = 0; j < 4; ++j) xv[j] = (f32x4){bf_lo(xA[j].x), bf_hi(xA[j].x), bf_lo(xA[j].y), bf_hi(xA[j].y)};
        if (b != curb) { curb = b; const float* g2 = ada + (size_t)b * 6 * D + 5 * D;
#pragma unroll
            for (int j = 0; j < 4; ++j) { const int c = 256 * j + 4 * lane; g2v[j] = *(const f32x4*)(g2 + c);
                const f32x4 g4 = *(const f32x4*)(gwn + c);
                if constexpr (FINAL) { mA[j] = g4; } else { const float* sh = ada_next + (size_t)b * 6 * D; mA[j] = g4 * (*(const f32x4*)(sh + D + c) + 1.f); mB[j] = *(const f32x4*)(sh + c); } } }
        f32x4 a[4];
#pragma unroll
        for (int j = 0; j < 4; ++j) a[j] = (f32x4){0.f, 0.f, 0.f, 0.f};
#pragma unroll
        for (int q = 0; q < 4; ++q)
#pragma unroll
            for (int j = 0; j < 4; ++j) { a[j].x += wvA[q] * bf_lo(yA[q][j].x); a[j].y += wvA[q] * bf_hi(yA[q][j].x); a[j].z += wvA[q] * bf_lo(yA[q][j].y); a[j].w += wvA[q] * bf_hi(yA[q][j].y); }
        unsigned mask = restA;
        while (mask) {
            const bf16_t* rp[4]; float wv[4];
#pragma unroll
            for (int q = 0; q < 4; ++q) { const bool ok = mask != 0u; const int e = ok ? __builtin_ctz(mask) : 0; mask &= mask - 1u;
                const int s = __builtin_amdgcn_readlane(myslot, e);
                rp[q] = ok ? y + ((size_t)(b * NE + e) * CAP + s) * D : y; wv[q] = ok ? gate[(b * NE + e) * CAP + s] : 0.f; }
            u32x2 w[4][4];
#pragma unroll
            for (int q = 0; q < 4; ++q)
#pragma unroll
                for (int j = 0; j < 4; ++j) w[q][j] = ((const u32x2*)rp[q] + lane)[64 * j];
#pragma unroll
            for (int q = 0; q < 4; ++q)
#pragma unroll
                for (int j = 0; j < 4; ++j) { a[j].x += wv[q] * bf_lo(w[q][j].x); a[j].y += wv[q] * bf_hi(w[q][j].x); a[j].z += wv[q] * bf_lo(w[q][j].y); a[j].w += wv[q] * bf_hi(w[q][j].y); }
        }
        slotA = slotB; slotB = slotC; restA = restB;
#pragma unroll
        for (int j = 0; j < 4; ++j) { xA[j] = xB[j]; xB[j] = xC[j]; }
#pragma unroll
        for (int q = 0; q < 4; ++q) { wvA[q] = wvB[q];
#pragma unroll
            for (int j = 0; j < 4; ++j) yA[q][j] = yB[q][j]; }
        f32x4 v[4]; float s = 0.f;
#pragma unroll
        for (int j = 0; j < 4; ++j) { v[j] = xv[j] + g2v[j] * a[j]; s += (v[j].x * v[j].x + v[j].y * v[j].y) + (v[j].z * v[j].z + v[j].w * v[j].w); }
        const float rs = rsqrtf(wsum(s) * (1.f / D) + EPS);
        if constexpr (FINAL) {
            f32x4* xr = (f32x4*)(outf + (size_t)r * D) + lane;
#pragma unroll
            for (int j = 0; j < 4; ++j) __builtin_nontemporal_store(v[j] * rs * mA[j], xr + 64 * j);
        } else {
            unsigned long long* x8 = (unsigned long long*)(xlb + (size_t)r * D) + lane;
            unsigned long long* o8 = (unsigned long long*)(act + (size_t)r * D) + lane;
#pragma unroll
            for (int j = 0; j < 4; ++j) { x8[64 * j] = (unsigned long long)pk2(v[j].x, v[j].y) | ((unsigned long long)pk2(v[j].z, v[j].w) << 32);
                const f32x4 o = v[j] * rs * mA[j] + mB[j];
                o8[64 * j] = (unsigned long long)pk2(o.x, o.y) | ((unsigned long long)pk2(o.z, o.w) << 32); }
        }
    }
}

__device__ __forceinline__ void ph_sc_glue(const Frame& F, const bf16_t* gb, const bf16_t* uu, const float* cw  , bf16_t* act) {
    const int gw_ = F.vcu * NWAVES + F.wave, NGW = F.G * NWAVES, lane = F.lane;
    float w0[16], w1[16], w2[16];
#pragma unroll
    for (int hh = 0; hh < 2; ++hh)
#pragma unroll
        for (int q = 0; q < 8; ++q) { const int c = hh * 512 + 8 * lane + q; w0[hh * 8 + q] = cw[c]; w1[hh * 8 + q] = cw[D + c]; w2[hh * 8 + q] = cw[2 * D + c]; }
    const u32x4 zero4 = (u32x4){0u, 0u, 0u, 0u};
    for (int blk = gw_; blk < M_LAT / 16; blk += NGW) {
        const int r0 = blk * 16, t0 = r0 & (SEQ - 1);
        u32x4 up[2], uc[2];
#pragma unroll
        for (int hh = 0; hh < 2; ++hh) { const int c = hh * 512 + 8 * lane;
            up[hh] = t0 > 0 ? *(const u32x4*)(uu + (size_t)(r0 - 1) * D + c) : zero4; uc[hh] = *(const u32x4*)(uu + (size_t)r0 * D + c); }
#pragma unroll 1
        for (int i0 = 0; i0 < 16; i0 += 4) {
            u32x4 gq[4][2], un[4][2];
#pragma unroll
            for (int i = 0; i < 4; ++i)
#pragma unroll
                for (int hh = 0; hh < 2; ++hh) { const int r = r0 + i0 + i, c = hh * 512 + 8 * lane;
                    gq[i][hh] = *(const u32x4*)(gb + (size_t)r * D + c);
                    un[i][hh] = (t0 + i0 + i + 1 < SEQ) ? *(const u32x4*)(uu + (size_t)(r + 1) * D + c) : zero4; }
#pragma unroll
            for (int i = 0; i < 4; ++i) {
#pragma unroll
                for (int hh = 0; hh < 2; ++hh) {
                    u32x4 o;
#pragma unroll
                    for (int q = 0; q < 4; ++q) {
                        const float lo = bf_lo(gq[i][hh][q]) * (w0[hh * 8 + 2 * q] * bf_lo(up[hh][q]) + w1[hh * 8 + 2 * q] * bf_lo(uc[hh][q]) + w2[hh * 8 + 2 * q] * bf_lo(un[i][hh][q]));
                        const float hi = bf_hi(gq[i][hh][q]) * (w0[hh * 8 + 2 * q + 1] * bf_hi(up[hh][q]) + w1[hh * 8 + 2 * q + 1] * bf_hi(uc[hh][q]) + w2[hh * 8 + 2 * q + 1] * bf_hi(un[i][hh][q]));
                        o[q] = pk2(lo, hi);
                    }
                    *(u32x4*)(act + (size_t)(r0 + i0 + i) * D + hh * 512 + 8 * lane) = o;
                    up[hh] = uc[hh]; uc[hh] = un[i][hh];
                }
            }
        }
    }
}

constexpr int NSLOT = 132;
constexpr int NCHAIN = BATCH * NH;
__device__ __forceinline__ int kperm(int s, int g, int j) { return 16 * (2 * s + (j >> 2)) + 4 * g + (j & 3); }

struct ScanPtrs { unsigned char* QN; unsigned char* KT; unsigned char* NWK; unsigned char* QK; unsigned char* U; float* SCL; };
__device__ __forceinline__ size_t so_shared(int chain, int slot) { return ((size_t)chain * NSLOT + slot) * 16384; }
__device__ __forceinline__ size_t so_dir(int dir, int chain, int slot) { return (((size_t)dir * NCHAIN + chain) * NSLOT + slot); }


__device__ __forceinline__ f32x4 mm16(const LAS float* A, const LAS float* B, f32x4 acc, int rr, int kq) {
#pragma unroll
    for (int t = 0; t < 4; ++t) acc = __builtin_amdgcn_mfma_f32_16x16x4f32(A[rr * 17 + 4 * t + kq], B[(4 * t + kq) * 17 + rr], acc, 0, 0, 0);
    return acc;
}
__device__ __forceinline__ f32x4 ld16(const LAS float* C, int rr, int kq) { return (f32x4){C[(4 * kq + 0) * 17 + rr], C[(4 * kq + 1) * 17 + rr], C[(4 * kq + 2) * 17 + rr], C[(4 * kq + 3) * 17 + rr]}; }
__device__ __forceinline__ void st16(LAS float* C, f32x4 v, int rr, int kq) {
#pragma unroll
    for (int r = 0; r < 4; ++r) C[(4 * kq + r) * 17 + rr] = v[r];
}

__device__ __forceinline__ int order_slot(int j) { if (j < 4) return (0x2130 >> (4 * j)) & 15; const int i = (j - 4) >> 1; return ((j - 4) & 1) ? 131 - i : 4 + i; }
__device__ __forceinline__ void ph_chunk_prep(const Frame& F, const bf16_t* QKV, const bf16_t* CKV, const float* GATES, const float* cw  , const ScanPtrs P, int item0, int istride, int icount, unsigned* flags) {
    const __amdgpu_buffer_rsrc_t rW = __builtin_amdgcn_make_buffer_rsrc(P.QN, 0, (int)(WS_END - WS_QN), 0x00020000);
    const __amdgpu_buffer_rsrc_t rO = __builtin_amdgcn_make_buffer_rsrc(P.U, 0, (int)(100 * MiB), 0x00020000);
    const unsigned oKT = (unsigned)(P.KT - P.QN), oNWK = (unsigned)(P.NWK - P.QN), oSCL = (unsigned)((unsigned char*)P.SCL - P.QN), oQK = (unsigned)(P.QK - P.U);
    LAS unsigned char* L = F.lds;
    LAS bf16_t* kn = (LAS bf16_t*)(L);
    LAS bf16_t* qn = (LAS bf16_t*)(L + 17408);
    LAS bf16_t* vT = (LAS bf16_t*)(L + 34816);
    LAS bf16_t* knT = (LAS bf16_t*)(L + 53376);
    LAS float* KK = (LAS float*)(L + 71936);
    LAS float* QKr = (LAS float*)(L + 89344);
    LAS bf16_t* XU = (LAS bf16_t*)(L + 71936);
    LAS bf16_t* XW = (LAS bf16_t*)(L + 71936 + 18432);
    LAS float* NBk = (LAS float*)(L + 108800);
    LAS float* XBk = (LAS float*)(L + 108800 + 21760);
    LAS float* TBk = (LAS float*)(L + 108800 + 43520);
    LAS float* SCRq = (LAS float*)(L + 17408);
    LAS float* gamP = (LAS float*)(L + 108800 + 52224);
    LAS float* betP = gamP + 128;
    LAS float* begP = gamP + 256;
    static_assert(108800 + 52224 + 1536 <= MISC_OFF, "E3 LDS map");
    const int wave = F.wave;
    unsigned wpk[3][3][8];
    { const int h0 = item0 & 3, cg0 = F.tid & 7;
#pragma unroll
      for (int w = 0; w < 3; ++w)
#pragma unroll
        for (int tap = 0; tap < 3; ++tap) { const float* wp0 = cw + tap * 1536 + w * 512 + h0 * 128 + cg0 * 16;
#pragma unroll
            for (int q = 0; q < 8; ++q) wpk[w][tap][q] = pk2(wp0[2 * q], wp0[2 * q + 1]); } }
    u32x4 pre[3][3][2];
    auto load_item = [&](int item_, int tid_) {
        const int chain_ = item_ & 15, slot_ = order_slot(item_ >> 4), b_ = chain_ >> 2, h_ = chain_ & 3;
        const bool ctx_ = slot_ < 4; const int L_ = ctx_ ? CTX : SEQ, t0_ = ctx_ ? slot_ * 64 : (slot_ - 4) * 64;
        const int i_ = tid_ >> 3, cg_ = tid_ & 7, t_ = t0_ + i_;
        const bf16_t* src_ = ctx_ ? CKV + (size_t)(b_ * CTX) * 1024 : QKV + (size_t)(b_ * SEQ) * 1536; const int ld_ = ctx_ ? 1024 : 1536;
        const u32x4 z4 = (u32x4){0u, 0u, 0u, 0u};
#pragma unroll
        for (int w = 0; w < 3; ++w) { const int off_ = ctx_ ? (w == 0 ? -1 : (w - 1) * 512 + h_ * 128) : w * 512 + h_ * 128;
#pragma unroll
            for (int tap = 0; tap < 3; ++tap) { const int tt = t_ + tap - 1; const bool ok = off_ >= 0 && tt >= 0 && tt < L_;
                const u32x4* p = (const u32x4*)(src_ + (size_t)(ok ? tt : t_) * ld_ + (ok ? off_ : h_ * 128) + cg_ * 16);
                pre[w][tap][0] = ok ? p[0] : z4; pre[w][tap][1] = ok ? p[1] : z4; } }
    };
    if (icount > 0) load_item(item0, F.tid);
    for (int ik = 0; ik < icount; ++ik) {
        const int item = item0 + ik * istride;
#pragma unroll
        for (int w = 0; w < 3; ++w)
#pragma unroll
            for (int tap = 0; tap < 3; ++tap) asm volatile("" : "+v"(wpk[w][tap][0]), "+v"(wpk[w][tap][1]), "+v"(wpk[w][tap][2]), "+v"(wpk[w][tap][3]),
                                                                "+v"(wpk[w][tap][4]), "+v"(wpk[w][tap][5]), "+v"(wpk[w][tap][6]), "+v"(wpk[w][tap][7]));
        int tid = F.tid; asm volatile("" : "+v"(tid));
        const int lane = tid & 63;
        const int chain = item & 15, slot = order_slot(item >> 4), b = chain >> 2, h = chain & 3;
        const bool isctx = slot < 4;
        const int Lseq = isctx ? CTX : SEQ, t0 = isctx ? slot * 64 : (slot - 4) * 64;
        {
            const int i = tid >> 3, cg = tid & 7;
#pragma unroll
            for (int w = 0; w < 3; ++w) {
                float o[16];
#pragma unroll
                for (int c = 0; c < 16; ++c) o[c] = 0.f;
#pragma unroll
                for (int tap = 0; tap < 3; ++tap) {
                    const u32x4 a0 = pre[w][tap][0], a1 = pre[w][tap][1];
#pragma unroll
                    for (int q = 0; q < 4; ++q) { o[2 * q] += bf_lo(wpk[w][tap][q]) * bf_lo(a0[q]); o[2 * q + 1] += bf_hi(wpk[w][tap][q]) * bf_hi(a0[q]);
                        o[8 + 2 * q] += bf_lo(wpk[w][tap][4 + q]) * bf_lo(a1[q]); o[8 + 2 * q + 1] += bf_hi(wpk[w][tap][4 + q]) * bf_hi(a1[q]); }
                }
#pragma unroll
                for (int c = 0; c < 16; ++c) o[c] = silu1(o[c]);
                float sc = 1.f;
                if (w < 2) { float s2 = 0.f;
#pragma unroll
                    for (int c = 0; c < 16; ++c) s2 += o[c] * o[c];
                    s2 += __shfl_xor(s2, 1); s2 += __shfl_xor(s2, 2); s2 += __shfl_xor(s2, 4);
                    sc = rsqrtf(s2 + EPS) * (w == 0 ? 0.08838834764831845f : 1.f); }
#pragma unroll
                for (int c = 0; c < 16; c += 2) {
                    const unsigned pw = pk2(o[c] * sc, o[c + 1] * sc);
                    if (w == 0) *(LAS unsigned*)(qn + i * 136 + cg * 16 + c) = pw;
                    else { if (w == 1) *(LAS unsigned*)(kn + i * 136 + cg * 16 + c) = pw;
                        LAS bf16_t* tT = w == 1 ? knT : vT;
                        tT[(cg * 16 + c) * 72 + cg * 8 + i] = (bf16_t)(pw & 0xffffu); tT[(cg * 16 + c + 1) * 72 + cg * 8 + i] = (bf16_t)(pw >> 16); }
                }
            }
        }
        if (wave < 2) {
            const int dir = wave, i = dir ? 63 - lane : lane;
            const size_t grow = isctx ? (size_t)M_LAT + b * CTX + t0 + i : (size_t)b * SEQ + t0 + i;
            float g = GATES[grow * 16 + 8 + dir * 4 + h];
#pragma unroll
            for (int o2 = 1; o2 < 64; o2 <<= 1) { const float x = __shfl_up(g, o2); if (lane >= o2) g += x; }
            gamP[dir * 64 + lane] = g; const float bt0 = GATES[grow * 16 + dir * 4 + h]; betP[dir * 64 + lane] = bt0; begP[dir * 64 + lane] = bt0 * __expf(g);
        }
        lds_barrier();
        {
            const int fr = lane & 15, fq = lane >> 4;
#pragma unroll
            for (int tt = 0; tt < 4; ++tt) {
                const int tile = wave * 4 + tt, which = tile >> 4, mt = (tile >> 2) & 3, nt = tile & 3;
                LAS bf16_t* Am = which ? qn : kn;
                f32x4 acc = (f32x4){0.f, 0.f, 0.f, 0.f};
#pragma unroll
                for (int s = 0; s < 4; ++s) {
                    const bf16x8 a = *(const LAS bf16x8*)(Am + (16 * mt + fr) * 136 + 32 * s + 8 * fq);
                    const bf16x8 bb = *(const LAS bf16x8*)(kn + (16 * nt + fr) * 136 + 32 * s + 8 * fq);
                    acc = __builtin_amdgcn_mfma_f32_16x16x32_bf16(a, bb, acc, 0, 0, 0);
                }
                LAS float* Om = which ? QKr : KK;
#pragma unroll
                for (int r = 0; r < 4; ++r) Om[(16 * mt + 4 * fq + r) * 68 + 16 * nt + fr] = acc[r];
            }
        }
        lds_barrier();
        {
#pragma unroll 2
            for (int it = 0; it < 10; ++it) {
                const int idx = tid + 512 * it, dir = idx / 2560, rem = idx % 2560, blk = rem >> 8, e = rem & 255, r = e >> 4, c = e & 15;
                const int bi = blk < 1 ? 0 : (blk < 3 ? 1 : (blk < 6 ? 2 : 3)), bj = blk - bi * (bi + 1) / 2;
                const int p = 16 * bi + r, pp = 16 * bj + c;
                float val = 0.f;
                if (p > pp) { const int ip = dir ? 63 - p : p, ipp = dir ? 63 - pp : pp;
                    val = betP[dir * 64 + p] * KK[ip * 68 + ipp] * __expf(gamP[dir * 64 + p] - gamP[dir * 64 + pp]); }
                NBk[(dir * 10 + blk) * 272 + r * 17 + c] = val;
            }
            const int f = tid >> 6, l2 = tid & 63, g = l2 >> 4;
            if (!isctx) {
#pragma unroll
                for (int dir = 0; dir < 2; ++dir) {
                    const int m = f >> 1, s = f & 1, io = 16 * m + (l2 & 15);
                    const float gi = gamP[dir * 64 + (dir ? 63 - io : io)];
                    float vals[8];
#pragma unroll
                    for (int e = 0; e < 8; ++e) { const int j = kperm(s, g, e); const bool keep = dir ? (j >= io) : (j <= io);
                        vals[e] = keep ? QKr[io * 68 + j] * __expf(gi - gamP[dir * 64 + (dir ? 63 - j : j)]) : 0.f; }
                    u32x4 w; w.x = pk2(vals[0], vals[1]); w.y = pk2(vals[2], vals[3]); w.z = pk2(vals[4], vals[5]); w.w = pk2(vals[6], vals[7]);
                    __builtin_amdgcn_raw_buffer_store_b128(w, rO, oQK + (unsigned)(so_dir(dir, chain, slot) * 8192) + (unsigned)tid * 16u, 0, 16);
                }
#pragma unroll
                for (int it = 0; it < 2; ++it) {
                    const int q = tid + 512 * it, ff = q >> 6, m = ff >> 2, s = ff & 3, row = 16 * m + (l2 & 15);
                    const u32x2 lo = *(const LAS u32x2*)(qn + row * 136 + 32 * s + 4 * g), hi = *(const LAS u32x2*)(qn + row * 136 + 32 * s + 16 + 4 * g);
                    __builtin_amdgcn_raw_buffer_store_b128((u32x4){lo.x, lo.y, hi.x, hi.y}, rW, (unsigned)so_shared(chain, slot) + (unsigned)q * 16u, 0, 16);
                }
            }
#pragma unroll
            for (int it = 0; it < 2; ++it) {
                const int q = tid + 512 * it, ff = q >> 6, mp = ff >> 1, s = ff & 1, dk = 16 * mp + (l2 & 15);
                unsigned short e8[8];
#pragma unroll
                for (int e = 0; e < 8; ++e) e8[e] = kn[kperm(s, g, e) * 136 + dk];
                u32x4 w; w.x = e8[0] | ((unsigned)e8[1] << 16); w.y = e8[2] | ((unsigned)e8[3] << 16); w.z = e8[4] | ((unsigned)e8[5] << 16); w.w = e8[6] | ((unsigned)e8[7] << 16);
                __builtin_amdgcn_raw_buffer_store_b128(w, rW, oKT + (unsigned)so_shared(chain, slot) + (unsigned)q * 16u, 0, 16);
            }
            if (tid < 128) { const int dir = tid >> 6, i = tid & 63, p = dir ? 63 - i : i;
                const float gl = gamP[dir * 64 + 63], gi = gamP[dir * 64 + p];
                const unsigned sc = oSCL + (unsigned)(so_dir(dir, chain, slot) * 1024) + (unsigned)i * 4u;
                __builtin_amdgcn_raw_buffer_store_b32(__builtin_bit_cast(unsigned, __expf(gi)), rW, sc, 0, 16); __builtin_amdgcn_raw_buffer_store_b32(__builtin_bit_cast(unsigned, __expf(gl - gi)), rW, sc + 256u, 0, 16);
                if (i == 0) __builtin_amdgcn_raw_buffer_store_b32(__builtin_bit_cast(unsigned, __expf(gl)), rW, sc + 512u, 0, 16); }
        }
        lds_barrier();
        if (ik + 1 < icount) load_item(item + istride, tid);
        {
            const int rr = lane & 15, kq = lane >> 4, dir = wave >> 2, wq = wave & 3;
            const f32x4 z4 = (f32x4){0.f, 0.f, 0.f, 0.f};
#define NB_(d, bi, bj) (NBk + ((d) * 10 + (bi) * ((bi) + 1) / 2 + (bj)) * 272)
#define XB_(d, bi, bj) (XBk + ((d) * 10 + (bi) * ((bi) + 1) / 2 + (bj)) * 272)
#define SLOT_(g) ((g) < 16 ? SCRq + (g) * 272 : TBk + ((g) - 16) * 272)
#define EMIT_X(d, bi, bj, v) do { const int pp_ = 16 * (bj) + rr, jx_ = (d) ? 63 - pp_ : pp_; const float bu_ = betP[(d) * 64 + pp_], bw_ = begP[(d) * 64 + pp_]; \
                _Pragma("unroll") for (int r_ = 0; r_ < 4; ++r_) { const int p_ = 16 * (bi) + 4 * kq + r_, i_ = (d) ? 63 - p_ : p_; \
                    XU[((d) * 64 + i_) * 72 + jx_] = (bf16_t)f2bf((v)[r_] * bu_); XW[((d) * 64 + i_) * 72 + jx_] = (bf16_t)f2bf((v)[r_] * bw_); } } while (0)
            { const u32x4 z = (u32x4){0u, 0u, 0u, 0u};
#pragma unroll
                for (int q = 0; q < 5; ++q) { const int o = (tid + 512 * q) * 16; if (o < 36864) *(LAS u32x4*)((LAS unsigned char*)XU + o) = z; } }
            lds_barrier();
            {
                const LAS float* M = NB_(dir, wq, wq);
                LAS float* S0 = SLOT_(wave * 3), *S1 = SLOT_(wave * 3 + 1), *Pb = SLOT_(wave * 3 + 2), *Xd = XB_(dir, wq, wq);
                const f32x4 m = ld16(M, rr, kq);
                f32x4 p0;
#pragma unroll
                for (int r = 0; r < 4; ++r) p0[r] = ((4 * kq + r) == rr ? 1.f : 0.f) - m[r];
                st16(Pb, p0, rr, kq);
                const f32x4 m2 = mm16(M, M, z4, rr, kq); st16(S0, m2, rr, kq);
                const f32x4 p1 = mm16(Pb, S0, p0, rr, kq); st16(Xd, p1, rr, kq);
                const f32x4 m4 = mm16(S0, S0, z4, rr, kq); st16(S1, m4, rr, kq);
                const f32x4 p2 = mm16(Xd, S1, p1, rr, kq); st16(Pb, p2, rr, kq);
                const f32x4 m8 = mm16(S1, S1, z4, rr, kq); st16(S0, m8, rr, kq);
                const f32x4 p3 = mm16(Pb, S0, p2, rr, kq); st16(Xd, p3, rr, kq); EMIT_X(dir, wq, wq, p3);
            }
            lds_barrier();
            if (wave < 4) {
                const int d1 = wave >> 1, lo = (wave & 1) * 2, hi = lo + 1;
                LAS float* T1 = SLOT_(wave);
                st16(T1, mm16(NB_(d1, hi, lo), XB_(d1, lo, lo), z4, rr, kq), rr, kq);
                const f32x4 x = mm16(XB_(d1, hi, hi), T1, z4, rr, kq);
                const f32x4 nx_ = -x; st16(XB_(d1, hi, lo), nx_, rr, kq); EMIT_X(d1, hi, lo, nx_);
            }
            lds_barrier();
            {
                const int bi = 2 + (wq >> 1), bj = wq & 1;
                f32x4 t = mm16(NB_(dir, bi, 1), XB_(dir, 1, bj), z4, rr, kq);
                if (bj == 0) t = mm16(NB_(dir, bi, 0), XB_(dir, 0, 0), t, rr, kq);
                st16(TBk + (dir * 4 + wq) * 272, t, rr, kq);
            }
            lds_barrier();
            {
                const int bi = 2 + (wq >> 1), bj = wq & 1;
                f32x4 x = mm16(XB_(dir, bi, 2), TBk + (dir * 4 + bj) * 272, z4, rr, kq);
                if (bi == 3) x = mm16(XB_(dir, 3, 3), TBk + (dir * 4 + 2 + bj) * 272, x, rr, kq);
                const f32x4 nx_ = -x; EMIT_X(dir, bi, bj, nx_);
            }
#undef NB_
#undef XB_
#undef SLOT_
#undef EMIT_X
        }
        lds_barrier();
        {
            const int dir = wave >> 2, wq = wave & 3, rr = lane & 15, kq = lane >> 4;
            const LAS bf16_t* xu = XU + (dir * 64 + 16 * wq + rr) * 72 + 8 * kq;
            const LAS bf16_t* xw = XW + (dir * 64 + 16 * wq + rr) * 72 + 8 * kq;
            const bf16x8 au0 = *(const LAS bf16x8*)(xu), au1 = *(const LAS bf16x8*)(xu + 32);
            const bf16x8 bw0 = *(const LAS bf16x8*)(xw), bw1 = *(const LAS bf16x8*)(xw + 32);
            const unsigned ub = (unsigned)(so_dir(dir, chain, slot) * 16384);
            const unsigned nb = oNWK + (unsigned)(so_dir(dir, chain, slot) * 16384);
#pragma unroll
            for (int ct = 0; ct < 8; ++ct) {
                const LAS bf16_t* vp = vT + (16 * ct + rr) * 72 + ct * 8 + 8 * kq;
                f32x4 acc = (f32x4){0.f, 0.f, 0.f, 0.f};
                acc = __builtin_amdgcn_mfma_f32_16x16x32_bf16(au0, *(const LAS bf16x8*)(vp), acc, 0, 0, 0);
                acc = __builtin_amdgcn_mfma_f32_16x16x32_bf16(au1, *(const LAS bf16x8*)(vp + 32), acc, 0, 0, 0);
                __builtin_amdgcn_raw_buffer_store_b64((u32x2){cvt_pk_bf16(acc[0], acc[1]), cvt_pk_bf16(acc[2], acc[3])}, rO, ub + (unsigned)((ct * 4 + wq) * 64 + lane) * 8u, 0, 16);
            }
#pragma unroll
            for (int s2 = 0; s2 < 4; ++s2) {
                f32x4 a2[2];
#pragma unroll
                for (int hh = 0; hh < 2; ++hh) { const LAS bf16_t* kp = knT + (16 * (2 * s2 + hh) + rr) * 72 + (2 * s2 + hh) * 8 + 8 * kq;
                    f32x4 acc = (f32x4){0.f, 0.f, 0.f, 0.f};
                    acc = __builtin_amdgcn_mfma_f32_16x16x32_bf16(*(const LAS bf16x8*)(kp), bw0, acc, 0, 0, 0);
                    acc = __builtin_amdgcn_mfma_f32_16x16x32_bf16(*(const LAS bf16x8*)(kp + 32), bw1, acc, 0, 0, 0);
                    a2[hh] = acc; }
                u32x4 w; w.x = cvt_pk_bf16(-a2[0][0], -a2[0][1]); w.y = cvt_pk_bf16(-a2[0][2], -a2[0][3]); w.z = cvt_pk_bf16(-a2[1][0], -a2[1][1]); w.w = cvt_pk_bf16(-a2[1][2], -a2[1][3]);
                __builtin_amdgcn_raw_buffer_store_b128(w, rW, nb + (unsigned)((wq * 4 + s2) * 64 + lane) * 16u, 0, 16);
            }
        }
        asm volatile("s_waitcnt vmcnt(0)" ::: "memory");
        lds_barrier();
        if (tid == 0) __hip_atomic_store(flags + 16 * (chain * NSLOT + slot), 1u, __ATOMIC_RELAXED, __HIP_MEMORY_SCOPE_AGENT);
    }
}

constexpr int SC_NWK = 0, SC_QN = 16384, SC_KT = 32768, SC_QK = 49152, SC_U = 57344, SC_SCL = 65536, SC_STAGE = 66560;
constexpr int SC_HS = 2 * SC_STAGE  , SC_HW = SC_HS + 16384  ;
static_assert(SC_HW + 8192 <= MISC_OFF, "scan LDS map");
__device__ __forceinline__ void ph_scan(const Frame& F, const ScanPtrs P, bf16_t* OF, bf16_t* OB, unsigned* prog, unsigned* flags) {
    const int xg = F.vcu >> 5, xj = F.vcu & 31;
    if (xj >= 8 || xg >= 8) return;
    const int sb = xg * 8 + xj, half = sb & 1, dir = (sb >> 1) & 1, chain = sb >> 2, b = chain >> 2, h = chain & 3;
    LAS unsigned char* L = F.lds;
    const int lane = F.lane, wave = F.wave, g = lane >> 4, tile = wave & 3;
    const bool isR = wave < 4;
    bf16_t* O = dir ? OB : OF;
    const unsigned lbase = (unsigned)(unsigned long long)(L);
    auto slot_of = [&](int step) { return dir ? (step < 4 ? 3 - step : 135 - step) : step; };
    constexpr int SC_FLG = SC_HW + 8192;
    static_assert(SC_FLG + 4096 <= MISC_OFF, "scan LDS map (flags)");
    auto issueH1 = [&](int st) {
        const int slot = slot_of(st < NSLOT ? st : NSLOT - 1); const unsigned sbase = (unsigned)(st & 1) * SC_STAGE;
        const unsigned char* nwk = P.NWK + so_dir(dir, chain, slot) * 16384;
        const unsigned char* uu = P.U + so_dir(dir, chain, slot) * 16384 + half * 8192; const unsigned char* sc = (const unsigned char*)(P.SCL + so_dir(dir, chain, slot) * 256);
#pragma unroll
        for (int i = 0; i < 2; ++i) { const int pc = wave * 2 + i;
            __builtin_amdgcn_global_load_lds((const unsigned*)(nwk + pc * 1024 + lane * 16), (LAS unsigned*)(L + sbase + SC_NWK + pc * 1024), 16, 0, 0); }
        __builtin_amdgcn_global_load_lds((const unsigned*)(uu + wave * 1024 + lane * 16), (LAS unsigned*)(L + sbase + SC_U + wave * 1024), 16, 0, 0);
        __builtin_amdgcn_global_load_lds((const unsigned*)(sc + (wave & 3) * 256 + lane * 4), (LAS unsigned*)(L + sbase + SC_SCL + (wave & 3) * 256), 4, 0, 0);
    };
    auto issueH2 = [&](int st) {
        const int slot = slot_of(st < NSLOT ? st : NSLOT - 1); const unsigned sbase = (unsigned)(st & 1) * SC_STAGE;
        const unsigned char* kt = P.KT + so_shared(chain, slot); const unsigned char* qn = P.QN + so_shared(chain, slot); const unsigned char* qk = P.QK + so_dir(dir, chain, slot) * 8192;
#pragma unroll
        for (int i = 0; i < 2; ++i) { const int pc = wave * 2 + i;
            __builtin_amdgcn_global_load_lds((const unsigned*)(qn + pc * 1024 + lane * 16), (LAS unsigned*)(L + sbase + SC_QN + pc * 1024), 16, 0, 0); }
#pragma unroll
        for (int i = 0; i < 2; ++i) { const int pc = wave * 2 + i;
            __builtin_amdgcn_global_load_lds((const unsigned*)(kt + pc * 1024 + lane * 16), (LAS unsigned*)(L + sbase + SC_KT + pc * 1024), 16, 0, 0); }
        __builtin_amdgcn_global_load_lds((const unsigned*)(qk + wave * 1024 + lane * 16), (LAS unsigned*)(L + sbase + SC_QK + wave * 1024), 16, 0, 0);
    };
#define SC_RD128(dst, addr, off) asm volatile("ds_read_b128 %0, %1 offset:%2" : "=v"(dst) : "v"(addr), "n"(off))
#define SC_WR128(addr, off, src) asm volatile("ds_write_b128 %0, %1 offset:%2\n\ts_nop 3" :: "v"(addr), "v"(src), "n"(off) : "memory")
#define SC_LOAD(dst, base, first) do { _Pragma("unroll") for (int i_ = 0; i_ < 8; ++i_) SC_RD128(dst[i_], sva, (base) + ((first) + i_) * 1024); } while (0)
#define SC_WAIT0(a) do { asm volatile("s_waitcnt lgkmcnt(0)" : "+v"(a[0]), "+v"(a[1]), "+v"(a[2]), "+v"(a[3]), "+v"(a[4]), "+v"(a[5]), "+v"(a[6]), "+v"(a[7])); __builtin_amdgcn_sched_barrier(0); } while (0)
    const unsigned hsa = lbase + SC_HS + (unsigned)tile * 4096u + (unsigned)lane * 16u;
    const unsigned hwa = lbase + SC_HW + (unsigned)tile * 2048u + (unsigned)lane * 16u;
    f32x4 accS[8];
#pragma unroll
    for (int m = 0; m < 8; ++m) accS[m] = (f32x4){0.f, 0.f, 0.f, 0.f};
    bf16x8 bS[4];
#pragma unroll
    for (int s = 0; s < 4; ++s) bS[s] = (bf16x8){0, 0, 0, 0, 0, 0, 0, 0};
    if (isR) {
#pragma unroll
        for (int s = 0; s < 4; ++s) SC_WR128(hsa, s * 1024, bS[s]);
    }
#if PROBE_SEL >= 0
    const unsigned long long tscan0_ = __builtin_amdgcn_s_memrealtime();
#endif
    auto flag_of = [&](int step) { return flags + 16 * (chain * NSLOT + slot_of(step < NSLOT ? step : NSLOT - 1)); };
    auto wait_flag = [&](unsigned fv, int step) {
        while (__builtin_amdgcn_readfirstlane(fv) == 0u) { __builtin_amdgcn_s_sleep(4); const unsigned* fp = flag_of(step);
            asm volatile("global_load_dword %0, %1, off sc1\n\ts_waitcnt vmcnt(0)" : "=v"(fv) : "v"(fp) : "memory"); }
    };
    auto flag_dma = [&](int st, int par) {
        __builtin_amdgcn_global_load_lds((const unsigned*)flag_of(st), (LAS unsigned*)(L + SC_FLG + wave * 512 + par * 256), 4, 0, 16); };
    wait_flag(0u, 0); wait_flag(0u, 1);
    issueH1(0); issueH2(0); flag_dma(2, 0); issueH1(1);
    asm volatile("s_waitcnt vmcnt(0)" ::: "memory");
    lds_barrier();
    for (int step = 0; step < NSLOT; ++step) {
        const int slot = slot_of(step); const bool emit = slot >= 4;
#if PROBE_SEL >= 0
        if (sb == 0 && F.tid == 0 && (step == 8 || step == 36 || step == 68)) { unsigned long long* ts = (unsigned long long*)(prog - CW_PROG + CW_TS); ts[step == 8 ? 14 : (step == 36 ? 15 : 12)] = __builtin_amdgcn_s_memrealtime() - tscan0_; }
#endif
        const unsigned sva = lbase + (unsigned)(step & 1) * SC_STAGE + (unsigned)lane * 16u;
        const unsigned ssa = sva - (unsigned)lane * 16u + SC_SCL + (unsigned)g * 16u;
#if PROBE_SEL >= 0
        const bool pw = (sb == 0 && wave == PROBE_WAVE);
        unsigned long long t0_ = 0, t1_ = 0, t2_ = 0, t3_ = 0, t4_ = 0, t5_ = 0;
        if (pw) t0_ = __builtin_amdgcn_s_memrealtime();
#endif
        issueH2(step + 1);
#if PROBE_SEL >= 0
        if (pw) t1_ = __builtin_amdgcn_s_memrealtime();
#endif
        bf16x8 fa[8], fb[8];
        f32x4 acco[4]; bf16x8 bWx[2];
        if (isR) {
            const unsigned sua = sva - (unsigned)lane * 8u + SC_U + (unsigned)tile * 2048u;
            f32x4 accw[4], ek4[4]; u32x2 uv[4]; float cd;
#pragma unroll
            for (int m = 0; m < 4; ++m) asm volatile("ds_read_b64 %0, %1 offset:%2" : "=v"(uv[m]) : "v"(sua), "n"(m * 512));
            SC_LOAD(fa, SC_NWK, 0);
            asm volatile("s_waitcnt lgkmcnt(0)" : "+v"(uv[0]), "+v"(uv[1]), "+v"(uv[2]), "+v"(uv[3]),
                         "+v"(fa[0]), "+v"(fa[1]), "+v"(fa[2]), "+v"(fa[3]), "+v"(fa[4]), "+v"(fa[5]), "+v"(fa[6]), "+v"(fa[7])); __builtin_amdgcn_sched_barrier(0);
            SC_LOAD(fb, SC_NWK, 8);
#pragma unroll
            for (int m = 0; m < 4; ++m) SC_RD128(ek4[m], ssa, 256 + m * 64);
            asm volatile("ds_read_b32 %0, %1 offset:512" : "=v"(cd) : "v"(ssa - (unsigned)g * 16u));
#pragma unroll
            for (int m = 0; m < 4; ++m) accw[m] = (f32x4){bf_lo(uv[m].x), bf_hi(uv[m].x), bf_lo(uv[m].y), bf_hi(uv[m].y)};
#pragma unroll
            for (int f = 0; f < 8; ++f) accw[f >> 2] = __builtin_amdgcn_mfma_f32_16x16x32_bf16(fa[f], bS[f & 3], accw[f >> 2], 0, 0, 0);
            asm volatile("s_waitcnt lgkmcnt(0)" : "+v"(ek4[0]), "+v"(ek4[1]), "+v"(ek4[2]), "+v"(ek4[3]), "+v"(cd),
                         "+v"(fb[0]), "+v"(fb[1]), "+v"(fb[2]), "+v"(fb[3]), "+v"(fb[4]), "+v"(fb[5]), "+v"(fb[6]), "+v"(fb[7])); __builtin_amdgcn_sched_barrier(0);
            SC_LOAD(fa, SC_KT, 0);
#pragma unroll
            for (int f = 0; f < 8; ++f) accw[2 + (f >> 2)] = __builtin_amdgcn_mfma_f32_16x16x32_bf16(fb[f], bS[f & 3], accw[2 + (f >> 2)], 0, 0, 0);
            SC_WAIT0(fa);
            SC_LOAD(fb, SC_KT, 8);
            bf16x8 bWs[2];
#pragma unroll
            for (int s = 0; s < 2; ++s) {
                const f32x4 w0 = accw[2 * s], w1 = accw[2 * s + 1], e0 = ek4[2 * s], e1 = ek4[2 * s + 1];
                u32x4 a, c2;
                a.x = cvt_pk_bf16(w0[0], w0[1]); a.y = cvt_pk_bf16(w0[2], w0[3]); a.z = cvt_pk_bf16(w1[0], w1[1]); a.w = cvt_pk_bf16(w1[2], w1[3]);
                c2.x = cvt_pk_bf16(w0[0] * e0[0], w0[1] * e0[1]); c2.y = cvt_pk_bf16(w0[2] * e0[2], w0[3] * e0[3]); c2.z = cvt_pk_bf16(w1[0] * e1[0], w1[1] * e1[1]); c2.w = cvt_pk_bf16(w1[2] * e1[2], w1[3] * e1[3]);
                bWx[s] = __builtin_bit_cast(bf16x8, a); bWs[s] = __builtin_bit_cast(bf16x8, c2);
                if (emit) SC_WR128(hwa, s * 1024, bWx[s]);
            }
#pragma unroll
            for (int m = 0; m < 8; ++m) accS[m] = accS[m] * cd;
#if PROBE_SEL >= 0
            if (pw) t2_ = __builtin_amdgcn_s_memrealtime();
#endif
            asm volatile("s_waitcnt vmcnt(5)" ::: "memory");
            lds_barrier();
#if PROBE_SEL >= 0
            if (pw) t3_ = __builtin_amdgcn_s_memrealtime();
#endif
            {
                unsigned fvs; const unsigned fla = lbase + SC_FLG + (unsigned)wave * 512u + (unsigned)(step & 1) * 256u + (unsigned)lane * 4u;
                asm volatile("ds_read_b32 %0, %1\n\ts_waitcnt lgkmcnt(0)" : "=v"(fvs) : "v"(fla) : "memory");
                wait_flag(fvs, step + 2);
                flag_dma(step + 3, (step + 1) & 1);
                issueH1(step + 2);
            }
            SC_WAIT0(fb);
#pragma unroll
            for (int f = 0; f < 8; ++f) accS[f >> 1] = __builtin_amdgcn_mfma_f32_16x16x32_bf16(fa[f], bWs[f & 1], accS[f >> 1], 0, 0, 0);
#pragma unroll
            for (int f = 0; f < 8; ++f) accS[4 + (f >> 1)] = __builtin_amdgcn_mfma_f32_16x16x32_bf16(fb[f], bWs[f & 1], accS[4 + (f >> 1)], 0, 0, 0);
#pragma unroll
            for (int s = 0; s < 4; ++s) {
                const f32x4 s0 = accS[2 * s], s1 = accS[2 * s + 1];
                u32x4 a; a.x = cvt_pk_bf16(s0[0], s0[1]); a.y = cvt_pk_bf16(s0[2], s0[3]); a.z = cvt_pk_bf16(s1[0], s1[1]); a.w = cvt_pk_bf16(s1[2], s1[3]);
                bS[s] = __builtin_bit_cast(bf16x8, a);
                SC_WR128(hsa, s * 1024, bS[s]);
            }
        } else {
            f32x4 eg4[4];
            if (emit) {
#pragma unroll
                for (int s = 0; s < 4; ++s) SC_RD128(bS[s], hsa, s * 1024);
                SC_LOAD(fa, SC_QN, 0);
                asm volatile("s_waitcnt lgkmcnt(0)" : "+v"(bS[0]), "+v"(bS[1]), "+v"(bS[2]), "+v"(bS[3]),
                             "+v"(fa[0]), "+v"(fa[1]), "+v"(fa[2]), "+v"(fa[3]), "+v"(fa[4]), "+v"(fa[5]), "+v"(fa[6]), "+v"(fa[7])); __builtin_amdgcn_sched_barrier(0);
                SC_LOAD(fb, SC_QN, 8);
#pragma unroll
                for (int m = 0; m < 4; ++m) SC_RD128(eg4[m], ssa, m * 64);
#pragma unroll
                for (int m = 0; m < 4; ++m) acco[m] = (f32x4){0.f, 0.f, 0.f, 0.f};
#pragma unroll
                for (int f = 0; f < 8; ++f) acco[f >> 2] = __builtin_amdgcn_mfma_f32_16x16x32_bf16(fa[f], bS[f & 3], acco[f >> 2], 0, 0, 0);
                asm volatile("s_waitcnt lgkmcnt(0)" : "+v"(eg4[0]), "+v"(eg4[1]), "+v"(eg4[2]), "+v"(eg4[3]),
                             "+v"(fb[0]), "+v"(fb[1]), "+v"(fb[2]), "+v"(fb[3]), "+v"(fb[4]), "+v"(fb[5]), "+v"(fb[6]), "+v"(fb[7])); __builtin_amdgcn_sched_barrier(0);
                SC_LOAD(fa, SC_QK, 0);
#pragma unroll
                for (int f = 0; f < 8; ++f) acco[2 + (f >> 2)] = __builtin_amdgcn_mfma_f32_16x16x32_bf16(fb[f], bS[f & 3], acco[2 + (f >> 2)], 0, 0, 0);
#pragma unroll
                for (int m = 0; m < 4; ++m) acco[m] = acco[m] * eg4[m];
            }
#if PROBE_SEL >= 0
            if (pw) t2_ = __builtin_amdgcn_s_memrealtime();
#endif
            asm volatile("s_waitcnt vmcnt(5)" ::: "memory");
            lds_barrier();
#if PROBE_SEL >= 0
            if (pw) t3_ = __builtin_amdgcn_s_memrealtime();
#endif
            {
                unsigned fvs; const unsigned fla = lbase + SC_FLG + (unsigned)wave * 512u + (unsigned)(step & 1) * 256u + (unsigned)lane * 4u;
                asm volatile("ds_read_b32 %0, %1\n\ts_waitcnt lgkmcnt(0)" : "=v"(fvs) : "v"(fla) : "memory");
                wait_flag(fvs, step + 2);
                flag_dma(step + 3, (step + 1) & 1);
                issueH1(step + 2);
            }
            if (emit) {
                SC_RD128(bWx[0], hwa, 0); SC_RD128(bWx[1], hwa, 1024);
                asm volatile("s_waitcnt lgkmcnt(0)" : "+v"(bWx[0]), "+v"(bWx[1]), "+v"(fa[0]), "+v"(fa[1]), "+v"(fa[2]), "+v"(fa[3]), "+v"(fa[4]), "+v"(fa[5]), "+v"(fa[6]), "+v"(fa[7])); __builtin_amdgcn_sched_barrier(0);
#pragma unroll
                for (int f = 0; f < 8; ++f) acco[f >> 1] = __builtin_amdgcn_mfma_f32_16x16x32_bf16(fa[f], bWx[f & 1], acco[f >> 1], 0, 0, 0);
                bf16_t* orow = O + ((size_t)b * SEQ + (slot - 4) * 64) * 512 + h * 128 + half * 64 + tile * 16 + (lane & 15);
#pragma unroll
                for (int m = 0; m < 4; ++m) { const unsigned p01 = cvt_pk_bf16(acco[m][0], acco[m][1]), p23 = cvt_pk_bf16(acco[m][2], acco[m][3]);
                    bf16_t* q = orow + (size_t)(16 * m + 4 * g) * 512;
                    q[0] = (bf16_t)(p01 & 0xffffu); q[512] = (bf16_t)(p01 >> 16); q[1024] = (bf16_t)(p23 & 0xffffu); q[1536] = (bf16_t)(p23 >> 16); }
            }
        }
#if PROBE_SEL >= 0
        if (pw) t4_ = __builtin_amdgcn_s_memrealtime();
#endif
        if (!isR && emit) asm volatile("s_waitcnt vmcnt(21)" ::: "memory"); else asm volatile("s_waitcnt vmcnt(5)" ::: "memory");
#if PROBE_SEL >= 0
        if (pw) t5_ = __builtin_amdgcn_s_memrealtime();
#endif
        lds_barrier();
#if PROBE_SEL >= 0
        if (pw && lane == 0) { const unsigned long long t6_ = __builtin_amdgcn_s_memrealtime(); unsigned long long* ts = (unsigned long long*)(prog - CW_PROG + CW_TS);
            ts[0] += t1_ - t0_; ts[1] += t2_ - t1_; ts[2] += t3_ - t2_; ts[3] += t4_ - t3_; ts[4] += t5_ - t4_; ts[5] += t6_ - t5_; ts[6] += t6_ - t0_; }
#endif
    }
    asm volatile("s_waitcnt vmcnt(0)" ::: "memory");
    lds_barrier();
#undef SC_LOAD
#undef SC_WAIT0
#undef SC_RD128
#undef SC_WR128
}

__device__ __forceinline__ void scan_l2_warm(const Frame& F, const ScanPtrs P, int stream, int quarter, unsigned* prog) {
    const int dir = stream & 1, chain = stream >> 1, lane = F.lane;
    const int wq = quarter * NWAVES + F.wave;
    constexpr int AHEAD = 6;
    int done = 0;
    u32x4 junk = (u32x4){0u, 0u, 0u, 0u};
    for (unsigned spins = 0; spins < (1u << 20); ++spins) {
        const int cur = (int)__hip_atomic_load(prog + 16 * stream, __ATOMIC_RELAXED, __HIP_MEMORY_SCOPE_AGENT);
        int tgt = cur + AHEAD; if (tgt > NSLOT) tgt = NSLOT;
        for (int s = done > cur ? done : cur; s < tgt; ++s) {
            const int slot = dir ? (s < 4 ? 3 - s : 135 - s) : s;
#pragma unroll
            for (int i = 0; i < 3; ++i) { const int p = wq + 32 * i;
                const unsigned char* src = nullptr;
                if (p < 16) src = P.NWK + so_dir(dir, chain, slot) * 16384 + p * 1024;
                else if (p < 32) src = P.KT + so_shared(chain, slot) + (p - 16) * 1024;
                else if (p < 48) src = P.U + so_dir(dir, chain, slot) * 16384 + (p - 32) * 1024;
                else if (p < 64) { if (slot >= 4) src = P.QN + so_shared(chain, slot) + (p - 48) * 1024; }
                else if (p < 72) { if (slot >= 4) src = P.QK + so_dir(dir, chain, slot) * 8192 + (p - 64) * 1024; }
                else if (p == 72) src = (const unsigned char*)(P.SCL + so_dir(dir, chain, slot) * 256);
                if (src) asm volatile("global_load_dwordx4 %0, %1, off" : "+v"(junk) : "v"(src + lane * 16)); }
        }
        if (tgt > done) done = tgt;
        if (done >= NSLOT) break;
        __builtin_amdgcn_s_sleep(16);
    }
    asm volatile("s_waitcnt vmcnt(0)" : "+v"(junk) :: "memory");
}

__device__ __forceinline__ void ph_even_A(const Frame& F, const bf16_t* OF, const bf16_t* OB, const bf16_t* Z, const bf16_t* POOL, const float* onorm, bf16_t* act) {
    LAS float* Pp = (LAS float*)F.lds;
    LAS float* Tt = (LAS float*)(F.lds + 65 * 2048);
    static_assert(65 * 2048 + 8 * 2048 <= MISC_OFF, "E5 LDS map");
    for (int seg = F.vcu; seg < M_LAT / 64; seg += F.G) {
        int tid = F.tid; asm volatile("" : "+v"(tid));
        const int lane = tid & 63;
        const size_t row0 = (size_t)seg * 64;
        u32x4 av0[4], bv0[4], zv0[4];
        {
            const int rg = tid >> 6, co = tid & 63;
            u32x4 pv[8];
#pragma unroll
            for (int j = 0; j < 8; ++j) pv[j] = __builtin_nontemporal_load((const u32x4*)(POOL + (row0 + rg * 8 + j) * 512 + co * 8));
#pragma unroll
            for (int i = 0; i < 4; ++i) { const size_t r = row0 + F.wave * 8 + i;
                av0[i] = __builtin_nontemporal_load((const u32x4*)(OF + r * 512 + 8 * lane)); bv0[i] = __builtin_nontemporal_load((const u32x4*)(OB + r * 512 + 8 * lane)); zv0[i] = __builtin_nontemporal_load((const u32x4*)(Z + r * 512 + 8 * lane)); }
            float run[8];
#pragma unroll
            for (int c = 0; c < 8; ++c) run[c] = 0.f;
#pragma unroll
            for (int j = 0; j < 8; ++j)
#pragma unroll
                for (int q = 0; q < 4; ++q) { run[2 * q] += bf_lo(pv[j][q]); run[2 * q + 1] += bf_hi(pv[j][q]); }
            *(LAS f32x4*)(Tt + rg * 512 + co * 8) = (f32x4){run[0], run[1], run[2], run[3]}; *(LAS f32x4*)(Tt + rg * 512 + co * 8 + 4) = (f32x4){run[4], run[5], run[6], run[7]};
            __syncthreads();
            f32x4 g0 = (f32x4){0.f, 0.f, 0.f, 0.f}, g1 = g0;
#pragma unroll
            for (int g = 0; g < 7; ++g) if (g < rg) { g0 += *(const LAS f32x4*)(Tt + g * 512 + co * 8); g1 += *(const LAS f32x4*)(Tt + g * 512 + co * 8 + 4); }
            if (rg == 0) { *(LAS f32x4*)(Pp + co * 8) = g0; *(LAS f32x4*)(Pp + co * 8 + 4) = g1; }
#pragma unroll
            for (int j = 0; j < 8; ++j) {
                g0 += (f32x4){bf_lo(pv[j][0]), bf_hi(pv[j][0]), bf_lo(pv[j][1]), bf_hi(pv[j][1])}; g1 += (f32x4){bf_lo(pv[j][2]), bf_hi(pv[j][2]), bf_lo(pv[j][3]), bf_hi(pv[j][3])};
                *(LAS f32x4*)(Pp + (rg * 8 + j + 1) * 512 + co * 8) = g0; *(LAS f32x4*)(Pp + (rg * 8 + j + 1) * 512 + co * 8 + 4) = g1; }
        }
        __syncthreads();
#define E5_LOAD(av, bv, zv, i0) do { _Pragma("unroll") for (int i = 0; i < 4; ++i) { const size_t r = row0 + F.wave * 8 + (i0) + i; \
            av[i] = __builtin_nontemporal_load((const u32x4*)(OF + r * 512 + 8 * lane)); bv[i] = __builtin_nontemporal_load((const u32x4*)(OB + r * 512 + 8 * lane)); zv[i] = __builtin_nontemporal_load((const u32x4*)(Z + r * 512 + 8 * lane)); } } while (0)
#define E5_ROWS(av, bv, zv, i0) do { _Pragma("unroll") for (int i = 0; i < 4; ++i) { \
                const int pos = F.wave * 8 + (i0) + i; const size_t r = row0 + pos; \
                const int grp = lane >> 4, win = 2 << grp; \
                int lo = pos - win / 2; if (lo < 0) lo = 0; int hi = pos + win - win / 2; if (hi > 64) hi = 64; \
                const LAS float* ph = Pp + hi * 512 + lane * 8; const LAS float* pl = Pp + lo * 512 + lane * 8; const LAS float* ps = Pp + pos * 512 + lane * 8; \
                const f32x4 h0 = *(const LAS f32x4*)ph, h1 = *(const LAS f32x4*)(ph + 4), l0 = *(const LAS f32x4*)pl, l1 = *(const LAS f32x4*)(pl + 4); \
                const f32x4 s0 = *(const LAS f32x4*)ps, s1 = *(const LAS f32x4*)(ps + 4), t0 = *(const LAS f32x4*)(ps + 512), t1 = *(const LAS f32x4*)(ps + 516); \
                const u32x4 a = av[i], b2 = bv[i], z = zv[i]; \
                float o[8]; float s = 0.f; \
                _Pragma("unroll") for (int q = 0; q < 4; ++q) { o[2 * q] = bf_lo(a[q]) + bf_lo(b2[q]); o[2 * q + 1] = bf_hi(a[q]) + bf_hi(b2[q]); s += o[2 * q] * o[2 * q] + o[2 * q + 1] * o[2 * q + 1]; } \
                s += __shfl_xor(s, 1); s += __shfl_xor(s, 2); s += __shfl_xor(s, 4); s += __shfl_xor(s, 8); \
                const float rs = rsqrtf(s * (1.f / 128.f) + EPS); \
                const float* gn = onorm + ((8 * lane) & 127); \
                u32x4 w; \
                _Pragma("unroll") for (int q = 0; q < 4; ++q) w[q] = pk2(o[2 * q] * rs * gn[2 * q] * silu1(bf_lo(z[q])), o[2 * q + 1] * rs * gn[2 * q + 1] * silu1(bf_hi(z[q]))); \
                *(u32x4*)(act + r * D + 8 * lane) = w; \
                const float inv = 1.f / (float)(hi - lo); \
                const f32x4 m0 = (h0 - l0) * inv - (t0 - s0), m1 = (h1 - l1) * inv - (t1 - s1); \
                w.x = pk2(m0[0], m0[1]); w.y = pk2(m0[2], m0[3]); w.z = pk2(m1[0], m1[1]); w.w = pk2(m1[2], m1[3]); \
                *(u32x4*)(act + r * D + 512 + 8 * lane) = w; } } while (0)
        u32x4 av1[4], bv1[4], zv1[4];
        E5_LOAD(av1, bv1, zv1, 4);
        E5_ROWS(av0, bv0, zv0, 0);
        E5_ROWS(av1, bv1, zv1, 4);
#undef E5_LOAD
#undef E5_ROWS
        __syncthreads();
    }
}

struct TItem { const float* W; bf16_t* WT; int ldn, n0, k0, Kd, drow0; };
constexpr int N_LATE_T = 2304 + 2 * NE * 768;
__device__ __forceinline__ TItem late_item(const Args& args, int it, bf16_t* WOUT, bf16_t* SCIN, bf16_t* SCOUT, bf16_t* WGU, bf16_t* WDN) {
    TItem t;
    if (it < 256) { const int kb = it >> 5, nb = it & 31; t = TItem{args.in[16], WOUT, D, 32 * nb, 64 * kb, D, 32 * nb}; }
    else if (it < 1792) { const int q = it - 256, kb = q / 96, nb = q % 96, n0 = 32 * nb; int drow;
        if (n0 < D) drow = n0; else if (n0 < 2 * D) drow = D + ((n0 - D) >> 7) * 256 + (n0 & 127); else drow = D + ((n0 - 2 * D) >> 7) * 256 + 128 + (n0 & 127);
        t = TItem{args.in[17], SCIN, 3 * D, n0, 64 * kb, D, drow}; }
    else if (it < 2304) { const int q = it - 1792, kb = q >> 5, nb = q & 31; t = TItem{args.in[19], SCOUT, D, 32 * nb, 64 * kb, D, 32 * nb}; }
    else { const int q0 = it - 2304, le = q0 / 768, r = q0 % 768;
        if (r < 512) { const int up = r >> 8, q = r & 255, kb = q >> 4, nb = q & 15, n0 = 32 * nb;
            t = TItem{(up ? args.in[22] : args.in[21]) + (size_t)le * D * DE, WGU + (size_t)le * 1024 * D, DE, n0, 64 * kb, D, (n0 >> 7) * 256 + up * 128 + (n0 & 127)}; }
        else { const int q = r - 512, kb = q >> 5, nb = q & 31; t = TItem{args.in[23] + (size_t)le * DE * D, WDN + (size_t)le * D * DE, D, 32 * nb, 64 * kb, DE, 32 * nb}; } }
    return t;
}
__device__ __forceinline__ void t_load(const TItem& t, float (&tv)[32], int lane) {
#pragma unroll
    for (int i = 0; i < 32; ++i) tv[i] = __builtin_nontemporal_load(t.W + (size_t)(t.k0 + 2 * i + (lane >> 5)) * t.ldn + t.n0 + (lane & 31));
}
__device__ __forceinline__ void t_store(const TItem& t, const float (&tv)[32], LAS float* scr, int lane) {
#pragma unroll
    for (int i = 0; i < 32; ++i) scr[(2 * i + (lane >> 5)) * 33 + (lane & 31)] = tv[i];
    asm volatile("s_waitcnt lgkmcnt(0)" ::: "memory");
    const int c = lane & 7;
#pragma unroll
    for (int j = 0; j < 4; ++j) { const int n = (lane >> 3) + 8 * j; const LAS float* s = scr + (8 * c) * 33 + n;
        u32x4 o; o.x = pk2(s[0 * 33], s[1 * 33]); o.y = pk2(s[2 * 33], s[3 * 33]); o.z = pk2(s[4 * 33], s[5 * 33]); o.w = pk2(s[6 * 33], s[7 * 33]);
        __builtin_nontemporal_store(o, (u32x4*)(t.WT + (size_t)(t.drow0 + n) * t.Kd + t.k0 + 8 * c)); }
    asm volatile("s_waitcnt lgkmcnt(0)" ::: "memory");
}
__device__ __forceinline__ void prep_late(const Frame& F, const Args& args, int widx, int nw, bf16_t* WOUT, bf16_t* SCIN, bf16_t* SCOUT, bf16_t* WGU, bf16_t* WDN) {
    LAS float* scr = (LAS float*)(F.lds + F.wave * 16384);
    for (int it = widx; it < 4 * 128 * 16; it += nw) { const int gq = it >> 11, c = (it >> 4) & 127, n = (it & 15) * 64 + F.lane;
        const float* pw = args.in[14] + ((size_t)gq * 128 + c) * 128; const float* ps = args.in[15] + gq * 128; const float* wo = args.in[16] + (size_t)(512 + gq * 128) * D + n;
        float acc = 0.f;
#pragma unroll 1
        for (int d0 = 0; d0 < 128; d0 += 32) { float wv[32];
#pragma unroll
            for (int d = 0; d < 32; ++d) wv[d] = wo[(size_t)(d0 + d) * D];
#pragma unroll
            for (int d = 0; d < 32; ++d) acc += pw[d0 + d] * ps[d0 + d] * wv[d]; }
        WOUT[(size_t)n * D + 512 + gq * 128 + c] = (bf16_t)f2bf(acc); }
    float ta[32], tb[32];
    int it0 = widx;
    TItem A = late_item(args, it0 < N_LATE_T ? it0 : 0, WOUT, SCIN, SCOUT, WGU, WDN), B = A;
    if (it0 < N_LATE_T) t_load(A, ta, F.lane);
    while (it0 < N_LATE_T) {
        const int it1 = it0 + nw;
        if (it1 < N_LATE_T) { B = late_item(args, it1, WOUT, SCIN, SCOUT, WGU, WDN); t_load(B, tb, F.lane); }
        t_store(A, ta, scr, F.lane);
        it0 = it1 + nw;
        if (it0 < N_LATE_T) { A = late_item(args, it0, WOUT, SCIN, SCOUT, WGU, WDN); t_load(A, ta, F.lane); }
        if (it1 < N_LATE_T) t_store(B, tb, scr, F.lane);
        __builtin_amdgcn_s_sleep(127); __builtin_amdgcn_s_sleep(127);
    }
}

enum { PH_PREP = 0, PH_E1, PH_E2, PH_E4, PH_E5, PH_E6, PH_M1_0, PH_M2_0, PH_M3_0, PH_M4_0, PH_M5_0, PH_X1, PH_X2, PH_X3, PH_M1_1, PH_M2_1, PH_M3_1, PH_M4_1, PH_M5_1, PH_COUNT };

__global__ void __launch_bounds__(NTHREADS, 2) mega(Args args) {
    extern __shared__ __attribute__((aligned(16))) unsigned char lds_raw[];
    Frame F;
    F.lds = (LAS unsigned char*)lds_raw;
    F.tid = threadIdx.x; F.lane = F.tid & 63; F.wave = __builtin_amdgcn_readfirstlane(F.tid >> 6);
    F.G = gridDim.x; { const int bx = blockIdx.x; F.vcu = (F.G % 8 == 0) ? (bx % 8) * (F.G / 8) + bx / 8 : bx; }
    volatile LAS unsigned* MISC = (volatile LAS unsigned*)(F.lds + MISC_OFF);
    if (F.tid < 64) MISC[F.tid] = 0u;
    __syncthreads();
    unsigned char* ws = args.ws;
    XcdBarrier bar = xcd_barrier_post((unsigned*)(ws + WS_CTL) + CW_BAR + args.li * XCD_BAR_WORDS, MISC + 8);
    const int lo = args.ph_lo, hi = args.ph_hi;
#define IN(k) (lo <= (k) && (k) < hi)
#define SEAM(k) do { if (IN(k) && IN((k) + 1)) xcd_barrier(bar); } while (0)
    const float* ADA = (const float*)(ws + WS_ADA); float* ADAw = (float*)(ws + WS_ADA);
    float* AFF = (float*)(ws + WS_AFF); int* IDX = (int*)(ws + WS_IDX); float* GATE = (float*)(ws + WS_GATE); int* SEL = (int*)(ws + WS_SEL);
    bf16_t* WGU = (bf16_t*)(ws + WS_WGU); bf16_t* WDN = (bf16_t*)(ws + WS_WDN); bf16_t* SCIN = (bf16_t*)(ws + WS_SCIN); bf16_t* SCOUT = (bf16_t*)(ws + WS_SCOUT);
    bf16_t* GBp = (bf16_t*)(ws + WS_GB); bf16_t* UUp = (bf16_t*)(ws + WS_UU);
    bf16_t* WIN = (bf16_t*)(ws + WS_WIN); bf16_t* WOUT = (bf16_t*)(ws + WS_WOUT); float* GATES = (float*)(ws + WS_GATES);
    const ScanPtrs SP{ws + WS_QN, ws + WS_KT, ws + WS_NWK, (unsigned char*)args.out + 66 * MiB, (unsigned char*)args.out, (float*)(ws + WS_SCL)};
    bf16_t* OFp = (bf16_t*)(ws + WS_OF); bf16_t* OBp = (bf16_t*)(ws + WS_OB);
    bf16_t* QKV = (bf16_t*)(ws + WS_QKV); bf16_t* Zp = (bf16_t*)(ws + WS_Z); bf16_t* POOLp = (bf16_t*)(ws + WS_POOL); bf16_t* CKV = (bf16_t*)(ws + WS_CKV);
    bf16_t* ACT = (bf16_t*)(ws + WS_ACT); bf16_t* HID = (bf16_t*)(ws + WS_HID); bf16_t* Y = (bf16_t*)(ws + WS_Y);
    float* xl = args.out; (void)xl;
    bf16_t* XLB = (bf16_t*)(ws + WS_XLB);

    bf16_t* XC = (bf16_t*)(ws + WS_QKV); float* RSC = (float*)(ws + WS_QKV + 2 * MiB);
    if (IN(PH_PREP)) {
        LAS float* scr = (LAS float*)(F.lds + F.wave * 16384);
        const int gw_ = F.vcu * NWAVES + F.wave, NGW = F.G * NWAVES;
        if (F.vcu >= 192) {
            for (int r = (F.vcu - 192) * NWAVES + F.wave; r < BATCH * CTX; r += 64 * NWAVES) {
                const float* sp = args.in[2] + (size_t)r * D + F.lane * 16;
                const f32x4 v0 = *(const f32x4*)sp, v1 = *(const f32x4*)(sp + 4), v2 = *(const f32x4*)(sp + 8), v3 = *(const f32x4*)(sp + 12);
                float sq = (v0.x * v0.x + v0.y * v0.y) + (v0.z * v0.z + v0.w * v0.w) + (v1.x * v1.x + v1.y * v1.y) + (v1.z * v1.z + v1.w * v1.w)
                         + (v2.x * v2.x + v2.y * v2.y) + (v2.z * v2.z + v2.w * v2.w) + (v3.x * v3.x + v3.y * v3.y) + (v3.z * v3.z + v3.w * v3.w);
                sq = wsum(sq);
                u32x4* dp = (u32x4*)(XC + (size_t)r * D + F.lane * 16);
                dp[0] = (u32x4){cvt_pk_bf16(v0.x, v0.y), cvt_pk_bf16(v0.z, v0.w), cvt_pk_bf16(v1.x, v1.y), cvt_pk_bf16(v1.z, v1.w)};
                dp[1] = (u32x4){cvt_pk_bf16(v2.x, v2.y), cvt_pk_bf16(v2.z, v2.w), cvt_pk_bf16(v3.x, v3.y), cvt_pk_bf16(v3.z, v3.w)};
                if (F.lane == 0) RSC[r] = rsqrtf(sq * (1.f / D) + EPS); } }
        LAS float* cs = (LAS float*)(F.lds + 8 * 16384 + 10240);
        for (int i = F.tid; i < 5 * D; i += NTHREADS) { const int r = i >> 10, kk = i & 1023; cs[i] = silu1(r < 4 ? args.in[1][r * D + kk] : args.in[3][kk]); }
        __syncthreads();
        for (int it = F.vcu; it < 192; it += F.G) { const int l = it / 96, n = (it % 96) * 64 + F.lane;
            const float* w = args.in[4] + (size_t)l * D * 6 * D + (size_t)(128 * F.wave) * 6 * D + n; float acc[5] = {0.f, 0.f, 0.f, 0.f, 0.f};
#pragma unroll 2
            for (int k0 = 0; k0 < 128; k0 += 32) { float wv[32];
#pragma unroll
                for (int k2 = 0; k2 < 32; ++k2) wv[k2] = __builtin_nontemporal_load(w + (size_t)(k0 + k2) * 6 * D);
#pragma unroll
                for (int k2 = 0; k2 < 32; ++k2) { const int kk = 128 * F.wave + k0 + k2;
#pragma unroll
                    for (int r = 0; r < 5; ++r) acc[r] += cs[r * D + kk] * wv[k2]; } }
            LAS float* red = (LAS float*)(F.lds + 8 * 16384);
#pragma unroll
            for (int r = 0; r < 5; ++r) red[(F.wave * 5 + r) * 64 + F.lane] = acc[r];
            __syncthreads();
            if (F.tid < 320) { const int r = F.tid >> 6, ln = F.tid & 63; float sacc = 0.f;
#pragma unroll
                for (int w2 = 0; w2 < 8; ++w2) sacc += red[(w2 * 5 + r) * 64 + ln];
                const int n2 = (it % 96) * 64 + ln;
                ADAw[((size_t)l * 5 + r) * 6 * D + n2] = sacc + args.in[5][l * 6 * D + n2]; }
            __syncthreads(); }
        (void)scr; (void)gw_; (void)NGW;
    }
    SEAM(PH_PREP);
    if (IN(PH_E1)) { ph_norm16<1>(F, args.in[0], (const float*)XC, ACT, args.in[6], ADA, args.in[9] + 2048, EVEN_IN, GATES, args.in[11], args.in[12], nullptr, RSC);
        const int it = F.wave == 0 ? -1 : F.vcu * (NWAVES - 1) + F.wave - 1;
        if (it >= 0 && it < 1280) { const int kb = it / 80, nb = it % 80, n0 = 32 * nb;
            transpose_item(args.in[9], D, EVEN_IN, n0 < 2048 ? n0 : n0 + 16, 64 * kb, WIN, n0, (LAS float*)(F.lds + 81920 + F.wave * 8704), F.lane); } }
    SEAM(PH_E1);
    if (IN(PH_E2)) { SchedProj S{F.vcu, F.G}; EpiProj E{QKV, Zp, POOLp, CKV}; gemm_phase<EpiProj, SchedProj, false>(F.lds, ACT, WIN, D, S, E);
        ctx_proj_tile(F.lds, F.vcu, F.tid, F.wave, ACT + (size_t)M_LAT * D, WIN + (size_t)512 * D, CKV); }
    SEAM(PH_E2);
#if PROBE_SEL >= 0
    unsigned long long* tsq = (unsigned long long*)((unsigned*)(ws + WS_CTL) + CW_TS);
    const unsigned long long te0_ = __builtin_amdgcn_s_memrealtime();
#endif
    if (IN(PH_E4)) {
        unsigned* prog = (unsigned*)(ws + WS_CTL) + CW_PROG;
        const int xj = F.vcu & 31, xg = F.vcu >> 5;
        unsigned* flags = (unsigned*)(ws + WS_CTL) + CW_FLAG;
        constexpr int SCAN_ITEMS = 3;
        static_assert((NCHAIN * NSLOT - 64 * SCAN_ITEMS) % 192 == 0, "producer items");
        ph_chunk_prep(F, QKV, CKV, GATES, args.in[10], SP, xj < 8 ? xg * 8 + xj : 64 * SCAN_ITEMS + xg * 24 + (xj - 8), xj < 8 ? 64 : 192, xj < 8 ? SCAN_ITEMS : (NCHAIN * NSLOT - 64 * SCAN_ITEMS) / 192, flags);
        if (xj < 8) ph_scan(F, SP, OFp, OBp, prog, flags);
        else {
#if PROBE_SEL >= 0
            if (F.tid == 0 && blockIdx.x == 64) tsq[9] = __builtin_amdgcn_s_memrealtime() - te0_;
            if (F.tid == 0 && blockIdx.x == 255) tsq[13] = __builtin_amdgcn_s_memrealtime() - te0_;
#endif
            prep_late(F, args, (xg * 24 + (xj - 8)) * NWAVES + F.wave, 192 * NWAVES, WOUT, SCIN, SCOUT, WGU, WDN); }
    }
#if PROBE_SEL >= 0
    const unsigned long long te1_ = __builtin_amdgcn_s_memrealtime();
    if (F.tid == 0 && blockIdx.x == 0) tsq[8] = te1_ - te0_;
    if (F.tid == 0 && blockIdx.x == 64) tsq[10] = te1_ - te0_;
#endif
    SEAM(PH_E4);
#if PROBE_SEL >= 0
    if (F.tid == 0 && blockIdx.x == 0) tsq[11] = __builtin_amdgcn_s_memrealtime() - te0_;
#endif
    bf16_t* ACT2 = (bf16_t*)(ws + WS_ACT2);
    if (IN(PH_E5)) ph_even_A(F, OFp, OBp, Zp, POOLp, args.in[13], ACT2);
    SEAM(PH_E5);
    if (IN(PH_E6)) { SchedDense<4, 256> S{F.vcu, F.G, 128 * 4}; EpiResid<false> E{args.in[0], XLB, ADA + 2 * D}; gemm_phase<EpiResid<false>, SchedDense<4, 256>, false>(F.lds, ACT2, WOUT, D, S, E); }
    SEAM(PH_E6);
#define MOE_SEGMENT(l, p0) do { \
        const float* ada_l = ADA + (size_t)(l) * 5 * 6 * D; \
        if (IN(p0)) ph_norm16<0>(F, XLB, nullptr, ACT, args.in[7] + (l) * D, ada_l, args.in[20] + (size_t)(l) * D * NE, NE, AFF, nullptr, nullptr, SEL); \
        SEAM(p0); \
        if (IN((p0) + 1)) ph_topk(F, AFF, IDX, GATE, SEL); \
        SEAM((p0) + 1); \
        if (IN((p0) + 2)) { SchedMoeUp S{F.vcu, (l), IDX}; EpiSiluMul E{HID, DE}; gemm_phase<EpiSiluMul, SchedMoeUp, true>(F.lds, ACT, WGU, D, S, E); } \
        SEAM((p0) + 2); \
        if (IN((p0) + 3)) { SchedMoeDown S{F.vcu, (l)}; EpiRowScale E{Y, D, GATE}; gemm_phase<EpiRowScale, SchedMoeDown, false>(F.lds, HID, WDN, DE, S, E); } \
        SEAM((p0) + 3); \
        if (IN((p0) + 4)) { \
            if ((l) == 0) ph_combine<false>(F, XLB, nullptr, Y, SEL, GATE, ada_l, args.in[6] + D, ADA + (size_t)5 * 6 * D, ACT); \
            else ph_combine<true>(F, XLB, args.out, Y, SEL, GATE, ada_l, args.in[8], nullptr, nullptr); \
        } \
    } while (0)
    MOE_SEGMENT(0, PH_M1_0);
    SEAM(PH_M5_0);
    if (IN(PH_X1)) { SchedX1 S{F.vcu, F.G}; EpiScIn E{GBp, UUp}; gemm_phase<EpiScIn, SchedX1, false>(F.lds, ACT, SCIN, D, S, E); }
    SEAM(PH_X1);
    if (IN(PH_X2)) ph_sc_glue(F, GBp, UUp, args.in[18], ACT);
    SEAM(PH_X2);
    if (IN(PH_X3)) { SchedDense<4, 256> S{F.vcu, F.G, 128 * 4}; EpiResid<true> E{XLB, XLB, ADA + (size_t)5 * 6 * D + 2 * D}; gemm_phase<EpiResid<true>, SchedDense<4, 256>, false>(F.lds, ACT, SCOUT, D, S, E); }
    SEAM(PH_X3);
    MOE_SEGMENT(1, PH_M1_1);
#undef MOE_SEGMENT
#if PROBE_SEL >= 0
    if (blockIdx.x == 0 && F.tid == 0) { asm volatile("s_waitcnt vmcnt(0)" ::: "memory");
        const unsigned long long v = __hip_atomic_load((unsigned long long*)((unsigned*)(ws + WS_CTL) + CW_TS) + PROBE_SEL, __ATOMIC_RELAXED, __HIP_MEMORY_SCOPE_AGENT);
        const unsigned long long t0 = __builtin_amdgcn_s_memrealtime();
        while (__builtin_amdgcn_s_memrealtime() - t0 < 4ull * v) __builtin_amdgcn_s_sleep(8); }
#endif
#undef IN
#undef SEAM
}
}

}

extern "C" void kernel_launch(void* const* d_in, const int* in_sizes, int n_in, void* d_out, int out_size, void* d_ws, size_t ws_size, hipStream_t st) {
    static int grid = 0;
    if (grid == 0) {
        int dev = 0, cus = 0;
        if (hipGetDevice(&dev) != hipSuccess || hipDeviceGetAttribute(&cus, hipDeviceAttributeMultiprocessorCount, dev) != hipSuccess) { grid = -1; return; }
        if (hipFuncSetAttribute((const void*)mk::mega, hipFuncAttributeMaxDynamicSharedMemorySize, mk::LDS_BYTES) != hipSuccess) { fprintf(stderr, "hipFuncSetAttribute failed\n"); grid = -1; return; }
        if (ws_size < mk::WS_END) { fprintf(stderr, "workspace too small: %zu < %zu\n", ws_size, (size_t)mk::WS_END); grid = -1; return; }
        grid = cus >= 256 ? 256 : cus;
    }
    if (grid < 0) return;
    (void)hipMemsetAsync((char*)d_ws + mk::WS_CTL, 0, mk::MiB, st);
    mk::Args a{};
    for (int i = 0; i < 24; ++i) a.in[i] = (const float*)d_in[i];
    a.out = (float*)d_out; a.ws = (unsigned char*)d_ws;
    int n_mega = 0;
    auto mega = [&](int lo, int hi) { a.ph_lo = lo; a.ph_hi = hi; a.li = n_mega++; hipLaunchKernelGGL(mk::mega, dim3(grid), dim3(mk::NTHREADS), mk::LDS_BYTES, st, a); };
    mega(0, mk::PH_COUNT);
}
```
